# Optimizing an MI355X kernel written in HIP

```python
import math
import jax
import jax.numpy as jnp
from jax import lax
import numpy as np

D_MODEL = 1024
BATCH = 8
SEQ = 4096
DEPTH = 1

CTX_LEN = 256
GRID_W = 64

MIX_W = 2 * D_MODEL
SSD_HEADDIM = 64
SSD_W = 3 * MIX_W // 4
SSD_HEADS = SSD_W // SSD_HEADDIM
SSD_GROUPS = 4
SSD_HPG = SSD_HEADS // SSD_GROUPS
SSD_STATE = 128
SSD_CONV = 5
SSD_CHUNK = 128
CONV_CH = SSD_W + 2 * SSD_GROUPS * SSD_STATE
XBCDT_COLS = CONV_CH + 2 * SSD_HEADS
POOL_W = MIX_W - SSD_W
POOL_WINDOWS = (2, 4, 8, 16)
POOL_GROUPS = len(POOL_WINDOWS)
POOL_GW = POOL_W // POOL_GROUPS
IN_COLS = XBCDT_COLS + SSD_W + POOL_W
N_EXPERTS = 32
TOP_K = 4
D_FF = D_MODEL
SWIGLU_ALPHA = 1.702
SWIGLU_LIMIT = 7.0
MOE_BLOCK = 128
RMS_EPS = 1e-6

kernel_name = "hybrid_ssd_pool_moe_prefix_dit"


def rmsnorm(h, w):
    hf = h.astype(jnp.float32)
    hf = hf * lax.rsqrt(jnp.mean(hf * hf, axis=-1, keepdims=True) + RMS_EPS)
    return (hf * w.astype(jnp.float32)).astype(h.dtype)


def modulate(h, shift, scale):
    return h * (1 + scale) + shift


def dwconv_centred(u, w, b):
    ch = u.shape[-1]
    y = lax.conv_general_dilated(
        u, w[:, None, :].astype(u.dtype), window_strides=(1,),
        padding=[(SSD_CONV // 2, SSD_CONV // 2)],
        dimension_numbers=("NWC", "WIO", "NWC"), feature_group_count=ch)
    return y + b.astype(u.dtype)


def segsum(a):
    t = a.shape[-1]
    cs = jnp.cumsum(a, axis=-1)
    diff = cs[..., :, None] - cs[..., None, :]
    return jnp.where(np.tril(np.ones((t, t), dtype=bool)), diff, -jnp.inf)


def ssd_direction_inputs(xbc, dt_raw, dt_bias, a_log, d):
    dtr = dt_raw[..., d, :]
    if d == 1:
        xbc = xbc[:, ::-1]
        dtr = dtr[:, ::-1]
    b, L, _ = xbc.shape
    gn = SSD_GROUPS * SSD_STATE
    xh = xbc[..., :SSD_W].reshape(b, L, SSD_GROUPS, SSD_HPG, SSD_HEADDIM).astype(jnp.float32)
    bm = xbc[..., SSD_W:SSD_W + gn].reshape(b, L, SSD_GROUPS, SSD_STATE).astype(jnp.float32)
    cm = xbc[..., SSD_W + gn:].reshape(b, L, SSD_GROUPS, SSD_STATE).astype(jnp.float32)
    dt = jax.nn.softplus(dtr.astype(jnp.float32) + dt_bias[d].astype(jnp.float32))
    dt = dt.reshape(b, L, SSD_GROUPS, SSD_HPG)
    log_a = -jnp.exp(a_log[d].astype(jnp.float32)).reshape(SSD_GROUPS, SSD_HPG) * dt
    return xh * dt[..., None], log_a, bm, cm


def ssd_chunked(xs, log_a, bm, cm, init_state):
    b, L, G, E, P = xs.shape
    n = bm.shape[-1]
    nc = L // SSD_CHUNK
    xs = xs.reshape(b, nc, SSD_CHUNK, G, E, P)
    bm = bm.reshape(b, nc, SSD_CHUNK, G, n)
    cm = cm.reshape(b, nc, SSD_CHUNK, G, n)
    a = jnp.moveaxis(log_a.reshape(b, nc, SSD_CHUNK, G, E), 2, -1)
    a_cs = jnp.cumsum(a, axis=-1)
    lmat = jnp.exp(segsum(a))
    cb = jnp.einsum("bclgn,bcsgn->bcgls", cm, bm)
    y_diag = jnp.einsum("bcgls,bcgels,bcsgep->bclgep", cb, lmat, xs)
    decay_states = jnp.exp(a_cs[..., -1:] - a_cs)
    states = jnp.einsum("bclgn,bcgel,bclgep->bcgepn", bm, decay_states, xs)
    states = jnp.concatenate([init_state[:, None], states], axis=1)
    chunk_end = jnp.pad(a_cs[..., -1], ((0, 0), (1, 0), (0, 0), (0, 0)))
    decay_chunk = jnp.exp(segsum(jnp.moveaxis(chunk_end, 1, -1)))
    new_states = jnp.einsum("bgezy,bygepn->bzgepn", decay_chunk, states)
    prev_states, final_state = new_states[:, :-1], new_states[:, -1]
    y_off = jnp.einsum("bclgn,bcgepn,bcgel->bclgep", cm, prev_states, jnp.exp(a_cs))
    return (y_diag + y_off).reshape(b, L, G, E, P), final_state


def ssd_final_state(xbc, dt_raw, dt_bias, a_log, d):
    xs, log_a, bm, _ = ssd_direction_inputs(xbc, dt_raw, dt_bias, a_log, d)
    a_cs = jnp.cumsum(log_a, axis=1)
    w = jnp.exp(a_cs[:, -1:] - a_cs)
    return jnp.einsum("blgn,blge,blgep->bgepn", bm, w, xs)


def ssd_bidir(xbc, dt_raw, dt_bias, a_log, d_skip, init_states):
    b, L, _ = xbc.shape
    xs_f, la_f, bm_f, cm_f = ssd_direction_inputs(xbc, dt_raw, dt_bias, a_log, 0)
    y_f, fin_f = ssd_chunked(xs_f, la_f, bm_f, cm_f, init_states[0])
    xs_b, la_b, bm_b, cm_b = ssd_direction_inputs(xbc, dt_raw, dt_bias, a_log, 1)
    y_b, fin_b = ssd_chunked(xs_b, la_b, bm_b, cm_b, init_states[1])
    x_heads = xbc[..., :SSD_W].reshape(b, L, SSD_HEADS, SSD_HEADDIM).astype(jnp.float32)
    y = (y_f + y_b[:, ::-1]).reshape(b, L, SSD_W) \
        + (x_heads * d_skip.astype(jnp.float32)[:, None]).reshape(b, L, SSD_W)
    return y.astype(xbc.dtype), fin_f, fin_b


def centred_mean_minus_self(u, window):
    wl = u.shape[1]
    cs = jnp.pad(jnp.cumsum(u.astype(jnp.float32), axis=1), ((0, 0), (1, 0), (0, 0)))
    t = np.arange(wl)
    lo = np.clip(t - window // 2, 0, wl)
    hi = np.clip(t + window - window // 2, 0, wl)
    cnt = (hi - lo).astype(np.float32)
    mean = (cs[:, hi] - cs[:, lo]) / cnt[None, :, None]
    return mean.astype(u.dtype) - u


def pool_mixer(u, pool_w, pool_scale):
    n, wl, _ = u.shape
    ug = u.reshape(n, wl, POOL_GROUPS, POOL_GW)
    pooled = jnp.stack([centred_mean_minus_self(ug[:, :, g], w)
                        for g, w in enumerate(POOL_WINDOWS)], axis=2)
    y = jnp.einsum("nwgi,gio->nwgo", pooled, pool_w)
    return y.reshape(n, wl, POOL_W) * pool_scale


def mixer_out(y_ssd, z, y_pool, ssd_norm_w, w_out):
    y_ssd = rmsnorm(y_ssd * jax.nn.silu(z), ssd_norm_w)
    return jnp.concatenate([y_ssd, y_pool], axis=-1) @ w_out


def moe_ffn(h, router_w, router_b, w1, b1, w2, b2):
    shp = h.shape
    xt = h.reshape(-1, shp[-1])
    t = xt.shape[0]
    logits = (xt @ router_w + router_b).astype(jnp.float32)
    top_val, top_idx = lax.top_k(logits, TOP_K)
    gates = jax.nn.softmax(top_val, axis=-1)
    e_flat = top_idx.reshape(-1).astype(jnp.int32)
    tok_flat = jnp.repeat(jnp.arange(t, dtype=jnp.int32), TOP_K)
    g_flat = gates.reshape(-1)
    n_assign = t * TOP_K
    order = jnp.argsort(e_flat)
    e_sorted = e_flat[order]
    counts = jnp.bincount(e_flat, length=N_EXPERTS).astype(jnp.int32)
    padded = (counts + MOE_BLOCK - 1) // MOE_BLOCK * MOE_BLOCK
    pad_end = jnp.cumsum(padded)
    pad_start = pad_end - padded
    grp_start = jnp.cumsum(counts) - counts
    rank = jnp.arange(n_assign, dtype=jnp.int32) - grp_start[e_sorted]
    dest = pad_start[e_sorted] + rank
    n_blocks = -(-n_assign // MOE_BLOCK) + N_EXPERTS
    n_slots = n_blocks * MOE_BLOCK
    slot_tok = jnp.full((n_slots,), t, jnp.int32).at[dest].set(tok_flat[order])
    slot_gate = jnp.zeros((n_slots,), jnp.float32).at[dest].set(g_flat[order])
    block_start = jnp.arange(n_blocks, dtype=jnp.int32) * MOE_BLOCK
    block_exp = jnp.minimum(jnp.searchsorted(pad_end, block_start, side="right"),
                            N_EXPERTS - 1).astype(jnp.int32)
    x_pad = jnp.concatenate([xt, jnp.zeros((1, shp[-1]), xt.dtype)], axis=0)

    def run_block(args):
        toks, e = args
        hb = x_pad[toks] @ w1[e] + b1[e]
        g_part = jnp.minimum(hb[..., ::2], SWIGLU_LIMIT)
        u_part = jnp.clip(hb[..., 1::2], -SWIGLU_LIMIT, SWIGLU_LIMIT)
        act = g_part * jax.nn.sigmoid(SWIGLU_ALPHA * g_part) * (u_part + 1)
        return act @ w2[e] + b2[e]

    y_slots = lax.map(run_block, (slot_tok.reshape(n_blocks, MOE_BLOCK), block_exp))
    y_slots = y_slots.reshape(n_slots, shp[-1]) * slot_gate[:, None].astype(xt.dtype)
    out = jnp.zeros((t + 1, shp[-1]), xt.dtype).at[slot_tok].add(y_slots)[:t]
    return out.reshape(shp)


def setup_inputs(seed: int = 0) -> dict:
    key = jax.random.key(seed)
    ks = jax.random.split(key, 25)
    f32 = jnp.float32

    def nrm(k, shape, s):
        return jax.random.normal(k, shape, f32) * s

    dt0 = jnp.exp(jax.random.uniform(ks[10], (DEPTH, 2, SSD_HEADS), f32,
                                     math.log(1e-3), math.log(1e-1)))
    return {
        "x": nrm(ks[0], (BATCH, SEQ, D_MODEL), 1.0),
        "c": nrm(ks[1], (BATCH, D_MODEL), 1.0),
        "ctx": nrm(ks[2], (BATCH, CTX_LEN, D_MODEL), 1.0),
        "c_ctx": nrm(ks[3], (D_MODEL,), 1.0),
        "w_mod": nrm(ks[4], (DEPTH, D_MODEL, 6 * D_MODEL), 0.5 * D_MODEL ** -0.5),
        "b_mod": nrm(ks[5], (DEPTH, 6 * D_MODEL), 0.01),
        "norm1_w": 1.0 + nrm(ks[6], (DEPTH, D_MODEL), 0.02),
        "norm2_w": 1.0 + nrm(ks[7], (DEPTH, D_MODEL), 0.02),
        "w_in": nrm(ks[8], (DEPTH, D_MODEL, IN_COLS), D_MODEL ** -0.5),
        "conv_w": nrm(ks[9], (DEPTH, SSD_CONV, CONV_CH), SSD_CONV ** -0.5),
        "conv_b": nrm(ks[11], (DEPTH, CONV_CH), 0.01),
        "dt_bias": dt0 + jnp.log(-jnp.expm1(-dt0)),
        "a_log": jnp.log(jax.random.uniform(ks[12], (DEPTH, 2, SSD_HEADS), f32, 1.0, 16.0)),
        "d_skip": 1.0 + nrm(ks[13], (DEPTH, SSD_HEADS), 0.1),
        "ssd_norm_w": 1.0 + nrm(ks[14], (DEPTH, SSD_W), 0.02),
        "pool_w": nrm(ks[15], (DEPTH, POOL_GROUPS, POOL_GW, POOL_GW), POOL_GW ** -0.5),
        "pool_scale": 1.0 + nrm(ks[16], (DEPTH, POOL_W), 0.1),
        "w_out": nrm(ks[17], (DEPTH, MIX_W, D_MODEL), MIX_W ** -0.5),
        "router_w": nrm(ks[18], (DEPTH, D_MODEL, N_EXPERTS), D_MODEL ** -0.5),
        "router_b": nrm(ks[19], (DEPTH, N_EXPERTS), 0.01),
        "w1": nrm(ks[20], (DEPTH, N_EXPERTS, D_MODEL, 2 * D_FF), D_MODEL ** -0.5),
        "b1": nrm(ks[21], (DEPTH, N_EXPERTS, 2 * D_FF), 0.01),
        "w2": nrm(ks[22], (DEPTH, N_EXPERTS, D_FF, D_MODEL), D_FF ** -0.5),
        "b2": nrm(ks[23], (DEPTH, N_EXPERTS, D_MODEL), 0.01),
        "final_norm_w": 1.0 + nrm(ks[24], (D_MODEL,), 0.02),
    }


def reference(x, c, ctx, c_ctx, w_mod, b_mod, norm1_w, norm2_w, w_in, conv_w, conv_b,
              dt_bias, a_log, d_skip, ssd_norm_w, pool_w, pool_scale, w_out,
              router_w, router_b, w1, b1, w2, b2, final_norm_w):
    b, L, _ = x.shape
    rows = L // GRID_W
    zero_state = jnp.zeros((b, SSD_GROUPS, SSD_HPG, SSD_HEADDIM, SSD_STATE), jnp.float32)
    for l in range(DEPTH):
        last = l == DEPTH - 1
        mod = (jax.nn.silu(c) @ w_mod[l] + b_mod[l])[:, None, :]
        mod_c = jax.nn.silu(c_ctx) @ w_mod[l] + b_mod[l]
        sh1, sc1, g1, sh2, sc2, g2 = jnp.split(mod, 6, axis=-1)
        csh1, csc1, cg1, csh2, csc2, cg2 = jnp.split(mod_c, 6, axis=-1)

        hc = modulate(rmsnorm(ctx, norm1_w[l]), csh1, csc1)
        pc = hc @ w_in[l][:, :(XBCDT_COLS if last else IN_COLS)]
        xbc_c = jax.nn.silu(dwconv_centred(pc[..., :CONV_CH], conv_w[l], conv_b[l]))
        dt_c = pc[..., CONV_CH:XBCDT_COLS].reshape(b, -1, 2, SSD_HEADS)
        if last:
            init_states = (ssd_final_state(xbc_c, dt_c, dt_bias[l], a_log[l], 0),
                           ssd_final_state(xbc_c, dt_c, dt_bias[l], a_log[l], 1))
            ctx_next = ctx
        else:
            y_c, fin_cf, fin_cb = ssd_bidir(xbc_c, dt_c, dt_bias[l], a_log[l], d_skip[l],
                                            (zero_state, zero_state))
            init_states = (fin_cf, fin_cb)
            yp_c = pool_mixer(pc[..., XBCDT_COLS + SSD_W:], pool_w[l], pool_scale[l])
            ctx_next = ctx + cg1 * mixer_out(y_c, pc[..., XBCDT_COLS:XBCDT_COLS + SSD_W],
                                             yp_c, ssd_norm_w[l], w_out[l])
            ctx_next = ctx_next + cg2 * moe_ffn(
                modulate(rmsnorm(ctx_next, norm2_w[l]), csh2, csc2),
                router_w[l], router_b[l], w1[l], b1[l], w2[l], b2[l])

        hx = modulate(rmsnorm(x, norm1_w[l]), sh1, sc1)
        p = hx @ w_in[l]
        xbc = jax.nn.silu(dwconv_centred(p[..., :CONV_CH], conv_w[l], conv_b[l]))
        dt_x = p[..., CONV_CH:XBCDT_COLS].reshape(b, L, 2, SSD_HEADS)
        y_x, _, _ = ssd_bidir(xbc, dt_x, dt_bias[l], a_log[l], d_skip[l], init_states)
        u_pool = p[..., XBCDT_COLS + SSD_W:].reshape(b * rows, GRID_W, POOL_W)
        y_pool = pool_mixer(u_pool, pool_w[l], pool_scale[l]).reshape(b, L, POOL_W)
        x = x + g1 * mixer_out(y_x, p[..., XBCDT_COLS:XBCDT_COLS + SSD_W], y_pool,
                               ssd_norm_w[l], w_out[l])
        x = x + g2 * moe_ffn(modulate(rmsnorm(x, norm2_w[l]), sh2, sc2),
                             router_w[l], router_b[l], w1[l], b1[l], w2[l], b2[l])
        ctx = ctx_next
    return rmsnorm(x, final_norm_w)
```

```cpp
#include <hip/hip_runtime.h>
#include <cstdio>
#include <cstdint>

#ifndef MK_SPLIT
#define MK_SPLIT 0
#endif

#define GAS __attribute__((address_space(1)))
#define LAS __attribute__((address_space(3)))
typedef unsigned short bf16;
typedef unsigned v4u __attribute__((ext_vector_type(4)));
typedef unsigned v2u __attribute__((ext_vector_type(2)));
typedef float f32x4 __attribute__((ext_vector_type(4)));
typedef float f32x2 __attribute__((ext_vector_type(2)));
typedef short bf16x8 __attribute__((ext_vector_type(8)));
typedef short s16x4 __attribute__((ext_vector_type(4)));
#define RLX_AGENT __ATOMIC_RELAXED, __HIP_MEMORY_SCOPE_AGENT
#define LDS_WAIT() asm volatile("s_waitcnt lgkmcnt(0)" ::: "memory")
#define VM_WAIT() asm volatile("s_waitcnt vmcnt(0)" ::: "memory")

__device__ __forceinline__ unsigned f2bf(float f) { unsigned u = __builtin_bit_cast(unsigned, f); return (u + 0x7fffu + ((u >> 16) & 1u)) >> 16; }
__device__ __forceinline__ unsigned pk2(float lo, float hi) { return f2bf(lo) | (f2bf(hi) << 16); }
__device__ __forceinline__ float bflo(unsigned w) { return __builtin_bit_cast(float, w << 16); }
__device__ __forceinline__ float bfhi(unsigned w) { return __builtin_bit_cast(float, w & 0xffff0000u); }
__device__ __forceinline__ float silu_f(float v) { return v / (1.f + __expf(-v)); }
__device__ __forceinline__ float wave_sum(float v) {
#pragma unroll
    for (int o = 1; o < 64; o <<= 1) v += __shfl_xor(v, o);
    return v;
}

constexpr int D = 1024, NB = 8, SEQ = 4096, CTXL = 256, T = NB * SEQ, TC = NB * CTXL, RTOT = T + TC;
constexpr int CONV_CH = 2560, SSD_W = 1536, NH = 24, HDIM = 64, NGRP = 4, HPG = 6, NST = 128, CHUNK = 128;
constexpr int NCC = (CTXL + SEQ) / CHUNK;
constexpr int IN_COLS = 4656, N1 = 4864;
constexpr int NE = 32, TOPK = 4, DFF = 1024;
constexpr int MAX_TILES = (T * TOPK) / 256 + NE;
constexpr int MAX_SLOTS = MAX_TILES * 256;
constexpr float RMS_EPS = 1e-6f;

constexpr size_t MiB = 1u << 20;
constexpr size_t WS_CTL = 0, CTL_ZERO_BYTES = 1 * MiB;
constexpr size_t WS_MOD = 1 * MiB;
constexpr size_t WS_TOPE = 2 * MiB, WS_TOPG = WS_TOPE + 512 * 1024, WS_TOPR = WS_TOPG + 512 * 1024, WS_TOKSLOT = WS_TOPR + 512 * 1024;
constexpr size_t WS_SLOTTOK = 4 * MiB, WS_SLOTGATE = WS_SLOTTOK + 576 * 1024, WS_BB = WS_SLOTGATE + 576 * 1024, WS_CHS = WS_BB + 64 * 1024;
constexpr size_t WS_DTRAW = 6 * MiB;
constexpr size_t WS_DT = 15 * MiB;
constexpr size_t WS_ROWSC = 22 * MiB;
constexpr size_t WS_WINT = 32 * MiB, WS_WOUTT = 42 * MiB, WS_W1T = 46 * MiB, WS_W2T = 174 * MiB;
constexpr size_t WS_A = 240 * MiB;
constexpr size_t WS_A1 = WS_A, WS_XBCPRE = WS_A + 68 * MiB, WS_Z = WS_A + 238 * MiB, WS_V = WS_A + 334 * MiB, WS_XBC = WS_A + 366 * MiB;
constexpr size_t WS_ST = WS_A, WS_Y = WS_A + 536 * MiB, WS_YB = WS_A + 632 * MiB;
constexpr size_t WS_A2 = WS_XBC, WS_X1 = WS_A, WS_H2 = WS_A + 128 * MiB, WS_ACT = WS_A + 204 * MiB, WS_YS = WS_A + 476 * MiB;
constexpr size_t WS_END = WS_A + 748 * MiB;
static_assert(WS_END <= 1024 * MiB, "workspace map");
static_assert((size_t)RTOT * D * 2 <= 68 * MiB && (size_t)RTOT * CONV_CH * 2 <= 170 * MiB && (size_t)MAX_SLOTS * D * 2 <= 272 * MiB, "workspace map sizes");
static_assert((size_t)NB * NCC * NH * 2 * 8192 * 2 <= 204 * MiB, "ST size");
constexpr int CW_TMO = 0, CW_GCOUNT = 64  , CW_BAR = 4096;

constexpr int LDS_BYTES = 163840;
constexpr int MISC_OFF = LDS_BYTES - 256;
constexpr int TE_OFF = 131072;
constexpr int MOE_CNT_OFF = TE_OFF + 4096;

namespace pg8 {
constexpr int BM = 256, BK = 64, HALF = 128, HTB = HALF * BK * 2, STAGE_BYTES = 8 * HTB, NXCD = 8, WGM = 8;
__host__ __device__ __forceinline__ int lds_byte(int r, int c) { const int st = (r >> 4) * 2 + (c >> 5), rr = r & 15, cc = c & 31, ob = rr * 64 + cc * 2; return st * 1024 + (ob ^ (((ob >> 9) & 1) << 5)); }
__host__ __device__ __forceinline__ void stage_rc(int b, int& R, int& C) { const int st = b / 1024, sb = b % 1024, swz = sb ^ (((sb >> 9) & 1) << 5); R = (st >> 1) * 16 + swz / 64; C = (st & 1) * 32 + (swz % 64) / 2; }
__host__ __device__ __forceinline__ int perm32(int rho) { const int n = rho >> 4, i = rho & 15; return 8 * (i >> 2) + 4 * n + (i & 3); }
struct Unit { int pm, pn, e; };
__device__ __forceinline__ unsigned cvt_pk_bf16(float lo, float hi) { unsigned r; asm volatile("v_cvt_pk_bf16_f32 %0, %1, %2" : "=v"(r) : "v"(lo), "v"(hi)); return r; }

__device__ __forceinline__ void static_map(int wgid, int nM, int nN, int& pm, int& pn) {
    const int nwg = nM * nN;
    { const int q = nwg / NXCD, r = nwg % NXCD, xcd = wgid % NXCD, off = wgid / NXCD; wgid = (xcd < r ? xcd * (q + 1) : r * (q + 1) + (xcd - r) * q) + off; }
    const int nig = WGM * nN, gid = wgid / nig, fm = gid * WGM, gsz = (nM - fm) < WGM ? (nM - fm) : WGM;
    pm = fm + ((wgid % nig) % gsz); pn = (wgid % nig) / gsz;
}

template <class Epi, class Sched, bool GATHER, bool ALIGN_EPI = true>
__device__ __forceinline__ void gemm_phase(LAS unsigned char* lds, const int K, const Sched& S, const Epi& E) {
    const int tid = threadIdx.x, wid = __builtin_amdgcn_readfirstlane(tid >> 6), lane = tid & 63, wr = wid >> 2, wc = wid & 3, fr = lane & 15, fq = lane >> 4;
    const int nt = K / BK;
    unsigned voffB[2]; int RA[2], CA[2];
#pragma unroll
    for (int i = 0; i < 2; ++i) { int R, C; stage_rc(tid * 16 + i * 8192, R, C); const int Rb = Epi::PERM ? ((R & ~31) + perm32(R & 31)) : R;
        RA[i] = R; CA[i] = C; voffB[i] = (unsigned)(Rb * K + C) * 2u; }
    const size_t kstep = (size_t)(BK * 2);
    const size_t hstep = (size_t)HALF * K * 2;
    const unsigned ldsw = (unsigned)wid * 1024u;
    const int aoff = lds_byte(wr * 64 + fr, fq * 8), boff = lds_byte(wc * 32 + fr, fq * 8);
#define PG8_SA(b, h) (((b) * 2 + (h)) * HTB)
#define PG8_SB(b, h) ((4 + (b) * 2 + (h)) * HTB)
#define PG8_STAGE(bufoff, gbase, voff) do { _Pragma("unroll") for (int _i = 0; _i < 2; ++_i) \
        __builtin_amdgcn_global_load_lds((const unsigned*)((const char*)(gbase) + (voff)[_i]), (LAS unsigned*)(lds + (bufoff) + ldsw + _i * 8192), 16, 0, 0); } while (0)
#define PG8_LDA(dst, b, h) do { _Pragma("unroll") for (int m = 0; m < 4; ++m) _Pragma("unroll") for (int k = 0; k < 2; ++k) dst[m][k] = *(const LAS bf16x8*)(lds + PG8_SA(b, h) + aoff + m * 2048 + k * 1024); } while (0)
#define PG8_LDB(dst, b, h) do { _Pragma("unroll") for (int n = 0; n < 2; ++n) _Pragma("unroll") for (int k = 0; k < 2; ++k) dst[n][k] = *(const LAS bf16x8*)(lds + PG8_SB(b, h) + boff + n * 2048 + k * 1024); } while (0)
#define PG8_MMA(ai, bj, At, Bt) do { __builtin_amdgcn_s_setprio(1); _Pragma("unroll") for (int m = 0; m < 4; ++m) _Pragma("unroll") for (int n = 0; n < 2; ++n) _Pragma("unroll") for (int k = 0; k < 2; ++k) \
        acc[ai][bj][m][n] = __builtin_amdgcn_mfma_f32_16x16x32_bf16(Bt[n][k], At[m][k], acc[ai][bj][m][n], 0, 0, 0); __builtin_amdgcn_s_setprio(0); } while (0)
#define PG8_WAIT_V(n) asm volatile("s_waitcnt vmcnt(" #n ")" ::: "memory")
#define PG8_WAIT_L(n) asm volatile("s_waitcnt lgkmcnt(" #n ")" ::: "memory")
#define PG8_BAR __builtin_amdgcn_s_barrier()
#define PG8_SCHED __builtin_amdgcn_sched_barrier(0)
#define PG8_AOFFS(U, dst) do { _Pragma("unroll") for (int _h = 0; _h < 2; ++_h) _Pragma("unroll") for (int _i = 0; _i < 2; ++_i) { \
        if constexpr (GATHER) dst[_h][_i] = S.a_row(U, _h * HALF + RA[_i]) * (unsigned)(K * 2) + (unsigned)(CA[_i] * 2); \
        else dst[_h][_i] = (unsigned)((_h * HALF + RA[_i]) * K + CA[_i]) * 2u; } } while (0)
    Unit cur, nxt; int ui = 0;
    if (!S.next(0, cur)) return;
    f32x4 acc[2][2][4][2];
#pragma unroll
    for (int a = 0; a < 2; ++a)
#pragma unroll
        for (int b = 0; b < 2; ++b)
#pragma unroll
            for (int m = 0; m < 4; ++m)
#pragma unroll
                for (int n = 0; n < 2; ++n) acc[a][b][m][n] = (f32x4){0.f, 0.f, 0.f, 0.f};
    bf16x8 At[4][2], B0[2][2], B1[2][2];
    unsigned oc[2][2], on[2][2];
    const char* cA = S.a_base(cur); const char* cB = S.b_base(cur);
    PG8_AOFFS(cur, oc);
    PG8_STAGE(PG8_SB(0, 0), cB, voffB); PG8_STAGE(PG8_SB(0, 1), cB + hstep, voffB); PG8_STAGE(PG8_SA(0, 0), cA, oc[0]); PG8_STAGE(PG8_SA(0, 1), cA, oc[1]);
    if (wr == 1) PG8_BAR;
    PG8_WAIT_V(2); PG8_BAR;
    PG8_STAGE(PG8_SB(1, 0), cB + kstep, voffB); PG8_STAGE(PG8_SA(1, 0), cA + kstep, oc[0]); PG8_STAGE(PG8_SB(1, 1), cB + hstep + kstep, voffB);
    PG8_WAIT_V(6); PG8_BAR;
    for (;;) {
        const bool has_next = S.next(ui + 1, nxt);
        const char* nA = has_next ? S.a_base(nxt) : cA; const char* nB = has_next ? S.b_base(nxt) : cB;
#pragma unroll
        for (int h = 0; h < 2; ++h)
#pragma unroll
            for (int i = 0; i < 2; ++i) on[h][i] = oc[h][i];
        for (int t = 0; t < nt; t += 2) {
            const bool last = (t == nt - 2);
            if (last && has_next) { PG8_AOFFS(nxt, on); }
            const char* a1 = cA + (size_t)(t + 1) * kstep;
            const char* a2 = last ? nA : cA + (size_t)(t + 2) * kstep; const char* b2 = last ? nB : cB + (size_t)(t + 2) * kstep;
            const char* a3 = a2 + kstep; const char* b3 = b2 + kstep;
            unsigned o2[2][2];
#pragma unroll
            for (int h = 0; h < 2; ++h)
#pragma unroll
                for (int i = 0; i < 2; ++i) o2[h][i] = last ? on[h][i] : oc[h][i];
            PG8_LDB(B0, 0, 0); PG8_LDB(B1, 0, 1); PG8_SCHED; PG8_LDA(At, 0, 0); PG8_STAGE(PG8_SA(1, 1), a1, oc[1]);
            PG8_WAIT_V(8); PG8_WAIT_L(0); PG8_BAR; PG8_MMA(0, 0, At, B0); PG8_MMA(0, 1, At, B1); PG8_BAR; PG8_SCHED;
            PG8_LDA(At, 0, 1); PG8_STAGE(PG8_SB(0, 0), b2, voffB); PG8_STAGE(PG8_SB(0, 1), b2 + hstep, voffB); PG8_STAGE(PG8_SA(0, 0), a2, o2[0]);
            PG8_WAIT_V(8); PG8_WAIT_L(0); PG8_BAR; PG8_MMA(1, 0, At, B0); PG8_MMA(1, 1, At, B1); PG8_BAR; PG8_SCHED;
            PG8_LDB(B0, 1, 0); PG8_LDB(B1, 1, 1); PG8_SCHED; PG8_LDA(At, 1, 0); PG8_STAGE(PG8_SA(0, 1), a2, o2[1]);
            PG8_WAIT_V(8); PG8_WAIT_L(0); PG8_BAR; PG8_MMA(0, 0, At, B0); PG8_MMA(0, 1, At, B1); PG8_BAR; PG8_SCHED;
            PG8_LDA(At, 1, 1); PG8_STAGE(PG8_SB(1, 0), b3, voffB); PG8_STAGE(PG8_SB(1, 1), b3 + hstep, voffB); PG8_STAGE(PG8_SA(1, 0), a3, o2[0]);
            PG8_WAIT_V(8); PG8_WAIT_L(0); PG8_BAR; PG8_MMA(1, 0, At, B0); PG8_MMA(1, 1, At, B1); PG8_BAR; PG8_SCHED;
        }
        if constexpr (ALIGN_EPI) { if (wr == 0) PG8_BAR; }
        E(acc, cur, wr, wc, fr, fq);
        if (!has_next) break;
#pragma unroll
        for (int a = 0; a < 2; ++a)
#pragma unroll
            for (int b = 0; b < 2; ++b)
#pragma unroll
                for (int m = 0; m < 4; ++m)
#pragma unroll
                    for (int n = 0; n < 2; ++n) acc[a][b][m][n] = (f32x4){0.f, 0.f, 0.f, 0.f};
        cur = nxt; cA = nA; cB = nB; ++ui;
#pragma unroll
        for (int h = 0; h < 2; ++h)
#pragma unroll
            for (int i = 0; i < 2; ++i) oc[h][i] = on[h][i];
        if constexpr (ALIGN_EPI) { if (wr == 1) PG8_BAR; }
    }
    PG8_WAIT_V(0);
    if constexpr (!ALIGN_EPI) { if (wr == 0) PG8_BAR; }
    PG8_BAR;
#undef PG8_SA
#undef PG8_SB
#undef PG8_STAGE
#undef PG8_LDA
#undef PG8_LDB
#undef PG8_MMA
#undef PG8_WAIT_V
#undef PG8_WAIT_L
#undef PG8_BAR
#undef PG8_SCHED
#undef PG8_AOFFS
}
}

#define XB_TMO      128
#define XB_XCNT(j)  (256  + 64 * (j))
#define XB_XSUB(j)  (1280 + 64 * (j))
#define XB_XGEN(j)  (2304 + 64 * (j))
#define XB_TOP      3328
#define XB_TOPGEN   3392
#define XCD_BAR_WORDS 3456
#define XB_SPIN_CAP (1u << 18)
__device__ __forceinline__ unsigned xb_ld(unsigned* p)              { return __hip_atomic_load(p, __ATOMIC_RELAXED, __HIP_MEMORY_SCOPE_AGENT); }
__device__ __forceinline__ unsigned xb_add(unsigned* p, unsigned v) { return __hip_atomic_fetch_add(p, v, __ATOMIC_RELAXED, __HIP_MEMORY_SCOPE_AGENT); }
__device__ __forceinline__ unsigned xb_xcc_id() { return (unsigned)__builtin_amdgcn_s_getreg((3 << 11) | 20) & 0xFu; }
#define XB_SPIN(cond, bar) do { unsigned _sp = 0; while (cond) { __builtin_amdgcn_s_sleep(1); \
    if ((++_sp & 255u) == 0u) { if (xb_ld(&(bar)[XB_TMO])) break; if (_sp > XB_SPIN_CAP) { atomicAdd(&(bar)[XB_TMO], 1u); break; } } } } while (0)
struct XcdBarrier { unsigned* bar; unsigned x; volatile LAS unsigned* st; };
__device__ __forceinline__ XcdBarrier xcd_barrier_post(unsigned* bar, volatile LAS unsigned* st) {
    XcdBarrier b; b.bar = bar; b.x = xb_xcc_id(); b.st = st;
    if (threadIdx.x == 0) (void)xb_add(&bar[XB_XCNT(b.x)], 1u);
    return b;
}
__device__ __forceinline__ void xcd_barrier_complete(unsigned* bar, unsigned x, unsigned& nloc, unsigned& nx) {
    const unsigned G = gridDim.x * gridDim.y * gridDim.z;
    unsigned sum, cnt, mine, sp = 0u;
    for (;;) {
        sum = 0u; cnt = 0u; mine = 0u;
#pragma unroll
        for (unsigned j = 0; j < 16; ++j) { const unsigned c = xb_ld(&bar[XB_XCNT(j)]); sum += c; cnt += (c > 0u) ? 1u : 0u; mine = (j == x) ? c : mine; }
        if (sum == G) break;
        __builtin_amdgcn_s_sleep(1);
        if ((++sp & 255u) == 0u) { if (xb_ld(&bar[XB_TMO])) break; if (sp > XB_SPIN_CAP) { atomicAdd(&bar[XB_TMO], 1u); break; } }
    }
    nloc = mine > 0u ? mine : 1u; nx = cnt > 0u ? cnt : 1u;
}
__device__ __forceinline__ void xcd_barrier(const XcdBarrier& b) {
    asm volatile("s_waitcnt vmcnt(0)" ::: "memory");
    __syncthreads();
    if (threadIdx.x == 0) {
        unsigned* bar = b.bar;
        __builtin_amdgcn_s_waitcnt(0);
        unsigned nloc = b.st[0], nx = b.st[1];
        if (nloc == 0u) { xcd_barrier_complete(bar, b.x, nloc, nx); b.st[0] = nloc; b.st[1] = nx; }
        const unsigned old = xb_add(&bar[XB_XSUB(b.x)], 1u);
        const unsigned gen = old / nloc;
        if (old + 1u == (gen + 1u) * nloc) {
            __builtin_amdgcn_fence(__ATOMIC_RELEASE, "agent");
            asm volatile("s_waitcnt vmcnt(0)" ::: "memory");
            const unsigned og = xb_add(&bar[XB_TOP], 1u);
            const unsigned tg = og / nx;
            if (og + 1u == (tg + 1u) * nx) xb_add(&bar[XB_TOPGEN], 1u);
            else XB_SPIN(xb_ld(&bar[XB_TOPGEN]) == tg, bar);
            __builtin_amdgcn_fence(__ATOMIC_ACQUIRE, "agent");
            xb_add(&bar[XB_XGEN(b.x)], 1u);
            asm volatile("s_waitcnt vmcnt(0)" ::: "memory");
        } else {
            XB_SPIN(xb_ld(&bar[XB_XGEN(b.x)]) == gen, bar);
            __builtin_amdgcn_fence(__ATOMIC_ACQUIRE, "agent");
            asm volatile("s_waitcnt vmcnt(0)" ::: "memory");
        }
    }
    __syncthreads();
}

struct Frame {
    LAS unsigned char* lds;
    unsigned* ctl;
    int tid, lane, wave, G;
    const float *x, *c, *ctx, *c_ctx, *w_mod, *b_mod, *norm1_w, *norm2_w, *w_in, *conv_w, *conv_b, *dt_bias, *a_log, *d_skip, *ssd_norm_w, *pool_w, *pool_scale, *w_out, *router_w, *router_b, *w1, *b1, *w2, *b2, *final_norm_w;
    float* out;
    float *MOD, *DTRAW, *DT, *ROWSC, *CHS, *X1, *TOPG, *SLOTGATE;
    int *TOPE, *TOPR, *TOKSLOT, *SLOTTOK, *BB;
    bf16 *WINT, *WOUTT, *W1T, *W2T, *A1, *XBCPRE, *Z, *V, *XBC, *ST, *Y, *YB, *A2, *H2, *ACT, *YS;
};

template <class RowMap>
__device__ __forceinline__ void p0_emit(bf16* WT, int Kd, RowMap rm, int k0, int n0, int nvalid, LAS float* scr, int lane) {
    const int c = lane & 7;
#pragma unroll
    for (int j = 0; j < 4; ++j) { const int n = (lane >> 3) + 8 * j; const LAS float* s = scr + (8 * c) * 33 + n;
        v4u o; o.x = pk2(s[0 * 33], s[1 * 33]); o.y = pk2(s[2 * 33], s[3 * 33]); o.z = pk2(s[4 * 33], s[5 * 33]); o.w = pk2(s[6 * 33], s[7 * 33]);
        if (n0 + n < nvalid) *(v4u*)(WT + (size_t)rm(n0 + n) * Kd + k0 + 8 * c) = o; }
    LDS_WAIT(); asm volatile("" ::: "memory");
}
template <class RowMap>
__device__ __forceinline__ void p0_transpose_item(const float* W, int N, int nvalid, bf16* WT, int Kd, RowMap rm, LAS float* scr, int kb, int nb, int lane) {
    const int k0 = 64 * kb, n0 = 32 * nb, nn = n0 + (lane & 31); const bool ok = nn < nvalid;
#pragma unroll 8
    for (int i = 0; i < 32; ++i) { const int kk = 2 * i + (lane >> 5); scr[kk * 33 + (lane & 31)] = ok ? W[(size_t)(k0 + kk) * N + nn] : 0.f; }
    LDS_WAIT(); asm volatile("" ::: "memory");
    p0_emit(WT, Kd, rm, k0, n0, nvalid, scr, lane);
}
struct RmId { __device__ __forceinline__ int operator()(int n) const { return n; } };
struct RmOff { int off; __device__ __forceinline__ int operator()(int n) const { return n + off; } };
struct RmWin { __device__ __forceinline__ int operator()(int n) const { return n < 2560 ? n : (n < 2608 ? 4608 + (n - 2560) : 2560 + (n - 2608)); } };
struct RmW1 { __device__ __forceinline__ int operator()(int n) const { const int j = n >> 1; return 256 * (j >> 7) + 128 * (n & 1) + (j & 127); } };

__device__ __forceinline__ void p0_prologue(Frame& F) {
    if ((int)blockIdx.x < 96) {
        LAS float* sc = (LAS float*)F.lds;
        LAS float* part = (LAS float*)(F.lds + 36864);
        for (int idx = F.tid; idx < 9 * 1024; idx += 512) { const int r = idx >> 10, k = idx & 1023; const float v = (r < 8) ? F.c[r * 1024 + k] : F.c_ctx[k]; sc[idx] = silu_f(v); }
        __syncthreads();
        const int n = 64 * (int)blockIdx.x + F.lane, kb = 128 * F.wave;
        float acc[9];
#pragma unroll
        for (int r = 0; r < 9; ++r) acc[r] = 0.f;
#pragma unroll 8
        for (int k = 0; k < 128; ++k) { const float wv = F.w_mod[(size_t)(kb + k) * 6144 + n];
#pragma unroll
            for (int r = 0; r < 9; ++r) acc[r] += sc[r * 1024 + kb + k] * wv; }
#pragma unroll
        for (int r = 0; r < 9; ++r) part[(F.wave * 9 + r) * 64 + F.lane] = acc[r];
        __syncthreads();
        for (int idx = F.tid; idx < 9 * 64; idx += 512) { const int r = idx >> 6, col = idx & 63; float s = 0.f;
#pragma unroll
            for (int w = 0; w < 8; ++w) s += part[(w * 9 + r) * 64 + col];
            F.MOD[r * 6144 + 64 * (int)blockIdx.x + col] = s + F.b_mod[64 * (int)blockIdx.x + col]; }
        __syncthreads();
    }
    LAS float* scr = (LAS float*)(F.lds + F.wave * 16384);
    const int gw = (int)blockIdx.x * 8 + F.wave, NGW = F.G * 8, lane = F.lane;
    constexpr int I_POOL = 16 * 4 * 4, I_WIN = 16 * 130, I_WOUT = 32 * 32, I_W1 = 32 * 16 * 64, I_W2 = 32 * 16 * 32, I_PAD = N1 - IN_COLS;
    constexpr int NITEMS = I_POOL + I_WIN + I_WOUT + I_W1 + I_W2 + I_PAD;
    for (int it = gw; it < NITEMS; it += NGW) {
        int r = it;
        if (r < I_POOL) {
            const int kb = r >> 4, g = (r >> 2) & 3, ob = r & 3, k = 64 * kb + lane, o0 = 32 * ob;
            float acc[32];
#pragma unroll
            for (int o = 0; o < 32; ++o) acc[o] = 0.f;
            const float* arow = F.w_in + (size_t)k * IN_COLS + 4144 + g * 128;
            for (int i = 0; i < 128; ++i) { const float a = arow[i]; const float* pw = F.pool_w + (size_t)(g * 128 + i) * 128 + o0;
#pragma unroll
                for (int o = 0; o < 32; ++o) acc[o] += a * pw[o]; }
#pragma unroll
            for (int o = 0; o < 32; ++o) scr[lane * 33 + o] = acc[o] * F.pool_scale[g * 128 + o0 + o];
            LDS_WAIT(); asm volatile("" ::: "memory");
            p0_emit(F.WINT, D, RmOff{4096 + g * 128}, 64 * kb, o0, 1 << 30, scr, lane);
            continue; }
        r -= I_POOL;
        if (r < I_WIN) { p0_transpose_item(F.w_in, IN_COLS, 4144, F.WINT, D, RmWin{}, scr, r / 130, r % 130, lane); continue; } r -= I_WIN;
        if (r < I_WOUT) { p0_transpose_item(F.w_out, D, D, F.WOUTT, 2048, RmId{}, scr, r >> 5, r & 31, lane); continue; } r -= I_WOUT;
        if (r < I_W1) { const int e = r >> 10, q = r & 1023; p0_transpose_item(F.w1 + (size_t)e * D * 2048, 2048, 2048, F.W1T + (size_t)e * 2048 * D, D, RmW1{}, scr, q >> 6, q & 63, lane); continue; } r -= I_W1;
        if (r < I_W2) { const int e = r >> 9, q = r & 511; p0_transpose_item(F.w2 + (size_t)e * D * D, D, D, F.W2T + (size_t)e * D * D, D, RmId{}, scr, q >> 5, q & 31, lane); continue; } r -= I_W2;
        { v4u z = {0u, 0u, 0u, 0u}; v4u* p = (v4u*)(F.WINT + (size_t)(IN_COLS + r) * D); p[lane] = z; p[lane + 64] = z; }
    }
}

__device__ __forceinline__ void p1_norm1(Frame& F) {
    const int gw = (int)blockIdx.x * 8 + F.wave, NGW = F.G * 8, lane = F.lane;
    for (int r = gw; r < RTOT; r += NGW) {
        const float* xr = (r < T) ? F.x + (size_t)r * D : F.ctx + (size_t)(r - T) * D;
        const float* mod = F.MOD + (size_t)((r < T) ? (r >> 12) : 8) * 6144;
        f32x4 v[4]; float ss = 0.f;
#pragma unroll
        for (int j = 0; j < 4; ++j) { v[j] = *(const f32x4*)(xr + 4 * lane + 256 * j); ss += (v[j].x * v[j].x + v[j].y * v[j].y) + (v[j].z * v[j].z + v[j].w * v[j].w); }
        const float rs = 1.f / sqrtf(wave_sum(ss) * (1.f / D) + RMS_EPS);
#pragma unroll
        for (int j = 0; j < 4; ++j) { const int col = 4 * lane + 256 * j;
            const f32x4 w = *(const f32x4*)(F.norm1_w + col), sh = *(const f32x4*)(mod + col), sc = *(const f32x4*)(mod + 1024 + col);
            const f32x4 h = (v[j] * rs) * w * (sc + 1.f) + sh;
            v2u o; o.x = pk2(h.x, h.y); o.y = pk2(h.z, h.w);
            *(v2u*)(F.A1 + (size_t)r * D + col) = o; }
    }
}

struct Sched1 {
    const char* A; const char* Bt; int G, c;
    __device__ __forceinline__ bool next(int i, pg8::Unit& u) const {
        const int L = i * G + c; if (L >= 2432 + 88) return false;
        if (L < 2432) pg8::static_map(L, 128, 19, u.pm, u.pn);
        else { const int Lc = L - 2432, j = Lc >> 3; u.pm = 128 + (Lc & 7); u.pn = j < 10 ? j : 18; }
        u.e = 0; return true; }
    __device__ __forceinline__ const char* a_base(const pg8::Unit& u) const { return A + (size_t)u.pm * 256 * D * 2; }
    __device__ __forceinline__ const char* b_base(const pg8::Unit& u) const { return Bt + (size_t)u.pn * 256 * D * 2; }
    __device__ __forceinline__ unsigned a_row(const pg8::Unit&, int) const { return 0u; }
};
struct Epi1 {
    static constexpr bool PERM = true;
    bf16 *XBCPRE, *Z, *V; float* DTRAW;
    __device__ __forceinline__ void operator()(const f32x4 (&acc)[2][2][4][2], const pg8::Unit& u, int wr, int wc, int fr, int fq) const {
        const int row0 = u.pm * 256 + wr * 64 + fr;
        if (u.pn < 18) {
            bf16* base; int ldc, colt;
            if (u.pn < 10) { base = XBCPRE; ldc = CONV_CH; colt = u.pn * 256; } else if (u.pn < 16) { base = Z; ldc = SSD_W; colt = (u.pn - 10) * 256; } else { base = V; ldc = 512; colt = (u.pn - 16) * 256; }
            const int col0 = colt + wc * 32 + 8 * fq;
#pragma unroll
            for (int ai = 0; ai < 2; ++ai)
#pragma unroll
                for (int m = 0; m < 4; ++m) { bf16* rowp = base + (size_t)(row0 + ai * 128 + m * 16) * ldc + col0;
#pragma unroll
                    for (int bj = 0; bj < 2; ++bj) { const f32x4 v0 = acc[ai][bj][m][0], v1 = acc[ai][bj][m][1];
                        v4u w; w.x = pg8::cvt_pk_bf16(v0[0], v0[1]); w.y = pg8::cvt_pk_bf16(v0[2], v0[3]); w.z = pg8::cvt_pk_bf16(v1[0], v1[1]); w.w = pg8::cvt_pk_bf16(v1[2], v1[3]);
                        *(v4u*)(rowp + bj * 128) = w; } }
        } else if (wc < 2) {
            const int col0 = wc * 32 + 8 * fq;
#pragma unroll
            for (int ai = 0; ai < 2; ++ai)
#pragma unroll
                for (int m = 0; m < 4; ++m) { float* rowp = DTRAW + (size_t)(row0 + ai * 128 + m * 16) * 64 + col0;
                    *(f32x4*)(rowp) = acc[ai][0][m][0]; *(f32x4*)(rowp + 4) = acc[ai][0][m][1]; }
        }
    }
};

__device__ __forceinline__ void p3_conv(Frame& F) {
    const int gt = (int)blockIdx.x * 512 + F.tid, NT_ = F.G * 512;
    constexpr int NTASK = (RTOT / 32) * 320;
    for (int task = gt; task < NTASK; task += NT_) {
        const int rt = task / 320, cg = task - rt * 320, r0 = rt * 32, ch = cg * 8;
        int slo, shi; if (r0 < T) { slo = r0 & ~(SEQ - 1); shi = slo + SEQ; } else { slo = T + ((r0 - T) & ~(CTXL - 1)); shi = slo + CTXL; }
        float w[5][8], bias[8];
#pragma unroll
        for (int j = 0; j < 5; ++j) { const f32x4 a = *(const f32x4*)(F.conv_w + j * CONV_CH + ch), b = *(const f32x4*)(F.conv_w + j * CONV_CH + ch + 4);
            w[j][0] = a.x; w[j][1] = a.y; w[j][2] = a.z; w[j][3] = a.w; w[j][4] = b.x; w[j][5] = b.y; w[j][6] = b.z; w[j][7] = b.w; }
        { const f32x4 a = *(const f32x4*)(F.conv_b + ch), b = *(const f32x4*)(F.conv_b + ch + 4); bias[0] = a.x; bias[1] = a.y; bias[2] = a.z; bias[3] = a.w; bias[4] = b.x; bias[5] = b.y; bias[6] = b.z; bias[7] = b.w; }
        v4u win[5];
        const v4u zero = {0u, 0u, 0u, 0u};
#pragma unroll
        for (int j = 0; j < 4; ++j) { const int r = r0 - 2 + j; win[j + 1] = (r >= slo && r < shi) ? *(const v4u*)(F.XBCPRE + (size_t)r * CONV_CH + ch) : zero; }
#pragma unroll 4
        for (int i = 0; i < 32; ++i) {
#pragma unroll
            for (int j = 0; j < 4; ++j) win[j] = win[j + 1];
            { const int r = r0 + i + 2; win[4] = (r < shi) ? *(const v4u*)(F.XBCPRE + (size_t)r * CONV_CH + ch) : zero; }
            float o[8];
#pragma unroll
            for (int e = 0; e < 8; ++e) o[e] = bias[e];
#pragma unroll
            for (int j = 0; j < 5; ++j) { const v4u q = win[j];
                o[0] += w[j][0] * bflo(q.x); o[1] += w[j][1] * bfhi(q.x); o[2] += w[j][2] * bflo(q.y); o[3] += w[j][3] * bfhi(q.y);
                o[4] += w[j][4] * bflo(q.z); o[5] += w[j][5] * bfhi(q.z); o[6] += w[j][6] * bflo(q.w); o[7] += w[j][7] * bfhi(q.w); }
            v4u ov; ov.x = pk2(silu_f(o[0]), silu_f(o[1])); ov.y = pk2(silu_f(o[2]), silu_f(o[3])); ov.z = pk2(silu_f(o[4]), silu_f(o[5])); ov.w = pk2(silu_f(o[6]), silu_f(o[7]));
            *(v4u*)(F.XBC + (size_t)(r0 + i) * CONV_CH + ch) = ov;
        }
    }
    for (int idx = gt; idx < RTOT * 48; idx += NT_) { const int r = idx / 48, j = idx - r * 48; const float v = F.DTRAW[(size_t)r * 64 + j] + F.dt_bias[j];
        F.DT[idx] = v > 20.f ? v : log1pf(__expf(v)); }
}

__device__ __forceinline__ bf16x8 frag_row(const LAS unsigned char* base, int rs, int row, int k0, int q) { return *(const LAS bf16x8*)(base + row * rs + (k0 + 8 * q) * 2); }
__device__ __forceinline__ bf16x8 frag_tr(const LAS unsigned char* base, int rs, int k0, int c0, int lane) {
    const int g = lane >> 4, qq = (lane & 15) >> 2, p = lane & 3;
    const LAS unsigned char* a = base + (k0 + 8 * g + qq) * rs + c0 * 2 + 8 * p;
    const s16x4 lo = __builtin_amdgcn_ds_read_tr16_b64_v4i16((LAS s16x4*)a);
    const s16x4 hi = __builtin_amdgcn_ds_read_tr16_b64_v4i16((LAS s16x4*)(a + 4 * rs));
    bf16x8 r; r[0] = lo[0]; r[1] = lo[1]; r[2] = lo[2]; r[3] = lo[3]; r[4] = hi[0]; r[5] = hi[1]; r[6] = hi[2]; r[7] = hi[3]; return r;
}
__device__ __forceinline__ f32x4 mfma16(bf16x8 a, bf16x8 b, f32x4 c) { return __builtin_amdgcn_mfma_f32_16x16x32_bf16(a, b, c, 0, 0, 0); }
__device__ __forceinline__ float wave_incl_scan(float v, int lane) {
#pragma unroll
    for (int o = 1; o < 64; o <<= 1) { const float t = __shfl_up(v, o); if (lane >= o) v += t; }
    return v;
}

__device__ __forceinline__ void p4_ssd_local(Frame& F) {
    constexpr int RS = 272, RSX = 144;
    constexpr int O_C = 0, O_B = 34816, O_M = 69632, O_X = 104448, O_T = 122880;
    LAS unsigned char* L = F.lds;
    LAS float* TAB = (LAS float*)(L + O_T);
    const int tid = F.tid, lane = F.lane, w = F.wave, i16 = lane & 15, q4 = lane >> 4;
    const int lb = 64 * (w & 1), sb = 32 * (w >> 1);
    for (int u = (int)blockIdx.x; u < NB * NCC * NGRP; u += F.G) {
        const int b = u / (NCC * NGRP), rem = u - b * (NCC * NGRP), cc = rem >> 2, g = rem & 3;
        const bool lat = cc >= 2;
        const int r0 = lat ? b * SEQ + (cc - 2) * CHUNK : T + b * CTXL + cc * CHUNK;
#pragma unroll
        for (int k = 0; k < 4; ++k) { const int pc = tid + 512 * k, row = pc >> 4, ch = pc & 15;
            const bf16* src = F.XBC + (size_t)(r0 + row) * CONV_CH + SSD_W + g * NST + ch * 8;
            const v4u vb = *(const v4u*)src, vc = *(const v4u*)(src + NGRP * NST);
            *(LAS v4u*)(L + O_B + row * RS + ch * 16) = vb; *(LAS v4u*)(L + O_C + row * RS + ch * 16) = vc; }
        for (int idx = w; idx < 12; idx += 8) {
            const int e = idx % 6, d = idx / 6, h = g * HPG + e;
            const int s0 = d ? 127 - 2 * lane : 2 * lane, s1 = d ? s0 - 1 : s0 + 1;
            const float dt0 = F.DT[(size_t)(r0 + s0) * 48 + d * NH + h], dt1 = F.DT[(size_t)(r0 + s1) * 48 + d * NH + h];
            const float A = __expf(F.a_log[d * NH + h]);
            const float a0 = -A * dt0, a1 = -A * dt1;
            const float incl = wave_incl_scan(a0 + a1, lane);
            const float c1 = incl, c0 = incl - a1, tot = __shfl(incl, 63);
            LAS float* Te = TAB + e * 768;
            Te[d * 128 + s0] = c0; Te[d * 128 + s1] = c1;
            Te[(2 + d) * 128 + s0] = dt0; Te[(2 + d) * 128 + s1] = dt1;
            Te[(4 + d) * 128 + s0] = dt0 * __expf(tot - c0); Te[(4 + d) * 128 + s1] = dt1 * __expf(tot - c1);
            if (lane == 63) F.CHS[((size_t)(b * NCC + cc) * NH + h) * 2 + d] = tot;
            if (lat) { float* rp = F.ROWSC + ((size_t)(b * 2 + d) * NH + h) * SEQ + (cc - 2) * CHUNK; rp[s0] = __expf(c0); rp[s1] = __expf(c1); }
        }
        __syncthreads();
        f32x4 cb[2][4];
        if (lat) {
#pragma unroll
            for (int ts = 0; ts < 2; ++ts)
#pragma unroll
                for (int tl = 0; tl < 4; ++tl) cb[ts][tl] = (f32x4){0.f, 0.f, 0.f, 0.f};
#pragma unroll
            for (int ks = 0; ks < 4; ++ks) { bf16x8 af[2], bfr[4];
#pragma unroll
                for (int ts = 0; ts < 2; ++ts) af[ts] = frag_row(L + O_B, RS, sb + 16 * ts + i16, 32 * ks, q4);
#pragma unroll
                for (int tl = 0; tl < 4; ++tl) bfr[tl] = frag_row(L + O_C, RS, lb + 16 * tl + i16, 32 * ks, q4);
#pragma unroll
                for (int ts = 0; ts < 2; ++ts)
#pragma unroll
                    for (int tl = 0; tl < 4; ++tl) cb[ts][tl] = mfma16(af[ts], bfr[tl], cb[ts][tl]); }
        }
        for (int e = 0; e < HPG; ++e) {
            const int h = g * HPG + e;
            const LAS float* Te = TAB + e * 768;
#pragma unroll
            for (int k = 0; k < 2; ++k) { const int pc = tid + 512 * k, row = pc >> 3, ch = pc & 7;
                const v4u v = *(const v4u*)(F.XBC + (size_t)(r0 + row) * CONV_CH + h * HDIM + ch * 8); *(LAS v4u*)(L + O_X + row * RSX + ch * 16) = v; }
            if (lat) {
                const float Dh = F.d_skip[h];
#pragma unroll
                for (int tl = 0; tl < 4; ++tl) { const int l = lb + 16 * tl + i16; const float af_l = Te[l], rb_l = Te[128 + l];
#pragma unroll
                    for (int ts = 0; ts < 2; ++ts) { const int s0 = sb + 16 * ts + 4 * q4;
                        const f32x4 acs = *(const LAS f32x4*)(Te + s0), rbs = *(const LAS f32x4*)(Te + 128 + s0), dtf = *(const LAS f32x4*)(Te + 256 + s0), dtb = *(const LAS f32x4*)(Te + 384 + s0);
                        float m[4];
#pragma unroll
                        for (int r = 0; r < 4; ++r) { const int s = s0 + r;
                            const float wf = (s <= l) ? __expf(af_l - acs[r]) * dtf[r] : 0.f;
                            const float wb = (s >= l) ? __expf(rb_l - rbs[r]) * dtb[r] : 0.f;
                            m[r] = cb[ts][tl][r] * (wf + wb) + ((s == l) ? Dh : 0.f); }
                        v2u o; o.x = pk2(m[0], m[1]); o.y = pk2(m[2], m[3]);
                        *(LAS v2u*)(L + O_M + l * RS + s0 * 2) = o; } }
            }
            __syncthreads();
            bf16x8 xf[4][4];
#pragma unroll
            for (int pt = 0; pt < 4; ++pt)
#pragma unroll
                for (int ks = 0; ks < 4; ++ks) xf[pt][ks] = frag_tr(L + O_X, RSX, 32 * ks, 16 * pt, lane);
            if (lat) {
                f32x4 ya[4];
#pragma unroll
                for (int pt = 0; pt < 4; ++pt) ya[pt] = (f32x4){0.f, 0.f, 0.f, 0.f};
#pragma unroll
                for (int ks = 0; ks < 4; ++ks) { const bf16x8 bm = frag_row(L + O_M, RS, 16 * w + i16, 32 * ks, q4);
#pragma unroll
                    for (int pt = 0; pt < 4; ++pt) ya[pt] = mfma16(xf[pt][ks], bm, ya[pt]); }
                bf16* yp = F.Y + (size_t)(r0 + 16 * w + i16) * SSD_W + h * HDIM + 4 * q4;
#pragma unroll
                for (int pt = 0; pt < 4; ++pt) { v2u o; o.x = pk2(ya[pt][0], ya[pt][1]); o.y = pk2(ya[pt][2], ya[pt][3]); *(v2u*)(yp + 16 * pt) = o; }
            }
#pragma unroll
            for (int d = 0; d < 2; ++d) {
                f32x4 sa[4];
#pragma unroll
                for (int pt = 0; pt < 4; ++pt) sa[pt] = (f32x4){0.f, 0.f, 0.f, 0.f};
#pragma unroll
                for (int ks = 0; ks < 4; ++ks) { const bf16x8 braw = frag_tr(L + O_B, RS, 32 * ks, 16 * w, lane);
                    const LAS float* wg = Te + (4 + d) * 128 + 32 * ks + 8 * q4;
                    const f32x4 w0 = *(const LAS f32x4*)wg, w1 = *(const LAS f32x4*)(wg + 4);
                    const v4u bu = __builtin_bit_cast(v4u, braw); v4u su;
                    su.x = pk2(bflo(bu.x) * w0[0], bfhi(bu.x) * w0[1]); su.y = pk2(bflo(bu.y) * w0[2], bfhi(bu.y) * w0[3]);
                    su.z = pk2(bflo(bu.z) * w1[0], bfhi(bu.z) * w1[1]); su.w = pk2(bflo(bu.w) * w1[2], bfhi(bu.w) * w1[3]);
                    const bf16x8 bs = __builtin_bit_cast(bf16x8, su);
#pragma unroll
                    for (int pt = 0; pt < 4; ++pt) sa[pt] = mfma16(bs, xf[pt][ks], sa[pt]); }
                bf16* sp = F.ST + ((((size_t)(b * NCC + cc) * NH + h) * 2 + d) * HDIM + i16) * NST + 16 * w + 4 * q4;
#pragma unroll
                for (int pt = 0; pt < 4; ++pt) { v2u o; o.x = pk2(sa[pt][0], sa[pt][1]); o.y = pk2(sa[pt][2], sa[pt][3]); *(v2u*)(sp + (size_t)16 * pt * NST) = o; }
            }
            __syncthreads();
        }
    }
}

__device__ __forceinline__ void p5_ssd_scan(Frame& F) {
    constexpr int RS = 272, O_RS = 4 * 34816;
    LAS unsigned char* L = F.lds;
    LAS float* RSB = (LAS float*)(L + O_RS);
    const int tid = F.tid, lane = F.lane, w = F.wave, i16 = lane & 15, q4 = lane >> 4;
    const int d = w >> 2, ps = w & 3, t8 = tid & 255;
    for (int u = (int)blockIdx.x; u < NB * NH; u += F.G) {
        const int b = u / NH, h = u - b * NH, g = h / HPG;
        float S[32];
#pragma unroll
        for (int k = 0; k < 32; ++k) S[k] = 0.f;
        v4u creg[8]; float rsreg = 0.f;
#pragma unroll
        for (int k = 0; k < 8; ++k) creg[k] = (v4u){0u, 0u, 0u, 0u};
        for (int j = 0; j < NCC; ++j) {
            const int cc = d == 0 ? j : (j < 2 ? 1 - j : 35 - j);
            LAS unsigned char* Cb = L + ((j & 1) * 2 + d) * 34816;
            if (j >= 2) {
#pragma unroll
                for (int k = 0; k < 8; ++k) { const int pc = t8 + 256 * k, row = pc >> 4, ch = pc & 15; *(LAS v4u*)(Cb + row * RS + ch * 16) = creg[k]; }
                if (t8 < 128) RSB[((j & 1) * 2 + d) * 128 + t8] = rsreg;
            }
            __syncthreads();
            if (j + 1 >= 2 && j + 1 < NCC) {
                const int cn = d == 0 ? j + 1 : 34 - j;
                const size_t rown = (size_t)b * SEQ + (size_t)(cn - 2) * CHUNK;
#pragma unroll
                for (int k = 0; k < 8; ++k) { const int pc = t8 + 256 * k, row = pc >> 4, ch = pc & 15; creg[k] = *(const v4u*)(F.XBC + (rown + row) * CONV_CH + SSD_W + NGRP * NST + g * NST + ch * 8); }
                if (t8 < 128) rsreg = F.ROWSC[((size_t)(b * 2 + d) * NH + h) * SEQ + (cn - 2) * CHUNK + t8];
            }
            const size_t sidx = ((size_t)(b * NCC + cc) * NH + h) * 2 + d;
            const bf16* stp = F.ST + (sidx * HDIM + 16 * ps + i16) * NST + 8 * q4;
            v4u stv[4];
#pragma unroll
            for (int ks = 0; ks < 4; ++ks) stv[ks] = *(const v4u*)(stp + 32 * ks);
            const float decay = __expf(F.CHS[sidx]);
            if (j >= 2) {
                bf16x8 sf[4];
#pragma unroll
                for (int ks = 0; ks < 4; ++ks) { v4u t; t.x = pk2(S[ks * 8 + 0], S[ks * 8 + 1]); t.y = pk2(S[ks * 8 + 2], S[ks * 8 + 3]); t.z = pk2(S[ks * 8 + 4], S[ks * 8 + 5]); t.w = pk2(S[ks * 8 + 6], S[ks * 8 + 7]); sf[ks] = __builtin_bit_cast(bf16x8, t); }
                const size_t rowb = (size_t)b * SEQ + (size_t)(cc - 2) * CHUNK;
                const LAS float* rsl = RSB + ((j & 1) * 2 + d) * 128;
#pragma unroll
                for (int lt = 0; lt < 8; ++lt) {
                    f32x4 a = (f32x4){0.f, 0.f, 0.f, 0.f};
#pragma unroll
                    for (int ks = 0; ks < 4; ++ks) a = mfma16(sf[ks], frag_row(Cb, RS, 16 * lt + i16, 32 * ks, q4), a);
                    const float sc = rsl[16 * lt + i16];
                    const size_t off = (rowb + 16 * lt + i16) * SSD_W + h * HDIM + 16 * ps + 4 * q4;
                    if (d == 0) { const v2u old = *(const v2u*)(F.Y + off); v2u o; o.x = pk2(bflo(old.x) + a[0] * sc, bfhi(old.x) + a[1] * sc); o.y = pk2(bflo(old.y) + a[2] * sc, bfhi(old.y) + a[3] * sc); *(v2u*)(F.Y + off) = o; }
                    else { v2u o; o.x = pk2(a[0] * sc, a[1] * sc); o.y = pk2(a[2] * sc, a[3] * sc); *(v2u*)(F.YB + off) = o; }
                }
            }
#pragma unroll
            for (int ks = 0; ks < 4; ++ks) { const v4u t = stv[ks];
                S[ks * 8 + 0] = decay * S[ks * 8 + 0] + bflo(t.x); S[ks * 8 + 1] = decay * S[ks * 8 + 1] + bfhi(t.x);
                S[ks * 8 + 2] = decay * S[ks * 8 + 2] + bflo(t.y); S[ks * 8 + 3] = decay * S[ks * 8 + 3] + bfhi(t.y);
                S[ks * 8 + 4] = decay * S[ks * 8 + 4] + bflo(t.z); S[ks * 8 + 5] = decay * S[ks * 8 + 5] + bfhi(t.z);
                S[ks * 8 + 6] = decay * S[ks * 8 + 6] + bflo(t.w); S[ks * 8 + 7] = decay * S[ks * 8 + 7] + bfhi(t.w); }
        }
        __syncthreads();
    }
}

__device__ __forceinline__ void p6_gate_pool(Frame& F) {
    LAS unsigned char* L = F.lds;
    const int tid = F.tid, lane = F.lane, w = F.wave;
    for (int gr = (int)blockIdx.x; gr < T / 64; gr += F.G) {
        const int rb = gr * 64;
#pragma unroll
        for (int k = 0; k < 8; ++k) { const int pc = tid + 512 * k, row = pc >> 6, ch = pc & 63; *(LAS v4u*)(L + row * 1024 + ch * 16) = *(const v4u*)(F.V + (size_t)(rb + row) * 512 + ch * 8); }
        for (int rr = 0; rr < 8; ++rr) {
            const int r = rb + 8 * w + rr;
            float v[24]; float ss = 0.f;
#pragma unroll
            for (int j = 0; j < 3; ++j) { const int col = 8 * (lane + 64 * j);
                const v4u ya = *(const v4u*)(F.Y + (size_t)r * SSD_W + col), yb = *(const v4u*)(F.YB + (size_t)r * SSD_W + col), z = *(const v4u*)(F.Z + (size_t)r * SSD_W + col);
                const unsigned yaw[4] = {ya.x, ya.y, ya.z, ya.w}, ybw[4] = {yb.x, yb.y, yb.z, yb.w}, zw[4] = {z.x, z.y, z.z, z.w};
#pragma unroll
                for (int e = 0; e < 4; ++e) { const float y0 = bflo(yaw[e]) + bflo(ybw[e]), y1 = bfhi(yaw[e]) + bfhi(ybw[e]);
                    const float g0 = y0 * silu_f(bflo(zw[e])), g1 = y1 * silu_f(bfhi(zw[e])); v[j * 8 + 2 * e] = g0; v[j * 8 + 2 * e + 1] = g1; ss += g0 * g0 + g1 * g1; } }
            const float rs = 1.f / sqrtf(wave_sum(ss) * (1.f / SSD_W) + RMS_EPS);
#pragma unroll
            for (int j = 0; j < 3; ++j) { const int col = 8 * (lane + 64 * j);
                const f32x4 w0 = *(const f32x4*)(F.ssd_norm_w + col), w1 = *(const f32x4*)(F.ssd_norm_w + col + 4);
                v4u o; o.x = pk2(v[j * 8 + 0] * rs * w0.x, v[j * 8 + 1] * rs * w0.y); o.y = pk2(v[j * 8 + 2] * rs * w0.z, v[j * 8 + 3] * rs * w0.w);
                o.z = pk2(v[j * 8 + 4] * rs * w1.x, v[j * 8 + 5] * rs * w1.y); o.w = pk2(v[j * 8 + 6] * rs * w1.z, v[j * 8 + 7] * rs * w1.w);
                *(v4u*)(F.A2 + (size_t)r * 2048 + col) = o; }
        }
        __syncthreads();
        {
            const int ch = tid, hw = 1 << (ch >> 7);
            const LAS bf16* col = (const LAS bf16*)L + ch;
            for (int t = 0; t < 64; ++t) { const int lo = t - hw < 0 ? 0 : t - hw, hi = t + hw > 64 ? 64 : t + hw; float s = 0.f;
                for (int q = lo; q < hi; ++q) s += __builtin_bit_cast(float, (unsigned)col[q * 512] << 16);
                const float self = __builtin_bit_cast(float, (unsigned)col[t * 512] << 16);
                F.A2[(size_t)(rb + t) * 2048 + SSD_W + ch] = (bf16)f2bf(s / (float)(hi - lo) - self); }
        }
        __syncthreads();
    }
}

struct Sched7 {
    const char* A; const char* Bt; int G, c;
    __device__ __forceinline__ bool next(int i, pg8::Unit& u) const { const int L = i * G + c; if (L >= 512) return false; pg8::static_map(L, 128, 4, u.pm, u.pn); u.e = 0; return true; }
    __device__ __forceinline__ const char* a_base(const pg8::Unit& u) const { return A + (size_t)u.pm * 256 * 2048 * 2; }
    __device__ __forceinline__ const char* b_base(const pg8::Unit& u) const { return Bt + (size_t)u.pn * 256 * 2048 * 2; }
    __device__ __forceinline__ unsigned a_row(const pg8::Unit&, int) const { return 0u; }
};
struct Epi7 {
    static constexpr bool PERM = false;
    const float* x; const float* MOD; float* X1;
    __device__ __forceinline__ void operator()(const f32x4 (&acc)[2][2][4][2], const pg8::Unit& u, int wr, int wc, int fr, int fq) const {
        const int row0 = u.pm * 256 + wr * 64 + fr, col0 = u.pn * 256 + wc * 32 + 4 * fq;
        const float* g1 = MOD + (size_t)(u.pm >> 4) * 6144 + 2048;
        f32x4 gv[2][2];
#pragma unroll
        for (int bj = 0; bj < 2; ++bj)
#pragma unroll
            for (int n = 0; n < 2; ++n) gv[bj][n] = *(const f32x4*)(g1 + col0 + bj * 128 + n * 16);
#pragma unroll
        for (int ai = 0; ai < 2; ++ai)
#pragma unroll
            for (int m = 0; m < 4; ++m) { const size_t off = (size_t)(row0 + ai * 128 + m * 16) * D + col0;
#pragma unroll
                for (int bj = 0; bj < 2; ++bj)
#pragma unroll
                    for (int n = 0; n < 2; ++n) { const f32x4 xv = *(const f32x4*)(x + off + bj * 128 + n * 16); *(f32x4*)(X1 + off + bj * 128 + n * 16) = xv + gv[bj][n] * acc[ai][bj][m][n]; } }
    }
};

__device__ __forceinline__ void p8_router(Frame& F) {
    LAS unsigned char* L = F.lds;
    LAS float* H2F = (LAS float*)L;
    constexpr int HP = 1028;
    LAS float* PART = (LAS float*)(L + 16 * HP * 4);
    LAS unsigned* HIST = (LAS unsigned*)(L + 16 * HP * 4 + 16384);
    const int tid = F.tid, lane = F.lane, w = F.wave, i16 = lane & 15, q4 = lane >> 4;
    if (tid < 32) HIST[tid] = 0u;
    __syncthreads();
    for (int gi = (int)blockIdx.x; gi < T / 16; gi += F.G) {
        const int rbase = gi * 16;
#pragma unroll
        for (int rr = 0; rr < 2; ++rr) {
            const int r16 = 2 * w + rr, r = rbase + r16;
            const float* xr = F.X1 + (size_t)r * D; const float* mod = F.MOD + (size_t)(r >> 12) * 6144;
            f32x4 v[4]; float ss = 0.f;
#pragma unroll
            for (int j = 0; j < 4; ++j) { v[j] = *(const f32x4*)(xr + 4 * lane + 256 * j); ss += (v[j].x * v[j].x + v[j].y * v[j].y) + (v[j].z * v[j].z + v[j].w * v[j].w); }
            const float rs = 1.f / sqrtf(wave_sum(ss) * (1.f / D) + RMS_EPS);
#pragma unroll
            for (int j = 0; j < 4; ++j) { const int col = 4 * lane + 256 * j;
                const f32x4 wv = *(const f32x4*)(F.norm2_w + col), sh = *(const f32x4*)(mod + 3072 + col), sc = *(const f32x4*)(mod + 4096 + col);
                const f32x4 hh = (v[j] * rs) * wv * (sc + 1.f) + sh;
                *(LAS f32x4*)(H2F + r16 * HP + col) = hh;
                v2u o; o.x = pk2(hh.x, hh.y); o.y = pk2(hh.z, hh.w); *(v2u*)(F.H2 + (size_t)r * D + col) = o; }
        }
        __syncthreads();
        {
            f32x4 a0 = (f32x4){0.f, 0.f, 0.f, 0.f}, a1 = a0;
#pragma unroll 8
            for (int kk = 0; kk < 32; ++kk) { const int k = 128 * w + 4 * kk + q4;
                const float av = H2F[i16 * HP + k]; const float b0 = F.router_w[k * 32 + i16], b1 = F.router_w[k * 32 + 16 + i16];
                a0 = __builtin_amdgcn_mfma_f32_16x16x4f32(av, b0, a0, 0, 0, 0); a1 = __builtin_amdgcn_mfma_f32_16x16x4f32(av, b1, a1, 0, 0, 0); }
#pragma unroll
            for (int r = 0; r < 4; ++r) { PART[(w * 16 + 4 * q4 + r) * 32 + i16] = a0[r]; PART[(w * 16 + 4 * q4 + r) * 32 + 16 + i16] = a1[r]; }
        }
        __syncthreads();
        {
            const int row = tid >> 5, e = tid & 31;
            float lg = F.router_b[e];
#pragma unroll
            for (int ww = 0; ww < 8; ++ww) lg += PART[(ww * 16 + row) * 32 + e];
            float tv[4]; int ti[4];
#pragma unroll
            for (int k = 0; k < 4; ++k) { float bv = lg; int bi = e;
#pragma unroll
                for (int o = 1; o < 32; o <<= 1) { const float ov = __shfl_xor(bv, o); const int oi = __shfl_xor(bi, o); if (ov > bv || (ov == bv && oi < bi)) { bv = ov; bi = oi; } }
                tv[k] = bv; ti[k] = bi; if (e == bi) lg = -INFINITY; }
            if (e == 0) {
                const float e1 = __expf(tv[1] - tv[0]), e2 = __expf(tv[2] - tv[0]), e3 = __expf(tv[3] - tv[0]); const float inv = 1.f / (1.f + e1 + e2 + e3);
                const float gt[4] = {inv, e1 * inv, e2 * inv, e3 * inv};
                const int tok = rbase + row;
#pragma unroll
                for (int k = 0; k < 4; ++k) { const unsigned lr = atomicAdd((unsigned*)&HIST[ti[k]], 1u); F.TOPE[tok * 4 + k] = ti[k]; F.TOPG[tok * 4 + k] = gt[k]; F.TOPR[tok * 4 + k] = (int)lr; }
            }
        }
        __syncthreads();
    }
    if (tid < 32) { const unsigned base = __hip_atomic_fetch_add(F.ctl + CW_GCOUNT + tid, HIST[tid], RLX_AGENT); F.BB[(int)blockIdx.x * 32 + tid] = (int)base; }
}

__device__ __forceinline__ int moe_tables(Frame& F) {
    LAS int* TE = (LAS int*)(F.lds + TE_OFF);
    LAS int* MC = (LAS int*)(F.lds + MOE_CNT_OFF);
    __syncthreads();
    if (F.tid == 0) { int ps = 0;
        for (int e = 0; e < NE; ++e) { const int c = (int)__hip_atomic_load(F.ctl + CW_GCOUNT + e, RLX_AGENT); MC[e] = c; MC[32 + e] = ps; const int nt = (c + 255) >> 8; for (int t = 0; t < nt; ++t) TE[(ps >> 8) + t] = e; ps += nt << 8; }
        MC[64] = ps >> 8; }
    __syncthreads();
    return MC[64];
}
__device__ __forceinline__ void p9_slots(Frame& F) {
    (void)moe_tables(F);
    const LAS int* MC = (const LAS int*)(F.lds + MOE_CNT_OFF);
    const int gt = (int)blockIdx.x * 512 + F.tid, NT_ = F.G * 512;
    for (int a = gt; a < T * TOPK; a += NT_) { const int tok = a >> 2, e = F.TOPE[a], blk = (tok >> 4) % F.G;
        const int slot = MC[32 + e] + F.BB[blk * 32 + e] + F.TOPR[a];
        F.SLOTTOK[slot] = tok; F.SLOTGATE[slot] = F.TOPG[a]; F.TOKSLOT[a] = slot; }
    if ((int)blockIdx.x < NE) { const int e = (int)blockIdx.x, c = MC[e], ps = MC[32 + e], pe = ps + (((c + 255) >> 8) << 8);
        for (int s = ps + c + F.tid; s < pe; s += 512) { F.SLOTTOK[s] = 0; F.SLOTGATE[s] = 0.f; } }
}

struct SchedMoe {
    const char* A; const char* W; const int* slot_tok; const LAS int* TE; int nM, nN, G, c; size_t wbytes  , tilebytes  , arowbytes;
    __device__ __forceinline__ bool next(int i, pg8::Unit& u) const { const int L = i * G + c; if (L >= nM * nN) return false; pg8::static_map(L, nM, nN, u.pm, u.pn); u.e = TE[u.pm]; return true; }
    __device__ __forceinline__ const char* a_base(const pg8::Unit& u) const { return slot_tok ? A : A + (size_t)u.pm * 256 * arowbytes; }
    __device__ __forceinline__ const char* b_base(const pg8::Unit& u) const { return W + (size_t)u.e * wbytes + (size_t)u.pn * tilebytes; }
    __device__ __forceinline__ unsigned a_row(const pg8::Unit& u, int r) const { return (unsigned)slot_tok[u.pm * 256 + r]; }
};
struct Epi10 {
    static constexpr bool PERM = true;
    const float* b1; bf16* ACT;
    __device__ __forceinline__ void operator()(const f32x4 (&acc)[2][2][4][2], const pg8::Unit& u, int wr, int wc, int fr, int fq) const {
        const int row0 = u.pm * 256 + wr * 64 + fr, j0 = u.pn * 128 + wc * 32 + 8 * fq;
        const float* bp = b1 + (size_t)u.e * 2048 + 2 * j0;
        const f32x4 q0 = *(const f32x4*)bp, q1 = *(const f32x4*)(bp + 4), q2 = *(const f32x4*)(bp + 8), q3 = *(const f32x4*)(bp + 12);
        const float bg[8] = {q0.x, q0.z, q1.x, q1.z, q2.x, q2.z, q3.x, q3.z}, bu[8] = {q0.y, q0.w, q1.y, q1.w, q2.y, q2.w, q3.y, q3.w};
#pragma unroll
        for (int ai = 0; ai < 2; ++ai)
#pragma unroll
            for (int m = 0; m < 4; ++m) { float o[8];
#pragma unroll
                for (int n = 0; n < 2; ++n)
#pragma unroll
                    for (int t = 0; t < 4; ++t) { const float hg = acc[ai][0][m][n][t] + bg[4 * n + t], hu = acc[ai][1][m][n][t] + bu[4 * n + t];
                        const float gp = fminf(hg, 7.f), up = fminf(fmaxf(hu, -7.f), 7.f);
                        o[4 * n + t] = gp / (1.f + __expf(-1.702f * gp)) * (up + 1.f); }
                v4u wv; wv.x = pg8::cvt_pk_bf16(o[0], o[1]); wv.y = pg8::cvt_pk_bf16(o[2], o[3]); wv.z = pg8::cvt_pk_bf16(o[4], o[5]); wv.w = pg8::cvt_pk_bf16(o[6], o[7]);
                *(v4u*)(ACT + (size_t)(row0 + ai * 128 + m * 16) * DFF + j0) = wv; }
    }
};
struct Epi11 {
    static constexpr bool PERM = true;
    const float* b2; const float* gate; bf16* YS;
    __device__ __forceinline__ void operator()(const f32x4 (&acc)[2][2][4][2], const pg8::Unit& u, int wr, int wc, int fr, int fq) const {
        const int row0 = u.pm * 256 + wr * 64 + fr, col0 = u.pn * 256 + wc * 32 + 8 * fq;
        f32x4 bv[2][2];
#pragma unroll
        for (int bj = 0; bj < 2; ++bj)
#pragma unroll
            for (int n = 0; n < 2; ++n) bv[bj][n] = *(const f32x4*)(b2 + (size_t)u.e * D + col0 + bj * 128 + 4 * n);
#pragma unroll
        for (int ai = 0; ai < 2; ++ai)
#pragma unroll
            for (int m = 0; m < 4; ++m) { const int row = row0 + ai * 128 + m * 16; const float gt = gate[row];
#pragma unroll
                for (int bj = 0; bj < 2; ++bj) { const f32x4 v0 = (acc[ai][bj][m][0] + bv[bj][0]) * gt, v1 = (acc[ai][bj][m][1] + bv[bj][1]) * gt;
                    v4u wv; wv.x = pg8::cvt_pk_bf16(v0[0], v0[1]); wv.y = pg8::cvt_pk_bf16(v0[2], v0[3]); wv.z = pg8::cvt_pk_bf16(v1[0], v1[1]); wv.w = pg8::cvt_pk_bf16(v1[2], v1[3]);
                    *(v4u*)(YS + (size_t)row * D + col0 + bj * 128) = wv; } }
    }
};

__device__ __forceinline__ void p12_combine(Frame& F) {
    const int gw = (int)blockIdx.x * 8 + F.wave, NGW = F.G * 8, lane = F.lane;
    for (int r = gw; r < T; r += NGW) {
        const float* g2 = F.MOD + (size_t)(r >> 12) * 6144 + 5120;
        int sl[4];
#pragma unroll
        for (int k = 0; k < 4; ++k) sl[k] = F.TOKSLOT[r * 4 + k];
        f32x4 v[4]; float ss = 0.f;
#pragma unroll
        for (int j = 0; j < 4; ++j) { const int col = 4 * lane + 256 * j; f32x4 m = (f32x4){0.f, 0.f, 0.f, 0.f};
#pragma unroll
            for (int k = 0; k < 4; ++k) { const v2u y = *(const v2u*)(F.YS + (size_t)sl[k] * D + col); m.x += bflo(y.x); m.y += bfhi(y.x); m.z += bflo(y.y); m.w += bfhi(y.y); }
            v[j] = *(const f32x4*)(F.X1 + (size_t)r * D + col) + *(const f32x4*)(g2 + col) * m;
            ss += (v[j].x * v[j].x + v[j].y * v[j].y) + (v[j].z * v[j].z + v[j].w * v[j].w); }
        const float rs = 1.f / sqrtf(wave_sum(ss) * (1.f / D) + RMS_EPS);
#pragma unroll
        for (int j = 0; j < 4; ++j) { const int col = 4 * lane + 256 * j; *(f32x4*)(F.out + (size_t)r * D + col) = (v[j] * rs) * *(const f32x4*)(F.final_norm_w + col); }
    }
}

constexpr int NPHASE = 13;
struct Args { const float* in[25]; float* out; unsigned char* ws; int ph_lo, ph_hi; };
__global__ void __launch_bounds__(512, 2) mk_fwd(Args args) {
    extern __shared__ __attribute__((aligned(16))) unsigned char lds[];
    Frame F;
    F.lds = (LAS unsigned char*)lds;
    F.tid = threadIdx.x; F.lane = F.tid & 63; F.wave = __builtin_amdgcn_readfirstlane(F.tid >> 6); F.G = gridDim.x;
    unsigned char* ws = args.ws;
    F.ctl = (unsigned*)(ws + WS_CTL);
    F.x = args.in[0]; F.c = args.in[1]; F.ctx = args.in[2]; F.c_ctx = args.in[3]; F.w_mod = args.in[4]; F.b_mod = args.in[5]; F.norm1_w = args.in[6]; F.norm2_w = args.in[7];
    F.w_in = args.in[8]; F.conv_w = args.in[9]; F.conv_b = args.in[10]; F.dt_bias = args.in[11]; F.a_log = args.in[12]; F.d_skip = args.in[13]; F.ssd_norm_w = args.in[14];
    F.pool_w = args.in[15]; F.pool_scale = args.in[16]; F.w_out = args.in[17]; F.router_w = args.in[18]; F.router_b = args.in[19]; F.w1 = args.in[20]; F.b1 = args.in[21];
    F.w2 = args.in[22]; F.b2 = args.in[23]; F.final_norm_w = args.in[24]; F.out = args.out;
    F.MOD = (float*)(ws + WS_MOD); F.DTRAW = (float*)(ws + WS_DTRAW); F.DT = (float*)(ws + WS_DT); F.ROWSC = (float*)(ws + WS_ROWSC); F.CHS = (float*)(ws + WS_CHS); F.X1 = (float*)(ws + WS_X1);
    F.TOPG = (float*)(ws + WS_TOPG); F.SLOTGATE = (float*)(ws + WS_SLOTGATE); F.TOPE = (int*)(ws + WS_TOPE); F.TOPR = (int*)(ws + WS_TOPR); F.TOKSLOT = (int*)(ws + WS_TOKSLOT);
    F.SLOTTOK = (int*)(ws + WS_SLOTTOK); F.BB = (int*)(ws + WS_BB);
    F.WINT = (bf16*)(ws + WS_WINT); F.WOUTT = (bf16*)(ws + WS_WOUTT); F.W1T = (bf16*)(ws + WS_W1T); F.W2T = (bf16*)(ws + WS_W2T); F.A1 = (bf16*)(ws + WS_A1); F.XBCPRE = (bf16*)(ws + WS_XBCPRE);
    F.Z = (bf16*)(ws + WS_Z); F.V = (bf16*)(ws + WS_V); F.XBC = (bf16*)(ws + WS_XBC); F.ST = (bf16*)(ws + WS_ST); F.Y = (bf16*)(ws + WS_Y); F.YB = (bf16*)(ws + WS_YB);
    F.A2 = (bf16*)(ws + WS_A2); F.H2 = (bf16*)(ws + WS_H2); F.ACT = (bf16*)(ws + WS_ACT); F.YS = (bf16*)(ws + WS_YS);
    volatile LAS unsigned* MISC = (volatile LAS unsigned*)(F.lds + MISC_OFF);
    for (int u = F.tid; u < 64; u += 512) MISC[u] = 0u;
    __syncthreads();
    const int lo = args.ph_lo, hi = args.ph_hi;
    XcdBarrier bar; bar.bar = F.ctl + CW_BAR; bar.x = 0; bar.st = nullptr;
    if (hi - lo > 1) bar = xcd_barrier_post(F.ctl + CW_BAR, MISC + 8);
#define IN(k) (lo <= (k) && (k) < hi)
#define SEAM(k) do { if (IN(k) && IN((k) + 1)) xcd_barrier(bar); } while (0)
    if (IN(0)) { p0_prologue(F); } SEAM(0);
    if (IN(1)) { p1_norm1(F); } SEAM(1);
    if (IN(2)) { Sched1 S{(const char*)F.A1, (const char*)F.WINT, F.G, (int)blockIdx.x}; Epi1 E{F.XBCPRE, F.Z, F.V, F.DTRAW};
        pg8::gemm_phase<Epi1, Sched1, false>(F.lds, D, S, E); } SEAM(2);
    if (IN(3)) { p3_conv(F); } SEAM(3);
    if (IN(4)) { p4_ssd_local(F); } SEAM(4);
    if (IN(5)) { p5_ssd_scan(F); } SEAM(5);
    if (IN(6)) { p6_gate_pool(F); } SEAM(6);
    if (IN(7)) { Sched7 S{(const char*)F.A2, (const char*)F.WOUTT, F.G, (int)blockIdx.x}; Epi7 E{F.x, F.MOD, F.X1};
        pg8::gemm_phase<Epi7, Sched7, false>(F.lds, 2048, S, E); } SEAM(7);
    if (IN(8)) { p8_router(F); } SEAM(8);
    if (IN(9)) { p9_slots(F); } SEAM(9);
    if (IN(10)) { const int ntl = moe_tables(F);
        SchedMoe S{(const char*)F.H2, (const char*)F.W1T, F.SLOTTOK, (const LAS int*)(F.lds + TE_OFF), ntl, 8, F.G, (int)blockIdx.x, (size_t)2048 * D * 2, (size_t)256 * D * 2, (size_t)D * 2};
        Epi10 E{F.b1, F.ACT};
        pg8::gemm_phase<Epi10, SchedMoe, true>(F.lds, D, S, E); } SEAM(10);
    if (IN(11)) { const int ntl = moe_tables(F);
        SchedMoe S{(const char*)F.ACT, (const char*)F.W2T, nullptr, (const LAS int*)(F.lds + TE_OFF), ntl, 4, F.G, (int)blockIdx.x, (size_t)D * D * 2, (size_t)256 * D * 2, (size_t)D * 2};
        Epi11 E{F.b2, F.SLOTGATE, F.YS};
        pg8::gemm_phase<Epi11, SchedMoe, false>(F.lds, D, S, E); } SEAM(11);
    if (IN(12)) { p12_combine(F); }
#undef IN
#undef SEAM
}

extern "C" void kernel_launch(void* const* d_in, const int* in_sizes, int n_in, void* d_out, int out_size, void* d_ws, size_t ws_size, hipStream_t stream) {
    static int grid = 0;
    if (grid == 0) {
        if (n_in != 25 || out_size != T * D || ws_size < WS_END) { fprintf(stderr, "kernel_launch: unexpected shapes (n_in %d, out %d, ws %zu)\n", n_in, out_size, ws_size); grid = -1; return; }
        int dev = 0, cus = 0, per_cu = 0;
        if (hipGetDevice(&dev) != hipSuccess || hipDeviceGetAttribute(&cus, hipDeviceAttributeMultiprocessorCount, dev) != hipSuccess) { grid = -1; return; }
        if (hipFuncSetAttribute((const void*)mk_fwd, hipFuncAttributeMaxDynamicSharedMemorySize, LDS_BYTES) != hipSuccess) { fprintf(stderr, "kernel_launch: hipFuncSetAttribute failed\n"); grid = -1; return; }
        if (hipOccupancyMaxActiveBlocksPerMultiprocessor(&per_cu, (const void*)mk_fwd, 512, LDS_BYTES) != hipSuccess || per_cu < 1) { fprintf(stderr, "kernel_launch: occupancy query says %d\n", per_cu); }
        (void)hipGetLastError();
        grid = cus;
    }
    if (grid < 0) return;
    (void)hipMemsetAsync((char*)d_ws + WS_CTL, 0, CTL_ZERO_BYTES, stream);
    Args a{};
    for (int i = 0; i < 25; ++i) a.in[i] = (const float*)d_in[i];
    a.out = (float*)d_out; a.ws = (unsigned char*)d_ws;
#if MK_SPLIT
    for (int p = 0; p < NPHASE; ++p) { a.ph_lo = p; a.ph_hi = p + 1; hipLaunchKernelGGL(mk_fwd, dim3(grid), dim3(512), LDS_BYTES, stream, a); }
#else
    a.ph_lo = 0; a.ph_hi = NPHASE; hipLaunchKernelGGL(mk_fwd, dim3(grid), dim3(512), LDS_BYTES, stream, a);
#endif
}
```

```cpp
#include <hip/hip_runtime.h>
#include <cstdio>
#include <cstdint>

#ifndef MK_SPLIT
#define MK_SPLIT 0
#endif

#ifndef PROBE_PH
#define PROBE_PH -1
#endif

#define GAS __attribute__((address_space(1)))
#define LAS __attribute__((address_space(3)))
typedef unsigned short bf16;
typedef unsigned v4u __attribute__((ext_vector_type(4)));
typedef unsigned v2u __attribute__((ext_vector_type(2)));
typedef float f32x4 __attribute__((ext_vector_type(4)));
typedef float f32x2 __attribute__((ext_vector_type(2)));
typedef short bf16x8 __attribute__((ext_vector_type(8)));
typedef short s16x4 __attribute__((ext_vector_type(4)));
#define RLX_AGENT __ATOMIC_RELAXED, __HIP_MEMORY_SCOPE_AGENT
#define LDS_WAIT() asm volatile("s_waitcnt lgkmcnt(0)" ::: "memory")
#define VM_WAIT() asm volatile("s_waitcnt vmcnt(0)" ::: "memory")

__device__ __forceinline__ unsigned f2bf(float f) { unsigned u = __builtin_bit_cast(unsigned, f); return (u + 0x7fffu + ((u >> 16) & 1u)) >> 16; }
typedef __bf16 nbf16x2 __attribute__((ext_vector_type(2)));
__device__ __forceinline__ unsigned pk2(float lo, float hi) { const f32x2 v = {lo, hi}; return __builtin_bit_cast(unsigned, __builtin_convertvector(v, nbf16x2)); }
__device__ __forceinline__ float bflo(unsigned w) { return __builtin_bit_cast(float, w << 16); }
__device__ __forceinline__ float bfhi(unsigned w) { return __builtin_bit_cast(float, w & 0xffff0000u); }
__device__ __forceinline__ float silu_f(float v) { return v / (1.f + __expf(-v)); }
__device__ __forceinline__ float wave_sum(float v) {
#pragma unroll
    for (int o = 1; o < 64; o <<= 1) v += __shfl_xor(v, o);
    return v;
}

constexpr int D = 1024, NB = 8, SEQ = 4096, CTXL = 256, T = NB * SEQ, TC = NB * CTXL, RTOT = T + TC;
constexpr int CONV_CH = 2560, SSD_W = 1536, NH = 24, HDIM = 64, NGRP = 4, HPG = 6, NST = 128, CHUNK = 128;
constexpr int NCC = (CTXL + SEQ) / CHUNK;
constexpr int IN_COLS = 4656, N1 = 4864;
constexpr int NE = 32, TOPK = 4, DFF = 1024;
constexpr int MAX_TILES = (T * TOPK) / 256 + NE;
constexpr int MAX_SLOTS = MAX_TILES * 256;
constexpr float RMS_EPS = 1e-6f;

constexpr size_t MiB = 1u << 20;
constexpr size_t WS_CTL = 0, CTL_ZERO_BYTES = 1 * MiB;
constexpr size_t WS_MOD = 1 * MiB;
constexpr size_t WS_TOPE = 2 * MiB, WS_TOPG = WS_TOPE + 512 * 1024, WS_TOPR = WS_TOPG + 512 * 1024, WS_TOKSLOT = WS_TOPR + 512 * 1024;
constexpr size_t WS_SLOTTOK = 4 * MiB, WS_SLOTGATE = WS_SLOTTOK + 576 * 1024, WS_BB = WS_SLOTGATE + 576 * 1024, WS_CHS = WS_BB + 64 * 1024;
constexpr size_t WS_DTRAW = 6 * MiB;
constexpr size_t WS_DT = 15 * MiB;
constexpr size_t WS_ROWSC = 22 * MiB;
constexpr size_t WS_WINT = 32 * MiB, WS_WOUTT = 42 * MiB, WS_W1T = 46 * MiB, WS_W2T = 174 * MiB;
constexpr size_t WS_A = 240 * MiB;
constexpr size_t WS_A1 = WS_A, WS_XBCPRE = WS_A + 68 * MiB, WS_Z = WS_A + 238 * MiB, WS_V = WS_A + 334 * MiB, WS_XBC = WS_A + 366 * MiB;
constexpr size_t WS_ST = WS_A, WS_Y = WS_A + 536 * MiB, WS_YB = WS_A + 632 * MiB;
constexpr size_t WS_A2 = WS_XBC, WS_X1 = WS_A, WS_H2 = WS_A + 128 * MiB, WS_ACT = WS_A + 204 * MiB, WS_YS = WS_A + 476 * MiB;
constexpr size_t WS_END = WS_A + 748 * MiB;
static_assert(WS_END <= 1024 * MiB, "workspace map");
static_assert((size_t)RTOT * D * 2 <= 68 * MiB && (size_t)RTOT * CONV_CH * 2 <= 170 * MiB && (size_t)MAX_SLOTS * D * 2 <= 272 * MiB, "workspace map sizes");
static_assert((size_t)NB * NCC * NH * 2 * 8192 * 2 <= 204 * MiB, "ST size");
constexpr int CW_TMO = 0, CW_GCOUNT = 64  , CW_BAR = 4096;

constexpr int LDS_BYTES = 163840;
constexpr int MISC_OFF = LDS_BYTES - 256;
constexpr int TE_OFF = 131072;
constexpr int MOE_CNT_OFF = TE_OFF + 4096;

namespace pg8 {
constexpr int BM = 256, BK = 64, HALF = 128, HTB = HALF * BK * 2, STAGE_BYTES = 8 * HTB, NXCD = 8, WGM = 8;
__host__ __device__ __forceinline__ int lds_byte(int r, int c) { const int st = (r >> 4) * 2 + (c >> 5), rr = r & 15, cc = c & 31, ob = rr * 64 + cc * 2; return st * 1024 + (ob ^ (((ob >> 9) & 1) << 5)); }
__host__ __device__ __forceinline__ void stage_rc(int b, int& R, int& C) { const int st = b / 1024, sb = b % 1024, swz = sb ^ (((sb >> 9) & 1) << 5); R = (st >> 1) * 16 + swz / 64; C = (st & 1) * 32 + (swz % 64) / 2; }
__host__ __device__ __forceinline__ int perm32(int rho) { const int n = rho >> 4, i = rho & 15; return 8 * (i >> 2) + 4 * n + (i & 3); }
struct Unit { int pm, pn, e; };
__device__ __forceinline__ unsigned cvt_pk_bf16(float lo, float hi) { unsigned r; asm volatile("v_cvt_pk_bf16_f32 %0, %1, %2" : "=v"(r) : "v"(lo), "v"(hi)); return r; }

__device__ __forceinline__ void static_map(int wgid, int nM, int nN, int& pm, int& pn) {
    const int nwg = nM * nN;
    { const int q = nwg / NXCD, r = nwg % NXCD, xcd = wgid % NXCD, off = wgid / NXCD; wgid = (xcd < r ? xcd * (q + 1) : r * (q + 1) + (xcd - r) * q) + off; }
    const int nig = WGM * nN, gid = wgid / nig, fm = gid * WGM, gsz = (nM - fm) < WGM ? (nM - fm) : WGM;
    pm = fm + ((wgid % nig) % gsz); pn = (wgid % nig) / gsz;
}

template <class Epi, class Sched, bool GATHER, bool ALIGN_EPI = true>
__device__ __forceinline__ void gemm_phase(LAS unsigned char* lds, const int K, const Sched& S, const Epi& E) {
    const int tid = threadIdx.x, wid = __builtin_amdgcn_readfirstlane(tid >> 6), lane = tid & 63, wr = wid >> 2, wc = wid & 3, fr = lane & 15, fq = lane >> 4;
    const int nt = K / BK;
    unsigned voffB[2]; int RA[2], CA[2];
#pragma unroll
    for (int i = 0; i < 2; ++i) { int R, C; stage_rc(tid * 16 + i * 8192, R, C); const int Rb = Epi::PERM ? ((R & ~31) + perm32(R & 31)) : R;
        RA[i] = R; CA[i] = C; voffB[i] = (unsigned)(Rb * K + C) * 2u; }
    const size_t kstep = (size_t)(BK * 2);
    const size_t hstep = (size_t)HALF * K * 2;
    const unsigned ldsw = (unsigned)wid * 1024u;
    const int aoff = lds_byte(wr * 64 + fr, fq * 8), boff = lds_byte(wc * 32 + fr, fq * 8);
#define PG8_SA(b, h) (((b) * 2 + (h)) * HTB)
#define PG8_SB(b, h) ((4 + (b) * 2 + (h)) * HTB)
#define PG8_STAGE(bufoff, gbase, voff) do { _Pragma("unroll") for (int _i = 0; _i < 2; ++_i) \
        __builtin_amdgcn_global_load_lds((const unsigned*)((const char*)(gbase) + (voff)[_i]), (LAS unsigned*)(lds + (bufoff) + ldsw + _i * 8192), 16, 0, 0); } while (0)
#define PG8_LDA(dst, b, h) do { _Pragma("unroll") for (int m = 0; m < 4; ++m) _Pragma("unroll") for (int k = 0; k < 2; ++k) dst[m][k] = *(const LAS bf16x8*)(lds + PG8_SA(b, h) + aoff + m * 2048 + k * 1024); } while (0)
#define PG8_LDB(dst, b, h) do { _Pragma("unroll") for (int n = 0; n < 2; ++n) _Pragma("unroll") for (int k = 0; k < 2; ++k) dst[n][k] = *(const LAS bf16x8*)(lds + PG8_SB(b, h) + boff + n * 2048 + k * 1024); } while (0)
#define PG8_MMA(ai, bj, At, Bt) do { __builtin_amdgcn_s_setprio(1); _Pragma("unroll") for (int m = 0; m < 4; ++m) _Pragma("unroll") for (int n = 0; n < 2; ++n) _Pragma("unroll") for (int k = 0; k < 2; ++k) \
        acc[ai][bj][m][n] = __builtin_amdgcn_mfma_f32_16x16x32_bf16(Bt[n][k], At[m][k], acc[ai][bj][m][n], 0, 0, 0); __builtin_amdgcn_s_setprio(0); } while (0)
#define PG8_WAIT_V(n) asm volatile("s_waitcnt vmcnt(" #n ")" ::: "memory")
#define PG8_WAIT_L(n) asm volatile("s_waitcnt lgkmcnt(" #n ")" ::: "memory")
#define PG8_BAR __builtin_amdgcn_s_barrier()
#define PG8_SCHED __builtin_amdgcn_sched_barrier(0)
#define PG8_AOFFS(U, dst) do { _Pragma("unroll") for (int _h = 0; _h < 2; ++_h) _Pragma("unroll") for (int _i = 0; _i < 2; ++_i) { \
        if constexpr (GATHER) dst[_h][_i] = S.a_row(U, _h * HALF + RA[_i]) * (unsigned)(K * 2) + (unsigned)(CA[_i] * 2); \
        else dst[_h][_i] = (unsigned)((_h * HALF + RA[_i]) * K + CA[_i]) * 2u; } } while (0)
    Unit cur, nxt; int ui = 0;
    if (!S.next(0, cur)) return;
    f32x4 acc[2][2][4][2];
#pragma unroll
    for (int a = 0; a < 2; ++a)
#pragma unroll
        for (int b = 0; b < 2; ++b)
#pragma unroll
            for (int m = 0; m < 4; ++m)
#pragma unroll
                for (int n = 0; n < 2; ++n) acc[a][b][m][n] = (f32x4){0.f, 0.f, 0.f, 0.f};
    bf16x8 At[4][2], B0[2][2], B1[2][2];
    unsigned oc[2][2], on[2][2];
    const char* cA = S.a_base(cur); const char* cB = S.b_base(cur);
    PG8_AOFFS(cur, oc);
    PG8_STAGE(PG8_SB(0, 0), cB, voffB); PG8_STAGE(PG8_SB(0, 1), cB + hstep, voffB); PG8_STAGE(PG8_SA(0, 0), cA, oc[0]); PG8_STAGE(PG8_SA(0, 1), cA, oc[1]);
    if (wr == 1) PG8_BAR;
    PG8_WAIT_V(2); PG8_BAR;
    PG8_STAGE(PG8_SB(1, 0), cB + kstep, voffB); PG8_STAGE(PG8_SA(1, 0), cA + kstep, oc[0]); PG8_STAGE(PG8_SB(1, 1), cB + hstep + kstep, voffB);
    PG8_WAIT_V(6); PG8_BAR;
    for (;;) {
        const bool has_next = S.next(ui + 1, nxt);
        const char* nA = has_next ? S.a_base(nxt) : cA; const char* nB = has_next ? S.b_base(nxt) : cB;
#pragma unroll
        for (int h = 0; h < 2; ++h)
#pragma unroll
            for (int i = 0; i < 2; ++i) on[h][i] = oc[h][i];
        for (int t = 0; t < nt; t += 2) {
            const bool last = (t == nt - 2);
            if (last && has_next) { PG8_AOFFS(nxt, on); }
            const char* a1 = cA + (size_t)(t + 1) * kstep;
            const char* a2 = last ? nA : cA + (size_t)(t + 2) * kstep; const char* b2 = last ? nB : cB + (size_t)(t + 2) * kstep;
            const char* a3 = a2 + kstep; const char* b3 = b2 + kstep;
            unsigned o2[2][2];
#pragma unroll
            for (int h = 0; h < 2; ++h)
#pragma unroll
                for (int i = 0; i < 2; ++i) o2[h][i] = last ? on[h][i] : oc[h][i];
            PG8_LDB(B0, 0, 0); PG8_LDB(B1, 0, 1); PG8_SCHED; PG8_LDA(At, 0, 0); PG8_STAGE(PG8_SA(1, 1), a1, oc[1]);
            PG8_WAIT_V(8); PG8_WAIT_L(0); PG8_BAR; PG8_MMA(0, 0, At, B0); PG8_MMA(0, 1, At, B1); PG8_BAR; PG8_SCHED;
            PG8_LDA(At, 0, 1); PG8_STAGE(PG8_SB(0, 0), b2, voffB); PG8_STAGE(PG8_SB(0, 1), b2 + hstep, voffB); PG8_STAGE(PG8_SA(0, 0), a2, o2[0]);
            PG8_WAIT_V(8); PG8_WAIT_L(0); PG8_BAR; PG8_MMA(1, 0, At, B0); PG8_MMA(1, 1, At, B1); PG8_BAR; PG8_SCHED;
            PG8_LDB(B0, 1, 0); PG8_LDB(B1, 1, 1); PG8_SCHED; PG8_LDA(At, 1, 0); PG8_STAGE(PG8_SA(0, 1), a2, o2[1]);
            PG8_WAIT_V(8); PG8_WAIT_L(0); PG8_BAR; PG8_MMA(0, 0, At, B0); PG8_MMA(0, 1, At, B1); PG8_BAR; PG8_SCHED;
            PG8_LDA(At, 1, 1); PG8_STAGE(PG8_SB(1, 0), b3, voffB); PG8_STAGE(PG8_SB(1, 1), b3 + hstep, voffB); PG8_STAGE(PG8_SA(1, 0), a3, o2[0]);
            PG8_WAIT_V(8); PG8_WAIT_L(0); PG8_BAR; PG8_MMA(1, 0, At, B0); PG8_MMA(1, 1, At, B1); PG8_BAR; PG8_SCHED;
        }
        if constexpr (ALIGN_EPI) { if (wr == 0) PG8_BAR; }
        E(acc, cur, wr, wc, fr, fq);
        if (!has_next) break;
#pragma unroll
        for (int a = 0; a < 2; ++a)
#pragma unroll
            for (int b = 0; b < 2; ++b)
#pragma unroll
                for (int m = 0; m < 4; ++m)
#pragma unroll
                    for (int n = 0; n < 2; ++n) acc[a][b][m][n] = (f32x4){0.f, 0.f, 0.f, 0.f};
        cur = nxt; cA = nA; cB = nB; ++ui;
#pragma unroll
        for (int h = 0; h < 2; ++h)
#pragma unroll
            for (int i = 0; i < 2; ++i) oc[h][i] = on[h][i];
        if constexpr (ALIGN_EPI) { if (wr == 1) PG8_BAR; }
    }
    PG8_WAIT_V(0);
    if constexpr (!ALIGN_EPI) { if (wr == 0) PG8_BAR; }
    PG8_BAR;
#undef PG8_SA
#undef PG8_SB
#undef PG8_STAGE
#undef PG8_LDA
#undef PG8_LDB
#undef PG8_MMA
#undef PG8_WAIT_V
#undef PG8_WAIT_L
#undef PG8_BAR
#undef PG8_SCHED
#undef PG8_AOFFS
}
}

#define XB_TMO      128
#define XB_XCNT(j)  (256  + 64 * (j))
#define XB_XSUB(j)  (1280 + 64 * (j))
#define XB_XGEN(j)  (2304 + 64 * (j))
#define XB_TOP      3328
#define XB_TOPGEN   3392
#define XCD_BAR_WORDS 3456
#define XB_SPIN_CAP (1u << 18)
__device__ __forceinline__ unsigned xb_ld(unsigned* p)              { return __hip_atomic_load(p, __ATOMIC_RELAXED, __HIP_MEMORY_SCOPE_AGENT); }
__device__ __forceinline__ unsigned xb_add(unsigned* p, unsigned v) { return __hip_atomic_fetch_add(p, v, __ATOMIC_RELAXED, __HIP_MEMORY_SCOPE_AGENT); }
__device__ __forceinline__ unsigned xb_xcc_id() { return (unsigned)__builtin_amdgcn_s_getreg((3 << 11) | 20) & 0xFu; }
#define XB_SPIN(cond, bar) do { unsigned _sp = 0; while (cond) { __builtin_amdgcn_s_sleep(1); \
    if ((++_sp & 255u) == 0u) { if (xb_ld(&(bar)[XB_TMO])) break; if (_sp > XB_SPIN_CAP) { atomicAdd(&(bar)[XB_TMO], 1u); break; } } } } while (0)
struct XcdBarrier { unsigned* bar; unsigned x; volatile LAS unsigned* st; };
__device__ __forceinline__ XcdBarrier xcd_barrier_post(unsigned* bar, volatile LAS unsigned* st) {
    XcdBarrier b; b.bar = bar; b.x = xb_xcc_id(); b.st = st;
    if (threadIdx.x == 0) (void)xb_add(&bar[XB_XCNT(b.x)], 1u);
    return b;
}
__device__ __forceinline__ void xcd_barrier_complete(unsigned* bar, unsigned x, unsigned& nloc, unsigned& nx) {
    const unsigned G = gridDim.x * gridDim.y * gridDim.z;
    unsigned sum, cnt, mine, sp = 0u;
    for (;;) {
        sum = 0u; cnt = 0u; mine = 0u;
#pragma unroll
        for (unsigned j = 0; j < 16; ++j) { const unsigned c = xb_ld(&bar[XB_XCNT(j)]); sum += c; cnt += (c > 0u) ? 1u : 0u; mine = (j == x) ? c : mine; }
        if (sum == G) break;
        __builtin_amdgcn_s_sleep(1);
        if ((++sp & 255u) == 0u) { if (xb_ld(&bar[XB_TMO])) break; if (sp > XB_SPIN_CAP) { atomicAdd(&bar[XB_TMO], 1u); break; } }
    }
    nloc = mine > 0u ? mine : 1u; nx = cnt > 0u ? cnt : 1u;
}
__device__ __forceinline__ void xcd_barrier(const XcdBarrier& b) {
    asm volatile("s_waitcnt vmcnt(0)" ::: "memory");
    __syncthreads();
    if (threadIdx.x == 0) {
        unsigned* bar = b.bar;
        __builtin_amdgcn_s_waitcnt(0);
        unsigned nloc = b.st[0], nx = b.st[1];
        if (nloc == 0u) { xcd_barrier_complete(bar, b.x, nloc, nx); b.st[0] = nloc; b.st[1] = nx; }
        const unsigned old = xb_add(&bar[XB_XSUB(b.x)], 1u);
        const unsigned gen = old / nloc;
        if (old + 1u == (gen + 1u) * nloc) {
            __builtin_amdgcn_fence(__ATOMIC_RELEASE, "agent");
            asm volatile("s_waitcnt vmcnt(0)" ::: "memory");
            const unsigned og = xb_add(&bar[XB_TOP], 1u);
            const unsigned tg = og / nx;
            if (og + 1u == (tg + 1u) * nx) xb_add(&bar[XB_TOPGEN], 1u);
            else XB_SPIN(xb_ld(&bar[XB_TOPGEN]) == tg, bar);
            __builtin_amdgcn_fence(__ATOMIC_ACQUIRE, "agent");
            xb_add(&bar[XB_XGEN(b.x)], 1u);
            asm volatile("s_waitcnt vmcnt(0)" ::: "memory");
        } else {
            XB_SPIN(xb_ld(&bar[XB_XGEN(b.x)]) == gen, bar);
            __builtin_amdgcn_fence(__ATOMIC_ACQUIRE, "agent");
            asm volatile("s_waitcnt vmcnt(0)" ::: "memory");
        }
    }
    __syncthreads();
}

struct Frame {
    LAS unsigned char* lds;
    unsigned* ctl;
    int tid, lane, wave, G;
    const float *x, *c, *ctx, *c_ctx, *w_mod, *b_mod, *norm1_w, *norm2_w, *w_in, *conv_w, *conv_b, *dt_bias, *a_log, *d_skip, *ssd_norm_w, *pool_w, *pool_scale, *w_out, *router_w, *router_b, *w1, *b1, *w2, *b2, *final_norm_w;
    float* out;
    float *MOD, *DTRAW, *DT, *ROWSC, *CHS, *X1, *TOPG, *SLOTGATE;
    int *TOPE, *TOPR, *TOKSLOT, *SLOTTOK, *BB;
    bf16 *WINT, *WOUTT, *W1T, *W2T, *A1, *XBCPRE, *Z, *V, *XBC, *ST, *Y, *YB, *A2, *H2, *ACT, *YS;
};

template <class RowMap>
__device__ __forceinline__ void p0_emit(bf16* WT, int Kd, RowMap rm, int k0, int n0, int nvalid, LAS float* scr, int lane) {
    const int c = lane & 7;
#pragma unroll
    for (int j = 0; j < 4; ++j) { const int n = (lane >> 3) + 8 * j; const LAS float* s = scr + (8 * c) * 33 + n;
        v4u o; o.x = pk2(s[0 * 33], s[1 * 33]); o.y = pk2(s[2 * 33], s[3 * 33]); o.z = pk2(s[4 * 33], s[5 * 33]); o.w = pk2(s[6 * 33], s[7 * 33]);
        if (n0 + n < nvalid) *(v4u*)(WT + (size_t)rm(n0 + n) * Kd + k0 + 8 * c) = o; }
    LDS_WAIT(); asm volatile("" ::: "memory");
}
template <class RowMap>
__device__ __forceinline__ void p0_transpose_item(const float* W, int N, int nvalid, bf16* WT, int Kd, RowMap rm, LAS float* scr, int kb, int nb, int lane) {
    const int k0 = 64 * kb, n0 = 32 * nb, nn = n0 + (lane & 31); const bool ok = nn < nvalid;
    float tv[32];
#pragma unroll
    for (int i = 0; i < 32; ++i) { const int kk = 2 * i + (lane >> 5); tv[i] = ok ? W[(size_t)(k0 + kk) * N + nn] : 0.f; }
#pragma unroll
    for (int i = 0; i < 32; ++i) { const int kk = 2 * i + (lane >> 5); scr[kk * 33 + (lane & 31)] = tv[i]; }
    LDS_WAIT(); asm volatile("" ::: "memory");
    p0_emit(WT, Kd, rm, k0, n0, nvalid, scr, lane);
}
struct RmId { __device__ __forceinline__ int operator()(int n) const { return n; } };
struct RmOff { int off; __device__ __forceinline__ int operator()(int n) const { return n + off; } };
struct RmWin { __device__ __forceinline__ int operator()(int n) const { return n < 2560 ? n : (n < 2608 ? 4608 + (n - 2560) : 2560 + (n - 2608)); } };
struct RmW1 { __device__ __forceinline__ int operator()(int n) const { const int j = n >> 1; return 256 * (j >> 7) + 128 * (n & 1) + (j & 127); } };

__device__ __forceinline__ void p0_prologue(Frame& F) {
    if ((int)blockIdx.x < 96) {
        LAS float* sc = (LAS float*)F.lds;
        LAS float* part = (LAS float*)(F.lds + 36864);
        for (int idx = F.tid; idx < 9 * 1024; idx += 512) { const int r = idx >> 10, k = idx & 1023; const float v = (r < 8) ? F.c[r * 1024 + k] : F.c_ctx[k]; sc[idx] = silu_f(v); }
        __syncthreads();
        const int n = 64 * (int)blockIdx.x + F.lane, kb = 128 * F.wave;
        float acc[9];
#pragma unroll
        for (int r = 0; r < 9; ++r) acc[r] = 0.f;
#pragma unroll 8
        for (int k = 0; k < 128; ++k) { const float wv = F.w_mod[(size_t)(kb + k) * 6144 + n];
#pragma unroll
            for (int r = 0; r < 9; ++r) acc[r] += sc[r * 1024 + kb + k] * wv; }
#pragma unroll
        for (int r = 0; r < 9; ++r) part[(F.wave * 9 + r) * 64 + F.lane] = acc[r];
        __syncthreads();
        for (int idx = F.tid; idx < 9 * 64; idx += 512) { const int r = idx >> 6, col = idx & 63; float s = 0.f;
#pragma unroll
            for (int w = 0; w < 8; ++w) s += part[(w * 9 + r) * 64 + col];
            F.MOD[r * 6144 + 64 * (int)blockIdx.x + col] = s + F.b_mod[64 * (int)blockIdx.x + col]; }
        __syncthreads();
    }
    LAS float* scr = (LAS float*)(F.lds + F.wave * 16384);
    const int gw = (int)blockIdx.x * 8 + F.wave, NGW = F.G * 8, lane = F.lane;
    constexpr int I_POOL = 16 * 4 * 4, I_PAD = N1 - IN_COLS;
    for (int r = NGW - 1 - gw; r < I_POOL + I_PAD; r += NGW) {
        if (r < I_POOL) {
            const int kb = r >> 4, g = (r >> 2) & 3, ob = r & 3, k = 64 * kb + lane, o0 = 32 * ob;
            float acc[32];
#pragma unroll
            for (int o = 0; o < 32; ++o) acc[o] = 0.f;
            const float* arow = F.w_in + (size_t)k * IN_COLS + 4144 + g * 128;
            for (int i = 0; i < 128; ++i) { const float a = arow[i]; const float* pw = F.pool_w + (size_t)(g * 128 + i) * 128 + o0;
#pragma unroll
                for (int o = 0; o < 32; ++o) acc[o] += a * pw[o]; }
#pragma unroll
            for (int o = 0; o < 32; ++o) scr[lane * 33 + o] = acc[o] * F.pool_scale[g * 128 + o0 + o];
            LDS_WAIT(); asm volatile("" ::: "memory");
            p0_emit(F.WINT, D, RmOff{4096 + g * 128}, 64 * kb, o0, 1 << 30, scr, lane);
        } else { v4u z = {0u, 0u, 0u, 0u}; v4u* p = (v4u*)(F.WINT + (size_t)(IN_COLS + (r - I_POOL)) * D); p[lane] = z; p[lane + 64] = z; }
    }
    constexpr int I_WIN = 16 * 130, I_WOUT = 32 * 32, I_W1 = 32 * 16 * 64, I_W2 = 32 * 16 * 32, NI = I_WIN + I_WOUT + I_W1 + I_W2;
    const bool wdeal = (F.G == 256);
    const int blk = (int)blockIdx.x;
#define P0_ITEM(k) (wdeal ? ((k) < 20 ? (k) * 2048 + gw : ((k) < 27 ? (blk >= 96 ? 40960 + ((k) - 20) * 1280 + (gw - 768) : -1) : ((k) < 30 ? ((blk >= 96 && blk < 198) ? 49920 + ((k) - 27) * 816 + (gw - 768) : -1) : -1))) : (k) * NGW + gw)
    const int nrounds = wdeal ? 30 : (NI + NGW - 1) / NGW;
    struct It { const float* src; bf16* dst; int N, nvalid, Kd, kind, k0, n0; };
#define P0_DECODE(it, I) do { int r_ = (it); \
        if (r_ < I_WIN) { I.src = F.w_in; I.dst = F.WINT; I.N = IN_COLS; I.nvalid = 4144; I.Kd = D; I.kind = 1; I.k0 = 64 * (r_ / 130); I.n0 = 32 * (r_ % 130); } \
        else if ((r_ -= I_WIN) < I_WOUT) { I.src = F.w_out; I.dst = F.WOUTT; I.N = D; I.nvalid = D; I.Kd = 2048; I.kind = 0; I.k0 = 64 * (r_ >> 5); I.n0 = 32 * (r_ & 31); } \
        else if ((r_ -= I_WOUT) < I_W1) { const int e_ = r_ >> 10, q_ = r_ & 1023; I.src = F.w1 + (size_t)e_ * D * 2048; I.dst = F.W1T + (size_t)e_ * 2048 * D; I.N = 2048; I.nvalid = 2048; I.Kd = D; I.kind = 2; I.k0 = 64 * (q_ >> 6); I.n0 = 32 * (q_ & 63); } \
        else { r_ -= I_W1; const int e_ = r_ >> 9, q_ = r_ & 511; I.src = F.w2 + (size_t)e_ * D * D; I.dst = F.W2T + (size_t)e_ * D * D; I.N = D; I.nvalid = D; I.Kd = D; I.kind = 0; I.k0 = 64 * (q_ >> 5); I.n0 = 32 * (q_ & 31); } } while (0)
#define P0_LOAD(I, tv) do { const int nn_ = I.n0 + (lane & 31); const bool ok_ = nn_ < I.nvalid; const float* sp_ = I.src + (size_t)(I.k0 + (lane >> 5)) * I.N + nn_; \
        _Pragma("unroll") for (int i_ = 0; i_ < 32; ++i_) tv[i_] = ok_ ? sp_[(size_t)(2 * i_) * I.N] : 0.f; } while (0)
    It cur{}; float tv[32]; int itc = -1; int kr = 0;
    for (; kr < nrounds && itc < 0; ++kr) { const int it = P0_ITEM(kr); if (it >= 0 && it < NI) itc = it; }
    if (itc >= 0) { P0_DECODE(itc, cur); P0_LOAD(cur, tv); }
    while (itc >= 0) {
        int itn = -1; It nx{}; float tn[32];
        for (; kr < nrounds && itn < 0; ++kr) { const int it = P0_ITEM(kr); if (it >= 0 && it < NI) itn = it; }
        if (itn >= 0) { P0_DECODE(itn, nx); P0_LOAD(nx, tn); }
#pragma unroll
        for (int i = 0; i < 32; ++i) { const int kk = 2 * i + (lane >> 5); scr[kk * 33 + (lane & 31)] = tv[i]; }
        LDS_WAIT(); asm volatile("" ::: "memory");
        { const int c = lane & 7;
#pragma unroll
          for (int j = 0; j < 4; ++j) { const int n = (lane >> 3) + 8 * j; const LAS float* sq = scr + (8 * c) * 33 + n;
            v4u o; o.x = pk2(sq[0 * 33], sq[1 * 33]); o.y = pk2(sq[2 * 33], sq[3 * 33]); o.z = pk2(sq[4 * 33], sq[5 * 33]); o.w = pk2(sq[6 * 33], sq[7 * 33]);
            const int ng = cur.n0 + n; const int row = cur.kind == 0 ? ng : (cur.kind == 1 ? RmWin{}(ng) : RmW1{}(ng));
            if (ng < cur.nvalid) *(v4u*)(cur.dst + (size_t)row * cur.Kd + cur.k0 + 8 * c) = o; }
          LDS_WAIT(); asm volatile("" ::: "memory"); }
        itc = itn; cur = nx;
#pragma unroll
        for (int i = 0; i < 32; ++i) tv[i] = tn[i];
    }
#undef P0_ITEM
#undef P0_DECODE
#undef P0_LOAD
}

__device__ __forceinline__ void p1_norm1(Frame& F) {
    const int gw = (int)blockIdx.x * 8 + F.wave, NGW = F.G * 8, lane = F.lane;
    for (int rq = gw; rq < RTOT / 4; rq += NGW) {
        f32x4 v[4][4];
#pragma unroll
        for (int k = 0; k < 4; ++k) { const int r = rq * 4 + k; const float* xr = (r < T) ? F.x + (size_t)r * D : F.ctx + (size_t)(r - T) * D;
#pragma unroll
            for (int j = 0; j < 4; ++j) v[k][j] = *(const f32x4*)(xr + 4 * lane + 256 * j); }
#pragma unroll
        for (int k = 0; k < 4; ++k) { const int r = rq * 4 + k;
            const float* mod = F.MOD + (size_t)((r < T) ? (r >> 12) : 8) * 6144;
            float ss = 0.f;
#pragma unroll
            for (int j = 0; j < 4; ++j) ss += (v[k][j].x * v[k][j].x + v[k][j].y * v[k][j].y) + (v[k][j].z * v[k][j].z + v[k][j].w * v[k][j].w);
            const float rs = 1.f / sqrtf(wave_sum(ss) * (1.f / D) + RMS_EPS);
#pragma unroll
            for (int j = 0; j < 4; ++j) { const int col = 4 * lane + 256 * j;
                const f32x4 w = *(const f32x4*)(F.norm1_w + col), sh = *(const f32x4*)(mod + col), sc = *(const f32x4*)(mod + 1024 + col);
                const f32x4 h = (v[k][j] * rs) * w * (sc + 1.f) + sh;
                v2u o; o.x = pk2(h.x, h.y); o.y = pk2(h.z, h.w);
                *(v2u*)(F.A1 + (size_t)r * D + col) = o; } }
    }
}

struct Sched1 {
    const char* A; const char* Bt; int G, c;
    __device__ __forceinline__ bool next(int i, pg8::Unit& u) const {
        const int L = i * G + c; if (L >= 2432 + 88) return false;
        if (L < 2432) pg8::static_map(L, 128, 19, u.pm, u.pn);
        else { const int Lc = L - 2432, j = Lc >> 3; u.pm = 128 + (Lc & 7); u.pn = j < 10 ? j : 18; }
        u.e = 0; return true; }
    __device__ __forceinline__ const char* a_base(const pg8::Unit& u) const { return A + (size_t)u.pm * 256 * D * 2; }
    __device__ __forceinline__ const char* b_base(const pg8::Unit& u) const { return Bt + (size_t)u.pn * 256 * D * 2; }
    __device__ __forceinline__ unsigned a_row(const pg8::Unit&, int) const { return 0u; }
};
struct Epi1 {
    static constexpr bool PERM = true;
    bf16 *XBCPRE, *Z, *V; float* DTRAW;
    __device__ __forceinline__ void operator()(const f32x4 (&acc)[2][2][4][2], const pg8::Unit& u, int wr, int wc, int fr, int fq) const {
        const int row0 = u.pm * 256 + wr * 64 + fr;
        if (u.pn < 18) {
            bf16* base; int ldc, colt;
            if (u.pn < 10) { base = XBCPRE; ldc = CONV_CH; colt = u.pn * 256; } else if (u.pn < 16) { base = Z; ldc = SSD_W; colt = (u.pn - 10) * 256; } else { base = V; ldc = 512; colt = (u.pn - 16) * 256; }
            const int col0 = colt + wc * 32 + 8 * fq;
#pragma unroll
            for (int ai = 0; ai < 2; ++ai)
#pragma unroll
                for (int m = 0; m < 4; ++m) { bf16* rowp = base + (size_t)(row0 + ai * 128 + m * 16) * ldc + col0;
#pragma unroll
                    for (int bj = 0; bj < 2; ++bj) { const f32x4 v0 = acc[ai][bj][m][0], v1 = acc[ai][bj][m][1];
                        v4u w; w.x = pg8::cvt_pk_bf16(v0[0], v0[1]); w.y = pg8::cvt_pk_bf16(v0[2], v0[3]); w.z = pg8::cvt_pk_bf16(v1[0], v1[1]); w.w = pg8::cvt_pk_bf16(v1[2], v1[3]);
                        *(v4u*)(rowp + bj * 128) = w; } }
        } else if (wc < 2) {
            const int col0 = wc * 32 + 8 * fq;
#pragma unroll
            for (int ai = 0; ai < 2; ++ai)
#pragma unroll
                for (int m = 0; m < 4; ++m) { float* rowp = DTRAW + (size_t)(row0 + ai * 128 + m * 16) * 64 + col0;
                    *(f32x4*)(rowp) = acc[ai][0][m][0]; *(f32x4*)(rowp + 4) = acc[ai][0][m][1]; }
        }
    }
};

__device__ __forceinline__ void p3_conv(Frame& F) {
    const int gt = (int)blockIdx.x * 512 + F.tid, NT_ = F.G * 512;
    constexpr int RPT = 16, NTASK = (RTOT / RPT) * 320;
    for (int task = gt; task < NTASK; task += NT_) {
        const int rt = task / 320, cg = task - rt * 320, r0 = rt * RPT, ch = cg * 8;
        int slo, shi; if (r0 < T) { slo = r0 & ~(SEQ - 1); shi = slo + SEQ; } else { slo = T + ((r0 - T) & ~(CTXL - 1)); shi = slo + CTXL; }
        const v4u zero = {0u, 0u, 0u, 0u};
        v4u win[RPT + 4];
#pragma unroll
        for (int j = 0; j < RPT + 4; ++j) { const int r = r0 - 2 + j; win[j] = (r >= slo && r < shi) ? *(const v4u*)(F.XBCPRE + (size_t)r * CONV_CH + ch) : zero; }
        float w[5][8], bias[8];
#pragma unroll
        for (int j = 0; j < 5; ++j) { const f32x4 a = *(const f32x4*)(F.conv_w + j * CONV_CH + ch), b = *(const f32x4*)(F.conv_w + j * CONV_CH + ch + 4);
            w[j][0] = a.x; w[j][1] = a.y; w[j][2] = a.z; w[j][3] = a.w; w[j][4] = b.x; w[j][5] = b.y; w[j][6] = b.z; w[j][7] = b.w; }
        { const f32x4 a = *(const f32x4*)(F.conv_b + ch), b = *(const f32x4*)(F.conv_b + ch + 4); bias[0] = a.x; bias[1] = a.y; bias[2] = a.z; bias[3] = a.w; bias[4] = b.x; bias[5] = b.y; bias[6] = b.z; bias[7] = b.w; }
#pragma unroll
        for (int i = 0; i < RPT; ++i) {
            float o[8];
#pragma unroll
            for (int e = 0; e < 8; ++e) o[e] = bias[e];
#pragma unroll
            for (int j = 0; j < 5; ++j) { const v4u q = win[i + j];
                o[0] += w[j][0] * bflo(q.x); o[1] += w[j][1] * bfhi(q.x); o[2] += w[j][2] * bflo(q.y); o[3] += w[j][3] * bfhi(q.y);
                o[4] += w[j][4] * bflo(q.z); o[5] += w[j][5] * bfhi(q.z); o[6] += w[j][6] * bflo(q.w); o[7] += w[j][7] * bfhi(q.w); }
            v4u ov; ov.x = pk2(silu_f(o[0]), silu_f(o[1])); ov.y = pk2(silu_f(o[2]), silu_f(o[3])); ov.z = pk2(silu_f(o[4]), silu_f(o[5])); ov.w = pk2(silu_f(o[6]), silu_f(o[7]));
            *(v4u*)(F.XBC + (size_t)(r0 + i) * CONV_CH + ch) = ov;
        }
    }
    for (int idx = gt; idx < RTOT * 48; idx += NT_) { const int r = idx / 48, j = idx - r * 48; const float v = F.DTRAW[(size_t)r * 64 + j] + F.dt_bias[j];
        F.DT[idx] = v > 20.f ? v : log1pf(__expf(v)); }
}

__device__ __forceinline__ bf16x8 frag_row(const LAS unsigned char* base, int rs, int row, int k0, int q) { return *(const LAS bf16x8*)(base + row * rs + (k0 + 8 * q) * 2); }
__device__ __forceinline__ bf16x8 frag_tr(const LAS unsigned char* base, int rs, int k0, int c0, int lane) {
    const int g = lane >> 4, qq = (lane & 15) >> 2, p = lane & 3;
    const LAS unsigned char* a = base + (k0 + 8 * g + qq) * rs + c0 * 2 + 8 * p;
    const s16x4 lo = __builtin_amdgcn_ds_read_tr16_b64_v4i16((LAS s16x4*)a);
    const s16x4 hi = __builtin_amdgcn_ds_read_tr16_b64_v4i16((LAS s16x4*)(a + 4 * rs));
    bf16x8 r; r[0] = lo[0]; r[1] = lo[1]; r[2] = lo[2]; r[3] = lo[3]; r[4] = hi[0]; r[5] = hi[1]; r[6] = hi[2]; r[7] = hi[3]; return r;
}
__device__ __forceinline__ f32x4 mfma16(bf16x8 a, bf16x8 b, f32x4 c) { return __builtin_amdgcn_mfma_f32_16x16x32_bf16(a, b, c, 0, 0, 0); }
__device__ __forceinline__ float wave_incl_scan(float v, int lane) {
#pragma unroll
    for (int o = 1; o < 64; o <<= 1) { const float t = __shfl_up(v, o); if (lane >= o) v += t; }
    return v;
}

__device__ __forceinline__ void p4_scan(Frame& F, LAS float* Te, int d, int h, float dt0, float dt1, int lane, size_t chs_idx, float* rowsc) {
    const int s0 = d ? 127 - 2 * lane : 2 * lane, s1 = d ? s0 - 1 : s0 + 1;
    const float A2 = __expf(F.a_log[d * NH + h]) * 1.44269504f;
    const float a0 = -A2 * dt0, a1 = -A2 * dt1;
    const float incl = wave_incl_scan(a0 + a1, lane);
    const float c1 = incl, c0 = incl - a1, tot = __shfl(incl, 63);
    Te[d * 128 + s0] = c0; Te[d * 128 + s1] = c1;
    Te[(2 + d) * 128 + s0] = dt0; Te[(2 + d) * 128 + s1] = dt1;
    Te[(4 + d) * 128 + s0] = dt0 * __builtin_amdgcn_exp2f(tot - c0); Te[(4 + d) * 128 + s1] = dt1 * __builtin_amdgcn_exp2f(tot - c1);
    if (lane == 63) F.CHS[chs_idx] = tot;
    if (rowsc) { rowsc[s0] = __builtin_amdgcn_exp2f(c0); rowsc[s1] = __builtin_amdgcn_exp2f(c1); }
}
__device__ __forceinline__ void p4_states(Frame& F, const LAS unsigned char* Bs, const LAS float* Te, const LAS unsigned char* Xs, size_t st_base  , int w, int lane) {
    constexpr int RS = 272, RSX = 144;
    const int i16 = lane & 15, q4 = lane >> 4;
#pragma unroll
    for (int d = 0; d < 2; ++d) {
        f32x4 sa[4];
#pragma unroll
        for (int pt = 0; pt < 4; ++pt) sa[pt] = (f32x4){0.f, 0.f, 0.f, 0.f};
#pragma unroll
        for (int ks = 0; ks < 4; ++ks) { const bf16x8 braw = frag_tr(Bs, RS, 32 * ks, 16 * w, lane);
            const LAS float* wg = Te + (4 + d) * 128 + 32 * ks + 8 * q4;
            const f32x4 w0 = *(const LAS f32x4*)wg, w1 = *(const LAS f32x4*)(wg + 4);
            const v4u bu = __builtin_bit_cast(v4u, braw); v4u su;
            su.x = pk2(bflo(bu.x) * w0[0], bfhi(bu.x) * w0[1]); su.y = pk2(bflo(bu.y) * w0[2], bfhi(bu.y) * w0[3]);
            su.z = pk2(bflo(bu.z) * w1[0], bfhi(bu.z) * w1[1]); su.w = pk2(bflo(bu.w) * w1[2], bfhi(bu.w) * w1[3]);
            const bf16x8 bs = __builtin_bit_cast(bf16x8, su);
#pragma unroll
            for (int pt = 0; pt < 4; ++pt) sa[pt] = mfma16(bs, frag_tr(Xs, RSX, 32 * ks, 16 * pt, lane), sa[pt]); }
        bf16* sp = F.ST + st_base + ((size_t)d * HDIM + i16) * NST + 16 * w + 4 * q4;
#pragma unroll
        for (int pt = 0; pt < 4; ++pt) { v2u o; o.x = pk2(sa[pt][0], sa[pt][1]); o.y = pk2(sa[pt][2], sa[pt][3]); *(v2u*)(sp + (size_t)16 * pt * NST) = o; }
    }
}
__device__ __forceinline__ void p4_ssd_local(Frame& F) {
    constexpr int RS = 272, RSX = 144;
    constexpr int O_C = 0, O_B = 34816, O_M = 69632, O_X = 104448  , O_T = 141312;
    static_assert(O_T + 18432 <= MISC_OFF, "P4 LDS map");
    LAS unsigned char* L = F.lds;
    LAS float* TAB = (LAS float*)(L + O_T);
    const int tid = F.tid, lane = F.lane, w = F.wave, i16 = lane & 15, q4 = lane >> 4;
    const int lb = 64 * (w & 1), sb = 32 * (w >> 1);
    constexpr int NLAT = NB * 32 * NGRP;
    v4u pb[4], pc[4], px[2]; float pdt[2][2];
    const unsigned offBC = (unsigned)((tid >> 4) * (CONV_CH * 2) + (tid & 15) * 16), offX = (unsigned)((tid >> 3) * (CONV_CH * 2) + (tid & 7) * 16);
    const unsigned ldsBC = (unsigned)((tid >> 4) * RS + (tid & 15) * 16), ldsX = (unsigned)((tid >> 3) * RSX + (tid & 7) * 16);
#define P4_ISSUE(uu) do { const int b_ = (uu) >> 7, c_ = ((uu) >> 2) & 31, g_ = (uu) & 3, r0_ = b_ * SEQ + c_ * CHUNK; \
        const char* ub_ = (const char*)F.XBC + (size_t)r0_ * (CONV_CH * 2) + (SSD_W + g_ * NST) * 2; \
        _Pragma("unroll") for (int k = 0; k < 4; ++k) { pb[k] = *(const v4u*)(ub_ + (size_t)k * 32 * CONV_CH * 2 + offBC); pc[k] = *(const v4u*)(ub_ + (size_t)k * 32 * CONV_CH * 2 + NGRP * NST * 2 + offBC); } \
        const char* ux_ = (const char*)F.XBC + (size_t)r0_ * (CONV_CH * 2) + (g_ * HPG) * HDIM * 2; \
        _Pragma("unroll") for (int k = 0; k < 2; ++k) px[k] = *(const v4u*)(ux_ + (size_t)k * 64 * CONV_CH * 2 + offX); \
        _Pragma("unroll") for (int ii = 0; ii < 2; ++ii) { const int idx = w + 8 * ii; if (idx < 12) { const int e_ = idx % 6, d_ = idx / 6, h_ = g_ * HPG + e_; const int s0 = d_ ? 127 - 2 * lane : 2 * lane, s1 = d_ ? s0 - 1 : s0 + 1; \
            pdt[ii][0] = F.DT[(size_t)(r0_ + s0) * 48 + d_ * NH + h_]; pdt[ii][1] = F.DT[(size_t)(r0_ + s1) * 48 + d_ * NH + h_]; } } } while (0)
    for (int u = (int)blockIdx.x; u < NLAT; u += F.G) {
        P4_ISSUE(u);
        const int b = u >> 7, c = (u >> 2) & 31, g = u & 3, r0 = b * SEQ + c * CHUNK, cc = c + 2;
#pragma unroll
        for (int k = 0; k < 4; ++k) { *(LAS v4u*)(L + O_B + k * 32 * RS + ldsBC) = pb[k]; *(LAS v4u*)(L + O_C + k * 32 * RS + ldsBC) = pc[k]; }
#pragma unroll
        for (int ii = 0; ii < 2; ++ii) { const int idx = w + 8 * ii; if (idx < 12) { const int e = idx % 6, d = idx / 6, h = g * HPG + e;
            p4_scan(F, TAB + e * 768, d, h, pdt[ii][0], pdt[ii][1], lane, ((size_t)(b * NCC + cc) * NH + h) * 2 + d, F.ROWSC + ((size_t)(b * 2 + d) * NH + h) * SEQ + c * CHUNK); } }
        __syncthreads();
        f32x4 cb[2][4];
#pragma unroll
        for (int ts = 0; ts < 2; ++ts)
#pragma unroll
            for (int tl = 0; tl < 4; ++tl) cb[ts][tl] = (f32x4){0.f, 0.f, 0.f, 0.f};
#pragma unroll
        for (int ks = 0; ks < 4; ++ks) { bf16x8 af[2], bfr[4];
#pragma unroll
            for (int ts = 0; ts < 2; ++ts) af[ts] = frag_row(L + O_B, RS, sb + 16 * ts + i16, 32 * ks, q4);
#pragma unroll
            for (int tl = 0; tl < 4; ++tl) bfr[tl] = frag_row(L + O_C, RS, lb + 16 * tl + i16, 32 * ks, q4);
#pragma unroll
            for (int ts = 0; ts < 2; ++ts)
#pragma unroll
                for (int tl = 0; tl < 4; ++tl) cb[ts][tl] = mfma16(af[ts], bfr[tl], cb[ts][tl]); }
        for (int e = 0; e < HPG; ++e) {
            const int h = g * HPG + e;
            const LAS float* Te = TAB + e * 768;
            LAS unsigned char* Xs = L + O_X + (e & 1) * 18432;
            LAS unsigned char* Ms = L + ((e & 1) ? O_C : O_M);
#pragma unroll
            for (int k = 0; k < 2; ++k) *(LAS v4u*)(Xs + k * 64 * RSX + ldsX) = px[k];
            if (e < HPG - 1) { const char* ux = (const char*)F.XBC + (size_t)r0 * (CONV_CH * 2) + (h + 1) * HDIM * 2;
#pragma unroll
                for (int k = 0; k < 2; ++k) px[k] = *(const v4u*)(ux + (size_t)k * 64 * CONV_CH * 2 + offX);
            }
            {
                const float Dh = F.d_skip[h];
#pragma unroll
                for (int tl = 0; tl < 4; ++tl) { const int l = lb + 16 * tl + i16; const int lt_abs = 4 * (w & 1) + tl; const float af_l = Te[l], rb_l = Te[128 + l];
#pragma unroll
                    for (int ts = 0; ts < 2; ++ts) { const int s0 = sb + 16 * ts + 4 * q4; const int st_abs = 2 * (w >> 1) + ts;
                        float m[4];
                        if (st_abs < lt_abs) {
                            const f32x4 acs = *(const LAS f32x4*)(Te + s0), dtf = *(const LAS f32x4*)(Te + 256 + s0);
#pragma unroll
                            for (int r = 0; r < 4; ++r) m[r] = cb[ts][tl][r] * (__builtin_amdgcn_exp2f(af_l - acs[r]) * dtf[r]);
                        } else if (st_abs > lt_abs) {
                            const f32x4 rbs = *(const LAS f32x4*)(Te + 128 + s0), dtb = *(const LAS f32x4*)(Te + 384 + s0);
#pragma unroll
                            for (int r = 0; r < 4; ++r) m[r] = cb[ts][tl][r] * (__builtin_amdgcn_exp2f(rb_l - rbs[r]) * dtb[r]);
                        } else {
                            const f32x4 acs = *(const LAS f32x4*)(Te + s0), rbs = *(const LAS f32x4*)(Te + 128 + s0), dtf = *(const LAS f32x4*)(Te + 256 + s0), dtb = *(const LAS f32x4*)(Te + 384 + s0);
#pragma unroll
                            for (int r = 0; r < 4; ++r) { const int sidx = s0 + r;
                                const float wf = (sidx <= l) ? __builtin_amdgcn_exp2f(af_l - acs[r]) * dtf[r] : 0.f;
                                const float wb = (sidx >= l) ? __builtin_amdgcn_exp2f(rb_l - rbs[r]) * dtb[r] : 0.f;
                                m[r] = cb[ts][tl][r] * (wf + wb) + ((sidx == l) ? Dh : 0.f); }
                        }
                        v2u o; o.x = pk2(m[0], m[1]); o.y = pk2(m[2], m[3]);
                        *(LAS v2u*)(Ms + l * RS + s0 * 2) = o; } }
            }
            __syncthreads();
            {
                f32x4 ya[4];
#pragma unroll
                for (int pt = 0; pt < 4; ++pt) ya[pt] = (f32x4){0.f, 0.f, 0.f, 0.f};
#pragma unroll
                for (int ks = 0; ks < 4; ++ks) { const bf16x8 bm = frag_row(Ms, RS, 16 * w + i16, 32 * ks, q4);
#pragma unroll
                    for (int pt = 0; pt < 4; ++pt) ya[pt] = mfma16(frag_tr(Xs, RSX, 32 * ks, 16 * pt, lane), bm, ya[pt]); }
                bf16* yp = F.Y + (size_t)(r0 + 16 * w + i16) * SSD_W + h * HDIM + 4 * q4;
#pragma unroll
                for (int pt = 0; pt < 4; ++pt) { v2u o; o.x = pk2(ya[pt][0], ya[pt][1]); o.y = pk2(ya[pt][2], ya[pt][3]); *(v2u*)(yp + 16 * pt) = o; }
            }
            p4_states(F, L + O_B, Te, Xs, (((size_t)(b * NCC + cc) * NH + h) * 2) * HDIM * NST, w, lane);
        }
        __syncthreads();
    }
#undef P4_ISSUE
    for (int v = (int)blockIdx.x; v < NB * 2 * NGRP * HPG; v += F.G) {
        const int e = v % HPG; int t = v / HPG; const int g = t & 3; t >>= 2; const int cc = t & 1, b = t >> 1, h = g * HPG + e;
        const int r0 = T + b * CTXL + cc * CHUNK;
        LAS float* Te = TAB;
#pragma unroll
        for (int k = 0; k < 4; ++k) { const int pc_ = tid + 512 * k, row = pc_ >> 4, ch = pc_ & 15; *(LAS v4u*)(L + O_B + row * RS + ch * 16) = *(const v4u*)(F.XBC + (size_t)(r0 + row) * CONV_CH + SSD_W + g * NST + ch * 8); }
#pragma unroll
        for (int k = 0; k < 2; ++k) { const int pc_ = tid + 512 * k, row = pc_ >> 3, ch = pc_ & 7; *(LAS v4u*)(L + O_X + row * RSX + ch * 16) = *(const v4u*)(F.XBC + (size_t)(r0 + row) * CONV_CH + h * HDIM + ch * 8); }
        if (w < 2) { const int d = w; const int s0 = d ? 127 - 2 * lane : 2 * lane, s1 = d ? s0 - 1 : s0 + 1;
            p4_scan(F, Te, d, h, F.DT[(size_t)(r0 + s0) * 48 + d * NH + h], F.DT[(size_t)(r0 + s1) * 48 + d * NH + h], lane, ((size_t)(b * NCC + cc) * NH + h) * 2 + d, nullptr); }
        __syncthreads();
        p4_states(F, L + O_B, Te, L + O_X, (((size_t)(b * NCC + cc) * NH + h) * 2) * HDIM * NST, w, lane);
        __syncthreads();
    }
}

__device__ __forceinline__ void p5_ssd_scan(Frame& F) {
    constexpr int RS = 272, O_RS = 4 * 34816;
    LAS unsigned char* L = F.lds;
    LAS float* RSB = (LAS float*)(L + O_RS);
    const int tid = F.tid, lane = F.lane, w = F.wave, i16 = lane & 15, q4 = lane >> 4;
    const int d = w >> 2, ps = w & 3, t8 = tid & 255;
    for (int u = (int)blockIdx.x; u < NB * NH; u += F.G) {
        const int b = u / NH, h = u - b * NH, g = h / HPG;
        float S[32];
#pragma unroll
        for (int k = 0; k < 32; ++k) S[k] = 0.f;
        v4u creg[8]; float rsreg = 0.f;
#pragma unroll
        for (int k = 0; k < 8; ++k) creg[k] = (v4u){0u, 0u, 0u, 0u};
        for (int j = 0; j < NCC; ++j) {
            const int cc = d == 0 ? j : (j < 2 ? 1 - j : 35 - j);
            LAS unsigned char* Cb = L + ((j & 1) * 2 + d) * 34816;
            if (j >= 2) {
#pragma unroll
                for (int k = 0; k < 8; ++k) { const int pc = t8 + 256 * k, row = pc >> 4, ch = pc & 15; *(LAS v4u*)(Cb + row * RS + ch * 16) = creg[k]; }
                if (t8 < 128) RSB[((j & 1) * 2 + d) * 128 + t8] = rsreg;
            }
            __syncthreads();
            if (j + 1 >= 2 && j + 1 < NCC) {
                const int cn = d == 0 ? j + 1 : 34 - j;
                const size_t rown = (size_t)b * SEQ + (size_t)(cn - 2) * CHUNK;
#pragma unroll
                for (int k = 0; k < 8; ++k) { const int pc = t8 + 256 * k, row = pc >> 4, ch = pc & 15; creg[k] = *(const v4u*)(F.XBC + (rown + row) * CONV_CH + SSD_W + NGRP * NST + g * NST + ch * 8); }
                if (t8 < 128) rsreg = F.ROWSC[((size_t)(b * 2 + d) * NH + h) * SEQ + (cn - 2) * CHUNK + t8];
            }
            const size_t sidx = ((size_t)(b * NCC + cc) * NH + h) * 2 + d;
            const bf16* stp = F.ST + (sidx * HDIM + 16 * ps + i16) * NST + 8 * q4;
            v4u stv[4];
#pragma unroll
            for (int ks = 0; ks < 4; ++ks) stv[ks] = *(const v4u*)(stp + 32 * ks);
            const float decay = __builtin_amdgcn_exp2f(F.CHS[sidx]);
            if (j >= 2) {
                bf16x8 sf[4];
#pragma unroll
                for (int ks = 0; ks < 4; ++ks) { v4u t; t.x = pk2(S[ks * 8 + 0], S[ks * 8 + 1]); t.y = pk2(S[ks * 8 + 2], S[ks * 8 + 3]); t.z = pk2(S[ks * 8 + 4], S[ks * 8 + 5]); t.w = pk2(S[ks * 8 + 6], S[ks * 8 + 7]); sf[ks] = __builtin_bit_cast(bf16x8, t); }
                const size_t rowb = (size_t)b * SEQ + (size_t)(cc - 2) * CHUNK;
                const LAS float* rsl = RSB + ((j & 1) * 2 + d) * 128;
                v2u yold[8];
                if (d == 0) {
#pragma unroll
                    for (int lt = 0; lt < 8; ++lt) yold[lt] = *(const v2u*)(F.Y + (rowb + 16 * lt + i16) * SSD_W + h * HDIM + 16 * ps + 4 * q4);
                }
#pragma unroll
                for (int lt = 0; lt < 8; ++lt) {
                    f32x4 a = (f32x4){0.f, 0.f, 0.f, 0.f};
#pragma unroll
                    for (int ks = 0; ks < 4; ++ks) a = mfma16(sf[ks], frag_row(Cb, RS, 16 * lt + i16, 32 * ks, q4), a);
                    const float sc = rsl[16 * lt + i16];
                    const size_t off = (rowb + 16 * lt + i16) * SSD_W + h * HDIM + 16 * ps + 4 * q4;
                    if (d == 0) { const v2u old = yold[lt]; v2u o; o.x = pk2(bflo(old.x) + a[0] * sc, bfhi(old.x) + a[1] * sc); o.y = pk2(bflo(old.y) + a[2] * sc, bfhi(old.y) + a[3] * sc); *(v2u*)(F.Y + off) = o; }
                    else { v2u o; o.x = pk2(a[0] * sc, a[1] * sc); o.y = pk2(a[2] * sc, a[3] * sc); *(v2u*)(F.YB + off) = o; }
                }
            }
#pragma unroll
            for (int ks = 0; ks < 4; ++ks) { const v4u t = stv[ks];
                S[ks * 8 + 0] = decay * S[ks * 8 + 0] + bflo(t.x); S[ks * 8 + 1] = decay * S[ks * 8 + 1] + bfhi(t.x);
                S[ks * 8 + 2] = decay * S[ks * 8 + 2] + bflo(t.y); S[ks * 8 + 3] = decay * S[ks * 8 + 3] + bfhi(t.y);
                S[ks * 8 + 4] = decay * S[ks * 8 + 4] + bflo(t.z); S[ks * 8 + 5] = decay * S[ks * 8 + 5] + bfhi(t.z);
                S[ks * 8 + 6] = decay * S[ks * 8 + 6] + bflo(t.w); S[ks * 8 + 7] = decay * S[ks * 8 + 7] + bfhi(t.w); }
        }
        __syncthreads();
    }
}

__device__ __forceinline__ void p6_gate_pool(Frame& F) {
    LAS unsigned char* L = F.lds;
    const int tid = F.tid, lane = F.lane, w = F.wave;
    for (int gr = (int)blockIdx.x; gr < T / 64; gr += F.G) {
        const int rb = gr * 64;
        v4u pv[8];
#pragma unroll
        for (int k = 0; k < 8; ++k) { const int pc = tid + 512 * k, row = pc >> 6, ch = pc & 63; pv[k] = *(const v4u*)(F.V + (size_t)(rb + row) * 512 + ch * 8); }
#pragma unroll
        for (int k = 0; k < 8; ++k) { const int pc = tid + 512 * k, row = pc >> 6, ch = pc & 63; *(LAS v4u*)(L + row * 1024 + ch * 16) = pv[k]; }
        for (int rr = 0; rr < 8; rr += 2) {
            v4u ya[2][3], yb[2][3], zz[2][3];
#pragma unroll
            for (int k = 0; k < 2; ++k) { const int r = rb + 8 * w + rr + k;
#pragma unroll
                for (int j = 0; j < 3; ++j) { const int col = 8 * (lane + 64 * j);
                    ya[k][j] = *(const v4u*)(F.Y + (size_t)r * SSD_W + col); yb[k][j] = *(const v4u*)(F.YB + (size_t)r * SSD_W + col); zz[k][j] = *(const v4u*)(F.Z + (size_t)r * SSD_W + col); } }
#pragma unroll
            for (int k = 0; k < 2; ++k) { const int r = rb + 8 * w + rr + k;
                float v[24]; float ss = 0.f;
#pragma unroll
                for (int j = 0; j < 3; ++j) {
                    const unsigned yaw[4] = {ya[k][j].x, ya[k][j].y, ya[k][j].z, ya[k][j].w}, ybw[4] = {yb[k][j].x, yb[k][j].y, yb[k][j].z, yb[k][j].w}, zw[4] = {zz[k][j].x, zz[k][j].y, zz[k][j].z, zz[k][j].w};
#pragma unroll
                    for (int e = 0; e < 4; ++e) { const float y0 = bflo(yaw[e]) + bflo(ybw[e]), y1 = bfhi(yaw[e]) + bfhi(ybw[e]);
                        const float g0 = y0 * silu_f(bflo(zw[e])), g1 = y1 * silu_f(bfhi(zw[e])); v[j * 8 + 2 * e] = g0; v[j * 8 + 2 * e + 1] = g1; ss += g0 * g0 + g1 * g1; } }
                const float rs = 1.f / sqrtf(wave_sum(ss) * (1.f / SSD_W) + RMS_EPS);
#pragma unroll
                for (int j = 0; j < 3; ++j) { const int col = 8 * (lane + 64 * j);
                    const f32x4 w0 = *(const f32x4*)(F.ssd_norm_w + col), w1 = *(const f32x4*)(F.ssd_norm_w + col + 4);
                    v4u o; o.x = pk2(v[j * 8 + 0] * rs * w0.x, v[j * 8 + 1] * rs * w0.y); o.y = pk2(v[j * 8 + 2] * rs * w0.z, v[j * 8 + 3] * rs * w0.w);
                    o.z = pk2(v[j * 8 + 4] * rs * w1.x, v[j * 8 + 5] * rs * w1.y); o.w = pk2(v[j * 8 + 6] * rs * w1.z, v[j * 8 + 7] * rs * w1.w);
                    *(v4u*)(F.A2 + (size_t)r * 2048 + col) = o; } }
        }
        __syncthreads();
        {
            const int cg = tid & 63, tb = tid >> 6, hw = 1 << (cg >> 4);
            const LAS unsigned char* colp = L + cg * 16;
#pragma unroll 2
            for (int tt = 0; tt < 8; ++tt) { const int t = tb * 8 + tt; const int lo = t - hw < 0 ? 0 : t - hw, hi = t + hw > 64 ? 64 : t + hw;
                float s[8];
#pragma unroll
                for (int e = 0; e < 8; ++e) s[e] = 0.f;
                for (int q = lo; q < hi; ++q) { const v4u x = *(const LAS v4u*)(colp + q * 1024);
                    s[0] += bflo(x.x); s[1] += bfhi(x.x); s[2] += bflo(x.y); s[3] += bfhi(x.y); s[4] += bflo(x.z); s[5] += bfhi(x.z); s[6] += bflo(x.w); s[7] += bfhi(x.w); }
                const v4u x = *(const LAS v4u*)(colp + t * 1024); const float inv = 1.f / (float)(hi - lo);
                v4u o; o.x = pk2(s[0] * inv - bflo(x.x), s[1] * inv - bfhi(x.x)); o.y = pk2(s[2] * inv - bflo(x.y), s[3] * inv - bfhi(x.y));
                o.z = pk2(s[4] * inv - bflo(x.z), s[5] * inv - bfhi(x.z)); o.w = pk2(s[6] * inv - bflo(x.w), s[7] * inv - bfhi(x.w));
                *(v4u*)(F.A2 + (size_t)(rb + t) * 2048 + SSD_W + cg * 8) = o; }
        }
        __syncthreads();
    }
}

struct Sched7 {
    const char* A; const char* Bt; int G, c;
    __device__ __forceinline__ bool next(int i, pg8::Unit& u) const { const int L = i * G + c; if (L >= 512) return false; pg8::static_map(L, 128, 4, u.pm, u.pn); u.e = 0; return true; }
    __device__ __forceinline__ const char* a_base(const pg8::Unit& u) const { return A + (size_t)u.pm * 256 * 2048 * 2; }
    __device__ __forceinline__ const char* b_base(const pg8::Unit& u) const { return Bt + (size_t)u.pn * 256 * 2048 * 2; }
    __device__ __forceinline__ unsigned a_row(const pg8::Unit&, int) const { return 0u; }
};
struct Epi7 {
    static constexpr bool PERM = false;
    const float* x; const float* MOD; float* X1;
    __device__ __forceinline__ void operator()(const f32x4 (&acc)[2][2][4][2], const pg8::Unit& u, int wr, int wc, int fr, int fq) const {
        const int row0 = u.pm * 256 + wr * 64 + fr, col0 = u.pn * 256 + wc * 32 + 4 * fq;
        const float* g1 = MOD + (size_t)(u.pm >> 4) * 6144 + 2048;
        f32x4 gv[2][2];
#pragma unroll
        for (int bj = 0; bj < 2; ++bj)
#pragma unroll
            for (int n = 0; n < 2; ++n) gv[bj][n] = *(const f32x4*)(g1 + col0 + bj * 128 + n * 16);
#pragma unroll
        for (int ai = 0; ai < 2; ++ai)
#pragma unroll
            for (int m = 0; m < 4; ++m) { const size_t off = (size_t)(row0 + ai * 128 + m * 16) * D + col0;
#pragma unroll
                for (int bj = 0; bj < 2; ++bj)
#pragma unroll
                    for (int n = 0; n < 2; ++n) { const f32x4 xv = *(const f32x4*)(x + off + bj * 128 + n * 16); *(f32x4*)(X1 + off + bj * 128 + n * 16) = xv + gv[bj][n] * acc[ai][bj][m][n]; } }
    }
};

__device__ __forceinline__ void p8_router(Frame& F) {
    LAS unsigned char* L = F.lds;
    LAS float* H2F = (LAS float*)L;
    constexpr int HP = 1028;
    LAS float* PART = (LAS float*)(L + 16 * HP * 4);
    LAS unsigned* HIST = (LAS unsigned*)(L + 16 * HP * 4 + 16384);
    const int tid = F.tid, lane = F.lane, w = F.wave, i16 = lane & 15, q4 = lane >> 4;
    if (tid < 32) HIST[tid] = 0u;
    float rw0[32], rw1[32];
#pragma unroll
    for (int kk = 0; kk < 32; ++kk) { const int k = 128 * w + 4 * kk + q4; rw0[kk] = F.router_w[k * 32 + i16]; rw1[kk] = F.router_w[k * 32 + 16 + i16]; }
    __syncthreads();
    for (int gi = (int)blockIdx.x; gi < T / 16; gi += F.G) {
        const int rbase = gi * 16;
#pragma unroll
        for (int rr = 0; rr < 2; ++rr) {
            const int r16 = 2 * w + rr, r = rbase + r16;
            const float* xr = F.X1 + (size_t)r * D; const float* mod = F.MOD + (size_t)(r >> 12) * 6144;
            f32x4 v[4]; float ss = 0.f;
#pragma unroll
            for (int j = 0; j < 4; ++j) { v[j] = *(const f32x4*)(xr + 4 * lane + 256 * j); ss += (v[j].x * v[j].x + v[j].y * v[j].y) + (v[j].z * v[j].z + v[j].w * v[j].w); }
            const float rs = 1.f / sqrtf(wave_sum(ss) * (1.f / D) + RMS_EPS);
#pragma unroll
            for (int j = 0; j < 4; ++j) { const int col = 4 * lane + 256 * j;
                const f32x4 wv = *(const f32x4*)(F.norm2_w + col), sh = *(const f32x4*)(mod + 3072 + col), sc = *(const f32x4*)(mod + 4096 + col);
                const f32x4 hh = (v[j] * rs) * wv * (sc + 1.f) + sh;
                *(LAS f32x4*)(H2F + r16 * HP + col) = hh;
                v2u o; o.x = pk2(hh.x, hh.y); o.y = pk2(hh.z, hh.w); *(v2u*)(F.H2 + (size_t)r * D + col) = o; }
        }
        __syncthreads();
        {
            f32x4 a0 = (f32x4){0.f, 0.f, 0.f, 0.f}, a1 = a0;
#pragma unroll
            for (int kk = 0; kk < 32; ++kk) { const int k = 128 * w + 4 * kk + q4;
                const float av = H2F[i16 * HP + k];
                a0 = __builtin_amdgcn_mfma_f32_16x16x4f32(av, rw0[kk], a0, 0, 0, 0); a1 = __builtin_amdgcn_mfma_f32_16x16x4f32(av, rw1[kk], a1, 0, 0, 0); }
#pragma unroll
            for (int r = 0; r < 4; ++r) { PART[(w * 16 + 4 * q4 + r) * 32 + i16] = a0[r]; PART[(w * 16 + 4 * q4 + r) * 32 + 16 + i16] = a1[r]; }
        }
        __syncthreads();
        {
            const int row = tid >> 5, e = tid & 31;
            float lg = F.router_b[e];
#pragma unroll
            for (int ww = 0; ww < 8; ++ww) lg += PART[(ww * 16 + row) * 32 + e];
            float tv[4]; int ti[4];
#pragma unroll
            for (int k = 0; k < 4; ++k) { float bv = lg; int bi = e;
#pragma unroll
                for (int o = 1; o < 32; o <<= 1) { const float ov = __shfl_xor(bv, o); const int oi = __shfl_xor(bi, o); if (ov > bv || (ov == bv && oi < bi)) { bv = ov; bi = oi; } }
                tv[k] = bv; ti[k] = bi; if (e == bi) lg = -INFINITY; }
            if (e == 0) {
                const float e1 = __expf(tv[1] - tv[0]), e2 = __expf(tv[2] - tv[0]), e3 = __expf(tv[3] - tv[0]); const float inv = 1.f / (1.f + e1 + e2 + e3);
                const float gt[4] = {inv, e1 * inv, e2 * inv, e3 * inv};
                const int tok = rbase + row;
#pragma unroll
                for (int k = 0; k < 4; ++k) { const unsigned lr = atomicAdd((unsigned*)&HIST[ti[k]], 1u); F.TOPE[tok * 4 + k] = ti[k]; F.TOPG[tok * 4 + k] = gt[k]; F.TOPR[tok * 4 + k] = (int)lr; }
            }
        }
        __syncthreads();
    }
    if (tid < 32) { const unsigned base = __hip_atomic_fetch_add(F.ctl + CW_GCOUNT + tid, HIST[tid], RLX_AGENT); F.BB[(int)blockIdx.x * 32 + tid] = (int)base; }
}

__device__ __forceinline__ int moe_tables(Frame& F) {
    LAS int* TE = (LAS int*)(F.lds + TE_OFF);
    LAS int* MC = (LAS int*)(F.lds + MOE_CNT_OFF);
    __syncthreads();
    if (F.tid == 0) { int ps = 0;
        for (int e = 0; e < NE; ++e) { const int c = (int)__hip_atomic_load(F.ctl + CW_GCOUNT + e, RLX_AGENT); MC[e] = c; MC[32 + e] = ps; const int nt = (c + 255) >> 8; for (int t = 0; t < nt; ++t) TE[(ps >> 8) + t] = e; ps += nt << 8; }
        MC[64] = ps >> 8; }
    __syncthreads();
    return MC[64];
}
__device__ __forceinline__ void p9_slots(Frame& F) {
    (void)moe_tables(F);
    const LAS int* MC = (const LAS int*)(F.lds + MOE_CNT_OFF);
    const int gt = (int)blockIdx.x * 512 + F.tid, NT_ = F.G * 512;
    for (int a = gt; a < T * TOPK; a += NT_) { const int tok = a >> 2, e = F.TOPE[a], blk = (tok >> 4) % F.G;
        const int slot = MC[32 + e] + F.BB[blk * 32 + e] + F.TOPR[a];
        F.SLOTTOK[slot] = tok; F.SLOTGATE[slot] = F.TOPG[a]; F.TOKSLOT[a] = slot; }
    if ((int)blockIdx.x < NE) { const int e = (int)blockIdx.x, c = MC[e], ps = MC[32 + e], pe = ps + (((c + 255) >> 8) << 8);
        for (int s = ps + c + F.tid; s < pe; s += 512) { F.SLOTTOK[s] = 0; F.SLOTGATE[s] = 0.f; } }
}

struct SchedMoe {
    const char* A; const char* W; const int* slot_tok; const LAS int* TE; int nM, nN, G, c; size_t wbytes  , tilebytes  , arowbytes;
    __device__ __forceinline__ bool next(int i, pg8::Unit& u) const { const int L = i * G + c; if (L >= nM * nN) return false; pg8::static_map(L, nM, nN, u.pm, u.pn); u.e = TE[u.pm]; return true; }
    __device__ __forceinline__ const char* a_base(const pg8::Unit& u) const { return slot_tok ? A : A + (size_t)u.pm * 256 * arowbytes; }
    __device__ __forceinline__ const char* b_base(const pg8::Unit& u) const { return W + (size_t)u.e * wbytes + (size_t)u.pn * tilebytes; }
    __device__ __forceinline__ unsigned a_row(const pg8::Unit& u, int r) const { return (unsigned)slot_tok[u.pm * 256 + r]; }
};
struct Epi10 {
    static constexpr bool PERM = true;
    const float* b1; bf16* ACT;
    __device__ __forceinline__ void operator()(const f32x4 (&acc)[2][2][4][2], const pg8::Unit& u, int wr, int wc, int fr, int fq) const {
        const int row0 = u.pm * 256 + wr * 64 + fr, j0 = u.pn * 128 + wc * 32 + 8 * fq;
        const float* bp = b1 + (size_t)u.e * 2048 + 2 * j0;
        const f32x4 q0 = *(const f32x4*)bp, q1 = *(const f32x4*)(bp + 4), q2 = *(const f32x4*)(bp + 8), q3 = *(const f32x4*)(bp + 12);
        const float bg[8] = {q0.x, q0.z, q1.x, q1.z, q2.x, q2.z, q3.x, q3.z}, bu[8] = {q0.y, q0.w, q1.y, q1.w, q2.y, q2.w, q3.y, q3.w};
#pragma unroll
        for (int ai = 0; ai < 2; ++ai)
#pragma unroll
            for (int m = 0; m < 4; ++m) { float o[8];
#pragma unroll
                for (int n = 0; n < 2; ++n)
#pragma unroll
                    for (int t = 0; t < 4; ++t) { const float hg = acc[ai][0][m][n][t] + bg[4 * n + t], hu = acc[ai][1][m][n][t] + bu[4 * n + t];
                        const float gp = fminf(hg, 7.f), up = fminf(fmaxf(hu, -7.f), 7.f);
                        o[4 * n + t] = gp / (1.f + __expf(-1.702f * gp)) * (up + 1.f); }
                v4u wv; wv.x = pg8::cvt_pk_bf16(o[0], o[1]); wv.y = pg8::cvt_pk_bf16(o[2], o[3]); wv.z = pg8::cvt_pk_bf16(o[4], o[5]); wv.w = pg8::cvt_pk_bf16(o[6], o[7]);
                *(v4u*)(ACT + (size_t)(row0 + ai * 128 + m * 16) * DFF + j0) = wv; }
    }
};
struct Epi11 {
    static constexpr bool PERM = true;
    const float* b2; const float* gate; bf16* YS;
    __device__ __forceinline__ void operator()(const f32x4 (&acc)[2][2][4][2], const pg8::Unit& u, int wr, int wc, int fr, int fq) const {
        const int row0 = u.pm * 256 + wr * 64 + fr, col0 = u.pn * 256 + wc * 32 + 8 * fq;
        f32x4 bv[2][2];
#pragma unroll
        for (int bj = 0; bj < 2; ++bj)
#pragma unroll
            for (int n = 0; n < 2; ++n) bv[bj][n] = *(const f32x4*)(b2 + (size_t)u.e * D + col0 + bj * 128 + 4 * n);
#pragma unroll
        for (int ai = 0; ai < 2; ++ai)
#pragma unroll
            for (int m = 0; m < 4; ++m) { const int row = row0 + ai * 128 + m * 16; const float gt = gate[row];
#pragma unroll
                for (int bj = 0; bj < 2; ++bj) { const f32x4 v0 = (acc[ai][bj][m][0] + bv[bj][0]) * gt, v1 = (acc[ai][bj][m][1] + bv[bj][1]) * gt;
                    v4u wv; wv.x = pg8::cvt_pk_bf16(v0[0], v0[1]); wv.y = pg8::cvt_pk_bf16(v0[2], v0[3]); wv.z = pg8::cvt_pk_bf16(v1[0], v1[1]); wv.w = pg8::cvt_pk_bf16(v1[2], v1[3]);
                    *(v4u*)(YS + (size_t)row * D + col0 + bj * 128) = wv; } }
    }
};

__device__ __forceinline__ void p12_combine(Frame& F) {
    const int gw = (int)blockIdx.x * 8 + F.wave, NGW = F.G * 8, lane = F.lane;
    for (int rp = gw; rp < T / 2; rp += NGW) {
        int sl[2][4];
#pragma unroll
        for (int k2 = 0; k2 < 2; ++k2)
#pragma unroll
            for (int k = 0; k < 4; ++k) sl[k2][k] = F.TOKSLOT[(rp * 2 + k2) * 4 + k];
        v2u yv[2][4][4]; f32x4 xv[2][4];
#pragma unroll
        for (int k2 = 0; k2 < 2; ++k2)
#pragma unroll
            for (int j = 0; j < 4; ++j) { const int col = 4 * lane + 256 * j; xv[k2][j] = *(const f32x4*)(F.X1 + (size_t)(rp * 2 + k2) * D + col);
#pragma unroll
                for (int k = 0; k < 4; ++k) yv[k2][j][k] = *(const v2u*)(F.YS + (size_t)sl[k2][k] * D + col); }
#pragma unroll
        for (int k2 = 0; k2 < 2; ++k2) { const int r = rp * 2 + k2;
            const float* g2 = F.MOD + (size_t)(r >> 12) * 6144 + 5120;
            f32x4 v[4]; float ss = 0.f;
#pragma unroll
            for (int j = 0; j < 4; ++j) { const int col = 4 * lane + 256 * j; f32x4 m = (f32x4){0.f, 0.f, 0.f, 0.f};
#pragma unroll
                for (int k = 0; k < 4; ++k) { const v2u y = yv[k2][j][k]; m.x += bflo(y.x); m.y += bfhi(y.x); m.z += bflo(y.y); m.w += bfhi(y.y); }
                v[j] = xv[k2][j] + *(const f32x4*)(g2 + col) * m;
                ss += (v[j].x * v[j].x + v[j].y * v[j].y) + (v[j].z * v[j].z + v[j].w * v[j].w); }
            const float rs = 1.f / sqrtf(wave_sum(ss) * (1.f / D) + RMS_EPS);
#pragma unroll
            for (int j = 0; j < 4; ++j) { const int col = 4 * lane + 256 * j; *(f32x4*)(F.out + (size_t)r * D + col) = (v[j] * rs) * *(const f32x4*)(F.final_norm_w + col); } }
    }
}

constexpr int NPHASE = 13;
struct Args { const float* in[25]; float* out; unsigned char* ws; int ph_lo, ph_hi; };
__global__ void __launch_bounds__(512, 2) mk_fwd(Args args) {
    extern __shared__ __attribute__((aligned(16))) unsigned char lds[];
    Frame F;
    F.lds = (LAS unsigned char*)lds;
    F.tid = threadIdx.x; F.lane = F.tid & 63; F.wave = __builtin_amdgcn_readfirstlane(F.tid >> 6); F.G = gridDim.x;
    unsigned char* ws = args.ws;
    F.ctl = (unsigned*)(ws + WS_CTL);
    F.x = args.in[0]; F.c = args.in[1]; F.ctx = args.in[2]; F.c_ctx = args.in[3]; F.w_mod = args.in[4]; F.b_mod = args.in[5]; F.norm1_w = args.in[6]; F.norm2_w = args.in[7];
    F.w_in = args.in[8]; F.conv_w = args.in[9]; F.conv_b = args.in[10]; F.dt_bias = args.in[11]; F.a_log = args.in[12]; F.d_skip = args.in[13]; F.ssd_norm_w = args.in[14];
    F.pool_w = args.in[15]; F.pool_scale = args.in[16]; F.w_out = args.in[17]; F.router_w = args.in[18]; F.router_b = args.in[19]; F.w1 = args.in[20]; F.b1 = args.in[21];
    F.w2 = args.in[22]; F.b2 = args.in[23]; F.final_norm_w = args.in[24]; F.out = args.out;
    F.MOD = (float*)(ws + WS_MOD); F.DTRAW = (float*)(ws + WS_DTRAW); F.DT = (float*)(ws + WS_DT); F.ROWSC = (float*)(ws + WS_ROWSC); F.CHS = (float*)(ws + WS_CHS); F.X1 = (float*)(ws + WS_X1);
    F.TOPG = (float*)(ws + WS_TOPG); F.SLOTGATE = (float*)(ws + WS_SLOTGATE); F.TOPE = (int*)(ws + WS_TOPE); F.TOPR = (int*)(ws + WS_TOPR); F.TOKSLOT = (int*)(ws + WS_TOKSLOT);
    F.SLOTTOK = (int*)(ws + WS_SLOTTOK); F.BB = (int*)(ws + WS_BB);
    F.WINT = (bf16*)(ws + WS_WINT); F.WOUTT = (bf16*)(ws + WS_WOUTT); F.W1T = (bf16*)(ws + WS_W1T); F.W2T = (bf16*)(ws + WS_W2T); F.A1 = (bf16*)(ws + WS_A1); F.XBCPRE = (bf16*)(ws + WS_XBCPRE);
    F.Z = (bf16*)(ws + WS_Z); F.V = (bf16*)(ws + WS_V); F.XBC = (bf16*)(ws + WS_XBC); F.ST = (bf16*)(ws + WS_ST); F.Y = (bf16*)(ws + WS_Y); F.YB = (bf16*)(ws + WS_YB);
    F.A2 = (bf16*)(ws + WS_A2); F.H2 = (bf16*)(ws + WS_H2); F.ACT = (bf16*)(ws + WS_ACT); F.YS = (bf16*)(ws + WS_YS);
    volatile LAS unsigned* MISC = (volatile LAS unsigned*)(F.lds + MISC_OFF);
    for (int u = F.tid; u < 64; u += 512) MISC[u] = 0u;
    __syncthreads();
    const int lo = args.ph_lo, hi = args.ph_hi;
    XcdBarrier bar; bar.bar = F.ctl + CW_BAR; bar.x = 0; bar.st = nullptr;
    if (hi - lo > 1) bar = xcd_barrier_post(F.ctl + CW_BAR, MISC + 8);
#define IN(k) (lo <= (k) && (k) < hi)
#define SEAM(k) do { if (IN(k) && IN((k) + 1)) xcd_barrier(bar); } while (0)
#define BODY0 p0_prologue(F)
#define BODY1 p1_norm1(F)
#define BODY2 do { Sched1 S{(const char*)F.A1, (const char*)F.WINT, F.G, (int)blockIdx.x}; Epi1 E{F.XBCPRE, F.Z, F.V, F.DTRAW}; pg8::gemm_phase<Epi1, Sched1, false>(F.lds, D, S, E); } while (0)
#define BODY3 p3_conv(F)
#define BODY4 p4_ssd_local(F)
#define BODY5 p5_ssd_scan(F)
#define BODY6 p6_gate_pool(F)
#define BODY7 do { Sched7 S{(const char*)F.A2, (const char*)F.WOUTT, F.G, (int)blockIdx.x}; Epi7 E{F.x, F.MOD, F.X1}; pg8::gemm_phase<Epi7, Sched7, false>(F.lds, 2048, S, E); } while (0)
#define BODY8 p8_router(F)
#define BODY9 p9_slots(F)
#define BODY10 do { const int ntl = moe_tables(F); \
        SchedMoe S{(const char*)F.H2, (const char*)F.W1T, F.SLOTTOK, (const LAS int*)(F.lds + TE_OFF), ntl, 8, F.G, (int)blockIdx.x, (size_t)2048 * D * 2, (size_t)256 * D * 2, (size_t)D * 2}; \
        Epi10 E{F.b1, F.ACT}; pg8::gemm_phase<Epi10, SchedMoe, true>(F.lds, D, S, E); } while (0)
#define BODY11 do { const int ntl = moe_tables(F); \
        SchedMoe S{(const char*)F.ACT, (const char*)F.W2T, nullptr, (const LAS int*)(F.lds + TE_OFF), ntl, 4, F.G, (int)blockIdx.x, (size_t)D * D * 2, (size_t)256 * D * 2, (size_t)D * 2}; \
        Epi11 E{F.b2, F.SLOTGATE, F.YS}; pg8::gemm_phase<Epi11, SchedMoe, false>(F.lds, D, S, E); } while (0)
#define BODY12 p12_combine(F)
#define RUN(k) do { if (IN(k)) { BODY##k; if (PROBE_PH == (k)) { xcd_barrier(bar); BODY##k; } } SEAM(k); } while (0)
    RUN(0); RUN(1); RUN(2); RUN(3); RUN(4); RUN(5); RUN(6); RUN(7); RUN(8); RUN(9); RUN(10); RUN(11); RUN(12);
#undef IN
#undef SEAM
}

extern "C" void kernel_launch(void* const* d_in, const int* in_sizes, int n_in, void* d_out, int out_size, void* d_ws, size_t ws_size, hipStream_t stream) {
    static int grid = 0;
    if (grid == 0) {
        if (n_in != 25 || out_size != T * D || ws_size < WS_END) { fprintf(stderr, "kernel_launch: unexpected shapes (n_in %d, out %d, ws %zu)\n", n_in, out_size, ws_size); grid = -1; return; }
        int dev = 0, cus = 0, per_cu = 0;
        if (hipGetDevice(&dev) != hipSuccess || hipDeviceGetAttribute(&cus, hipDeviceAttributeMultiprocessorCount, dev) != hipSuccess) { grid = -1; return; }
        if (hipFuncSetAttribute((const void*)mk_fwd, hipFuncAttributeMaxDynamicSharedMemorySize, LDS_BYTES) != hipSuccess) { fprintf(stderr, "kernel_launch: hipFuncSetAttribute failed\n"); grid = -1; return; }
        if (hipOccupancyMaxActiveBlocksPerMultiprocessor(&per_cu, (const void*)mk_fwd, 512, LDS_BYTES) != hipSuccess || per_cu < 1) { fprintf(stderr, "kernel_launch: occupancy query says %d\n", per_cu); }
        (void)hipGetLastError();
        grid = cus;
    }
    if (grid < 0) return;
    (void)hipMemsetAsync((char*)d_ws + WS_CTL, 0, CTL_ZERO_BYTES, stream);
    Args a{};
    for (int i = 0; i < 25; ++i) a.in[i] = (const float*)d_in[i];
    a.out = (float*)d_out; a.ws = (unsigned char*)d_ws;
#if MK_SPLIT
    for (int p = 0; p < NPHASE; ++p) { a.ph_lo = p; a.ph_hi = p + 1; hipLaunchKernelGGL(mk_fwd, dim3(grid), dim3(512), LDS_BYTES, stream, a); }
#else
    a.ph_lo = 0; a.ph_hi = NPHASE; hipLaunchKernelGGL(mk_fwd, dim3(grid), dim3(512), LDS_BYTES, stream, a);
#endif
}
```

```cpp
#include <hip/hip_runtime.h>
#include <cstdio>
#include <cstdint>

#ifndef MK_SPLIT
#define MK_SPLIT 0
#endif

#ifndef PROBE_PH
#define PROBE_PH -1
#endif

#define GAS __attribute__((address_space(1)))
#define LAS __attribute__((address_space(3)))
typedef unsigned short bf16;
typedef unsigned v4u __attribute__((ext_vector_type(4)));
typedef unsigned v2u __attribute__((ext_vector_type(2)));
typedef float f32x4 __attribute__((ext_vector_type(4)));
typedef float f32x2 __attribute__((ext_vector_type(2)));
typedef short bf16x8 __attribute__((ext_vector_type(8)));
typedef short s16x4 __attribute__((ext_vector_type(4)));
#define RLX_AGENT __ATOMIC_RELAXED, __HIP_MEMORY_SCOPE_AGENT
#define LDS_WAIT() asm volatile("s_waitcnt lgkmcnt(0)" ::: "memory")
#define VM_WAIT() asm volatile("s_waitcnt vmcnt(0)" ::: "memory")

__device__ __forceinline__ unsigned f2bf(float f) { unsigned u = __builtin_bit_cast(unsigned, f); return (u + 0x7fffu + ((u >> 16) & 1u)) >> 16; }
typedef __bf16 nbf16x2 __attribute__((ext_vector_type(2)));
__device__ __forceinline__ unsigned pk2(float lo, float hi) { const f32x2 v = {lo, hi}; return __builtin_bit_cast(unsigned, __builtin_convertvector(v, nbf16x2)); }
constexpr float ASCALE = 4.f;
constexpr float WSCALE = 32.f;
__device__ __forceinline__ unsigned pk4_fp8(float a, float b, float c, float d) { int r = __builtin_amdgcn_cvt_pk_fp8_f32(a, b, 0, false); r = __builtin_amdgcn_cvt_pk_fp8_f32(c, d, r, true); return (unsigned)r; }
__device__ __forceinline__ float bflo(unsigned w) { return __builtin_bit_cast(float, w << 16); }
__device__ __forceinline__ float bfhi(unsigned w) { return __builtin_bit_cast(float, w & 0xffff0000u); }
__device__ __forceinline__ float silu_f(float v) { return v / (1.f + __expf(-v)); }
__device__ __forceinline__ float wave_sum(float v) {
#pragma unroll
    for (int o = 1; o < 64; o <<= 1) v += __shfl_xor(v, o);
    return v;
}

constexpr int D = 1024, NB = 8, SEQ = 4096, CTXL = 256, T = NB * SEQ, TC = NB * CTXL, RTOT = T + TC;
constexpr int CONV_CH = 2560, SSD_W = 1536, NH = 24, HDIM = 64, NGRP = 4, HPG = 6, NST = 128, CHUNK = 128;
constexpr int NCC = (CTXL + SEQ) / CHUNK;
constexpr int IN_COLS = 4656, N1 = 4864;
constexpr int NE = 32, TOPK = 4, DFF = 1024;
constexpr int MAX_TILES = (T * TOPK) / 256 + NE;
constexpr int MAX_SLOTS = MAX_TILES * 256;
constexpr float RMS_EPS = 1e-6f;

constexpr size_t MiB = 1u << 20;
constexpr size_t WS_CTL = 0, CTL_ZERO_BYTES = 1 * MiB;
constexpr size_t WS_MOD = 1 * MiB;
constexpr size_t WS_TOPE = 2 * MiB, WS_TOPG = WS_TOPE + 512 * 1024, WS_TOPR = WS_TOPG + 512 * 1024, WS_TOKSLOT = WS_TOPR + 512 * 1024;
constexpr size_t WS_SLOTTOK = 4 * MiB, WS_SLOTGATE = WS_SLOTTOK + 576 * 1024, WS_BB = WS_SLOTGATE + 576 * 1024, WS_CHS = WS_BB + 64 * 1024, WS_SLOTID = WS_CHS + 64 * 1024;
constexpr size_t WS_DTRAW = 6 * MiB;
constexpr size_t WS_DT = 15 * MiB;
constexpr size_t WS_ROWSC = 22 * MiB;
constexpr size_t WS_WINT = 32 * MiB, WS_WOUTT = 42 * MiB, WS_W1T = 46 * MiB, WS_W2T = 174 * MiB;
constexpr size_t WS_A = 240 * MiB;
constexpr size_t WS_A1 = WS_A, WS_CC = WS_A, WS_XBCPRE = WS_A + 68 * MiB, WS_Z = WS_A + 238 * MiB, WS_V = WS_A + 334 * MiB, WS_XBC = WS_A;
constexpr size_t WS_ST = WS_A + 366 * MiB, WS_Y = WS_A + 570 * MiB, WS_YB = WS_A + 666 * MiB;
constexpr size_t WS_A2 = WS_XBCPRE, WS_X1 = WS_A + 366 * MiB, WS_H2 = WS_A + 494 * MiB, WS_ACT = WS_A, WS_YS = WS_A + 494 * MiB;
constexpr size_t WS_END = WS_A + 766 * MiB;
static_assert(WS_END <= 1024 * MiB, "workspace map");
static_assert((size_t)RTOT * D * 2 <= 68 * MiB && (size_t)RTOT * CONV_CH * 2 <= 170 * MiB && (size_t)MAX_SLOTS * D * 2 <= 272 * MiB, "workspace map sizes");
static_assert((size_t)NB * NCC * NH * 2 * 8192 * 2 <= 204 * MiB, "ST size");
constexpr int CW_TMO = 0, CW_GCOUNT = 64  , CW_BAR = 4096;

constexpr int LDS_BYTES = 163840;
constexpr int MISC_OFF = LDS_BYTES - 256;
constexpr int TE_OFF = 131072;
constexpr int MOE_CNT_OFF = TE_OFF + 4096;

namespace pg8 {
constexpr int BM = 256, BK = 64, HALF = 128, HTB = HALF * BK * 2, STAGE_BYTES = 8 * HTB, NXCD = 8, WGM = 8;
__host__ __device__ __forceinline__ int lds_byte(int r, int c) { const int st = (r >> 4) * 2 + (c >> 5), rr = r & 15, cc = c & 31, ob = rr * 64 + cc * 2; return st * 1024 + (ob ^ (((ob >> 9) & 1) << 5)); }
__host__ __device__ __forceinline__ void stage_rc(int b, int& R, int& C) { const int st = b / 1024, sb = b % 1024, swz = sb ^ (((sb >> 9) & 1) << 5); R = (st >> 1) * 16 + swz / 64; C = (st & 1) * 32 + (swz % 64) / 2; }
__host__ __device__ __forceinline__ int perm32(int rho) { const int n = rho >> 4, i = rho & 15; return 8 * (i >> 2) + 4 * n + (i & 3); }
struct Unit { int pm, pn, e; };
__device__ __forceinline__ unsigned cvt_pk_bf16(float lo, float hi) { unsigned r; asm volatile("v_cvt_pk_bf16_f32 %0, %1, %2" : "=v"(r) : "v"(lo), "v"(hi)); return r; }

__device__ __forceinline__ void static_map(int wgid, int nM, int nN, int& pm, int& pn) {
    const int nwg = nM * nN;
    { const int q = nwg / NXCD, r = nwg % NXCD, xcd = wgid % NXCD, off = wgid / NXCD; wgid = (xcd < r ? xcd * (q + 1) : r * (q + 1) + (xcd - r) * q) + off; }
    const int nig = WGM * nN, gid = wgid / nig, fm = gid * WGM, gsz = (nM - fm) < WGM ? (nM - fm) : WGM;
    pm = fm + ((wgid % nig) % gsz); pn = (wgid % nig) / gsz;
}

typedef int i32x8 __attribute__((ext_vector_type(8)));
typedef int v4i_t __attribute__((ext_vector_type(4)));
template <class Epi, class Sched, bool GATHER, bool FP8 = false, bool ALIGN_EPI = true>
__device__ __forceinline__ void gemm_phase(LAS unsigned char* lds, const int K, const Sched& S, const Epi& E) {
    const int tid = threadIdx.x, wid = __builtin_amdgcn_readfirstlane(tid >> 6), lane = tid & 63, wr = wid >> 2, wc = wid & 3, fr = lane & 15, fq = lane >> 4;
    constexpr int ES = FP8 ? 1 : 2, KOFF = FP8 ? 16 : 1024;
    const int nt = K / (FP8 ? 2 * BK : BK);
    unsigned voffB[2]; int RA[2], CA[2];
#pragma unroll
    for (int i = 0; i < 2; ++i) { int R, C; stage_rc(tid * 16 + i * 8192, R, C); const int Rb = Epi::PERM ? ((R & ~31) + perm32(R & 31)) : R;
        RA[i] = R; CA[i] = C; voffB[i] = (unsigned)(Rb * K * ES + C * 2); }
    const size_t kstep = (size_t)(BK * 2);
    const size_t hstep = (size_t)HALF * K * ES;
    const unsigned ldsw = (unsigned)wid * 1024u;
    const int aoff = lds_byte(wr * 64 + fr, fq * (FP8 ? 16 : 8)), boff = lds_byte(wc * 32 + fr, fq * (FP8 ? 16 : 8));
#define PG8_SA(b, h) (((b) * 2 + (h)) * HTB)
#define PG8_SB(b, h) ((4 + (b) * 2 + (h)) * HTB)
#define PG8_STAGE(bufoff, gbase, voff) do { _Pragma("unroll") for (int _i = 0; _i < 2; ++_i) \
        __builtin_amdgcn_global_load_lds((const unsigned*)((const char*)(gbase) + (voff)[_i]), (LAS unsigned*)(lds + (bufoff) + ldsw + _i * 8192), 16, 0, 0); } while (0)
#define PG8_LDA(dst, b, h) do { _Pragma("unroll") for (int m = 0; m < 4; ++m) _Pragma("unroll") for (int k = 0; k < 2; ++k) dst[m][k] = *(const LAS bf16x8*)(lds + PG8_SA(b, h) + aoff + m * 2048 + k * KOFF); } while (0)
#define PG8_LDB(dst, b, h) do { _Pragma("unroll") for (int n = 0; n < 2; ++n) _Pragma("unroll") for (int k = 0; k < 2; ++k) dst[n][k] = *(const LAS bf16x8*)(lds + PG8_SB(b, h) + boff + n * 2048 + k * KOFF); } while (0)
#define PG8_CAT(lo, hi) __builtin_shufflevector(__builtin_bit_cast(v4i_t, lo), __builtin_bit_cast(v4i_t, hi), 0, 1, 2, 3, 4, 5, 6, 7)
#define PG8_MMA(ai, bj, At, Bt) do { __builtin_amdgcn_s_setprio(1); \
        if constexpr (FP8) { _Pragma("unroll") for (int m = 0; m < 4; ++m) _Pragma("unroll") for (int n = 0; n < 2; ++n) \
            acc[ai][bj][m][n] = __builtin_amdgcn_mfma_scale_f32_16x16x128_f8f6f4(PG8_CAT(Bt[n][0], Bt[n][1]), PG8_CAT(At[m][0], At[m][1]), acc[ai][bj][m][n], 0, 0, 0, 0x7f7f7f7f, 0, 0x7f7f7f7f); } \
        else { _Pragma("unroll") for (int m = 0; m < 4; ++m) _Pragma("unroll") for (int n = 0; n < 2; ++n) _Pragma("unroll") for (int k = 0; k < 2; ++k) \
            acc[ai][bj][m][n] = __builtin_amdgcn_mfma_f32_16x16x32_bf16(Bt[n][k], At[m][k], acc[ai][bj][m][n], 0, 0, 0); } \
        __builtin_amdgcn_s_setprio(0); } while (0)
#define PG8_WAIT_V(n) asm volatile("s_waitcnt vmcnt(" #n ")" ::: "memory")
#define PG8_WAIT_L(n) asm volatile("s_waitcnt lgkmcnt(" #n ")" ::: "memory")
#define PG8_BAR __builtin_amdgcn_s_barrier()
#define PG8_SCHED __builtin_amdgcn_sched_barrier(0)
#define PG8_AOFFS(U, dst) do { \
        if constexpr (GATHER) { int t_ = tid, R_, C_; asm volatile("" : "+v"(t_)); stage_rc(t_ * 16, R_, C_);     \
            const int* st_ = S.row_table(U) + R_; _Pragma("unroll") for (int _h = 0; _h < 2; ++_h) _Pragma("unroll") for (int _i = 0; _i < 2; ++_i) \
            dst[_h][_i] = (unsigned)st_[_h * HALF + _i * 64] * (unsigned)(K * ES) + (unsigned)(C_ * 2); } \
        else { _Pragma("unroll") for (int _h = 0; _h < 2; ++_h) _Pragma("unroll") for (int _i = 0; _i < 2; ++_i) dst[_h][_i] = (unsigned)((_h * HALF + RA[_i]) * K * ES + CA[_i] * 2); } } while (0)
    Unit cur, nxt; int ui = 0;
    if (!S.next(0, cur)) return;
    f32x4 acc[2][2][4][2];
#pragma unroll
    for (int a = 0; a < 2; ++a)
#pragma unroll
        for (int b = 0; b < 2; ++b)
#pragma unroll
            for (int m = 0; m < 4; ++m)
#pragma unroll
                for (int n = 0; n < 2; ++n) acc[a][b][m][n] = (f32x4){0.f, 0.f, 0.f, 0.f};
    bf16x8 At[4][2], B0[2][2], B1[2][2];
    unsigned oc[2][2];
    const char* cA = S.a_base(cur); const char* cB = S.b_base(cur);
    PG8_AOFFS(cur, oc);
    PG8_STAGE(PG8_SB(0, 0), cB, voffB); PG8_STAGE(PG8_SB(0, 1), cB + hstep, voffB); PG8_STAGE(PG8_SA(0, 0), cA, oc[0]); PG8_STAGE(PG8_SA(0, 1), cA, oc[1]);
    if (wr == 1) PG8_BAR;
    PG8_WAIT_V(2); PG8_BAR;
    PG8_STAGE(PG8_SB(1, 0), cB + kstep, voffB); PG8_STAGE(PG8_SA(1, 0), cA + kstep, oc[0]); PG8_STAGE(PG8_SB(1, 1), cB + hstep + kstep, voffB);
    PG8_WAIT_V(6); PG8_BAR;
    for (;;) {
        const bool has_next = S.next(ui + 1, nxt);
        const char* nA = has_next ? S.a_base(nxt) : cA; const char* nB = has_next ? S.b_base(nxt) : cB;
        for (int t = 0; t < nt; t += 2) {
            const bool last = (t == nt - 2);
            const char* a1 = cA + (size_t)(t + 1) * kstep;
            const char* a2 = last ? nA : cA + (size_t)(t + 2) * kstep; const char* b2 = last ? nB : cB + (size_t)(t + 2) * kstep;
            const char* a3 = a2 + kstep; const char* b3 = b2 + kstep;
            PG8_LDB(B0, 0, 0); PG8_LDB(B1, 0, 1); PG8_SCHED; PG8_LDA(At, 0, 0); PG8_STAGE(PG8_SA(1, 1), a1, oc[1]);
            PG8_WAIT_V(8); PG8_WAIT_L(0); PG8_BAR; PG8_MMA(0, 0, At, B0); PG8_MMA(0, 1, At, B1); PG8_BAR; PG8_SCHED;
            if (last && has_next) { PG8_AOFFS(nxt, oc); }
            PG8_LDA(At, 0, 1); PG8_STAGE(PG8_SB(0, 0), b2, voffB); PG8_STAGE(PG8_SB(0, 1), b2 + hstep, voffB); PG8_STAGE(PG8_SA(0, 0), a2, oc[0]);
            PG8_WAIT_V(8); PG8_WAIT_L(0); PG8_BAR; PG8_MMA(1, 0, At, B0); PG8_MMA(1, 1, At, B1); PG8_BAR; PG8_SCHED;
            PG8_LDB(B0, 1, 0); PG8_LDB(B1, 1, 1); PG8_SCHED; PG8_LDA(At, 1, 0); PG8_STAGE(PG8_SA(0, 1), a2, oc[1]);
            PG8_WAIT_V(8); PG8_WAIT_L(0); PG8_BAR; PG8_MMA(0, 0, At, B0); PG8_MMA(0, 1, At, B1); PG8_BAR; PG8_SCHED;
            PG8_LDA(At, 1, 1); PG8_STAGE(PG8_SB(1, 0), b3, voffB); PG8_STAGE(PG8_SB(1, 1), b3 + hstep, voffB); PG8_STAGE(PG8_SA(1, 0), a3, oc[0]);
            PG8_WAIT_V(8); PG8_WAIT_L(0); PG8_BAR; PG8_MMA(1, 0, At, B0); PG8_MMA(1, 1, At, B1); PG8_BAR; PG8_SCHED;
        }
        if constexpr (ALIGN_EPI) { if (wr == 0) PG8_BAR; }
        E(acc, cur, wr, wc, fr, fq);
        if (!has_next) break;
#pragma unroll
        for (int a = 0; a < 2; ++a)
#pragma unroll
            for (int b = 0; b < 2; ++b)
#pragma unroll
                for (int m = 0; m < 4; ++m)
#pragma unroll
                    for (int n = 0; n < 2; ++n) acc[a][b][m][n] = (f32x4){0.f, 0.f, 0.f, 0.f};
        cur = nxt; cA = nA; cB = nB; ++ui;
        if constexpr (ALIGN_EPI) { if (wr == 1) PG8_BAR; }
    }
    PG8_WAIT_V(0);
    if constexpr (!ALIGN_EPI) { if (wr == 0) PG8_BAR; }
    PG8_BAR;
#undef PG8_SA
#undef PG8_SB
#undef PG8_STAGE
#undef PG8_LDA
#undef PG8_LDB
#undef PG8_MMA
#undef PG8_WAIT_V
#undef PG8_WAIT_L
#undef PG8_BAR
#undef PG8_SCHED
#undef PG8_AOFFS
#undef PG8_CAT
}
}

#define XB_TMO      128
#define XB_XCNT(j)  (256  + 64 * (j))
#define XB_XSUB(j)  (1280 + 64 * (j))
#define XB_XGEN(j)  (2304 + 64 * (j))
#define XB_TOP      3328
#define XB_TOPGEN   3392
#define XCD_BAR_WORDS 3456
#define XB_SPIN_CAP (1u << 18)
__device__ __forceinline__ unsigned xb_ld(unsigned* p)              { return __hip_atomic_load(p, __ATOMIC_RELAXED, __HIP_MEMORY_SCOPE_AGENT); }
__device__ __forceinline__ unsigned xb_add(unsigned* p, unsigned v) { return __hip_atomic_fetch_add(p, v, __ATOMIC_RELAXED, __HIP_MEMORY_SCOPE_AGENT); }
__device__ __forceinline__ unsigned xb_xcc_id() { return (unsigned)__builtin_amdgcn_s_getreg((3 << 11) | 20) & 0xFu; }
#define XB_SPIN(cond, bar) do { unsigned _sp = 0; while (cond) { __builtin_amdgcn_s_sleep(1); \
    if ((++_sp & 255u) == 0u) { if (xb_ld(&(bar)[XB_TMO])) break; if (_sp > XB_SPIN_CAP) { atomicAdd(&(bar)[XB_TMO], 1u); break; } } } } while (0)
struct XcdBarrier { unsigned* bar; unsigned x; volatile LAS unsigned* st; };
__device__ __forceinline__ XcdBarrier xcd_barrier_post(unsigned* bar, volatile LAS unsigned* st) {
    XcdBarrier b; b.bar = bar; b.x = xb_xcc_id(); b.st = st;
    if (threadIdx.x == 0) (void)xb_add(&bar[XB_XCNT(b.x)], 1u);
    return b;
}
__device__ __forceinline__ void xcd_barrier_complete(unsigned* bar, unsigned x, unsigned& nloc, unsigned& nx) {
    const unsigned G = gridDim.x * gridDim.y * gridDim.z;
    unsigned sum, cnt, mine, sp = 0u;
    for (;;) {
        sum = 0u; cnt = 0u; mine = 0u;
#pragma unroll
        for (unsigned j = 0; j < 16; ++j) { const unsigned c = xb_ld(&bar[XB_XCNT(j)]); sum += c; cnt += (c > 0u) ? 1u : 0u; mine = (j == x) ? c : mine; }
        if (sum == G) break;
        __builtin_amdgcn_s_sleep(1);
        if ((++sp & 255u) == 0u) { if (xb_ld(&bar[XB_TMO])) break; if (sp > XB_SPIN_CAP) { atomicAdd(&bar[XB_TMO], 1u); break; } }
    }
    nloc = mine > 0u ? mine : 1u; nx = cnt > 0u ? cnt : 1u;
}
__device__ __forceinline__ void xcd_barrier(const XcdBarrier& b) {
    asm volatile("s_waitcnt vmcnt(0)" ::: "memory");
    __syncthreads();
    if (threadIdx.x == 0) {
        unsigned* bar = b.bar;
        __builtin_amdgcn_s_waitcnt(0);
        unsigned nloc = b.st[0], nx = b.st[1];
        if (nloc == 0u) { xcd_barrier_complete(bar, b.x, nloc, nx); b.st[0] = nloc; b.st[1] = nx; }
        const unsigned old = xb_add(&bar[XB_XSUB(b.x)], 1u);
        const unsigned gen = old / nloc;
        if (old + 1u == (gen + 1u) * nloc) {
            __builtin_amdgcn_fence(__ATOMIC_RELEASE, "agent");
            asm volatile("s_waitcnt vmcnt(0)" ::: "memory");
            const unsigned og = xb_add(&bar[XB_TOP], 1u);
            const unsigned tg = og / nx;
            if (og + 1u == (tg + 1u) * nx) xb_add(&bar[XB_TOPGEN], 1u);
            else XB_SPIN(xb_ld(&bar[XB_TOPGEN]) == tg, bar);
            __builtin_amdgcn_fence(__ATOMIC_ACQUIRE, "agent");
            xb_add(&bar[XB_XGEN(b.x)], 1u);
            asm volatile("s_waitcnt vmcnt(0)" ::: "memory");
        } else {
            XB_SPIN(xb_ld(&bar[XB_XGEN(b.x)]) == gen, bar);
            __builtin_amdgcn_fence(__ATOMIC_ACQUIRE, "agent");
            asm volatile("s_waitcnt vmcnt(0)" ::: "memory");
        }
    }
    __syncthreads();
}

struct Frame {
    LAS unsigned char* lds;
    unsigned* ctl;
    int tid, lane, wave, G;
    const float *x, *c, *ctx, *c_ctx, *w_mod, *b_mod, *norm1_w, *norm2_w, *w_in, *conv_w, *conv_b, *dt_bias, *a_log, *d_skip, *ssd_norm_w, *pool_w, *pool_scale, *w_out, *router_w, *router_b, *w1, *b1, *w2, *b2, *final_norm_w;
    float* out;
    float *MOD, *DTRAW, *DT, *ROWSC, *CHS, *X1, *TOPG, *SLOTGATE;
    int *TOPE, *TOPR, *TOKSLOT, *SLOTTOK, *SLOTID, *BB;
    bf16 *WINT, *WOUTT, *W1T, *W2T, *A1, *XBCPRE, *Z, *V, *XBC, *CC, *ST, *Y, *YB, *A2, *H2, *ACT, *YS;
};

template <class RowMap>
__device__ __forceinline__ void p0_emit(bf16* WT, int Kd, RowMap rm, int k0, int n0, int nvalid, LAS float* scr, int lane) {
    const int c = lane & 7;
#pragma unroll
    for (int j = 0; j < 4; ++j) { const int n = (lane >> 3) + 8 * j; const LAS float* s = scr + (8 * c) * 33 + n;
        v4u o; o.x = pk2(s[0 * 33], s[1 * 33]); o.y = pk2(s[2 * 33], s[3 * 33]); o.z = pk2(s[4 * 33], s[5 * 33]); o.w = pk2(s[6 * 33], s[7 * 33]);
        if (n0 + n < nvalid) *(v4u*)(WT + (size_t)rm(n0 + n) * Kd + k0 + 8 * c) = o; }
    LDS_WAIT(); asm volatile("" ::: "memory");
}
template <class RowMap>
__device__ __forceinline__ void p0_transpose_item(const float* W, int N, int nvalid, bf16* WT, int Kd, RowMap rm, LAS float* scr, int kb, int nb, int lane) {
    const int k0 = 64 * kb, n0 = 32 * nb, nn = n0 + (lane & 31); const bool ok = nn < nvalid;
    float tv[32];
#pragma unroll
    for (int i = 0; i < 32; ++i) { const int kk = 2 * i + (lane >> 5); tv[i] = ok ? W[(size_t)(k0 + kk) * N + nn] : 0.f; }
#pragma unroll
    for (int i = 0; i < 32; ++i) { const int kk = 2 * i + (lane >> 5); scr[kk * 33 + (lane & 31)] = tv[i]; }
    LDS_WAIT(); asm volatile("" ::: "memory");
    p0_emit(WT, Kd, rm, k0, n0, nvalid, scr, lane);
}
struct RmId { __device__ __forceinline__ int operator()(int n) const { return n; } };
struct RmOff { int off; __device__ __forceinline__ int operator()(int n) const { return n + off; } };
struct RmWin { __device__ __forceinline__ int operator()(int n) const { return n < 2560 ? n : (n < 2608 ? 4608 + (n - 2560) : 2560 + (n - 2608)); } };
struct RmW1 { __device__ __forceinline__ int operator()(int n) const { const int j = n >> 1; return 256 * (j >> 7) + 128 * (n & 1) + (j & 127); } };

__device__ __forceinline__ void p0_prologue(Frame& F) {
    if ((int)blockIdx.x < 96) {
        LAS float* sc = (LAS float*)F.lds;
        LAS float* part = (LAS float*)(F.lds + 36864);
        for (int idx = F.tid; idx < 9 * 1024; idx += 512) { const int r = idx >> 10, k = idx & 1023; const float v = (r < 8) ? F.c[r * 1024 + k] : F.c_ctx[k]; sc[idx] = silu_f(v); }
        __syncthreads();
        const int n = 64 * (int)blockIdx.x + F.lane, kb = 128 * F.wave;
        float acc[9];
#pragma unroll
        for (int r = 0; r < 9; ++r) acc[r] = 0.f;
#pragma unroll 8
        for (int k = 0; k < 128; ++k) { const float wv = F.w_mod[(size_t)(kb + k) * 6144 + n];
#pragma unroll
            for (int r = 0; r < 9; ++r) acc[r] += sc[r * 1024 + kb + k] * wv; }
#pragma unroll
        for (int r = 0; r < 9; ++r) part[(F.wave * 9 + r) * 64 + F.lane] = acc[r];
        __syncthreads();
        for (int idx = F.tid; idx < 9 * 64; idx += 512) { const int r = idx >> 6, col = idx & 63; float s = 0.f;
#pragma unroll
            for (int w = 0; w < 8; ++w) s += part[(w * 9 + r) * 64 + col];
            F.MOD[r * 6144 + 64 * (int)blockIdx.x + col] = s + F.b_mod[64 * (int)blockIdx.x + col]; }
        __syncthreads();
    }
    LAS float* scr = (LAS float*)(F.lds + F.wave * 16384);
    const int gw = (int)blockIdx.x * 8 + F.wave, NGW = F.G * 8, lane = F.lane;
    constexpr int I_POOL = 16 * 4 * 4, I_PAD = N1 - IN_COLS;
    for (int r = NGW - 1 - gw; r < I_POOL + I_PAD; r += NGW) {
        if (r < I_POOL) {
            const int kb = r >> 4, g = (r >> 2) & 3, ob = r & 3, k = 64 * kb + lane, o0 = 32 * ob;
            float acc[32];
#pragma unroll
            for (int o = 0; o < 32; ++o) acc[o] = 0.f;
            const float* arow = F.w_in + (size_t)k * IN_COLS + 4144 + g * 128;
            for (int i = 0; i < 128; ++i) { const float a = arow[i]; const float* pw = F.pool_w + (size_t)(g * 128 + i) * 128 + o0;
#pragma unroll
                for (int o = 0; o < 32; ++o) acc[o] += a * pw[o]; }
#pragma unroll
            for (int o = 0; o < 32; ++o) scr[lane * 33 + o] = acc[o] * F.pool_scale[g * 128 + o0 + o];
            LDS_WAIT(); asm volatile("" ::: "memory");
            p0_emit(F.WINT, D, RmOff{4096 + g * 128}, 64 * kb, o0, 1 << 30, scr, lane);
        } else { v4u z = {0u, 0u, 0u, 0u}; v4u* p = (v4u*)(F.WINT + (size_t)(IN_COLS + (r - I_POOL)) * D); p[lane] = z; p[lane + 64] = z; }
    }
    constexpr int I_WIN = 16 * 130, I_WOUT = 32 * 32, I_W1 = 32 * 16 * 64, I_W2 = 32 * 16 * 32, NI = I_WIN + I_WOUT + I_W1 + I_W2;
    const bool wdeal = (F.G == 256);
    const int blk = (int)blockIdx.x;
#define P0_ITEM(k) (wdeal ? ((k) < 20 ? (k) * 2048 + gw : ((k) < 27 ? (blk >= 96 ? 40960 + ((k) - 20) * 1280 + (gw - 768) : -1) : ((k) < 30 ? ((blk >= 96 && blk < 198) ? 49920 + ((k) - 27) * 816 + (gw - 768) : -1) : -1))) : (k) * NGW + gw)
    const int nrounds = wdeal ? 30 : (NI + NGW - 1) / NGW;
    struct It { const float* src; bf16* dst; int N, nvalid, Kd, kind, k0, n0; };
#define P0_DECODE(it, I) do { int r_ = (it); \
        if (r_ < I_WIN) { I.src = F.w_in; I.dst = F.WINT; I.N = IN_COLS; I.nvalid = 4144; I.Kd = D; I.kind = 1; I.k0 = 64 * (r_ / 130); I.n0 = 32 * (r_ % 130); } \
        else if ((r_ -= I_WIN) < I_WOUT) { I.src = F.w_out; I.dst = F.WOUTT; I.N = D; I.nvalid = D; I.Kd = 2048; I.kind = 0; I.k0 = 64 * (r_ >> 5); I.n0 = 32 * (r_ & 31); } \
        else if ((r_ -= I_WOUT) < I_W1) { const int e_ = r_ >> 10, q_ = r_ & 1023; I.src = F.w1 + (size_t)e_ * D * 2048; I.dst = (bf16*)((unsigned char*)F.W1T + (size_t)e_ * 2048 * D); I.N = 2048; I.nvalid = 2048; I.Kd = D; I.kind = 2; I.k0 = 64 * (q_ >> 6); I.n0 = 32 * (q_ & 63); } \
        else { r_ -= I_W1; const int e_ = r_ >> 9, q_ = r_ & 511; I.src = F.w2 + (size_t)e_ * D * D; I.dst = (bf16*)((unsigned char*)F.W2T + (size_t)e_ * D * D); I.N = D; I.nvalid = D; I.Kd = D; I.kind = 3; I.k0 = 64 * (q_ >> 5); I.n0 = 32 * (q_ & 31); } } while (0)
#define P0_LOAD(I, tv) do { int nn_ = I.n0 + (lane & 31); nn_ = nn_ < I.nvalid ? nn_ : I.nvalid - 1; const float* sp_ = I.src + (size_t)(I.k0 + (lane >> 5)) * I.N + nn_; \
        _Pragma("unroll") for (int i_ = 0; i_ < 32; ++i_) { const float* q_ = sp_ + (size_t)(2 * i_) * I.N; asm volatile("global_load_dword %0, %1, off" : "=v"(tv[i_]) : "v"(q_) : "memory"); } } while (0)
#define P0_NEXT(itv) do { itv = -1; for (; kr < nrounds && itv < 0; ++kr) { const int it_ = P0_ITEM(kr); if (it_ >= 0 && it_ < NI) itv = it_; } } while (0)
#define P0_PROCESS(I, tv) do { \
        _Pragma("unroll") for (int i = 0; i < 32; ++i) { const int kk = 2 * i + (lane >> 5); scr[kk * 33 + (lane & 31)] = tv[i]; } \
        LDS_WAIT(); asm volatile("" ::: "memory"); \
        { const int c = lane & 7; \
          _Pragma("unroll") for (int j = 0; j < 4; ++j) { const int n = (lane >> 3) + 8 * j; const LAS float* sq = scr + (8 * c) * 33 + n; \
            const int ng = I.n0 + n; const int row = (I.kind == 0 || I.kind == 3) ? ng : (I.kind == 1 ? RmWin{}(ng) : RmW1{}(ng)); \
            if (I.kind >= 2) { v2u o; o.x = pk4_fp8(sq[0 * 33] * WSCALE, sq[1 * 33] * WSCALE, sq[2 * 33] * WSCALE, sq[3 * 33] * WSCALE); o.y = pk4_fp8(sq[4 * 33] * WSCALE, sq[5 * 33] * WSCALE, sq[6 * 33] * WSCALE, sq[7 * 33] * WSCALE); \
                *(v2u*)((unsigned char*)I.dst + (size_t)row * I.Kd + I.k0 + 8 * c) = o; } \
            else { v4u o; o.x = pk2(sq[0 * 33], sq[1 * 33]); o.y = pk2(sq[2 * 33], sq[3 * 33]); o.z = pk2(sq[4 * 33], sq[5 * 33]); o.w = pk2(sq[6 * 33], sq[7 * 33]); \
                if (ng < I.nvalid) *(v4u*)(I.dst + (size_t)row * I.Kd + I.k0 + 8 * c) = o; } } \
          LDS_WAIT(); asm volatile("" ::: "memory"); } } while (0)
    It ia{}, ib{}; float ta[32], tb[32]; int ita = -1, itb = -1; int kr = 0;
    P0_NEXT(ita);
    if (ita >= 0) { P0_DECODE(ita, ia); P0_LOAD(ia, ta); }
    while (ita >= 0) {
        P0_NEXT(itb);
        if (itb >= 0) { P0_DECODE(itb, ib); P0_LOAD(ib, tb); asm volatile("s_waitcnt vmcnt(32)" ::: "memory"); } else { asm volatile("s_waitcnt vmcnt(0)" ::: "memory"); }
        __builtin_amdgcn_sched_barrier(0);
        P0_PROCESS(ia, ta);
        if (itb < 0) break;
        P0_NEXT(ita);
        if (ita >= 0) { P0_DECODE(ita, ia); P0_LOAD(ia, ta); asm volatile("s_waitcnt vmcnt(32)" ::: "memory"); } else { asm volatile("s_waitcnt vmcnt(0)" ::: "memory"); }
        __builtin_amdgcn_sched_barrier(0);
        P0_PROCESS(ib, tb);
    }
#undef P0_NEXT
#undef P0_PROCESS
#undef P0_ITEM
#undef P0_DECODE
#undef P0_LOAD
}

__device__ __forceinline__ void p1_norm1(Frame& F) {
    const int gw = (int)blockIdx.x * 8 + F.wave, NGW = F.G * 8, lane = F.lane;
    for (int rq = gw; rq < RTOT / 4; rq += NGW) {
        f32x4 v[4][4];
#pragma unroll
        for (int k = 0; k < 4; ++k) { const int r = rq * 4 + k; const float* xr = (r < T) ? F.x + (size_t)r * D : F.ctx + (size_t)(r - T) * D;
#pragma unroll
            for (int j = 0; j < 4; ++j) v[k][j] = *(const f32x4*)(xr + 4 * lane + 256 * j); }
#pragma unroll
        for (int k = 0; k < 4; ++k) { const int r = rq * 4 + k;
            const float* mod = F.MOD + (size_t)((r < T) ? (r >> 12) : 8) * 6144;
            float ss = 0.f;
#pragma unroll
            for (int j = 0; j < 4; ++j) ss += (v[k][j].x * v[k][j].x + v[k][j].y * v[k][j].y) + (v[k][j].z * v[k][j].z + v[k][j].w * v[k][j].w);
            const float rs = 1.f / sqrtf(wave_sum(ss) * (1.f / D) + RMS_EPS);
#pragma unroll
            for (int j = 0; j < 4; ++j) { const int col = 4 * lane + 256 * j;
                const f32x4 w = *(const f32x4*)(F.norm1_w + col), sh = *(const f32x4*)(mod + col), sc = *(const f32x4*)(mod + 1024 + col);
                const f32x4 h = (v[k][j] * rs) * w * (sc + 1.f) + sh;
                v2u o; o.x = pk2(h.x, h.y); o.y = pk2(h.z, h.w);
                *(v2u*)(F.A1 + (size_t)r * D + col) = o; } }
    }
}

struct Sched1 {
    const char* A; const char* Bt; int G, c;
    __device__ __forceinline__ bool next(int i, pg8::Unit& u) const {
        const int L = i * G + c; if (L >= 2432 + 88) return false;
        if (L < 2432) pg8::static_map(L, 128, 19, u.pm, u.pn);
        else { const int Lc = L - 2432, j = Lc >> 3; u.pm = 128 + (Lc & 7); u.pn = j < 10 ? j : 18; }
        u.e = 0; return true; }
    __device__ __forceinline__ const char* a_base(const pg8::Unit& u) const { return A + (size_t)u.pm * 256 * D * 2; }
    __device__ __forceinline__ const char* b_base(const pg8::Unit& u) const { return Bt + (size_t)u.pn * 256 * D * 2; }
    __device__ __forceinline__ const int* row_table(const pg8::Unit&) const { return nullptr; }
};
struct Epi1 {
    static constexpr bool PERM = true;
    bf16 *XBCPRE, *Z, *V; float* DTRAW;
    __device__ __forceinline__ void operator()(const f32x4 (&acc)[2][2][4][2], const pg8::Unit& u, int wr, int wc, int fr, int fq) const {
        const int row0 = u.pm * 256 + wr * 64 + fr;
        if (u.pn < 18) {
            bf16* base; int ldc, colt;
            if (u.pn < 10) { base = XBCPRE; ldc = CONV_CH; colt = u.pn * 256; } else if (u.pn < 16) { base = Z; ldc = SSD_W; colt = (u.pn - 10) * 256; } else { base = V; ldc = 512; colt = (u.pn - 16) * 256; }
            const int col0 = colt + wc * 32 + 8 * fq;
#pragma unroll
            for (int ai = 0; ai < 2; ++ai)
#pragma unroll
                for (int m = 0; m < 4; ++m) { bf16* rowp = base + (size_t)(row0 + ai * 128 + m * 16) * ldc + col0;
#pragma unroll
                    for (int bj = 0; bj < 2; ++bj) { const f32x4 v0 = acc[ai][bj][m][0], v1 = acc[ai][bj][m][1];
                        v4u w; w.x = pg8::cvt_pk_bf16(v0[0], v0[1]); w.y = pg8::cvt_pk_bf16(v0[2], v0[3]); w.z = pg8::cvt_pk_bf16(v1[0], v1[1]); w.w = pg8::cvt_pk_bf16(v1[2], v1[3]);
                        *(v4u*)(rowp + bj * 128) = w; } }
        } else if (wc < 2) {
            const int col0 = wc * 32 + 8 * fq;
#pragma unroll
            for (int ai = 0; ai < 2; ++ai)
#pragma unroll
                for (int m = 0; m < 4; ++m) { float* rowp = DTRAW + (size_t)(row0 + ai * 128 + m * 16) * 64 + col0;
                    *(f32x4*)(rowp) = acc[ai][0][m][0]; *(f32x4*)(rowp + 4) = acc[ai][0][m][1]; }
        }
    }
};

__device__ __forceinline__ void p3_conv(Frame& F) {
    const int gt = (int)blockIdx.x * 512 + F.tid, NT_ = F.G * 512;
    constexpr int RPT = 16, NTASK = (RTOT / RPT) * 320;
    for (int task = gt; task < NTASK; task += NT_) {
        const int rt = task / 320, cg = task - rt * 320, r0 = rt * RPT, ch = cg * 8;
        int slo, shi; if (r0 < T) { slo = r0 & ~(SEQ - 1); shi = slo + SEQ; } else { slo = T + ((r0 - T) & ~(CTXL - 1)); shi = slo + CTXL; }
        const v4u zero = {0u, 0u, 0u, 0u};
        v4u win[RPT + 4];
#pragma unroll
        for (int j = 0; j < RPT + 4; ++j) { const int r = r0 - 2 + j; win[j] = (r >= slo && r < shi) ? *(const v4u*)(F.XBCPRE + (size_t)r * CONV_CH + ch) : zero; }
        float w[5][8], bias[8];
#pragma unroll
        for (int j = 0; j < 5; ++j) { const f32x4 a = *(const f32x4*)(F.conv_w + j * CONV_CH + ch), b = *(const f32x4*)(F.conv_w + j * CONV_CH + ch + 4);
            w[j][0] = a.x; w[j][1] = a.y; w[j][2] = a.z; w[j][3] = a.w; w[j][4] = b.x; w[j][5] = b.y; w[j][6] = b.z; w[j][7] = b.w; }
        { const f32x4 a = *(const f32x4*)(F.conv_b + ch), b = *(const f32x4*)(F.conv_b + ch + 4); bias[0] = a.x; bias[1] = a.y; bias[2] = a.z; bias[3] = a.w; bias[4] = b.x; bias[5] = b.y; bias[6] = b.z; bias[7] = b.w; }
#pragma unroll
        for (int i = 0; i < RPT; ++i) {
            float o[8];
#pragma unroll
            for (int e = 0; e < 8; ++e) o[e] = bias[e];
#pragma unroll
            for (int j = 0; j < 5; ++j) { const v4u q = win[i + j];
                o[0] += w[j][0] * bflo(q.x); o[1] += w[j][1] * bfhi(q.x); o[2] += w[j][2] * bflo(q.y); o[3] += w[j][3] * bfhi(q.y);
                o[4] += w[j][4] * bflo(q.z); o[5] += w[j][5] * bfhi(q.z); o[6] += w[j][6] * bflo(q.w); o[7] += w[j][7] * bfhi(q.w); }
            v4u ov; ov.x = pk2(silu_f(o[0]), silu_f(o[1])); ov.y = pk2(silu_f(o[2]), silu_f(o[3])); ov.z = pk2(silu_f(o[4]), silu_f(o[5])); ov.w = pk2(silu_f(o[6]), silu_f(o[7]));
            *(v4u*)(F.XBC + (size_t)(r0 + i) * CONV_CH + ch) = ov;
        }
    }
    for (int idx = gt; idx < RTOT * 48; idx += NT_) { const int r = idx / 48, j = idx - r * 48; const float v = F.DTRAW[(size_t)r * 64 + j] + F.dt_bias[j];
        F.DT[idx] = v > 20.f ? v : log1pf(__expf(v)); }
}

__device__ __forceinline__ bf16x8 frag_row(const LAS unsigned char* base, int rs, int row, int k0, int q) { return *(const LAS bf16x8*)(base + row * rs + (k0 + 8 * q) * 2); }
__device__ __forceinline__ bf16x8 frag_tr(const LAS unsigned char* base, int rs, int k0, int c0, int lane) {
    const int g = lane >> 4, qq = (lane & 15) >> 2, p = lane & 3;
    const LAS unsigned char* a = base + (k0 + 8 * g + qq) * rs + c0 * 2 + 8 * p;
    const s16x4 lo = __builtin_amdgcn_ds_read_tr16_b64_v4i16((LAS s16x4*)a);
    const s16x4 hi = __builtin_amdgcn_ds_read_tr16_b64_v4i16((LAS s16x4*)(a + 4 * rs));
    bf16x8 r; r[0] = lo[0]; r[1] = lo[1]; r[2] = lo[2]; r[3] = lo[3]; r[4] = hi[0]; r[5] = hi[1]; r[6] = hi[2]; r[7] = hi[3]; return r;
}
__device__ __forceinline__ f32x4 mfma16(bf16x8 a, bf16x8 b, f32x4 c) { return __builtin_amdgcn_mfma_f32_16x16x32_bf16(a, b, c, 0, 0, 0); }
__device__ __forceinline__ float wave_incl_scan(float v, int lane) {
#pragma unroll
    for (int o = 1; o < 64; o <<= 1) { const float t = __shfl_up(v, o); if (lane >= o) v += t; }
    return v;
}

__device__ __forceinline__ float silu_fast(float v) { return v * __builtin_amdgcn_rcpf(1.f + __builtin_amdgcn_exp2f(-1.44269504f * v)); }
__device__ __forceinline__ float softplus_f(float v) { return v > 20.f ? v : log1pf(__expf(v)); }
__device__ __forceinline__ void p4_scan(Frame& F, LAS float* Te, volatile LAS float* TOT, int d, int h, float raw0, float raw1, int lane, size_t chs_idx, float* rowsc) {
    const int s0 = d ? 127 - 2 * lane : 2 * lane, s1 = d ? s0 - 1 : s0 + 1;
    const float bias = F.dt_bias[d * NH + h];
    const float dt0 = softplus_f(raw0 + bias), dt1 = softplus_f(raw1 + bias);
    const float A2 = __expf(F.a_log[d * NH + h]) * 1.44269504f;
    const float a0 = -A2 * dt0, a1 = -A2 * dt1;
    const float incl = wave_incl_scan(a0 + a1, lane);
    const float c1 = incl, c0 = incl - a1, tot = __shfl(incl, 63);
    Te[d * 128 + s0] = c0; Te[d * 128 + s1] = c1;
    Te[(2 + d) * 128 + s0] = c0 - __builtin_amdgcn_logf(dt0); Te[(2 + d) * 128 + s1] = c1 - __builtin_amdgcn_logf(dt1);
    if (lane == 63) { F.CHS[chs_idx] = tot; *TOT = tot; }
    if (rowsc) { rowsc[s0] = __builtin_amdgcn_exp2f(c0); rowsc[s1] = __builtin_amdgcn_exp2f(c1); }
}
__device__ __forceinline__ v4u conv_piece(const v4u& r0, const v4u& r1, const v4u& r2, const v4u& r3, const v4u& r4, const float (&w)[5][8], const float (&bias)[8]) {
    float o[8];
#pragma unroll
    for (int e = 0; e < 8; ++e) o[e] = bias[e];
    const v4u rr[5] = {r0, r1, r2, r3, r4};
#pragma unroll
    for (int j = 0; j < 5; ++j) { const v4u q = rr[j];
        o[0] += w[j][0] * bflo(q.x); o[1] += w[j][1] * bfhi(q.x); o[2] += w[j][2] * bflo(q.y); o[3] += w[j][3] * bfhi(q.y);
        o[4] += w[j][4] * bflo(q.z); o[5] += w[j][5] * bfhi(q.z); o[6] += w[j][6] * bflo(q.w); o[7] += w[j][7] * bfhi(q.w); }
    v4u ov; ov.x = pk2(silu_fast(o[0]), silu_fast(o[1])); ov.y = pk2(silu_fast(o[2]), silu_fast(o[3])); ov.z = pk2(silu_fast(o[4]), silu_fast(o[5])); ov.w = pk2(silu_fast(o[6]), silu_fast(o[7]));
    return ov;
}
__device__ __forceinline__ void p4_states(Frame& F, const bf16x8 (&braw)[4], const LAS float* Te, const volatile LAS float* TOT2, const LAS unsigned char* Xs, size_t st_base, int w, int lane) {
    constexpr int RSX = 144;
    const int i16 = lane & 15, q4 = lane >> 4;
#pragma unroll
    for (int d = 0; d < 2; ++d) {
        const float tot = TOT2[d];
        f32x4 sa[4];
#pragma unroll
        for (int pt = 0; pt < 4; ++pt) sa[pt] = (f32x4){0.f, 0.f, 0.f, 0.f};
#pragma unroll
        for (int ks = 0; ks < 4; ++ks) {
            const LAS float* cp = Te + (2 + d) * 128 + 32 * ks + 8 * q4;
            const f32x4 c0 = *(const LAS f32x4*)cp, c1 = *(const LAS f32x4*)(cp + 4);
            float wv[8];
#pragma unroll
            for (int j = 0; j < 4; ++j) { wv[j] = __builtin_amdgcn_exp2f(tot - c0[j]); wv[4 + j] = __builtin_amdgcn_exp2f(tot - c1[j]); }
            const v4u bu = __builtin_bit_cast(v4u, braw[ks]); v4u su;
            su.x = pk2(bflo(bu.x) * wv[0], bfhi(bu.x) * wv[1]); su.y = pk2(bflo(bu.y) * wv[2], bfhi(bu.y) * wv[3]);
            su.z = pk2(bflo(bu.z) * wv[4], bfhi(bu.z) * wv[5]); su.w = pk2(bflo(bu.w) * wv[6], bfhi(bu.w) * wv[7]);
            const bf16x8 bs = __builtin_bit_cast(bf16x8, su);
#pragma unroll
            for (int pt = 0; pt < 4; ++pt) sa[pt] = mfma16(bs, frag_tr(Xs, RSX, 32 * ks, 16 * pt, lane), sa[pt]); }
        bf16* sp = F.ST + st_base + ((size_t)d * HDIM + i16) * NST + 16 * w + 4 * q4;
#pragma unroll
        for (int pt = 0; pt < 4; ++pt) { v2u o; o.x = pk2(sa[pt][0], sa[pt][1]); o.y = pk2(sa[pt][2], sa[pt][3]); *(v2u*)(sp + (size_t)16 * pt * NST) = o; }
    }
}
__device__ __forceinline__ void p4_ssd_local(Frame& F) {
    constexpr int RS = 272, RSX = 144;
    constexpr int O_C = 0, O_B = 34816, O_M = 69632, O_X = 104448  , O_T = 141312  , O_CW = 153600  ;
    static_assert(O_CW + 9216 <= MISC_OFF, "P4 LDS map");
    LAS unsigned char* L = F.lds;
    LAS float* TAB = (LAS float*)(L + O_T);
    LAS float* CW = (LAS float*)(L + O_CW);
    volatile LAS float* TOT = (volatile LAS float*)(L + MISC_OFF + 64);
    volatile LAS float* DSK = (volatile LAS float*)(L + MISC_OFF + 128);
    const int tid = F.tid, lane = F.lane, w = F.wave, i16 = lane & 15, q4 = lane >> 4;
    const int lb = 64 * (w & 1), sb = 32 * (w >> 1);
    const v4u zero4 = {0u, 0u, 0u, 0u};
    constexpr int NLAT = NB * 32 * NGRP, NCTX = NB * 2 * NGRP * HPG;
    for (int v = (int)blockIdx.x; v < NLAT + NCTX; v += F.G) {
        const bool lat = v < NLAT;
        int tid_l = tid; asm volatile("" : "+v"(tid_l));
        const int lane_l = tid_l & 63;
        const int p32 = tid_l & 31, rg = tid_l >> 5;
        const int xpc = tid_l & 7, rg2 = tid_l >> 3;
        int b, g, cc, r0, e_lo, e_hi; bool lo_ok, hi_ok;
        if (lat) { b = v >> 7; const int c = (v >> 2) & 31; g = v & 3; cc = c + 2; r0 = b * SEQ + c * CHUNK; lo_ok = c > 0; hi_ok = c < 31; e_lo = 0; e_hi = HPG; }
        else { const int q = v - NLAT; const int e = q % HPG; int t = q / HPG; g = t & 3; t >>= 2; cc = t & 1; b = t >> 1; r0 = T + b * CTXL + cc * CHUNK; lo_ok = cc > 0; hi_ok = cc < 1; e_lo = e; e_hi = e + 1; }
        const int rmin = lo_ok ? -2 : 0, rmax = hi_ok ? 129 : 127;
        const int chBC = SSD_W + (p32 >> 4) * (NGRP * NST) + g * NST + 8 * (p32 & 15);
        v4u raw[12];
#pragma unroll
        for (int j = 0; j < 12; ++j) { const int rr = 8 * rg - 2 + j; const int rc = rr < rmin ? rmin : (rr > rmax ? rmax : rr);
            const v4u t = *(const v4u*)(F.XBCPRE + (size_t)(r0 + rc) * CONV_CH + chBC); raw[j] = (rr == rc) ? t : zero4; }
        if (tid < HPG) DSK[tid] = F.d_skip[g * HPG + tid];
        for (int idx = tid; idx < HPG * 6 * 64; idx += 512) { const int e_ = idx / 384, rem = idx - e_ * 384, j = rem >> 6, chl = rem & 63; const int ch = (g * HPG + e_) * HDIM + chl;
            CW[idx] = (j < 5) ? F.conv_w[j * CONV_CH + ch] : F.conv_b[ch]; }
        {
            float cw[5][8], cbias[8];
#pragma unroll
            for (int j = 0; j < 5; ++j) { const f32x4 a = *(const f32x4*)(F.conv_w + j * CONV_CH + chBC), bq = *(const f32x4*)(F.conv_w + j * CONV_CH + chBC + 4);
                cw[j][0] = a.x; cw[j][1] = a.y; cw[j][2] = a.z; cw[j][3] = a.w; cw[j][4] = bq.x; cw[j][5] = bq.y; cw[j][6] = bq.z; cw[j][7] = bq.w; }
            { const f32x4 a = *(const f32x4*)(F.conv_b + chBC), bq = *(const f32x4*)(F.conv_b + chBC + 4); cbias[0] = a.x; cbias[1] = a.y; cbias[2] = a.z; cbias[3] = a.w; cbias[4] = bq.x; cbias[5] = bq.y; cbias[6] = bq.z; cbias[7] = bq.w; }
            LAS unsigned char* dst = L + ((p32 >> 4) ? O_C : O_B) + (8 * rg) * RS + (p32 & 15) * 16;
#pragma unroll
            for (int i = 0; i < 8; ++i) { const v4u o = conv_piece(raw[i], raw[i + 1], raw[i + 2], raw[i + 3], raw[i + 4], cw, cbias);
                *(LAS v4u*)(dst + i * RS) = o;
                if (lat && (p32 >> 4)) *(v4u*)(F.CC + (size_t)(r0 + 8 * rg + i) * 512 + g * NST + 8 * (p32 & 15)) = o; }
        }
        v4u xraw[6];
#pragma unroll
        for (int j = 0; j < 6; ++j) { const int rr = 2 * rg2 - 2 + j; const int rc = rr < rmin ? rmin : (rr > rmax ? rmax : rr);
            xraw[j] = *(const v4u*)(F.XBCPRE + (size_t)(r0 + rc) * CONV_CH + (g * HPG + e_lo) * HDIM + 8 * xpc); }
        float pdt[2][2];
#pragma unroll
        for (int ii = 0; ii < 2; ++ii) { const int idx = (w + 8 * ii) < 12 ? (w + 8 * ii) : 11; const int e_ = idx % 6, d_ = idx / 6, h_ = g * HPG + e_; const int s0 = d_ ? 127 - 2 * lane_l : 2 * lane_l, s1 = d_ ? s0 - 1 : s0 + 1;
            pdt[ii][0] = F.DTRAW[(size_t)(r0 + s0) * 64 + d_ * NH + h_]; pdt[ii][1] = F.DTRAW[(size_t)(r0 + s1) * 64 + d_ * NH + h_]; }
#pragma unroll
        for (int ii = 0; ii < 2; ++ii) { const int idx = w + 8 * ii; const int e = idx % 6, d = idx / 6, h = g * HPG + e;
            if (idx < 12 && e >= e_lo && e < e_hi)
                p4_scan(F, TAB + e * 512, TOT + e * 2 + d, d, h, pdt[ii][0], pdt[ii][1], lane_l, ((size_t)(b * NCC + cc) * NH + h) * 2 + d, lat ? F.ROWSC + ((size_t)(b * 2 + d) * NH + h) * SEQ + (cc - 2) * CHUNK : nullptr); }
        __syncthreads();
        f32x4 cb[2][4];
        if (lat) {
#pragma unroll
            for (int ts = 0; ts < 2; ++ts)
#pragma unroll
                for (int tl = 0; tl < 4; ++tl) cb[ts][tl] = (f32x4){0.f, 0.f, 0.f, 0.f};
#pragma unroll
            for (int ks = 0; ks < 4; ++ks) { bf16x8 af[2], bfr[4];
#pragma unroll
                for (int ts = 0; ts < 2; ++ts) af[ts] = frag_row(L + O_B, RS, sb + 16 * ts + i16, 32 * ks, q4);
#pragma unroll
                for (int tl = 0; tl < 4; ++tl) bfr[tl] = frag_row(L + O_C, RS, lb + 16 * tl + i16, 32 * ks, q4);
#pragma unroll
                for (int ts = 0; ts < 2; ++ts)
#pragma unroll
                    for (int tl = 0; tl < 4; ++tl) cb[ts][tl] = mfma16(af[ts], bfr[tl], cb[ts][tl]); }
        }
        bf16x8 braw[4];
#pragma unroll
        for (int ks = 0; ks < 4; ++ks) braw[ks] = frag_tr(L + O_B, RS, 32 * ks, 16 * w, lane);
        for (int e = e_lo; e < e_hi; ++e) {
            const int h = g * HPG + e;
            const LAS float* Te = TAB + e * 512;
            LAS unsigned char* Xs = L + O_X + (e & 1) * 18432;
            LAS unsigned char* Ms = L + ((e & 1) ? O_C : O_M);
            {
                const LAS float* cwp = CW + (e * 6) * 64 + 8 * xpc;
#pragma unroll
                for (int i = 0; i < 2; ++i) {
                    f32x4 oa = *(const LAS f32x4*)(cwp + 5 * 64), ob = *(const LAS f32x4*)(cwp + 5 * 64 + 4);
#pragma unroll
                    for (int j = 0; j < 5; ++j) { const f32x4 wa = *(const LAS f32x4*)(cwp + j * 64), wb = *(const LAS f32x4*)(cwp + j * 64 + 4);
                        const int rr = 2 * rg2 - 2 + i + j; const v4u q = (rr >= rmin && rr <= rmax) ? xraw[i + j] : zero4;
                        oa.x += wa.x * bflo(q.x); oa.y += wa.y * bfhi(q.x); oa.z += wa.z * bflo(q.y); oa.w += wa.w * bfhi(q.y);
                        ob.x += wb.x * bflo(q.z); ob.y += wb.y * bfhi(q.z); ob.z += wb.z * bflo(q.w); ob.w += wb.w * bfhi(q.w); }
                    v4u ov; ov.x = pk2(silu_fast(oa.x), silu_fast(oa.y)); ov.y = pk2(silu_fast(oa.z), silu_fast(oa.w)); ov.z = pk2(silu_fast(ob.x), silu_fast(ob.y)); ov.w = pk2(silu_fast(ob.z), silu_fast(ob.w));
                    *(LAS v4u*)(Xs + (2 * rg2 + i) * RSX + xpc * 16) = ov; }
            }
            if (e + 1 < e_hi) {
#pragma unroll
                for (int j = 0; j < 6; ++j) { const int rr = 2 * rg2 - 2 + j; const int rc = rr < rmin ? rmin : (rr > rmax ? rmax : rr);
                    xraw[j] = *(const v4u*)(F.XBCPRE + (size_t)(r0 + rc) * CONV_CH + (h + 1) * HDIM + 8 * xpc); }
            }
            if (lat) {
                const float Dh = DSK[e];
#pragma unroll
                for (int tl = 0; tl < 4; ++tl) { const int l = lb + 16 * tl + i16; const int lt_abs = 4 * (w & 1) + tl; const float af_l = Te[l], rb_l = Te[128 + l];
#pragma unroll
                    for (int ts = 0; ts < 2; ++ts) { const int s0 = sb + 16 * ts + 4 * q4; const int st_abs = 2 * (w >> 1) + ts;
                        float m[4];
                        if (st_abs < lt_abs) {
                            const f32x4 acs = *(const LAS f32x4*)(Te + 256 + s0);
#pragma unroll
                            for (int r = 0; r < 4; ++r) m[r] = cb[ts][tl][r] * __builtin_amdgcn_exp2f(af_l - acs[r]);
                        } else if (st_abs > lt_abs) {
                            const f32x4 rbs = *(const LAS f32x4*)(Te + 384 + s0);
#pragma unroll
                            for (int r = 0; r < 4; ++r) m[r] = cb[ts][tl][r] * __builtin_amdgcn_exp2f(rb_l - rbs[r]);
                        } else {
                            const f32x4 acs = *(const LAS f32x4*)(Te + 256 + s0), rbs = *(const LAS f32x4*)(Te + 384 + s0);
#pragma unroll
                            for (int r = 0; r < 4; ++r) { const int sidx = s0 + r;
                                const float wf = (sidx <= l) ? __builtin_amdgcn_exp2f(af_l - acs[r]) : 0.f;
                                const float wb = (sidx >= l) ? __builtin_amdgcn_exp2f(rb_l - rbs[r]) : 0.f;
                                m[r] = cb[ts][tl][r] * (wf + wb) + ((sidx == l) ? Dh : 0.f); }
                        }
                        v2u o; o.x = pk2(m[0], m[1]); o.y = pk2(m[2], m[3]);
                        *(LAS v2u*)(Ms + l * RS + s0 * 2) = o; } }
            }
            __syncthreads();
            if (lat) {
                f32x4 ya[4];
#pragma unroll
                for (int pt = 0; pt < 4; ++pt) ya[pt] = (f32x4){0.f, 0.f, 0.f, 0.f};
#pragma unroll
                for (int ks = 0; ks < 4; ++ks) { const bf16x8 bm = frag_row(Ms, RS, 16 * w + i16, 32 * ks, q4);
#pragma unroll
                    for (int pt = 0; pt < 4; ++pt) ya[pt] = mfma16(frag_tr(Xs, RSX, 32 * ks, 16 * pt, lane), bm, ya[pt]); }
                bf16* yp = F.Y + (size_t)(r0 + 16 * w + i16) * SSD_W + h * HDIM + 4 * q4;
#pragma unroll
                for (int pt = 0; pt < 4; ++pt) { v2u o; o.x = pk2(ya[pt][0], ya[pt][1]); o.y = pk2(ya[pt][2], ya[pt][3]); *(v2u*)(yp + 16 * pt) = o; }
            }
            p4_states(F, braw, Te, TOT + e * 2, Xs, (((size_t)(b * NCC + cc) * NH + h) * 2) * HDIM * NST, w, lane);
        }
        __syncthreads();
    }
}

__device__ __forceinline__ void p5_ssd_scan(Frame& F) {
    constexpr int RS = 272, O_RS = 4 * 34816;
    LAS unsigned char* L = F.lds;
    LAS float* RSB = (LAS float*)(L + O_RS);
    const int tid = F.tid, lane = F.lane, w = F.wave, i16 = lane & 15, q4 = lane >> 4;
    const int d = w >> 2, ps = w & 3, t8 = tid & 255;
    for (int u = (int)blockIdx.x; u < NB * NH; u += F.G) {
        const int b = u / NH, h = u - b * NH, g = h / HPG;
        float S[32];
#pragma unroll
        for (int k = 0; k < 32; ++k) S[k] = 0.f;
        v4u creg[8]; float rsreg = 0.f;
#pragma unroll
        for (int k = 0; k < 8; ++k) creg[k] = (v4u){0u, 0u, 0u, 0u};
        for (int j = 0; j < NCC; ++j) {
            const int cc = d == 0 ? j : (j < 2 ? 1 - j : 35 - j);
            LAS unsigned char* Cb = L + ((j & 1) * 2 + d) * 34816;
            if (j >= 2) {
#pragma unroll
                for (int k = 0; k < 8; ++k) { const int pc = t8 + 256 * k, row = pc >> 4, ch = pc & 15; *(LAS v4u*)(Cb + row * RS + ch * 16) = creg[k]; }
                if (t8 < 128) RSB[((j & 1) * 2 + d) * 128 + t8] = rsreg;
            }
            __syncthreads();
            if (j + 1 >= 2 && j + 1 < NCC) {
                const int cn = d == 0 ? j + 1 : 34 - j;
                const size_t rown = (size_t)b * SEQ + (size_t)(cn - 2) * CHUNK;
#pragma unroll
                for (int k = 0; k < 8; ++k) { const int pc = t8 + 256 * k, row = pc >> 4, ch = pc & 15; creg[k] = *(const v4u*)(F.CC + (rown + row) * 512 + g * NST + ch * 8); }
                if (t8 < 128) rsreg = F.ROWSC[((size_t)(b * 2 + d) * NH + h) * SEQ + (cn - 2) * CHUNK + t8];
            }
            const size_t sidx = ((size_t)(b * NCC + cc) * NH + h) * 2 + d;
            const bf16* stp = F.ST + (sidx * HDIM + 16 * ps + i16) * NST + 8 * q4;
            v4u stv[4];
#pragma unroll
            for (int ks = 0; ks < 4; ++ks) stv[ks] = *(const v4u*)(stp + 32 * ks);
            const float decay = __builtin_amdgcn_exp2f(F.CHS[sidx]);
            if (j >= 2) {
                bf16x8 sf[4];
#pragma unroll
                for (int ks = 0; ks < 4; ++ks) { v4u t; t.x = pk2(S[ks * 8 + 0], S[ks * 8 + 1]); t.y = pk2(S[ks * 8 + 2], S[ks * 8 + 3]); t.z = pk2(S[ks * 8 + 4], S[ks * 8 + 5]); t.w = pk2(S[ks * 8 + 6], S[ks * 8 + 7]); sf[ks] = __builtin_bit_cast(bf16x8, t); }
                const size_t rowb = (size_t)b * SEQ + (size_t)(cc - 2) * CHUNK;
                const LAS float* rsl = RSB + ((j & 1) * 2 + d) * 128;
                v2u yold[8];
                if (d == 0) {
#pragma unroll
                    for (int lt = 0; lt < 8; ++lt) yold[lt] = *(const v2u*)(F.Y + (rowb + 16 * lt + i16) * SSD_W + h * HDIM + 16 * ps + 4 * q4);
                }
#pragma unroll
                for (int lt = 0; lt < 8; ++lt) {
                    f32x4 a = (f32x4){0.f, 0.f, 0.f, 0.f};
#pragma unroll
                    for (int ks = 0; ks < 4; ++ks) a = mfma16(sf[ks], frag_row(Cb, RS, 16 * lt + i16, 32 * ks, q4), a);
                    const float sc = rsl[16 * lt + i16];
                    const size_t off = (rowb + 16 * lt + i16) * SSD_W + h * HDIM + 16 * ps + 4 * q4;
                    if (d == 0) { const v2u old = yold[lt]; v2u o; o.x = pk2(bflo(old.x) + a[0] * sc, bfhi(old.x) + a[1] * sc); o.y = pk2(bflo(old.y) + a[2] * sc, bfhi(old.y) + a[3] * sc); *(v2u*)(F.Y + off) = o; }
                    else { v2u o; o.x = pk2(a[0] * sc, a[1] * sc); o.y = pk2(a[2] * sc, a[3] * sc); *(v2u*)(F.YB + off) = o; }
                }
            }
#pragma unroll
            for (int ks = 0; ks < 4; ++ks) { const v4u t = stv[ks];
                S[ks * 8 + 0] = decay * S[ks * 8 + 0] + bflo(t.x); S[ks * 8 + 1] = decay * S[ks * 8 + 1] + bfhi(t.x);
                S[ks * 8 + 2] = decay * S[ks * 8 + 2] + bflo(t.y); S[ks * 8 + 3] = decay * S[ks * 8 + 3] + bfhi(t.y);
                S[ks * 8 + 4] = decay * S[ks * 8 + 4] + bflo(t.z); S[ks * 8 + 5] = decay * S[ks * 8 + 5] + bfhi(t.z);
                S[ks * 8 + 6] = decay * S[ks * 8 + 6] + bflo(t.w); S[ks * 8 + 7] = decay * S[ks * 8 + 7] + bfhi(t.w); }
        }
        __syncthreads();
    }
}

__device__ __forceinline__ void p6_gate_pool(Frame& F) {
    LAS unsigned char* L = F.lds;
    const int tid = F.tid, lane = F.lane, w = F.wave;
    for (int gr = (int)blockIdx.x; gr < T / 64; gr += F.G) {
        const int rb = gr * 64;
        v4u pv[8];
#pragma unroll
        for (int k = 0; k < 8; ++k) { const int pc = tid + 512 * k, row = pc >> 6, ch = pc & 63; pv[k] = *(const v4u*)(F.V + (size_t)(rb + row) * 512 + ch * 8); }
#pragma unroll
        for (int k = 0; k < 8; ++k) { const int pc = tid + 512 * k, row = pc >> 6, ch = pc & 63; *(LAS v4u*)(L + row * 1024 + ch * 16) = pv[k]; }
        for (int rr = 0; rr < 8; rr += 2) {
            v4u ya[2][3], yb[2][3], zz[2][3];
#pragma unroll
            for (int k = 0; k < 2; ++k) { const int r = rb + 8 * w + rr + k;
#pragma unroll
                for (int j = 0; j < 3; ++j) { const int col = 8 * (lane + 64 * j);
                    ya[k][j] = *(const v4u*)(F.Y + (size_t)r * SSD_W + col); yb[k][j] = *(const v4u*)(F.YB + (size_t)r * SSD_W + col); zz[k][j] = *(const v4u*)(F.Z + (size_t)r * SSD_W + col); } }
#pragma unroll
            for (int k = 0; k < 2; ++k) { const int r = rb + 8 * w + rr + k;
                float v[24]; float ss = 0.f;
#pragma unroll
                for (int j = 0; j < 3; ++j) {
                    const unsigned yaw[4] = {ya[k][j].x, ya[k][j].y, ya[k][j].z, ya[k][j].w}, ybw[4] = {yb[k][j].x, yb[k][j].y, yb[k][j].z, yb[k][j].w}, zw[4] = {zz[k][j].x, zz[k][j].y, zz[k][j].z, zz[k][j].w};
#pragma unroll
                    for (int e = 0; e < 4; ++e) { const float y0 = bflo(yaw[e]) + bflo(ybw[e]), y1 = bfhi(yaw[e]) + bfhi(ybw[e]);
                        const float g0 = y0 * silu_f(bflo(zw[e])), g1 = y1 * silu_f(bfhi(zw[e])); v[j * 8 + 2 * e] = g0; v[j * 8 + 2 * e + 1] = g1; ss += g0 * g0 + g1 * g1; } }
                const float rs = 1.f / sqrtf(wave_sum(ss) * (1.f / SSD_W) + RMS_EPS);
#pragma unroll
                for (int j = 0; j < 3; ++j) { const int col = 8 * (lane + 64 * j);
                    const f32x4 w0 = *(const f32x4*)(F.ssd_norm_w + col), w1 = *(const f32x4*)(F.ssd_norm_w + col + 4);
                    v4u o; o.x = pk2(v[j * 8 + 0] * rs * w0.x, v[j * 8 + 1] * rs * w0.y); o.y = pk2(v[j * 8 + 2] * rs * w0.z, v[j * 8 + 3] * rs * w0.w);
                    o.z = pk2(v[j * 8 + 4] * rs * w1.x, v[j * 8 + 5] * rs * w1.y); o.w = pk2(v[j * 8 + 6] * rs * w1.z, v[j * 8 + 7] * rs * w1.w);
                    *(v4u*)(F.A2 + (size_t)r * 2048 + col) = o; } }
        }
        __syncthreads();
        {
            const int cg = tid & 63, tb = tid >> 6, hw = 1 << (cg >> 4);
            const LAS unsigned char* colp = L + cg * 16;
#pragma unroll 2
            for (int tt = 0; tt < 8; ++tt) { const int t = tb * 8 + tt; const int lo = t - hw < 0 ? 0 : t - hw, hi = t + hw > 64 ? 64 : t + hw;
                float s[8];
#pragma unroll
                for (int e = 0; e < 8; ++e) s[e] = 0.f;
                for (int q = lo; q < hi; ++q) { const v4u x = *(const LAS v4u*)(colp + q * 1024);
                    s[0] += bflo(x.x); s[1] += bfhi(x.x); s[2] += bflo(x.y); s[3] += bfhi(x.y); s[4] += bflo(x.z); s[5] += bfhi(x.z); s[6] += bflo(x.w); s[7] += bfhi(x.w); }
                const v4u x = *(const LAS v4u*)(colp + t * 1024); const float inv = 1.f / (float)(hi - lo);
                v4u o; o.x = pk2(s[0] * inv - bflo(x.x), s[1] * inv - bfhi(x.x)); o.y = pk2(s[2] * inv - bflo(x.y), s[3] * inv - bfhi(x.y));
                o.z = pk2(s[4] * inv - bflo(x.z), s[5] * inv - bfhi(x.z)); o.w = pk2(s[6] * inv - bflo(x.w), s[7] * inv - bfhi(x.w));
                *(v4u*)(F.A2 + (size_t)(rb + t) * 2048 + SSD_W + cg * 8) = o; }
        }
        __syncthreads();
    }
}

struct Sched7 {
    const char* A; const char* Bt; int G, c;
    __device__ __forceinline__ bool next(int i, pg8::Unit& u) const { const int L = i * G + c; if (L >= 512) return false; pg8::static_map(L, 128, 4, u.pm, u.pn); u.e = 0; return true; }
    __device__ __forceinline__ const char* a_base(const pg8::Unit& u) const { return A + (size_t)u.pm * 256 * 2048 * 2; }
    __device__ __forceinline__ const char* b_base(const pg8::Unit& u) const { return Bt + (size_t)u.pn * 256 * 2048 * 2; }
    __device__ __forceinline__ const int* row_table(const pg8::Unit&) const { return nullptr; }
};
struct Epi7 {
    static constexpr bool PERM = false;
    const float* x; const float* MOD; float* X1;
    __device__ __forceinline__ void operator()(const f32x4 (&acc)[2][2][4][2], const pg8::Unit& u, int wr, int wc, int fr, int fq) const {
        const int row0 = u.pm * 256 + wr * 64 + fr, col0 = u.pn * 256 + wc * 32 + 4 * fq;
        const float* g1 = MOD + (size_t)(u.pm >> 4) * 6144 + 2048;
        f32x4 gv[2][2];
#pragma unroll
        for (int bj = 0; bj < 2; ++bj)
#pragma unroll
            for (int n = 0; n < 2; ++n) gv[bj][n] = *(const f32x4*)(g1 + col0 + bj * 128 + n * 16);
#pragma unroll
        for (int ai = 0; ai < 2; ++ai)
#pragma unroll
            for (int m = 0; m < 4; ++m) { const size_t off = (size_t)(row0 + ai * 128 + m * 16) * D + col0;
#pragma unroll
                for (int bj = 0; bj < 2; ++bj)
#pragma unroll
                    for (int n = 0; n < 2; ++n) { const f32x4 xv = *(const f32x4*)(x + off + bj * 128 + n * 16); *(f32x4*)(X1 + off + bj * 128 + n * 16) = xv + gv[bj][n] * acc[ai][bj][m][n]; } }
    }
};

__device__ __forceinline__ void p8_router(Frame& F) {
    LAS unsigned char* L = F.lds;
    LAS float* H2F = (LAS float*)L;
    constexpr int HP = 1028;
    LAS float* PART = (LAS float*)(L + 16 * HP * 4);
    LAS unsigned* HIST = (LAS unsigned*)(L + 16 * HP * 4 + 16384);
    const int tid = F.tid, lane = F.lane, w = F.wave, i16 = lane & 15, q4 = lane >> 4;
    if (tid < 32) HIST[tid] = 0u;
    float rw0[32], rw1[32];
#pragma unroll
    for (int kk = 0; kk < 32; ++kk) { const int k = 128 * w + 4 * kk + q4; rw0[kk] = F.router_w[k * 32 + i16]; rw1[kk] = F.router_w[k * 32 + 16 + i16]; }
    __syncthreads();
    for (int gi = (int)blockIdx.x; gi < T / 16; gi += F.G) {
        const int rbase = gi * 16;
#pragma unroll
        for (int rr = 0; rr < 2; ++rr) {
            const int r16 = 2 * w + rr, r = rbase + r16;
            const float* xr = F.X1 + (size_t)r * D; const float* mod = F.MOD + (size_t)(r >> 12) * 6144;
            f32x4 v[4]; float ss = 0.f;
#pragma unroll
            for (int j = 0; j < 4; ++j) { v[j] = *(const f32x4*)(xr + 4 * lane + 256 * j); ss += (v[j].x * v[j].x + v[j].y * v[j].y) + (v[j].z * v[j].z + v[j].w * v[j].w); }
            const float rs = 1.f / sqrtf(wave_sum(ss) * (1.f / D) + RMS_EPS);
#pragma unroll
            for (int j = 0; j < 4; ++j) { const int col = 4 * lane + 256 * j;
                const f32x4 wv = *(const f32x4*)(F.norm2_w + col), sh = *(const f32x4*)(mod + 3072 + col), sc = *(const f32x4*)(mod + 4096 + col);
                const f32x4 hh = (v[j] * rs) * wv * (sc + 1.f) + sh;
                *(LAS f32x4*)(H2F + r16 * HP + col) = hh;
                *(unsigned*)((unsigned char*)F.H2 + (size_t)r * D + col) = pk4_fp8(hh.x, hh.y, hh.z, hh.w); }
        }
        __syncthreads();
        {
            f32x4 a0 = (f32x4){0.f, 0.f, 0.f, 0.f}, a1 = a0;
#pragma unroll
            for (int kk = 0; kk < 32; ++kk) { const int k = 128 * w + 4 * kk + q4;
                const float av = H2F[i16 * HP + k];
                a0 = __builtin_amdgcn_mfma_f32_16x16x4f32(av, rw0[kk], a0, 0, 0, 0); a1 = __builtin_amdgcn_mfma_f32_16x16x4f32(av, rw1[kk], a1, 0, 0, 0); }
#pragma unroll
            for (int r = 0; r < 4; ++r) { PART[(w * 16 + 4 * q4 + r) * 32 + i16] = a0[r]; PART[(w * 16 + 4 * q4 + r) * 32 + 16 + i16] = a1[r]; }
        }
        __syncthreads();
        {
            const int row = tid >> 5, e = tid & 31;
            float lg = F.router_b[e];
#pragma unroll
            for (int ww = 0; ww < 8; ++ww) lg += PART[(ww * 16 + row) * 32 + e];
            float tv[4]; int ti[4];
#pragma unroll
            for (int k = 0; k < 4; ++k) { float bv = lg; int bi = e;
#pragma unroll
                for (int o = 1; o < 32; o <<= 1) { const float ov = __shfl_xor(bv, o); const int oi = __shfl_xor(bi, o); if (ov > bv || (ov == bv && oi < bi)) { bv = ov; bi = oi; } }
                tv[k] = bv; ti[k] = bi; if (e == bi) lg = -INFINITY; }
            if (e == 0) {
                const float e1 = __expf(tv[1] - tv[0]), e2 = __expf(tv[2] - tv[0]), e3 = __expf(tv[3] - tv[0]); const float inv = 1.f / (1.f + e1 + e2 + e3);
                const float gt[4] = {inv, e1 * inv, e2 * inv, e3 * inv};
                const int tok = rbase + row;
#pragma unroll
                for (int k = 0; k < 4; ++k) { const unsigned lr = atomicAdd((unsigned*)&HIST[ti[k]], 1u); F.TOPE[tok * 4 + k] = ti[k]; F.TOPG[tok * 4 + k] = gt[k]; F.TOPR[tok * 4 + k] = (int)lr; }
            }
        }
        __syncthreads();
    }
    if (tid < 32) { const unsigned base = __hip_atomic_fetch_add(F.ctl + CW_GCOUNT + tid, HIST[tid], RLX_AGENT); F.BB[(int)blockIdx.x * 32 + tid] = (int)base; }
}

__device__ __forceinline__ int moe_tables(Frame& F) {
    LAS int* TE = (LAS int*)(F.lds + TE_OFF);
    LAS int* MC = (LAS int*)(F.lds + MOE_CNT_OFF);
    __syncthreads();
    if (F.tid == 0) { int ps = 0;
        for (int e = 0; e < NE; ++e) { const int c = (int)__hip_atomic_load(F.ctl + CW_GCOUNT + e, RLX_AGENT); MC[e] = c; MC[32 + e] = ps; const int nt = (c + 255) >> 8; for (int t = 0; t < nt; ++t) TE[(ps >> 8) + t] = e; ps += nt << 8; }
        MC[64] = ps >> 8; }
    __syncthreads();
    return MC[64];
}
__device__ __forceinline__ void p9_slots(Frame& F) {
    (void)moe_tables(F);
    const LAS int* MC = (const LAS int*)(F.lds + MOE_CNT_OFF);
    const int gt = (int)blockIdx.x * 512 + F.tid, NT_ = F.G * 512;
    for (int a = gt; a < T * TOPK; a += NT_) { const int tok = a >> 2, e = F.TOPE[a], blk = (tok >> 4) % F.G;
        const int slot = MC[32 + e] + F.BB[blk * 32 + e] + F.TOPR[a];
        F.SLOTTOK[slot] = tok; F.SLOTGATE[slot] = F.TOPG[a]; F.TOKSLOT[a] = slot; }
    for (int i = gt; i < MAX_SLOTS; i += NT_) F.SLOTID[i] = i;
    if ((int)blockIdx.x < NE) { const int e = (int)blockIdx.x, c = MC[e], ps = MC[32 + e], pe = ps + (((c + 255) >> 8) << 8);
        for (int s = ps + c + F.tid; s < pe; s += 512) { F.SLOTTOK[s] = 0; F.SLOTGATE[s] = 0.f; } }
}

struct SchedMoe {
    const char* A; const char* W; const int* slot_tok; const LAS int* TE; int nM, nN, G, c; size_t wbytes  , tilebytes  , arowbytes;
    __device__ __forceinline__ bool next(int i, pg8::Unit& u) const { const int L = i * G + c; if (L >= nM * nN) return false; pg8::static_map(L, nM, nN, u.pm, u.pn); u.e = TE[u.pm]; return true; }
    __device__ __forceinline__ const char* a_base(const pg8::Unit& u) const { return slot_tok ? A : A + (size_t)u.pm * 256 * arowbytes; }
    __device__ __forceinline__ const char* b_base(const pg8::Unit& u) const { return W + (size_t)u.e * wbytes + (size_t)u.pn * tilebytes; }
    __device__ __forceinline__ const int* row_table(const pg8::Unit& u) const { return slot_tok + u.pm * 256; }
};
struct Epi10 {
    static constexpr bool PERM = true;
    const float* b1; bf16* ACT;
    __device__ __forceinline__ void operator()(const f32x4 (&acc)[2][2][4][2], const pg8::Unit& u, int wr, int wc, int fr, int fq) const {
        const int row0 = u.pm * 256 + wr * 64 + fr, j0 = u.pn * 128 + wc * 32 + 8 * fq;
        const float* bp = b1 + (size_t)u.e * 2048 + 2 * j0;
        const f32x4 q0 = *(const f32x4*)bp, q1 = *(const f32x4*)(bp + 4), q2 = *(const f32x4*)(bp + 8), q3 = *(const f32x4*)(bp + 12);
        const float bg[8] = {q0.x, q0.z, q1.x, q1.z, q2.x, q2.z, q3.x, q3.z}, bu[8] = {q0.y, q0.w, q1.y, q1.w, q2.y, q2.w, q3.y, q3.w};
#pragma unroll
        for (int ai = 0; ai < 2; ++ai)
#pragma unroll
            for (int m = 0; m < 4; ++m) { float o[8];
#pragma unroll
                for (int n = 0; n < 2; ++n)
#pragma unroll
                    for (int t = 0; t < 4; ++t) { const float hg = acc[ai][0][m][n][t] * (1.f / WSCALE) + bg[4 * n + t], hu = acc[ai][1][m][n][t] * (1.f / WSCALE) + bu[4 * n + t];
                        const float gp = fminf(hg, 7.f), up = fminf(fmaxf(hu, -7.f), 7.f);
                        o[4 * n + t] = gp / (1.f + __expf(-1.702f * gp)) * (up + 1.f); }
                v2u wv; wv.x = pk4_fp8(o[0] * ASCALE, o[1] * ASCALE, o[2] * ASCALE, o[3] * ASCALE); wv.y = pk4_fp8(o[4] * ASCALE, o[5] * ASCALE, o[6] * ASCALE, o[7] * ASCALE);
                *(v2u*)((unsigned char*)ACT + (size_t)(row0 + ai * 128 + m * 16) * DFF + j0) = wv; }
    }
};
struct Epi11 {
    static constexpr bool PERM = true;
    const float* b2; const float* gate; bf16* YS;
    __device__ __forceinline__ void operator()(const f32x4 (&acc)[2][2][4][2], const pg8::Unit& u, int wr, int wc, int fr, int fq) const {
        const int row0 = u.pm * 256 + wr * 64 + fr, col0 = u.pn * 256 + wc * 32 + 8 * fq;
        f32x4 bv[2][2];
#pragma unroll
        for (int bj = 0; bj < 2; ++bj)
#pragma unroll
            for (int n = 0; n < 2; ++n) bv[bj][n] = *(const f32x4*)(b2 + (size_t)u.e * D + col0 + bj * 128 + 4 * n);
#pragma unroll
        for (int ai = 0; ai < 2; ++ai)
#pragma unroll
            for (int m = 0; m < 4; ++m) { const int row = row0 + ai * 128 + m * 16; const float gt = gate[row];
#pragma unroll
                for (int bj = 0; bj < 2; ++bj) { const f32x4 v0 = (acc[ai][bj][m][0] * (1.f / (WSCALE * ASCALE)) + bv[bj][0]) * gt, v1 = (acc[ai][bj][m][1] * (1.f / (WSCALE * ASCALE)) + bv[bj][1]) * gt;
                    v4u wv; wv.x = pg8::cvt_pk_bf16(v0[0], v0[1]); wv.y = pg8::cvt_pk_bf16(v0[2], v0[3]); wv.z = pg8::cvt_pk_bf16(v1[0], v1[1]); wv.w = pg8::cvt_pk_bf16(v1[2], v1[3]);
                    *(v4u*)(YS + (size_t)row * D + col0 + bj * 128) = wv; } }
    }
};

__device__ __forceinline__ void p12_combine(Frame& F) {
    const int gw = (int)blockIdx.x * 8 + F.wave, NGW = F.G * 8, lane = F.lane;
    for (int rp = gw; rp < T / 2; rp += NGW) {
        int sl[2][4];
#pragma unroll
        for (int k2 = 0; k2 < 2; ++k2)
#pragma unroll
            for (int k = 0; k < 4; ++k) sl[k2][k] = F.TOKSLOT[(rp * 2 + k2) * 4 + k];
        v2u yv[2][4][4]; f32x4 xv[2][4];
#pragma unroll
        for (int k2 = 0; k2 < 2; ++k2)
#pragma unroll
            for (int j = 0; j < 4; ++j) { const int col = 4 * lane + 256 * j; xv[k2][j] = *(const f32x4*)(F.X1 + (size_t)(rp * 2 + k2) * D + col);
#pragma unroll
                for (int k = 0; k < 4; ++k) yv[k2][j][k] = *(const v2u*)(F.YS + (size_t)sl[k2][k] * D + col); }
#pragma unroll
        for (int k2 = 0; k2 < 2; ++k2) { const int r = rp * 2 + k2;
            const float* g2 = F.MOD + (size_t)(r >> 12) * 6144 + 5120;
            f32x4 v[4]; float ss = 0.f;
#pragma unroll
            for (int j = 0; j < 4; ++j) { const int col = 4 * lane + 256 * j; f32x4 m = (f32x4){0.f, 0.f, 0.f, 0.f};
#pragma unroll
                for (int k = 0; k < 4; ++k) { const v2u y = yv[k2][j][k]; m.x += bflo(y.x); m.y += bfhi(y.x); m.z += bflo(y.y); m.w += bfhi(y.y); }
                v[j] = xv[k2][j] + *(const f32x4*)(g2 + col) * m;
                ss += (v[j].x * v[j].x + v[j].y * v[j].y) + (v[j].z * v[j].z + v[j].w * v[j].w); }
            const float rs = 1.f / sqrtf(wave_sum(ss) * (1.f / D) + RMS_EPS);
#pragma unroll
            for (int j = 0; j < 4; ++j) { const int col = 4 * lane + 256 * j; *(f32x4*)(F.out + (size_t)r * D + col) = (v[j] * rs) * *(const f32x4*)(F.final_norm_w + col); } }
    }
}

constexpr int NPHASE = 13;
struct Args { const float* in[25]; float* out; unsigned char* ws; int ph_lo, ph_hi; };
__global__ void __launch_bounds__(512, 2) mk_fwd(Args args) {
    extern __shared__ __attribute__((aligned(16))) unsigned char lds[];
    Frame F;
    F.lds = (LAS unsigned char*)lds;
    F.tid = threadIdx.x; F.lane = F.tid & 63; F.wave = __builtin_amdgcn_readfirstlane(F.tid >> 6); F.G = gridDim.x;
    unsigned char* ws = args.ws;
    F.ctl = (unsigned*)(ws + WS_CTL);
    F.x = args.in[0]; F.c = args.in[1]; F.ctx = args.in[2]; F.c_ctx = args.in[3]; F.w_mod = args.in[4]; F.b_mod = args.in[5]; F.norm1_w = args.in[6]; F.norm2_w = args.in[7];
    F.w_in = args.in[8]; F.conv_w = args.in[9]; F.conv_b = args.in[10]; F.dt_bias = args.in[11]; F.a_log = args.in[12]; F.d_skip = args.in[13]; F.ssd_norm_w = args.in[14];
    F.pool_w = args.in[15]; F.pool_scale = args.in[16]; F.w_out = args.in[17]; F.router_w = args.in[18]; F.router_b = args.in[19]; F.w1 = args.in[20]; F.b1 = args.in[21];
    F.w2 = args.in[22]; F.b2 = args.in[23]; F.final_norm_w = args.in[24]; F.out = args.out;
    F.MOD = (float*)(ws + WS_MOD); F.DTRAW = (float*)(ws + WS_DTRAW); F.DT = (float*)(ws + WS_DT); F.ROWSC = (float*)(ws + WS_ROWSC); F.CHS = (float*)(ws + WS_CHS); F.X1 = (float*)(ws + WS_X1);
    F.TOPG = (float*)(ws + WS_TOPG); F.SLOTGATE = (float*)(ws + WS_SLOTGATE); F.TOPE = (int*)(ws + WS_TOPE); F.TOPR = (int*)(ws + WS_TOPR); F.TOKSLOT = (int*)(ws + WS_TOKSLOT);
    F.SLOTTOK = (int*)(ws + WS_SLOTTOK); F.SLOTID = (int*)(ws + WS_SLOTID); F.BB = (int*)(ws + WS_BB);
    F.WINT = (bf16*)(ws + WS_WINT); F.WOUTT = (bf16*)(ws + WS_WOUTT); F.W1T = (bf16*)(ws + WS_W1T); F.W2T = (bf16*)(ws + WS_W2T); F.A1 = (bf16*)(ws + WS_A1); F.XBCPRE = (bf16*)(ws + WS_XBCPRE);
    F.Z = (bf16*)(ws + WS_Z); F.V = (bf16*)(ws + WS_V); F.XBC = (bf16*)(ws + WS_XBC); F.CC = (bf16*)(ws + WS_CC); F.ST = (bf16*)(ws + WS_ST); F.Y = (bf16*)(ws + WS_Y); F.YB = (bf16*)(ws + WS_YB);
    F.A2 = (bf16*)(ws + WS_A2); F.H2 = (bf16*)(ws + WS_H2); F.ACT = (bf16*)(ws + WS_ACT); F.YS = (bf16*)(ws + WS_YS);
    volatile LAS unsigned* MISC = (volatile LAS unsigned*)(F.lds + MISC_OFF);
    for (int u = F.tid; u < 64; u += 512) MISC[u] = 0u;
    __syncthreads();
    const int lo = args.ph_lo, hi = args.ph_hi;
    XcdBarrier bar; bar.bar = F.ctl + CW_BAR; bar.x = 0; bar.st = nullptr;
    if (hi - lo > 1) bar = xcd_barrier_post(F.ctl + CW_BAR, MISC + 8);
#define IN(k) (lo <= (k) && (k) < hi)
#define SEAM(k) do { if (IN(k) && IN((k) + 1)) xcd_barrier(bar); } while (0)
#define BODY0 p0_prologue(F)
#define BODY1 p1_norm1(F)
#define BODY2 do { Sched1 S{(const char*)F.A1, (const char*)F.WINT, F.G, (int)blockIdx.x}; Epi1 E{F.XBCPRE, F.Z, F.V, F.DTRAW}; pg8::gemm_phase<Epi1, Sched1, false>(F.lds, D, S, E); } while (0)
#define BODY3 p3_conv(F)
#define BODY4 p4_ssd_local(F)
#define BODY5 p5_ssd_scan(F)
#define BODY6 p6_gate_pool(F)
#define BODY7 do { Sched7 S{(const char*)F.A2, (const char*)F.WOUTT, F.G, (int)blockIdx.x}; Epi7 E{F.x, F.MOD, F.X1}; pg8::gemm_phase<Epi7, Sched7, false>(F.lds, 2048, S, E); } while (0)
#define BODY8 p8_router(F)
#define BODY9 p9_slots(F)
#define BODY10 do { const int ntl = moe_tables(F); \
        SchedMoe S{(const char*)F.H2, (const char*)F.W1T, F.SLOTTOK, (const LAS int*)(F.lds + TE_OFF), ntl, 8, F.G, (int)blockIdx.x, (size_t)2048 * D, (size_t)256 * D, (size_t)D}; \
        Epi10 E{F.b1, F.ACT}; pg8::gemm_phase<Epi10, SchedMoe, true, true>(F.lds, D, S, E); } while (0)
#define BODY11 do { const int ntl = moe_tables(F); \
        SchedMoe S{(const char*)F.ACT, (const char*)F.W2T, F.SLOTID, (const LAS int*)(F.lds + TE_OFF), ntl, 4, F.G, (int)blockIdx.x, (size_t)D * D, (size_t)256 * D, (size_t)D}; \
        Epi11 E{F.b2, F.SLOTGATE, F.YS}; pg8::gemm_phase<Epi11, SchedMoe, true, true>(F.lds, D, S, E); } while (0)
#define BODY12 p12_combine(F)
#define RUN(k) do { if (IN(k)) { BODY##k; if (PROBE_PH == (k)) { xcd_barrier(bar); BODY##k; } } SEAM(k); } while (0)
    RUN(0); RUN(1); RUN(2); RUN(4); RUN(5); RUN(6); RUN(7); RUN(8); RUN(9); RUN(10); RUN(11); RUN(12);
#undef IN
#undef SEAM
}

extern "C" void kernel_launch(void* const* d_in, const int* in_sizes, int n_in, void* d_out, int out_size, void* d_ws, size_t ws_size, hipStream_t stream) {
    static int grid = 0;
    if (grid == 0) {
        if (n_in != 25 || out_size != T * D || ws_size < WS_END) { fprintf(stderr, "kernel_launch: unexpected shapes (n_in %d, out %d, ws %zu)\n", n_in, out_size, ws_size); grid = -1; return; }
        int dev = 0, cus = 0, per_cu = 0;
        if (hipGetDevice(&dev) != hipSuccess || hipDeviceGetAttribute(&cus, hipDeviceAttributeMultiprocessorCount, dev) != hipSuccess) { grid = -1; return; }
        if (hipFuncSetAttribute((const void*)mk_fwd, hipFuncAttributeMaxDynamicSharedMemorySize, LDS_BYTES) != hipSuccess) { fprintf(stderr, "kernel_launch: hipFuncSetAttribute failed\n"); grid = -1; return; }
        if (hipOccupancyMaxActiveBlocksPerMultiprocessor(&per_cu, (const void*)mk_fwd, 512, LDS_BYTES) != hipSuccess || per_cu < 1) { fprintf(stderr, "kernel_launch: occupancy query says %d\n", per_cu); }
        (void)hipGetLastError();
        grid = cus;
    }
    if (grid < 0) return;
    (void)hipMemsetAsync((char*)d_ws + WS_CTL, 0, CTL_ZERO_BYTES, stream);
    Args a{};
    for (int i = 0; i < 25; ++i) a.in[i] = (const float*)d_in[i];
    a.out = (float*)d_out; a.ws = (unsigned char*)d_ws;
#if MK_SPLIT
    for (int p = 0; p < NPHASE; ++p) { a.ph_lo = p; a.ph_hi = p + 1; hipLaunchKernelGGL(mk_fwd, dim3(grid), dim3(512), LDS_BYTES, stream, a); }
#else
    a.ph_lo = 0; a.ph_hi = NPHASE; hipLaunchKernelGGL(mk_fwd, dim3(grid), dim3(512), LDS_BYTES, stream, a);
#endif
}
```

```cpp
#include <hip/hip_runtime.h>
#include <cstdio>
#include <cstdint>

#ifndef MK_SPLIT
#define MK_SPLIT 0
#endif

#ifndef PROBE_PH
#define PROBE_PH -1
#endif

#define GAS __attribute__((address_space(1)))
#define LAS __attribute__((address_space(3)))
typedef unsigned short bf16;
typedef unsigned v4u __attribute__((ext_vector_type(4)));
typedef unsigned v2u __attribute__((ext_vector_type(2)));
typedef float f32x4 __attribute__((ext_vector_type(4)));
typedef float f32x2 __attribute__((ext_vector_type(2)));
typedef short bf16x8 __attribute__((ext_vector_type(8)));
typedef short s16x4 __attribute__((ext_vector_type(4)));
#define RLX_AGENT __ATOMIC_RELAXED, __HIP_MEMORY_SCOPE_AGENT
#define LDS_WAIT() asm volatile("s_waitcnt lgkmcnt(0)" ::: "memory")
#define VM_WAIT() asm volatile("s_waitcnt vmcnt(0)" ::: "memory")

__device__ __forceinline__ unsigned f2bf(float f) { unsigned u = __builtin_bit_cast(unsigned, f); return (u + 0x7fffu + ((u >> 16) & 1u)) >> 16; }
typedef __bf16 nbf16x2 __attribute__((ext_vector_type(2)));
__device__ __forceinline__ unsigned pk2(float lo, float hi) { const f32x2 v = {lo, hi}; return __builtin_bit_cast(unsigned, __builtin_convertvector(v, nbf16x2)); }
constexpr float YSCALE = 8.f;
constexpr float ASCALE = 4.f;
constexpr float WSCALE = 32.f;
__device__ __forceinline__ unsigned pk4_fp8(float a, float b, float c, float d) { int r = __builtin_amdgcn_cvt_pk_fp8_f32(a, b, 0, false); r = __builtin_amdgcn_cvt_pk_fp8_f32(c, d, r, true); return (unsigned)r; }
__device__ __forceinline__ float bflo(unsigned w) { return __builtin_bit_cast(float, w << 16); }
__device__ __forceinline__ float bfhi(unsigned w) { return __builtin_bit_cast(float, w & 0xffff0000u); }
__device__ __forceinline__ float silu_f(float v) { return v / (1.f + __expf(-v)); }
__device__ __forceinline__ float wave_sum(float v) {
#pragma unroll
    for (int o = 1; o < 64; o <<= 1) v += __shfl_xor(v, o);
    return v;
}

constexpr int D = 1024, NB = 8, SEQ = 4096, CTXL = 256, T = NB * SEQ, TC = NB * CTXL, RTOT = T + TC;
constexpr int CONV_CH = 2560, SSD_W = 1536, NH = 24, HDIM = 64, NGRP = 4, HPG = 6, NST = 128, CHUNK = 128;
constexpr int NCC = (CTXL + SEQ) / CHUNK;
constexpr int IN_COLS = 4656, N1 = 4864;
constexpr int NE = 32, TOPK = 4, DFF = 1024;
constexpr int MAX_TILES = (T * TOPK) / 256 + NE;
constexpr int MAX_SLOTS = MAX_TILES * 256;
constexpr float RMS_EPS = 1e-6f;

constexpr size_t MiB = 1u << 20;
constexpr size_t WS_CTL = 0, CTL_ZERO_BYTES = 1 * MiB;
constexpr size_t WS_MOD = 1 * MiB;
constexpr size_t WS_TOPE = 2 * MiB, WS_TOPG = WS_TOPE + 512 * 1024, WS_TOPR = WS_TOPG + 512 * 1024, WS_TOKSLOT = WS_TOPR + 512 * 1024;
constexpr size_t WS_SLOTTOK = 4 * MiB, WS_SLOTGATE = WS_SLOTTOK + 576 * 1024, WS_BB = WS_SLOTGATE + 576 * 1024, WS_CHS = WS_BB + 64 * 1024, WS_SLOTID = WS_CHS + 64 * 1024;
constexpr size_t WS_DTRAW = 6 * MiB;
constexpr size_t WS_DT = 15 * MiB;
constexpr size_t WS_ROWSC = 22 * MiB;
constexpr size_t WS_WINT = 32 * MiB, WS_WOUTT = 42 * MiB, WS_W1T = 46 * MiB, WS_W2T = 174 * MiB;
constexpr size_t WS_A = 240 * MiB;
constexpr size_t WS_A1 = WS_A, WS_CC = WS_A, WS_XBCPRE = WS_A + 68 * MiB, WS_Z = WS_A + 238 * MiB, WS_V = WS_A + 334 * MiB, WS_XBC = WS_A;
constexpr size_t WS_ST = WS_A + 366 * MiB, WS_Y = WS_A + 570 * MiB, WS_YB = WS_A + 666 * MiB;
constexpr size_t WS_A2 = WS_XBCPRE, WS_X1 = WS_A + 366 * MiB, WS_H2 = WS_A + 494 * MiB, WS_ACT = WS_A, WS_YS = WS_A + 494 * MiB;
constexpr size_t WS_END = WS_A + 766 * MiB;
static_assert(WS_END <= 1024 * MiB, "workspace map");
static_assert((size_t)RTOT * D * 2 <= 68 * MiB && (size_t)RTOT * CONV_CH * 2 <= 170 * MiB && (size_t)MAX_SLOTS * D * 2 <= 272 * MiB, "workspace map sizes");
static_assert((size_t)NB * NCC * NH * 2 * 8192 * 2 <= 204 * MiB, "ST size");
constexpr int CW_TMO = 0, CW_GCOUNT = 64  , CW_BAR = 4096;

constexpr int LDS_BYTES = 163840;
constexpr int MISC_OFF = LDS_BYTES - 256;
constexpr int TE_OFF = 131072;
constexpr int MOE_CNT_OFF = TE_OFF + 4096;
constexpr int TBL_OFF = TE_OFF + 8192;

namespace pg8 {
constexpr int BM = 256, BK = 64, HALF = 128, HTB = HALF * BK * 2, STAGE_BYTES = 8 * HTB, NXCD = 8, WGM = 8;
__host__ __device__ __forceinline__ int lds_byte(int r, int c) { const int st = (r >> 4) * 2 + (c >> 5), rr = r & 15, cc = c & 31, ob = rr * 64 + cc * 2; return st * 1024 + (ob ^ (((ob >> 9) & 1) << 5)); }
__host__ __device__ __forceinline__ void stage_rc(int b, int& R, int& C) { const int st = b / 1024, sb = b % 1024, swz = sb ^ (((sb >> 9) & 1) << 5); R = (st >> 1) * 16 + swz / 64; C = (st & 1) * 32 + (swz % 64) / 2; }
__host__ __device__ __forceinline__ int perm32(int rho) { const int n = rho >> 4, i = rho & 15; return 8 * (i >> 2) + 4 * n + (i & 3); }
struct Unit { int pm, pn, e; };
__device__ __forceinline__ unsigned cvt_pk_bf16(float lo, float hi) { unsigned r; asm volatile("v_cvt_pk_bf16_f32 %0, %1, %2" : "=v"(r) : "v"(lo), "v"(hi)); return r; }

__device__ __forceinline__ void static_map(int wgid, int nM, int nN, int& pm, int& pn) {
    const int nwg = nM * nN;
    { const int q = nwg / NXCD, r = nwg % NXCD, xcd = wgid % NXCD, off = wgid / NXCD; wgid = (xcd < r ? xcd * (q + 1) : r * (q + 1) + (xcd - r) * q) + off; }
    const int nig = WGM * nN, gid = wgid / nig, fm = gid * WGM, gsz = (nM - fm) < WGM ? (nM - fm) : WGM;
    pm = fm + ((wgid % nig) % gsz); pn = (wgid % nig) / gsz;
}

typedef int i32x8 __attribute__((ext_vector_type(8)));
typedef int v4i_t __attribute__((ext_vector_type(4)));
template <class Epi, class Sched, bool GATHER, bool FP8 = false, bool ALIGN_EPI = true>
__device__ __forceinline__ void gemm_phase(LAS unsigned char* lds, const int K, const Sched& S, const Epi& E) {
    const int tid = threadIdx.x, wid = __builtin_amdgcn_readfirstlane(tid >> 6), lane = tid & 63, wr = wid >> 2, wc = wid & 3, fr = lane & 15, fq = lane >> 4;
    constexpr int ES = FP8 ? 1 : 2, KOFF = FP8 ? 16 : 1024;
    const int nt = K / (FP8 ? 2 * BK : BK);
    unsigned voffB[2]; int RA[2], CA[2];
#pragma unroll
    for (int i = 0; i < 2; ++i) { int R, C; stage_rc(tid * 16 + i * 8192, R, C); const int Rb = Epi::PERM ? ((R & ~31) + perm32(R & 31)) : R;
        RA[i] = R; CA[i] = C; voffB[i] = (unsigned)(Rb * K * ES + C * 2); }
    const size_t kstep = (size_t)(BK * 2);
    const size_t hstep = (size_t)HALF * K * ES;
    const unsigned ldsw = (unsigned)wid * 1024u;
    const int aoff = lds_byte(wr * 64 + fr, fq * (FP8 ? 16 : 8)), boff = lds_byte(wc * 32 + fr, fq * (FP8 ? 16 : 8));
#define PG8_SA(b, h) (((b) * 2 + (h)) * HTB)
#define PG8_SB(b, h) ((4 + (b) * 2 + (h)) * HTB)
#define PG8_STAGE(bufoff, gbase, voff) do { _Pragma("unroll") for (int _i = 0; _i < 2; ++_i) \
        __builtin_amdgcn_global_load_lds((const unsigned*)((const char*)(gbase) + (voff)[_i]), (LAS unsigned*)(lds + (bufoff) + ldsw + _i * 8192), 16, 0, 0); } while (0)
#define PG8_LDA(dst, b, h) do { _Pragma("unroll") for (int m = 0; m < 4; ++m) _Pragma("unroll") for (int k = 0; k < 2; ++k) dst[m][k] = *(const LAS bf16x8*)(lds + PG8_SA(b, h) + aoff + m * 2048 + k * KOFF); } while (0)
#define PG8_LDB(dst, b, h) do { _Pragma("unroll") for (int n = 0; n < 2; ++n) _Pragma("unroll") for (int k = 0; k < 2; ++k) dst[n][k] = *(const LAS bf16x8*)(lds + PG8_SB(b, h) + boff + n * 2048 + k * KOFF); } while (0)
#define PG8_CAT(lo, hi) __builtin_shufflevector(__builtin_bit_cast(v4i_t, lo), __builtin_bit_cast(v4i_t, hi), 0, 1, 2, 3, 4, 5, 6, 7)
#define PG8_MMA(ai, bj, At, Bt) do { __builtin_amdgcn_s_setprio(1); \
        if constexpr (FP8) { _Pragma("unroll") for (int m = 0; m < 4; ++m) _Pragma("unroll") for (int n = 0; n < 2; ++n) \
            acc[ai][bj][m][n] = __builtin_amdgcn_mfma_scale_f32_16x16x128_f8f6f4(PG8_CAT(Bt[n][0], Bt[n][1]), PG8_CAT(At[m][0], At[m][1]), acc[ai][bj][m][n], 0, 0, 0, 0x7f7f7f7f, 0, 0x7f7f7f7f); } \
        else { _Pragma("unroll") for (int m = 0; m < 4; ++m) _Pragma("unroll") for (int n = 0; n < 2; ++n) _Pragma("unroll") for (int k = 0; k < 2; ++k) \
            acc[ai][bj][m][n] = __builtin_amdgcn_mfma_f32_16x16x32_bf16(Bt[n][k], At[m][k], acc[ai][bj][m][n], 0, 0, 0); } \
        __builtin_amdgcn_s_setprio(0); } while (0)
#define PG8_WAIT_V(n) asm volatile("s_waitcnt vmcnt(" #n ")" ::: "memory")
#define PG8_WAIT_L(n) asm volatile("s_waitcnt lgkmcnt(" #n ")" ::: "memory")
#define PG8_BAR __builtin_amdgcn_s_barrier()
#define PG8_SCHED __builtin_amdgcn_sched_barrier(0)
#define PG8_AOFFS(U, dst) do { \
        if constexpr (GATHER) { int t_ = tid, R_, C_; asm volatile("" : "+v"(t_)); stage_rc(t_ * 16, R_, C_);     \
            const int* st_ = S.row_table(U) + R_; _Pragma("unroll") for (int _h = 0; _h < 2; ++_h) _Pragma("unroll") for (int _i = 0; _i < 2; ++_i) \
            dst[_h][_i] = (unsigned)st_[_h * HALF + _i * 64] * (unsigned)(K * ES) + (unsigned)(C_ * 2); } \
        else { _Pragma("unroll") for (int _h = 0; _h < 2; ++_h) _Pragma("unroll") for (int _i = 0; _i < 2; ++_i) dst[_h][_i] = (unsigned)((_h * HALF + RA[_i]) * K * ES + CA[_i] * 2); } } while (0)
#define PG8_AOFFS_NEXT(dst) do { if constexpr (false) { int t_ = tid, R_, C_; asm volatile("" : "+v"(t_)); stage_rc(t_ * 16, R_, C_); \
            const LAS int* st_ = (const LAS int*)(S.tb + ((ui + 1) % 3) * 1024) + R_; _Pragma("unroll") for (int _h = 0; _h < 2; ++_h) _Pragma("unroll") for (int _i = 0; _i < 2; ++_i) \
            dst[_h][_i] = (unsigned)st_[_h * HALF + _i * 64] * (unsigned)(K * ES) + (unsigned)(C_ * 2); } else { PG8_AOFFS(nxt, dst); } } while (0)
    Unit cur, nxt; int ui = 0;
    if (!S.next(0, cur)) return;
    f32x4 acc[2][2][4][2];
#pragma unroll
    for (int a = 0; a < 2; ++a)
#pragma unroll
        for (int b = 0; b < 2; ++b)
#pragma unroll
            for (int m = 0; m < 4; ++m)
#pragma unroll
                for (int n = 0; n < 2; ++n) acc[a][b][m][n] = (f32x4){0.f, 0.f, 0.f, 0.f};
    bf16x8 At[4][2], B0[2][2], B1[2][2];
    unsigned oc[2][2];
    const char* cA = S.a_base(cur); const char* cB = S.b_base(cur);
    PG8_AOFFS(cur, oc);
#define PG8_TABLES(U, buf) do { if constexpr (Sched::TBL) { LAS unsigned char* tb_ = S.tb + (buf) * 1024;   \
        if (wid < 4) { if (S.tab2(U)) __builtin_amdgcn_global_load_lds((const unsigned*)(S.tab2(U) + 64 * wid + lane), (LAS unsigned*)(tb_ + 6144 + wid * 256), 4, 0, 0); } \
        else { __builtin_amdgcn_global_load_lds((const unsigned*)(S.tab1(U) + 64 * (wid - 4) + lane), (LAS unsigned*)(tb_ + 3072 + (wid - 4) * 256), 4, 0, 0); } } } while (0)
    PG8_TABLES(cur, 0);
    PG8_STAGE(PG8_SB(0, 0), cB, voffB); PG8_STAGE(PG8_SB(0, 1), cB + hstep, voffB); PG8_STAGE(PG8_SA(0, 0), cA, oc[0]); PG8_STAGE(PG8_SA(0, 1), cA, oc[1]);
    if (wr == 1) PG8_BAR;
    PG8_WAIT_V(2); PG8_BAR;
    PG8_STAGE(PG8_SB(1, 0), cB + kstep, voffB); PG8_STAGE(PG8_SA(1, 0), cA + kstep, oc[0]); PG8_STAGE(PG8_SB(1, 1), cB + hstep + kstep, voffB);
    PG8_WAIT_V(6); PG8_BAR;
    for (;;) {
        const bool has_next = S.next(ui + 1, nxt);
        const char* nA = has_next ? S.a_base(nxt) : cA; const char* nB = has_next ? S.b_base(nxt) : cB;
        if (has_next) { PG8_TABLES(nxt, (ui + 1) % 3); }
        for (int t = 0; t < nt; t += 2) {
            const bool last = (t == nt - 2);
            const char* a1 = cA + (size_t)(t + 1) * kstep;
            const char* a2 = last ? nA : cA + (size_t)(t + 2) * kstep; const char* b2 = last ? nB : cB + (size_t)(t + 2) * kstep;
            const char* a3 = a2 + kstep; const char* b3 = b2 + kstep;
            PG8_LDB(B0, 0, 0); PG8_LDB(B1, 0, 1); PG8_SCHED; PG8_LDA(At, 0, 0); PG8_STAGE(PG8_SA(1, 1), a1, oc[1]);
            PG8_WAIT_V(8); PG8_WAIT_L(0); PG8_BAR; PG8_MMA(0, 0, At, B0); PG8_MMA(0, 1, At, B1); PG8_BAR; PG8_SCHED;
            if (last && has_next) { PG8_AOFFS_NEXT(oc); }
            PG8_LDA(At, 0, 1); PG8_STAGE(PG8_SB(0, 0), b2, voffB); PG8_STAGE(PG8_SB(0, 1), b2 + hstep, voffB); PG8_STAGE(PG8_SA(0, 0), a2, oc[0]);
            PG8_WAIT_V(8); PG8_WAIT_L(0); PG8_BAR; PG8_MMA(1, 0, At, B0); PG8_MMA(1, 1, At, B1); PG8_BAR; PG8_SCHED;
            PG8_LDB(B0, 1, 0); PG8_LDB(B1, 1, 1); PG8_SCHED; PG8_LDA(At, 1, 0); PG8_STAGE(PG8_SA(0, 1), a2, oc[1]);
            PG8_WAIT_V(8); PG8_WAIT_L(0); PG8_BAR; PG8_MMA(0, 0, At, B0); PG8_MMA(0, 1, At, B1); PG8_BAR; PG8_SCHED;
            PG8_LDA(At, 1, 1); PG8_STAGE(PG8_SB(1, 0), b3, voffB); PG8_STAGE(PG8_SB(1, 1), b3 + hstep, voffB); PG8_STAGE(PG8_SA(1, 0), a3, oc[0]);
            PG8_WAIT_V(8); PG8_WAIT_L(0); PG8_BAR; PG8_MMA(1, 0, At, B0); PG8_MMA(1, 1, At, B1); PG8_BAR; PG8_SCHED;
        }
        if constexpr (ALIGN_EPI) { if (wr == 0) PG8_BAR; }
        if constexpr (Sched::TBL) E(acc, cur, wr, wc, fr, fq, S.tb + (ui % 3) * 1024); else E(acc, cur, wr, wc, fr, fq);
        if (!has_next) break;
#pragma unroll
        for (int a = 0; a < 2; ++a)
#pragma unroll
            for (int b = 0; b < 2; ++b)
#pragma unroll
                for (int m = 0; m < 4; ++m)
#pragma unroll
                    for (int n = 0; n < 2; ++n) acc[a][b][m][n] = (f32x4){0.f, 0.f, 0.f, 0.f};
        cur = nxt; cA = nA; cB = nB; ++ui;
        if constexpr (ALIGN_EPI) { if (wr == 1) PG8_BAR; }
    }
    PG8_WAIT_V(0);
    if constexpr (!ALIGN_EPI) { if (wr == 0) PG8_BAR; }
    PG8_BAR;
#undef PG8_SA
#undef PG8_SB
#undef PG8_STAGE
#undef PG8_LDA
#undef PG8_LDB
#undef PG8_MMA
#undef PG8_WAIT_V
#undef PG8_WAIT_L
#undef PG8_BAR
#undef PG8_SCHED
#undef PG8_AOFFS
#undef PG8_AOFFS_NEXT
#undef PG8_TABLES
#undef PG8_CAT
}
}

#define XB_TMO      128
#define XB_XCNT(j)  (256  + 64 * (j))
#define XB_XSUB(j)  (1280 + 64 * (j))
#define XB_XGEN(j)  (2304 + 64 * (j))
#define XB_TOP      3328
#define XB_TOPGEN   3392
#define XCD_BAR_WORDS 3456
#define XB_SPIN_CAP (1u << 18)
__device__ __forceinline__ unsigned xb_ld(unsigned* p)              { return __hip_atomic_load(p, __ATOMIC_RELAXED, __HIP_MEMORY_SCOPE_AGENT); }
__device__ __forceinline__ unsigned xb_add(unsigned* p, unsigned v) { return __hip_atomic_fetch_add(p, v, __ATOMIC_RELAXED, __HIP_MEMORY_SCOPE_AGENT); }
__device__ __forceinline__ unsigned xb_xcc_id() { return (unsigned)__builtin_amdgcn_s_getreg((3 << 11) | 20) & 0xFu; }
#define XB_SPIN(cond, bar) do { unsigned _sp = 0; while (cond) { __builtin_amdgcn_s_sleep(1); \
    if ((++_sp & 255u) == 0u) { if (xb_ld(&(bar)[XB_TMO])) break; if (_sp > XB_SPIN_CAP) { atomicAdd(&(bar)[XB_TMO], 1u); break; } } } } while (0)
struct XcdBarrier { unsigned* bar; unsigned x; volatile LAS unsigned* st; };
__device__ __forceinline__ XcdBarrier xcd_barrier_post(unsigned* bar, volatile LAS unsigned* st) {
    XcdBarrier b; b.bar = bar; b.x = xb_xcc_id(); b.st = st;
    if (threadIdx.x == 0) (void)xb_add(&bar[XB_XCNT(b.x)], 1u);
    return b;
}
__device__ __forceinline__ void xcd_barrier_complete(unsigned* bar, unsigned x, unsigned& nloc, unsigned& nx) {
    const unsigned G = gridDim.x * gridDim.y * gridDim.z;
    unsigned sum, cnt, mine, sp = 0u;
    for (;;) {
        sum = 0u; cnt = 0u; mine = 0u;
#pragma unroll
        for (unsigned j = 0; j < 16; ++j) { const unsigned c = xb_ld(&bar[XB_XCNT(j)]); sum += c; cnt += (c > 0u) ? 1u : 0u; mine = (j == x) ? c : mine; }
        if (sum == G) break;
        __builtin_amdgcn_s_sleep(1);
        if ((++sp & 255u) == 0u) { if (xb_ld(&bar[XB_TMO])) break; if (sp > XB_SPIN_CAP) { atomicAdd(&bar[XB_TMO], 1u); break; } }
    }
    nloc = mine > 0u ? mine : 1u; nx = cnt > 0u ? cnt : 1u;
}
__device__ __forceinline__ void xcd_barrier(const XcdBarrier& b) {
    asm volatile("s_waitcnt vmcnt(0)" ::: "memory");
    __syncthreads();
    if (threadIdx.x == 0) {
        unsigned* bar = b.bar;
        __builtin_amdgcn_s_waitcnt(0);
        unsigned nloc = b.st[0], nx = b.st[1];
        if (nloc == 0u) { xcd_barrier_complete(bar, b.x, nloc, nx); b.st[0] = nloc; b.st[1] = nx; }
        const unsigned old = xb_add(&bar[XB_XSUB(b.x)], 1u);
        const unsigned gen = old / nloc;
        if (old + 1u == (gen + 1u) * nloc) {
            __builtin_amdgcn_fence(__ATOMIC_RELEASE, "agent");
            asm volatile("s_waitcnt vmcnt(0)" ::: "memory");
            const unsigned og = xb_add(&bar[XB_TOP], 1u);
            const unsigned tg = og / nx;
            if (og + 1u == (tg + 1u) * nx) xb_add(&bar[XB_TOPGEN], 1u);
            else XB_SPIN(xb_ld(&bar[XB_TOPGEN]) == tg, bar);
            __builtin_amdgcn_fence(__ATOMIC_ACQUIRE, "agent");
            xb_add(&bar[XB_XGEN(b.x)], 1u);
            asm volatile("s_waitcnt vmcnt(0)" ::: "memory");
        } else {
            XB_SPIN(xb_ld(&bar[XB_XGEN(b.x)]) == gen, bar);
            __builtin_amdgcn_fence(__ATOMIC_ACQUIRE, "agent");
            asm volatile("s_waitcnt vmcnt(0)" ::: "memory");
        }
    }
    __syncthreads();
}

struct Frame {
    LAS unsigned char* lds;
    unsigned* ctl;
    int tid, lane, wave, G;
    const float *x, *c, *ctx, *c_ctx, *w_mod, *b_mod, *norm1_w, *norm2_w, *w_in, *conv_w, *conv_b, *dt_bias, *a_log, *d_skip, *ssd_norm_w, *pool_w, *pool_scale, *w_out, *router_w, *router_b, *w1, *b1, *w2, *b2, *final_norm_w;
    float* out;
    float *MOD, *DTRAW, *DT, *ROWSC, *CHS, *TOPG, *SLOTGATE;
    bf16* X1;
    int *TOPE, *TOPR, *TOKSLOT, *SLOTTOK, *SLOTID, *BB;
    bf16 *WINT, *WOUTT, *W1T, *W2T, *A1, *XBCPRE, *Z, *V, *XBC, *CC, *ST, *Y, *YB, *A2, *H2, *ACT, *YS;
};

template <class RowMap>
__device__ __forceinline__ void p0_emit(bf16* WT, int Kd, RowMap rm, int k0, int n0, int nvalid, LAS float* scr, int lane) {
    const int c = lane & 7;
#pragma unroll
    for (int j = 0; j < 4; ++j) { const int n = (lane >> 3) + 8 * j; const LAS float* s = scr + (8 * c) * 33 + n;
        v4u o; o.x = pk2(s[0 * 33], s[1 * 33]); o.y = pk2(s[2 * 33], s[3 * 33]); o.z = pk2(s[4 * 33], s[5 * 33]); o.w = pk2(s[6 * 33], s[7 * 33]);
        if (n0 + n < nvalid) *(v4u*)(WT + (size_t)rm(n0 + n) * Kd + k0 + 8 * c) = o; }
    LDS_WAIT(); asm volatile("" ::: "memory");
}
template <class RowMap>
__device__ __forceinline__ void p0_transpose_item(const float* W, int N, int nvalid, bf16* WT, int Kd, RowMap rm, LAS float* scr, int kb, int nb, int lane) {
    const int k0 = 64 * kb, n0 = 32 * nb, nn = n0 + (lane & 31); const bool ok = nn < nvalid;
    float tv[32];
#pragma unroll
    for (int i = 0; i < 32; ++i) { const int kk = 2 * i + (lane >> 5); tv[i] = ok ? W[(size_t)(k0 + kk) * N + nn] : 0.f; }
#pragma unroll
    for (int i = 0; i < 32; ++i) { const int kk = 2 * i + (lane >> 5); scr[kk * 33 + (lane & 31)] = tv[i]; }
    LDS_WAIT(); asm volatile("" ::: "memory");
    p0_emit(WT, Kd, rm, k0, n0, nvalid, scr, lane);
}
struct RmId { __device__ __forceinline__ int operator()(int n) const { return n; } };
struct RmOff { int off; __device__ __forceinline__ int operator()(int n) const { return n + off; } };
struct RmWin { __device__ __forceinline__ int operator()(int n) const { return n < 2560 ? n : (n < 2608 ? 4608 + (n - 2560) : 2560 + (n - 2608)); } };
struct RmW1 { __device__ __forceinline__ int operator()(int n) const { const int j = n >> 1; return 256 * (j >> 7) + 128 * (n & 1) + (j & 127); } };

__device__ __forceinline__ void p0_prologue(Frame& F) {
    if ((int)blockIdx.x < 96) {
        LAS float* sc = (LAS float*)F.lds;
        LAS float* part = (LAS float*)(F.lds + 36864);
        for (int idx = F.tid; idx < 9 * 1024; idx += 512) { const int r = idx >> 10, k = idx & 1023; const float v = (r < 8) ? F.c[r * 1024 + k] : F.c_ctx[k]; sc[idx] = silu_f(v); }
        __syncthreads();
        const int n = 64 * (int)blockIdx.x + F.lane, kb = 128 * F.wave;
        float acc[9];
#pragma unroll
        for (int r = 0; r < 9; ++r) acc[r] = 0.f;
#pragma unroll 8
        for (int k = 0; k < 128; ++k) { const float wv = F.w_mod[(size_t)(kb + k) * 6144 + n];
#pragma unroll
            for (int r = 0; r < 9; ++r) acc[r] += sc[r * 1024 + kb + k] * wv; }
#pragma unroll
        for (int r = 0; r < 9; ++r) part[(F.wave * 9 + r) * 64 + F.lane] = acc[r];
        __syncthreads();
        for (int idx = F.tid; idx < 9 * 64; idx += 512) { const int r = idx >> 6, col = idx & 63; float s = 0.f;
#pragma unroll
            for (int w = 0; w < 8; ++w) s += part[(w * 9 + r) * 64 + col];
            F.MOD[r * 6144 + 64 * (int)blockIdx.x + col] = s + F.b_mod[64 * (int)blockIdx.x + col]; }
        __syncthreads();
    }
    LAS float* scr = (LAS float*)(F.lds + F.wave * 16384);
    const int gw = (int)blockIdx.x * 8 + F.wave, NGW = F.G * 8, lane = F.lane;
    constexpr int I_POOL = 16 * 4 * 4, I_PAD = N1 - IN_COLS;
    for (int r = NGW - 1 - gw; r < I_POOL + I_PAD; r += NGW) {
        if (r < I_POOL) {
            const int kb = r >> 4, g = (r >> 2) & 3, ob = r & 3, k = 64 * kb + lane, o0 = 32 * ob;
            float acc[32];
#pragma unroll
            for (int o = 0; o < 32; ++o) acc[o] = 0.f;
            const float* arow = F.w_in + (size_t)k * IN_COLS + 4144 + g * 128;
            for (int i = 0; i < 128; ++i) { const float a = arow[i]; const float* pw = F.pool_w + (size_t)(g * 128 + i) * 128 + o0;
#pragma unroll
                for (int o = 0; o < 32; ++o) acc[o] += a * pw[o]; }
#pragma unroll
            for (int o = 0; o < 32; ++o) scr[lane * 33 + o] = acc[o] * F.pool_scale[g * 128 + o0 + o];
            LDS_WAIT(); asm volatile("" ::: "memory");
            p0_emit(F.WINT, D, RmOff{4096 + g * 128}, 64 * kb, o0, 1 << 30, scr, lane);
        } else { v4u z = {0u, 0u, 0u, 0u}; v4u* p = (v4u*)(F.WINT + (size_t)(IN_COLS + (r - I_POOL)) * D); p[lane] = z; p[lane + 64] = z; }
    }
    constexpr int I_WIN = 16 * 130, I_WOUT = 32 * 32, I_W1 = 32 * 16 * 64, I_W2 = 32 * 16 * 32, NI = I_WIN + I_WOUT + I_W1 + I_W2;
    const bool wdeal = (F.G == 256);
    const int blk = (int)blockIdx.x;
#define P0_ITEM(k) (wdeal ? ((k) < 20 ? (k) * 2048 + gw : ((k) < 27 ? (blk >= 96 ? 40960 + ((k) - 20) * 1280 + (gw - 768) : -1) : ((k) < 30 ? ((blk >= 96 && blk < 198) ? 49920 + ((k) - 27) * 816 + (gw - 768) : -1) : -1))) : (k) * NGW + gw)
    const int nrounds = wdeal ? 30 : (NI + NGW - 1) / NGW;
    struct It { const float* src; bf16* dst; int N, nvalid, Kd, kind, k0, n0; };
#define P0_DECODE(it, I) do { int r_ = (it); \
        if (r_ < I_WIN) { I.src = F.w_in; I.dst = F.WINT; I.N = IN_COLS; I.nvalid = 4144; I.Kd = D; I.kind = 1; I.k0 = 64 * (r_ / 130); I.n0 = 32 * (r_ % 130); } \
        else if ((r_ -= I_WIN) < I_WOUT) { I.src = F.w_out; I.dst = F.WOUTT; I.N = D; I.nvalid = D; I.Kd = 2048; I.kind = 0; I.k0 = 64 * (r_ >> 5); I.n0 = 32 * (r_ & 31); } \
        else if ((r_ -= I_WOUT) < I_W1) { const int e_ = r_ >> 10, q_ = r_ & 1023; I.src = F.w1 + (size_t)e_ * D * 2048; I.dst = (bf16*)((unsigned char*)F.W1T + (size_t)e_ * 2048 * D); I.N = 2048; I.nvalid = 2048; I.Kd = D; I.kind = 2; I.k0 = 64 * (q_ >> 6); I.n0 = 32 * (q_ & 63); } \
        else { r_ -= I_W1; const int e_ = r_ >> 9, q_ = r_ & 511; I.src = F.w2 + (size_t)e_ * D * D; I.dst = (bf16*)((unsigned char*)F.W2T + (size_t)e_ * D * D); I.N = D; I.nvalid = D; I.Kd = D; I.kind = 3; I.k0 = 64 * (q_ >> 5); I.n0 = 32 * (q_ & 31); } } while (0)
#define P0_LOAD(I, tv) do { int nn_ = I.n0 + (lane & 31); nn_ = nn_ < I.nvalid ? nn_ : I.nvalid - 1; const float* sp_ = I.src + (size_t)(I.k0 + (lane >> 5)) * I.N + nn_; \
        _Pragma("unroll") for (int i_ = 0; i_ < 32; ++i_) { const float* q_ = sp_ + (size_t)(2 * i_) * I.N; asm volatile("global_load_dword %0, %1, off" : "=v"(tv[i_]) : "v"(q_) : "memory"); } } while (0)
#define P0_NEXT(itv) do { itv = -1; for (; kr < nrounds && itv < 0; ++kr) { const int it_ = P0_ITEM(kr); if (it_ >= 0 && it_ < NI) itv = it_; } } while (0)
#define P0_PROCESS(I, tv) do { \
        _Pragma("unroll") for (int i = 0; i < 32; ++i) { const int kk = 2 * i + (lane >> 5); scr[kk * 33 + (lane & 31)] = tv[i]; } \
        LDS_WAIT(); asm volatile("" ::: "memory"); \
        { const int c = lane & 7; \
          _Pragma("unroll") for (int j = 0; j < 4; ++j) { const int n = (lane >> 3) + 8 * j; const LAS float* sq = scr + (8 * c) * 33 + n; \
            const int ng = I.n0 + n; const int row = (I.kind == 0 || I.kind == 3) ? ng : (I.kind == 1 ? RmWin{}(ng) : RmW1{}(ng)); \
            if (I.kind >= 2) { v2u o; o.x = pk4_fp8(sq[0 * 33] * WSCALE, sq[1 * 33] * WSCALE, sq[2 * 33] * WSCALE, sq[3 * 33] * WSCALE); o.y = pk4_fp8(sq[4 * 33] * WSCALE, sq[5 * 33] * WSCALE, sq[6 * 33] * WSCALE, sq[7 * 33] * WSCALE); \
                *(v2u*)((unsigned char*)I.dst + (size_t)row * I.Kd + I.k0 + 8 * c) = o; } \
            else { v4u o; o.x = pk2(sq[0 * 33], sq[1 * 33]); o.y = pk2(sq[2 * 33], sq[3 * 33]); o.z = pk2(sq[4 * 33], sq[5 * 33]); o.w = pk2(sq[6 * 33], sq[7 * 33]); \
                if (ng < I.nvalid) *(v4u*)(I.dst + (size_t)row * I.Kd + I.k0 + 8 * c) = o; } } \
          LDS_WAIT(); asm volatile("" ::: "memory"); } } while (0)
    It ia{}, ib{}; float ta[32], tb[32]; int ita = -1, itb = -1; int kr = 0;
    P0_NEXT(ita);
    if (ita >= 0) { P0_DECODE(ita, ia); P0_LOAD(ia, ta); }
    while (ita >= 0) {
        P0_NEXT(itb);
        if (itb >= 0) { P0_DECODE(itb, ib); P0_LOAD(ib, tb); asm volatile("s_waitcnt vmcnt(32)" ::: "memory"); } else { asm volatile("s_waitcnt vmcnt(0)" ::: "memory"); }
        __builtin_amdgcn_sched_barrier(0);
        P0_PROCESS(ia, ta);
        if (itb < 0) break;
        P0_NEXT(ita);
        if (ita >= 0) { P0_DECODE(ita, ia); P0_LOAD(ia, ta); asm volatile("s_waitcnt vmcnt(32)" ::: "memory"); } else { asm volatile("s_waitcnt vmcnt(0)" ::: "memory"); }
        __builtin_amdgcn_sched_barrier(0);
        P0_PROCESS(ib, tb);
    }
#undef P0_NEXT
#undef P0_PROCESS
#undef P0_ITEM
#undef P0_DECODE
#undef P0_LOAD
}

__device__ __forceinline__ void p1_norm1(Frame& F) {
    const int gw = (int)blockIdx.x * 8 + F.wave, NGW = F.G * 8, lane = F.lane;
    for (int rq = gw; rq < RTOT / 4; rq += NGW) {
        f32x4 v[4][4];
#pragma unroll
        for (int k = 0; k < 4; ++k) { const int r = rq * 4 + k; const float* xr = (r < T) ? F.x + (size_t)r * D : F.ctx + (size_t)(r - T) * D;
#pragma unroll
            for (int j = 0; j < 4; ++j) v[k][j] = *(const f32x4*)(xr + 4 * lane + 256 * j); }
#pragma unroll
        for (int k = 0; k < 4; ++k) { const int r = rq * 4 + k;
            const float* mod = F.MOD + (size_t)((r < T) ? (r >> 12) : 8) * 6144;
            float ss = 0.f;
#pragma unroll
            for (int j = 0; j < 4; ++j) ss += (v[k][j].x * v[k][j].x + v[k][j].y * v[k][j].y) + (v[k][j].z * v[k][j].z + v[k][j].w * v[k][j].w);
            const float rs = 1.f / sqrtf(wave_sum(ss) * (1.f / D) + RMS_EPS);
#pragma unroll
            for (int j = 0; j < 4; ++j) { const int col = 4 * lane + 256 * j;
                const f32x4 w = *(const f32x4*)(F.norm1_w + col), sh = *(const f32x4*)(mod + col), sc = *(const f32x4*)(mod + 1024 + col);
                const f32x4 h = (v[k][j] * rs) * w * (sc + 1.f) + sh;
                v2u o; o.x = pk2(h.x, h.y); o.y = pk2(h.z, h.w);
                *(v2u*)(F.A1 + (size_t)r * D + col) = o; } }
    }
}

struct Sched1 {   static constexpr bool TBL = false;
    const char* A; const char* Bt; int G, c;
    __device__ __forceinline__ bool next(int i, pg8::Unit& u) const {
        const int L = i * G + c; if (L >= 2432 + 88) return false;
        if (L < 2432) pg8::static_map(L, 128, 19, u.pm, u.pn);
        else { const int Lc = L - 2432, j = Lc >> 3; u.pm = 128 + (Lc & 7); u.pn = j < 10 ? j : 18; }
        u.e = 0; return true; }
    __device__ __forceinline__ const char* a_base(const pg8::Unit& u) const { return A + (size_t)u.pm * 256 * D * 2; }
    __device__ __forceinline__ const char* b_base(const pg8::Unit& u) const { return Bt + (size_t)u.pn * 256 * D * 2; }
    __device__ __forceinline__ const int* row_table(const pg8::Unit&) const { return nullptr; }
};
struct Epi1 {
    static constexpr bool PERM = true;
    bf16 *XBCPRE, *Z, *V; float* DTRAW;
    __device__ __forceinline__ void operator()(const f32x4 (&acc)[2][2][4][2], const pg8::Unit& u, int wr, int wc, int fr, int fq) const {
        const int row0 = u.pm * 256 + wr * 64 + fr;
        if (u.pn < 18) {
            bf16* base; int ldc, colt;
            if (u.pn < 10) { base = XBCPRE; ldc = CONV_CH; colt = u.pn * 256; } else if (u.pn < 16) { base = Z; ldc = SSD_W; colt = (u.pn - 10) * 256; } else { base = V; ldc = 512; colt = (u.pn - 16) * 256; }
            const int col0 = colt + wc * 32 + 8 * fq;
#pragma unroll
            for (int ai = 0; ai < 2; ++ai)
#pragma unroll
                for (int m = 0; m < 4; ++m) { bf16* rowp = base + (size_t)(row0 + ai * 128 + m * 16) * ldc + col0;
#pragma unroll
                    for (int bj = 0; bj < 2; ++bj) { const f32x4 v0 = acc[ai][bj][m][0], v1 = acc[ai][bj][m][1];
                        v4u w; w.x = pg8::cvt_pk_bf16(v0[0], v0[1]); w.y = pg8::cvt_pk_bf16(v0[2], v0[3]); w.z = pg8::cvt_pk_bf16(v1[0], v1[1]); w.w = pg8::cvt_pk_bf16(v1[2], v1[3]);
                        *(v4u*)(rowp + bj * 128) = w; } }
        } else if (wc < 2) {
            const int col0 = wc * 32 + 8 * fq;
#pragma unroll
            for (int ai = 0; ai < 2; ++ai)
#pragma unroll
                for (int m = 0; m < 4; ++m) { float* rowp = DTRAW + (size_t)(row0 + ai * 128 + m * 16) * 64 + col0;
                    *(f32x4*)(rowp) = acc[ai][0][m][0]; *(f32x4*)(rowp + 4) = acc[ai][0][m][1]; }
        }
    }
};

__device__ __forceinline__ void p3_conv(Frame& F) {
    const int gt = (int)blockIdx.x * 512 + F.tid, NT_ = F.G * 512;
    constexpr int RPT = 16, NTASK = (RTOT / RPT) * 320;
    for (int task = gt; task < NTASK; task += NT_) {
        const int rt = task / 320, cg = task - rt * 320, r0 = rt * RPT, ch = cg * 8;
        int slo, shi; if (r0 < T) { slo = r0 & ~(SEQ - 1); shi = slo + SEQ; } else { slo = T + ((r0 - T) & ~(CTXL - 1)); shi = slo + CTXL; }
        const v4u zero = {0u, 0u, 0u, 0u};
        v4u win[RPT + 4];
#pragma unroll
        for (int j = 0; j < RPT + 4; ++j) { const int r = r0 - 2 + j; win[j] = (r >= slo && r < shi) ? *(const v4u*)(F.XBCPRE + (size_t)r * CONV_CH + ch) : zero; }
        float w[5][8], bias[8];
#pragma unroll
        for (int j = 0; j < 5; ++j) { const f32x4 a = *(const f32x4*)(F.conv_w + j * CONV_CH + ch), b = *(const f32x4*)(F.conv_w + j * CONV_CH + ch + 4);
            w[j][0] = a.x; w[j][1] = a.y; w[j][2] = a.z; w[j][3] = a.w; w[j][4] = b.x; w[j][5] = b.y; w[j][6] = b.z; w[j][7] = b.w; }
        { const f32x4 a = *(const f32x4*)(F.conv_b + ch), b = *(const f32x4*)(F.conv_b + ch + 4); bias[0] = a.x; bias[1] = a.y; bias[2] = a.z; bias[3] = a.w; bias[4] = b.x; bias[5] = b.y; bias[6] = b.z; bias[7] = b.w; }
#pragma unroll
        for (int i = 0; i < RPT; ++i) {
            float o[8];
#pragma unroll
            for (int e = 0; e < 8; ++e) o[e] = bias[e];
#pragma unroll
            for (int j = 0; j < 5; ++j) { const v4u q = win[i + j];
                o[0] += w[j][0] * bflo(q.x); o[1] += w[j][1] * bfhi(q.x); o[2] += w[j][2] * bflo(q.y); o[3] += w[j][3] * bfhi(q.y);
                o[4] += w[j][4] * bflo(q.z); o[5] += w[j][5] * bfhi(q.z); o[6] += w[j][6] * bflo(q.w); o[7] += w[j][7] * bfhi(q.w); }
            v4u ov; ov.x = pk2(silu_f(o[0]), silu_f(o[1])); ov.y = pk2(silu_f(o[2]), silu_f(o[3])); ov.z = pk2(silu_f(o[4]), silu_f(o[5])); ov.w = pk2(silu_f(o[6]), silu_f(o[7]));
            *(v4u*)(F.XBC + (size_t)(r0 + i) * CONV_CH + ch) = ov;
        }
    }
    for (int idx = gt; idx < RTOT * 48; idx += NT_) { const int r = idx / 48, j = idx - r * 48; const float v = F.DTRAW[(size_t)r * 64 + j] + F.dt_bias[j];
        F.DT[idx] = v > 20.f ? v : log1pf(__expf(v)); }
}

__device__ __forceinline__ bf16x8 frag_row(const LAS unsigned char* base, int rs, int row, int k0, int q) { return *(const LAS bf16x8*)(base + row * rs + (k0 + 8 * q) * 2); }
__device__ __forceinline__ bf16x8 frag_tr(const LAS unsigned char* base, int rs, int k0, int c0, int lane) {
    const int g = lane >> 4, qq = (lane & 15) >> 2, p = lane & 3;
    const LAS unsigned char* a = base + (k0 + 8 * g + qq) * rs + c0 * 2 + 8 * p;
    const s16x4 lo = __builtin_amdgcn_ds_read_tr16_b64_v4i16((LAS s16x4*)a);
    const s16x4 hi = __builtin_amdgcn_ds_read_tr16_b64_v4i16((LAS s16x4*)(a + 4 * rs));
    bf16x8 r; r[0] = lo[0]; r[1] = lo[1]; r[2] = lo[2]; r[3] = lo[3]; r[4] = hi[0]; r[5] = hi[1]; r[6] = hi[2]; r[7] = hi[3]; return r;
}
__device__ __forceinline__ f32x4 mfma16(bf16x8 a, bf16x8 b, f32x4 c) { return __builtin_amdgcn_mfma_f32_16x16x32_bf16(a, b, c, 0, 0, 0); }
__device__ __forceinline__ float wave_incl_scan(float v, int lane) {
#pragma unroll
    for (int o = 1; o < 64; o <<= 1) { const float t = __shfl_up(v, o); if (lane >= o) v += t; }
    return v;
}

__device__ __forceinline__ float silu_fast(float v) { return v * __builtin_amdgcn_rcpf(1.f + __builtin_amdgcn_exp2f(-1.44269504f * v)); }
__device__ __forceinline__ float softplus_f(float v) { return v > 20.f ? v : log1pf(__expf(v)); }
__device__ __forceinline__ void p4_scan(Frame& F, LAS float* Te, volatile LAS float* TOT, int d, int h, float raw0, float raw1, int lane, size_t chs_idx, float* rowsc) {
    const int s0 = d ? 127 - 2 * lane : 2 * lane, s1 = d ? s0 - 1 : s0 + 1;
    const float bias = F.dt_bias[d * NH + h];
    const float dt0 = softplus_f(raw0 + bias), dt1 = softplus_f(raw1 + bias);
    const float A2 = __expf(F.a_log[d * NH + h]) * 1.44269504f;
    const float a0 = -A2 * dt0, a1 = -A2 * dt1;
    const float incl = wave_incl_scan(a0 + a1, lane);
    const float c1 = incl, c0 = incl - a1, tot = __shfl(incl, 63);
    Te[d * 128 + s0] = c0; Te[d * 128 + s1] = c1;
    Te[(2 + d) * 128 + s0] = c0 - __builtin_amdgcn_logf(dt0); Te[(2 + d) * 128 + s1] = c1 - __builtin_amdgcn_logf(dt1);
    if (lane == 63) { F.CHS[chs_idx] = tot; *TOT = tot; }
    if (rowsc) { rowsc[s0] = __builtin_amdgcn_exp2f(c0); rowsc[s1] = __builtin_amdgcn_exp2f(c1); }
}
__device__ __forceinline__ v4u conv_piece(const v4u& r0, const v4u& r1, const v4u& r2, const v4u& r3, const v4u& r4, const float (&w)[5][8], const float (&bias)[8]) {
    float o[8];
#pragma unroll
    for (int e = 0; e < 8; ++e) o[e] = bias[e];
    const v4u rr[5] = {r0, r1, r2, r3, r4};
#pragma unroll
    for (int j = 0; j < 5; ++j) { const v4u q = rr[j];
        o[0] += w[j][0] * bflo(q.x); o[1] += w[j][1] * bfhi(q.x); o[2] += w[j][2] * bflo(q.y); o[3] += w[j][3] * bfhi(q.y);
        o[4] += w[j][4] * bflo(q.z); o[5] += w[j][5] * bfhi(q.z); o[6] += w[j][6] * bflo(q.w); o[7] += w[j][7] * bfhi(q.w); }
    v4u ov; ov.x = pk2(silu_fast(o[0]), silu_fast(o[1])); ov.y = pk2(silu_fast(o[2]), silu_fast(o[3])); ov.z = pk2(silu_fast(o[4]), silu_fast(o[5])); ov.w = pk2(silu_fast(o[6]), silu_fast(o[7]));
    return ov;
}
__device__ __forceinline__ void p4_states(Frame& F, const bf16x8 (&braw)[4], const LAS float* Te, const volatile LAS float* TOT2, const LAS unsigned char* Xs, size_t st_base, int w, int lane) {
    constexpr int RSX = 144;
    const int i16 = lane & 15, q4 = lane >> 4;
#pragma unroll
    for (int d = 0; d < 2; ++d) {
        const float tot = TOT2[d];
        f32x4 sa[4];
#pragma unroll
        for (int pt = 0; pt < 4; ++pt) sa[pt] = (f32x4){0.f, 0.f, 0.f, 0.f};
#pragma unroll
        for (int ks = 0; ks < 4; ++ks) {
            const LAS float* cp = Te + (2 + d) * 128 + 32 * ks + 8 * q4;
            const f32x4 c0 = *(const LAS f32x4*)cp, c1 = *(const LAS f32x4*)(cp + 4);
            float wv[8];
#pragma unroll
            for (int j = 0; j < 4; ++j) { wv[j] = __builtin_amdgcn_exp2f(tot - c0[j]); wv[4 + j] = __builtin_amdgcn_exp2f(tot - c1[j]); }
            const v4u bu = __builtin_bit_cast(v4u, braw[ks]); v4u su;
            su.x = pk2(bflo(bu.x) * wv[0], bfhi(bu.x) * wv[1]); su.y = pk2(bflo(bu.y) * wv[2], bfhi(bu.y) * wv[3]);
            su.z = pk2(bflo(bu.z) * wv[4], bfhi(bu.z) * wv[5]); su.w = pk2(bflo(bu.w) * wv[6], bfhi(bu.w) * wv[7]);
            const bf16x8 bs = __builtin_bit_cast(bf16x8, su);
#pragma unroll
            for (int pt = 0; pt < 4; ++pt) sa[pt] = mfma16(bs, frag_tr(Xs, RSX, 32 * ks, 16 * pt, lane), sa[pt]); }
        bf16* sp = F.ST + st_base + ((size_t)d * HDIM + i16) * NST + 16 * w + 4 * q4;
#pragma unroll
        for (int pt = 0; pt < 4; ++pt) { v2u o; o.x = pk2(sa[pt][0], sa[pt][1]); o.y = pk2(sa[pt][2], sa[pt][3]); *(v2u*)(sp + (size_t)16 * pt * NST) = o; }
    }
}
__device__ __forceinline__ void p4_ssd_local(Frame& F) {
    constexpr int RS = 272, RSX = 144;
    constexpr int O_C = 0, O_B = 34816, O_M = 69632, O_X = 104448  , O_T = 141312  , O_CW = 153600  ;
    static_assert(O_CW + 9216 <= MISC_OFF, "P4 LDS map");
    LAS unsigned char* L = F.lds;
    LAS float* TAB = (LAS float*)(L + O_T);
    LAS float* CW = (LAS float*)(L + O_CW);
    volatile LAS float* TOT = (volatile LAS float*)(L + MISC_OFF + 64);
    volatile LAS float* DSK = (volatile LAS float*)(L + MISC_OFF + 128);
    const int tid = F.tid, lane = F.lane, w = F.wave, i16 = lane & 15, q4 = lane >> 4;
    const int lb = 64 * (w & 1), sb = 32 * (w >> 1);
    const v4u zero4 = {0u, 0u, 0u, 0u};
    constexpr int NLAT = NB * 32 * NGRP, NCTX = NB * 2 * NGRP * HPG;
    for (int v = (int)blockIdx.x; v < NLAT + NCTX; v += F.G) {
        const bool lat = v < NLAT;
        int tid_l = tid; asm volatile("" : "+v"(tid_l));
        const int lane_l = tid_l & 63;
        const int p32 = tid_l & 31, rg = tid_l >> 5;
        const int xpc = tid_l & 7, rg2 = tid_l >> 3;
        int b, g, cc, r0, e_lo, e_hi; bool lo_ok, hi_ok;
        if (lat) { b = v >> 7; const int c = (v >> 2) & 31; g = v & 3; cc = c + 2; r0 = b * SEQ + c * CHUNK; lo_ok = c > 0; hi_ok = c < 31; e_lo = 0; e_hi = HPG; }
        else { const int q = v - NLAT; const int e = q % HPG; int t = q / HPG; g = t & 3; t >>= 2; cc = t & 1; b = t >> 1; r0 = T + b * CTXL + cc * CHUNK; lo_ok = cc > 0; hi_ok = cc < 1; e_lo = e; e_hi = e + 1; }
        const int rmin = lo_ok ? -2 : 0, rmax = hi_ok ? 129 : 127;
        const int chBC = SSD_W + (p32 >> 4) * (NGRP * NST) + g * NST + 8 * (p32 & 15);
        v4u raw[12];
#pragma unroll
        for (int j = 0; j < 12; ++j) { const int rr = 8 * rg - 2 + j; const int rc = rr < rmin ? rmin : (rr > rmax ? rmax : rr);
            const v4u t = *(const v4u*)(F.XBCPRE + (size_t)(r0 + rc) * CONV_CH + chBC); raw[j] = (rr == rc) ? t : zero4; }
        if (tid < HPG) DSK[tid] = F.d_skip[g * HPG + tid];
        for (int idx = tid; idx < HPG * 6 * 64; idx += 512) { const int e_ = idx / 384, rem = idx - e_ * 384, j = rem >> 6, chl = rem & 63; const int ch = (g * HPG + e_) * HDIM + chl;
            CW[idx] = (j < 5) ? F.conv_w[j * CONV_CH + ch] : F.conv_b[ch]; }
        {
            float cw[5][8], cbias[8];
#pragma unroll
            for (int j = 0; j < 5; ++j) { const f32x4 a = *(const f32x4*)(F.conv_w + j * CONV_CH + chBC), bq = *(const f32x4*)(F.conv_w + j * CONV_CH + chBC + 4);
                cw[j][0] = a.x; cw[j][1] = a.y; cw[j][2] = a.z; cw[j][3] = a.w; cw[j][4] = bq.x; cw[j][5] = bq.y; cw[j][6] = bq.z; cw[j][7] = bq.w; }
            { const f32x4 a = *(const f32x4*)(F.conv_b + chBC), bq = *(const f32x4*)(F.conv_b + chBC + 4); cbias[0] = a.x; cbias[1] = a.y; cbias[2] = a.z; cbias[3] = a.w; cbias[4] = bq.x; cbias[5] = bq.y; cbias[6] = bq.z; cbias[7] = bq.w; }
            LAS unsigned char* dst = L + ((p32 >> 4) ? O_C : O_B) + (8 * rg) * RS + (p32 & 15) * 16;
#pragma unroll
            for (int i = 0; i < 8; ++i) { const v4u o = conv_piece(raw[i], raw[i + 1], raw[i + 2], raw[i + 3], raw[i + 4], cw, cbias);
                *(LAS v4u*)(dst + i * RS) = o;
                if (lat && (p32 >> 4)) *(v4u*)(F.CC + (size_t)(r0 + 8 * rg + i) * 512 + g * NST + 8 * (p32 & 15)) = o; }
        }
        v4u xraw[6];
#pragma unroll
        for (int j = 0; j < 6; ++j) { const int rr = 2 * rg2 - 2 + j; const int rc = rr < rmin ? rmin : (rr > rmax ? rmax : rr);
            xraw[j] = *(const v4u*)(F.XBCPRE + (size_t)(r0 + rc) * CONV_CH + (g * HPG + e_lo) * HDIM + 8 * xpc); }
        float pdt[2][2];
#pragma unroll
        for (int ii = 0; ii < 2; ++ii) { const int idx = (w + 8 * ii) < 12 ? (w + 8 * ii) : 11; const int e_ = idx % 6, d_ = idx / 6, h_ = g * HPG + e_; const int s0 = d_ ? 127 - 2 * lane_l : 2 * lane_l, s1 = d_ ? s0 - 1 : s0 + 1;
            pdt[ii][0] = F.DTRAW[(size_t)(r0 + s0) * 64 + d_ * NH + h_]; pdt[ii][1] = F.DTRAW[(size_t)(r0 + s1) * 64 + d_ * NH + h_]; }
#pragma unroll
        for (int ii = 0; ii < 2; ++ii) { const int idx = w + 8 * ii; const int e = idx % 6, d = idx / 6, h = g * HPG + e;
            if (idx < 12 && e >= e_lo && e < e_hi)
                p4_scan(F, TAB + e * 512, TOT + e * 2 + d, d, h, pdt[ii][0], pdt[ii][1], lane_l, ((size_t)(b * NCC + cc) * NH + h) * 2 + d, lat ? F.ROWSC + ((size_t)(b * 2 + d) * NH + h) * SEQ + (cc - 2) * CHUNK : nullptr); }
        __syncthreads();
        f32x4 cb[2][4];
        if (lat) {
#pragma unroll
            for (int ts = 0; ts < 2; ++ts)
#pragma unroll
                for (int tl = 0; tl < 4; ++tl) cb[ts][tl] = (f32x4){0.f, 0.f, 0.f, 0.f};
#pragma unroll
            for (int ks = 0; ks < 4; ++ks) { bf16x8 af[2], bfr[4];
#pragma unroll
                for (int ts = 0; ts < 2; ++ts) af[ts] = frag_row(L + O_B, RS, sb + 16 * ts + i16, 32 * ks, q4);
#pragma unroll
                for (int tl = 0; tl < 4; ++tl) bfr[tl] = frag_row(L + O_C, RS, lb + 16 * tl + i16, 32 * ks, q4);
#pragma unroll
                for (int ts = 0; ts < 2; ++ts)
#pragma unroll
                    for (int tl = 0; tl < 4; ++tl) cb[ts][tl] = mfma16(af[ts], bfr[tl], cb[ts][tl]); }
        }
        bf16x8 braw[4];
#pragma unroll
        for (int ks = 0; ks < 4; ++ks) braw[ks] = frag_tr(L + O_B, RS, 32 * ks, 16 * w, lane);
        for (int e = e_lo; e < e_hi; ++e) {
            const int h = g * HPG + e;
            const LAS float* Te = TAB + e * 512;
            LAS unsigned char* Xs = L + O_X + (e & 1) * 18432;
            LAS unsigned char* Ms = L + ((e & 1) ? O_C : O_M);
            {
                const LAS float* cwp = CW + (e * 6) * 64 + 8 * xpc;
#pragma unroll
                for (int i = 0; i < 2; ++i) {
                    f32x4 oa = *(const LAS f32x4*)(cwp + 5 * 64), ob = *(const LAS f32x4*)(cwp + 5 * 64 + 4);
#pragma unroll
                    for (int j = 0; j < 5; ++j) { const f32x4 wa = *(const LAS f32x4*)(cwp + j * 64), wb = *(const LAS f32x4*)(cwp + j * 64 + 4);
                        const int rr = 2 * rg2 - 2 + i + j; const v4u q = (rr >= rmin && rr <= rmax) ? xraw[i + j] : zero4;
                        oa.x += wa.x * bflo(q.x); oa.y += wa.y * bfhi(q.x); oa.z += wa.z * bflo(q.y); oa.w += wa.w * bfhi(q.y);
                        ob.x += wb.x * bflo(q.z); ob.y += wb.y * bfhi(q.z); ob.z += wb.z * bflo(q.w); ob.w += wb.w * bfhi(q.w); }
                    v4u ov; ov.x = pk2(silu_fast(oa.x), silu_fast(oa.y)); ov.y = pk2(silu_fast(oa.z), silu_fast(oa.w)); ov.z = pk2(silu_fast(ob.x), silu_fast(ob.y)); ov.w = pk2(silu_fast(ob.z), silu_fast(ob.w));
                    *(LAS v4u*)(Xs + (2 * rg2 + i) * RSX + xpc * 16) = ov; }
            }
            if (e + 1 < e_hi) {
#pragma unroll
                for (int j = 0; j < 6; ++j) { const int rr = 2 * rg2 - 2 + j; const int rc = rr < rmin ? rmin : (rr > rmax ? rmax : rr);
                    xraw[j] = *(const v4u*)(F.XBCPRE + (size_t)(r0 + rc) * CONV_CH + (h + 1) * HDIM + 8 * xpc); }
            }
            if (lat) {
                const float Dh = DSK[e];
#pragma unroll
                for (int tl = 0; tl < 4; ++tl) { const int l = lb + 16 * tl + i16; const int lt_abs = 4 * (w & 1) + tl; const float af_l = Te[l], rb_l = Te[128 + l];
#pragma unroll
                    for (int ts = 0; ts < 2; ++ts) { const int s0 = sb + 16 * ts + 4 * q4; const int st_abs = 2 * (w >> 1) + ts;
                        float m[4];
                        if (st_abs < lt_abs) {
                            const f32x4 acs = *(const LAS f32x4*)(Te + 256 + s0);
#pragma unroll
                            for (int r = 0; r < 4; ++r) m[r] = cb[ts][tl][r] * __builtin_amdgcn_exp2f(af_l - acs[r]);
                        } else if (st_abs > lt_abs) {
                            const f32x4 rbs = *(const LAS f32x4*)(Te + 384 + s0);
#pragma unroll
                            for (int r = 0; r < 4; ++r) m[r] = cb[ts][tl][r] * __builtin_amdgcn_exp2f(rb_l - rbs[r]);
                        } else {
                            const f32x4 acs = *(const LAS f32x4*)(Te + 256 + s0), rbs = *(const LAS f32x4*)(Te + 384 + s0);
#pragma unroll
                            for (int r = 0; r < 4; ++r) { const int sidx = s0 + r;
                                const float wf = (sidx <= l) ? __builtin_amdgcn_exp2f(af_l - acs[r]) : 0.f;
                                const float wb = (sidx >= l) ? __builtin_amdgcn_exp2f(rb_l - rbs[r]) : 0.f;
                                m[r] = cb[ts][tl][r] * (wf + wb) + ((sidx == l) ? Dh : 0.f); }
                        }
                        v2u o; o.x = pk2(m[0], m[1]); o.y = pk2(m[2], m[3]);
                        *(LAS v2u*)(Ms + l * RS + s0 * 2) = o; } }
            }
            __syncthreads();
            if (lat) {
                f32x4 ya[4];
#pragma unroll
                for (int pt = 0; pt < 4; ++pt) ya[pt] = (f32x4){0.f, 0.f, 0.f, 0.f};
#pragma unroll
                for (int ks = 0; ks < 4; ++ks) { const bf16x8 bm = frag_row(Ms, RS, 16 * w + i16, 32 * ks, q4);
#pragma unroll
                    for (int pt = 0; pt < 4; ++pt) ya[pt] = mfma16(frag_tr(Xs, RSX, 32 * ks, 16 * pt, lane), bm, ya[pt]); }
                bf16* yp = F.Y + (size_t)(r0 + 16 * w + i16) * SSD_W + h * HDIM + 4 * q4;
#pragma unroll
                for (int pt = 0; pt < 4; ++pt) { v2u o; o.x = pk2(ya[pt][0], ya[pt][1]); o.y = pk2(ya[pt][2], ya[pt][3]); *(v2u*)(yp + 16 * pt) = o; }
            }
            p4_states(F, braw, Te, TOT + e * 2, Xs, (((size_t)(b * NCC + cc) * NH + h) * 2) * HDIM * NST, w, lane);
        }
        __syncthreads();
    }
}

__device__ __forceinline__ void p5_ssd_scan(Frame& F) {
    constexpr int RS = 272, O_RS = 4 * 34816;
    LAS unsigned char* L = F.lds;
    LAS float* RSB = (LAS float*)(L + O_RS);
    const int tid = F.tid, lane = F.lane, w = F.wave, i16 = lane & 15, q4 = lane >> 4;
    const int d = w >> 2, ps = w & 3, t8 = tid & 255;
    for (int u = (int)blockIdx.x; u < NB * NH; u += F.G) {
        const int b = u / NH, h = u - b * NH, g = h / HPG;
        float S[32];
#pragma unroll
        for (int k = 0; k < 32; ++k) S[k] = 0.f;
        v4u creg[8]; float rsreg = 0.f;
#pragma unroll
        for (int k = 0; k < 8; ++k) creg[k] = (v4u){0u, 0u, 0u, 0u};
        for (int j = 0; j < NCC; ++j) {
            const int cc = d == 0 ? j : (j < 2 ? 1 - j : 35 - j);
            LAS unsigned char* Cb = L + ((j & 1) * 2 + d) * 34816;
            if (j >= 2) {
#pragma unroll
                for (int k = 0; k < 8; ++k) { const int pc = t8 + 256 * k, row = pc >> 4, ch = pc & 15; *(LAS v4u*)(Cb + row * RS + ch * 16) = creg[k]; }
                if (t8 < 128) RSB[((j & 1) * 2 + d) * 128 + t8] = rsreg;
            }
            __syncthreads();
            if (j + 1 >= 2 && j + 1 < NCC) {
                const int cn = d == 0 ? j + 1 : 34 - j;
                const size_t rown = (size_t)b * SEQ + (size_t)(cn - 2) * CHUNK;
#pragma unroll
                for (int k = 0; k < 8; ++k) { const int pc = t8 + 256 * k, row = pc >> 4, ch = pc & 15; creg[k] = *(const v4u*)(F.CC + (rown + row) * 512 + g * NST + ch * 8); }
                if (t8 < 128) rsreg = F.ROWSC[((size_t)(b * 2 + d) * NH + h) * SEQ + (cn - 2) * CHUNK + t8];
            }
            const size_t sidx = ((size_t)(b * NCC + cc) * NH + h) * 2 + d;
            const bf16* stp = F.ST + (sidx * HDIM + 16 * ps + i16) * NST + 8 * q4;
            v4u stv[4];
#pragma unroll
            for (int ks = 0; ks < 4; ++ks) stv[ks] = *(const v4u*)(stp + 32 * ks);
            const float decay = __builtin_amdgcn_exp2f(F.CHS[sidx]);
            if (j >= 2) {
                bf16x8 sf[4];
#pragma unroll
                for (int ks = 0; ks < 4; ++ks) { v4u t; t.x = pk2(S[ks * 8 + 0], S[ks * 8 + 1]); t.y = pk2(S[ks * 8 + 2], S[ks * 8 + 3]); t.z = pk2(S[ks * 8 + 4], S[ks * 8 + 5]); t.w = pk2(S[ks * 8 + 6], S[ks * 8 + 7]); sf[ks] = __builtin_bit_cast(bf16x8, t); }
                const size_t rowb = (size_t)b * SEQ + (size_t)(cc - 2) * CHUNK;
                const LAS float* rsl = RSB + ((j & 1) * 2 + d) * 128;
                v2u yold[8];
                if (d == 0) {
#pragma unroll
                    for (int lt = 0; lt < 8; ++lt) yold[lt] = *(const v2u*)(F.Y + (rowb + 16 * lt + i16) * SSD_W + h * HDIM + 16 * ps + 4 * q4);
                }
#pragma unroll
                for (int lt = 0; lt < 8; ++lt) {
                    f32x4 a = (f32x4){0.f, 0.f, 0.f, 0.f};
#pragma unroll
                    for (int ks = 0; ks < 4; ++ks) a = mfma16(sf[ks], frag_row(Cb, RS, 16 * lt + i16, 32 * ks, q4), a);
                    const float sc = rsl[16 * lt + i16];
                    const size_t off = (rowb + 16 * lt + i16) * SSD_W + h * HDIM + 16 * ps + 4 * q4;
                    if (d == 0) { const v2u old = yold[lt]; v2u o; o.x = pk2(bflo(old.x) + a[0] * sc, bfhi(old.x) + a[1] * sc); o.y = pk2(bflo(old.y) + a[2] * sc, bfhi(old.y) + a[3] * sc); *(v2u*)(F.Y + off) = o; }
                    else { v2u o; o.x = pk2(a[0] * sc, a[1] * sc); o.y = pk2(a[2] * sc, a[3] * sc); *(v2u*)(F.YB + off) = o; }
                }
            }
#pragma unroll
            for (int ks = 0; ks < 4; ++ks) { const v4u t = stv[ks];
                S[ks * 8 + 0] = decay * S[ks * 8 + 0] + bflo(t.x); S[ks * 8 + 1] = decay * S[ks * 8 + 1] + bfhi(t.x);
                S[ks * 8 + 2] = decay * S[ks * 8 + 2] + bflo(t.y); S[ks * 8 + 3] = decay * S[ks * 8 + 3] + bfhi(t.y);
                S[ks * 8 + 4] = decay * S[ks * 8 + 4] + bflo(t.z); S[ks * 8 + 5] = decay * S[ks * 8 + 5] + bfhi(t.z);
                S[ks * 8 + 6] = decay * S[ks * 8 + 6] + bflo(t.w); S[ks * 8 + 7] = decay * S[ks * 8 + 7] + bfhi(t.w); }
        }
        __syncthreads();
    }
}

__device__ __forceinline__ void p6_gate_pool(Frame& F) {
    LAS unsigned char* L = F.lds;
    const int tid = F.tid, lane = F.lane, w = F.wave;
    for (int gr = (int)blockIdx.x; gr < T / 64; gr += F.G) {
        const int rb = gr * 64;
        v4u pv[8];
#pragma unroll
        for (int k = 0; k < 8; ++k) { const int pc = tid + 512 * k, row = pc >> 6, ch = pc & 63; pv[k] = *(const v4u*)(F.V + (size_t)(rb + row) * 512 + ch * 8); }
#pragma unroll
        for (int k = 0; k < 8; ++k) { const int pc = tid + 512 * k, row = pc >> 6, ch = pc & 63; *(LAS v4u*)(L + row * 1024 + ch * 16) = pv[k]; }
        for (int rr = 0; rr < 8; rr += 2) {
            v4u ya[2][3], yb[2][3], zz[2][3];
#pragma unroll
            for (int k = 0; k < 2; ++k) { const int r = rb + 8 * w + rr + k;
#pragma unroll
                for (int j = 0; j < 3; ++j) { const int col = 8 * (lane + 64 * j);
                    ya[k][j] = *(const v4u*)(F.Y + (size_t)r * SSD_W + col); yb[k][j] = *(const v4u*)(F.YB + (size_t)r * SSD_W + col); zz[k][j] = *(const v4u*)(F.Z + (size_t)r * SSD_W + col); } }
#pragma unroll
            for (int k = 0; k < 2; ++k) { const int r = rb + 8 * w + rr + k;
                float v[24]; float ss = 0.f;
#pragma unroll
                for (int j = 0; j < 3; ++j) {
                    const unsigned yaw[4] = {ya[k][j].x, ya[k][j].y, ya[k][j].z, ya[k][j].w}, ybw[4] = {yb[k][j].x, yb[k][j].y, yb[k][j].z, yb[k][j].w}, zw[4] = {zz[k][j].x, zz[k][j].y, zz[k][j].z, zz[k][j].w};
#pragma unroll
                    for (int e = 0; e < 4; ++e) { const float y0 = bflo(yaw[e]) + bflo(ybw[e]), y1 = bfhi(yaw[e]) + bfhi(ybw[e]);
                        const float g0 = y0 * silu_f(bflo(zw[e])), g1 = y1 * silu_f(bfhi(zw[e])); v[j * 8 + 2 * e] = g0; v[j * 8 + 2 * e + 1] = g1; ss += g0 * g0 + g1 * g1; } }
                const float rs = 1.f / sqrtf(wave_sum(ss) * (1.f / SSD_W) + RMS_EPS);
#pragma unroll
                for (int j = 0; j < 3; ++j) { const int col = 8 * (lane + 64 * j);
                    const f32x4 w0 = *(const f32x4*)(F.ssd_norm_w + col), w1 = *(const f32x4*)(F.ssd_norm_w + col + 4);
                    v4u o; o.x = pk2(v[j * 8 + 0] * rs * w0.x, v[j * 8 + 1] * rs * w0.y); o.y = pk2(v[j * 8 + 2] * rs * w0.z, v[j * 8 + 3] * rs * w0.w);
                    o.z = pk2(v[j * 8 + 4] * rs * w1.x, v[j * 8 + 5] * rs * w1.y); o.w = pk2(v[j * 8 + 6] * rs * w1.z, v[j * 8 + 7] * rs * w1.w);
                    *(v4u*)(F.A2 + (size_t)r * 2048 + col) = o; } }
        }
        __syncthreads();
        {
            const int cg = tid & 63, tb = tid >> 6, hw = 1 << (cg >> 4);
            const LAS unsigned char* colp = L + cg * 16;
#pragma unroll 2
            for (int tt = 0; tt < 8; ++tt) { const int t = tb * 8 + tt; const int lo = t - hw < 0 ? 0 : t - hw, hi = t + hw > 64 ? 64 : t + hw;
                float s[8];
#pragma unroll
                for (int e = 0; e < 8; ++e) s[e] = 0.f;
                for (int q = lo; q < hi; ++q) { const v4u x = *(const LAS v4u*)(colp + q * 1024);
                    s[0] += bflo(x.x); s[1] += bfhi(x.x); s[2] += bflo(x.y); s[3] += bfhi(x.y); s[4] += bflo(x.z); s[5] += bfhi(x.z); s[6] += bflo(x.w); s[7] += bfhi(x.w); }
                const v4u x = *(const LAS v4u*)(colp + t * 1024); const float inv = 1.f / (float)(hi - lo);
                v4u o; o.x = pk2(s[0] * inv - bflo(x.x), s[1] * inv - bfhi(x.x)); o.y = pk2(s[2] * inv - bflo(x.y), s[3] * inv - bfhi(x.y));
                o.z = pk2(s[4] * inv - bflo(x.z), s[5] * inv - bfhi(x.z)); o.w = pk2(s[6] * inv - bflo(x.w), s[7] * inv - bfhi(x.w));
                *(v4u*)(F.A2 + (size_t)(rb + t) * 2048 + SSD_W + cg * 8) = o; }
        }
        __syncthreads();
    }
}

struct Sched7 {
    static constexpr bool TBL = false;
    const char* A; const char* Bt; int G, c;
    __device__ __forceinline__ bool next(int i, pg8::Unit& u) const { const int L = i * G + c; if (L >= 512) return false; pg8::static_map(L, 128, 4, u.pm, u.pn); u.e = 0; return true; }
    __device__ __forceinline__ const char* a_base(const pg8::Unit& u) const { return A + (size_t)u.pm * 256 * 2048 * 2; }
    __device__ __forceinline__ const char* b_base(const pg8::Unit& u) const { return Bt + (size_t)u.pn * 256 * 2048 * 2; }
    __device__ __forceinline__ const int* row_table(const pg8::Unit&) const { return nullptr; }
};
struct Epi7 {
    static constexpr bool PERM = false;
    const float* x; const float* MOD; bf16* X1;
    __device__ __forceinline__ void operator()(const f32x4 (&acc)[2][2][4][2], const pg8::Unit& u, int wr, int wc, int fr, int fq) const {
        const int row0 = u.pm * 256 + wr * 64 + fr, col0 = u.pn * 256 + wc * 32 + 4 * fq;
        const float* g1 = MOD + (size_t)(u.pm >> 4) * 6144 + 2048;
        f32x4 gv[2][2];
#pragma unroll
        for (int bj = 0; bj < 2; ++bj)
#pragma unroll
            for (int n = 0; n < 2; ++n) gv[bj][n] = *(const f32x4*)(g1 + col0 + bj * 128 + n * 16);
#pragma unroll
        for (int ai = 0; ai < 2; ++ai)
#pragma unroll
            for (int m = 0; m < 4; ++m) { const size_t off = (size_t)(row0 + ai * 128 + m * 16) * D + col0;
#pragma unroll
                for (int bj = 0; bj < 2; ++bj)
#pragma unroll
                    for (int n = 0; n < 2; ++n) { const f32x4 xv = *(const f32x4*)(x + off + bj * 128 + n * 16); const f32x4 o = xv + gv[bj][n] * acc[ai][bj][m][n]; v2u ov; ov.x = pk2(o.x, o.y); ov.y = pk2(o.z, o.w); *(v2u*)(X1 + off + bj * 128 + n * 16) = ov; } }
    }
};

__device__ __forceinline__ void p8_router(Frame& F) {
    LAS unsigned char* L = F.lds;
    LAS float* H2F = (LAS float*)L;
    constexpr int HP = 1028;
    LAS float* PART = (LAS float*)(L + 16 * HP * 4);
    LAS unsigned* HIST = (LAS unsigned*)(L + 16 * HP * 4 + 16384);
    const int tid = F.tid, lane = F.lane, w = F.wave, i16 = lane & 15, q4 = lane >> 4;
    if (tid < 32) HIST[tid] = 0u;
    float rw0[32], rw1[32];
#pragma unroll
    for (int kk = 0; kk < 32; ++kk) { const int k = 128 * w + 4 * kk + q4; rw0[kk] = F.router_w[k * 32 + i16]; rw1[kk] = F.router_w[k * 32 + 16 + i16]; }
    __syncthreads();
    for (int gi = (int)blockIdx.x; gi < T / 16; gi += F.G) {
        const int rbase = gi * 16;
#pragma unroll
        for (int rr = 0; rr < 2; ++rr) {
            const int r16 = 2 * w + rr, r = rbase + r16;
            const bf16* xr = F.X1 + (size_t)r * D; const float* mod = F.MOD + (size_t)(r >> 12) * 6144;
            f32x4 v[4]; float ss = 0.f;
#pragma unroll
            for (int j = 0; j < 4; ++j) { const v2u xq = *(const v2u*)(xr + 4 * lane + 256 * j); v[j] = (f32x4){bflo(xq.x), bfhi(xq.x), bflo(xq.y), bfhi(xq.y)}; ss += (v[j].x * v[j].x + v[j].y * v[j].y) + (v[j].z * v[j].z + v[j].w * v[j].w); }
            const float rs = 1.f / sqrtf(wave_sum(ss) * (1.f / D) + RMS_EPS);
#pragma unroll
            for (int j = 0; j < 4; ++j) { const int col = 4 * lane + 256 * j;
                const f32x4 wv = *(const f32x4*)(F.norm2_w + col), sh = *(const f32x4*)(mod + 3072 + col), sc = *(const f32x4*)(mod + 4096 + col);
                const f32x4 hh = (v[j] * rs) * wv * (sc + 1.f) + sh;
                *(LAS f32x4*)(H2F + r16 * HP + col) = hh;
                *(unsigned*)((unsigned char*)F.H2 + (size_t)r * D + col) = pk4_fp8(hh.x, hh.y, hh.z, hh.w); }
        }
        __syncthreads();
        {
            f32x4 a0 = (f32x4){0.f, 0.f, 0.f, 0.f}, a1 = a0;
#pragma unroll
            for (int kk = 0; kk < 32; ++kk) { const int k = 128 * w + 4 * kk + q4;
                const float av = H2F[i16 * HP + k];
                a0 = __builtin_amdgcn_mfma_f32_16x16x4f32(av, rw0[kk], a0, 0, 0, 0); a1 = __builtin_amdgcn_mfma_f32_16x16x4f32(av, rw1[kk], a1, 0, 0, 0); }
#pragma unroll
            for (int r = 0; r < 4; ++r) { PART[(w * 16 + 4 * q4 + r) * 32 + i16] = a0[r]; PART[(w * 16 + 4 * q4 + r) * 32 + 16 + i16] = a1[r]; }
        }
        __syncthreads();
        {
            const int row = tid >> 5, e = tid & 31;
            float lg = F.router_b[e];
#pragma unroll
            for (int ww = 0; ww < 8; ++ww) lg += PART[(ww * 16 + row) * 32 + e];
            float tv[4]; int ti[4];
#pragma unroll
            for (int k = 0; k < 4; ++k) { float bv = lg; int bi = e;
#pragma unroll
                for (int o = 1; o < 32; o <<= 1) { const float ov = __shfl_xor(bv, o); const int oi = __shfl_xor(bi, o); if (ov > bv || (ov == bv && oi < bi)) { bv = ov; bi = oi; } }
                tv[k] = bv; ti[k] = bi; if (e == bi) lg = -INFINITY; }
            if (e == 0) {
                const float e1 = __expf(tv[1] - tv[0]), e2 = __expf(tv[2] - tv[0]), e3 = __expf(tv[3] - tv[0]); const float inv = 1.f / (1.f + e1 + e2 + e3);
                const float gt[4] = {inv, e1 * inv, e2 * inv, e3 * inv};
                const int tok = rbase + row;
#pragma unroll
                for (int k = 0; k < 4; ++k) { const unsigned lr = atomicAdd((unsigned*)&HIST[ti[k]], 1u); F.TOPE[tok * 4 + k] = ti[k]; F.TOPG[tok * 4 + k] = gt[k]; F.TOPR[tok * 4 + k] = (int)lr; }
            }
        }
        __syncthreads();
    }
    if (tid < 32) { const unsigned base = __hip_atomic_fetch_add(F.ctl + CW_GCOUNT + tid, HIST[tid], RLX_AGENT); F.BB[(int)blockIdx.x * 32 + tid] = (int)base; }
}

__device__ __forceinline__ int moe_tables(Frame& F) {
    LAS int* TE = (LAS int*)(F.lds + TE_OFF);
    LAS int* MC = (LAS int*)(F.lds + MOE_CNT_OFF);
    __syncthreads();
    if (F.tid == 0) { int ps = 0;
        for (int e = 0; e < NE; ++e) { const int c = (int)__hip_atomic_load(F.ctl + CW_GCOUNT + e, RLX_AGENT); MC[e] = c; MC[32 + e] = ps; const int nt = (c + 255) >> 8; for (int t = 0; t < nt; ++t) TE[(ps >> 8) + t] = e; ps += nt << 8; }
        MC[64] = ps >> 8; }
    __syncthreads();
    return MC[64];
}
__device__ __forceinline__ void p9_slots(Frame& F) {
    (void)moe_tables(F);
    const LAS int* MC = (const LAS int*)(F.lds + MOE_CNT_OFF);
    const int gt = (int)blockIdx.x * 512 + F.tid, NT_ = F.G * 512;
    for (int a = gt; a < T * TOPK; a += NT_) { const int tok = a >> 2, e = F.TOPE[a], blk = (tok >> 4) % F.G;
        const int slot = MC[32 + e] + F.BB[blk * 32 + e] + F.TOPR[a];
        F.SLOTTOK[slot] = tok; F.SLOTGATE[slot] = F.TOPG[a]; F.TOKSLOT[a] = slot; }
    for (int i = gt; i < MAX_SLOTS; i += NT_) F.SLOTID[i] = i;
    if ((int)blockIdx.x < NE) { const int e = (int)blockIdx.x, c = MC[e], ps = MC[32 + e], pe = ps + (((c + 255) >> 8) << 8);
        for (int s = ps + c + F.tid; s < pe; s += 512) { F.SLOTTOK[s] = 0; F.SLOTGATE[s] = 0.f; } }
}

struct SchedMoe {
    static constexpr bool TBL = true;
    const char* A; const char* W; const int* slot_tok; const LAS int* TE; int nM, nN, G, c; size_t wbytes  , tilebytes  , arowbytes;
    LAS unsigned char* tb;
    const float* f0; int f0_e, f0_n;
    const float* f1;
    __device__ __forceinline__ bool next(int i, pg8::Unit& u) const { const int L = i * G + c; if (L >= nM * nN) return false; pg8::static_map(L, nM, nN, u.pm, u.pn); u.e = TE[u.pm]; return true; }
    __device__ __forceinline__ const char* a_base(const pg8::Unit&) const { return A; }
    __device__ __forceinline__ const char* b_base(const pg8::Unit& u) const { return W + (size_t)u.e * wbytes + (size_t)u.pn * tilebytes; }
    __device__ __forceinline__ const int* row_table(const pg8::Unit& u) const { return slot_tok + u.pm * 256; }
    __device__ __forceinline__ const int* tab0(const pg8::Unit& u) const { return slot_tok + u.pm * 256; }
    __device__ __forceinline__ const float* tab1(const pg8::Unit& u) const { return f0 + (size_t)u.e * f0_e + u.pn * f0_n; }
    __device__ __forceinline__ const float* tab2(const pg8::Unit& u) const { return f1 ? f1 + u.pm * 256 : nullptr; }
};
struct Epi10 {
    static constexpr bool PERM = true;
    const float* b1; bf16* ACT;
    __device__ __forceinline__ void operator()(const f32x4 (&acc)[2][2][4][2], const pg8::Unit& u, int wr, int wc, int fr, int fq, const LAS unsigned char* tbuf) const {
        const int row0 = u.pm * 256 + wr * 64 + fr, j0 = u.pn * 128 + wc * 32 + 8 * fq;
        const LAS float* bp = (const LAS float*)(tbuf + 3072) + 2 * (wc * 32 + 8 * fq);
        const f32x4 q0 = *(const LAS f32x4*)bp, q1 = *(const LAS f32x4*)(bp + 4), q2 = *(const LAS f32x4*)(bp + 8), q3 = *(const LAS f32x4*)(bp + 12);
        const float bg[8] = {q0.x, q0.z, q1.x, q1.z, q2.x, q2.z, q3.x, q3.z}, bu[8] = {q0.y, q0.w, q1.y, q1.w, q2.y, q2.w, q3.y, q3.w};
#pragma unroll
        for (int ai = 0; ai < 2; ++ai)
#pragma unroll
            for (int m = 0; m < 4; ++m) { float o[8];
#pragma unroll
                for (int n = 0; n < 2; ++n)
#pragma unroll
                    for (int t = 0; t < 4; ++t) { const float hg = acc[ai][0][m][n][t] * (1.f / WSCALE) + bg[4 * n + t], hu = acc[ai][1][m][n][t] * (1.f / WSCALE) + bu[4 * n + t];
                        const float gp = fminf(hg, 7.f), up = fminf(fmaxf(hu, -7.f), 7.f);
                        o[4 * n + t] = gp / (1.f + __expf(-1.702f * gp)) * (up + 1.f); }
                v2u wv; wv.x = pk4_fp8(o[0] * ASCALE, o[1] * ASCALE, o[2] * ASCALE, o[3] * ASCALE); wv.y = pk4_fp8(o[4] * ASCALE, o[5] * ASCALE, o[6] * ASCALE, o[7] * ASCALE);
                *(v2u*)((unsigned char*)ACT + (size_t)(row0 + ai * 128 + m * 16) * DFF + j0) = wv; }
    }
};
struct Epi11 {
    static constexpr bool PERM = true;
    bf16* YS;
    __device__ __forceinline__ void operator()(const f32x4 (&acc)[2][2][4][2], const pg8::Unit& u, int wr, int wc, int fr, int fq, const LAS unsigned char* tbuf) const {
        const int row0 = u.pm * 256 + wr * 64 + fr, col0 = u.pn * 256 + wc * 32 + 8 * fq;
        const LAS float* bl = (const LAS float*)(tbuf + 3072) + wc * 32 + 8 * fq; const LAS float* gl = (const LAS float*)(tbuf + 6144) + wr * 64 + fr;
        f32x4 bv[2][2];
#pragma unroll
        for (int bj = 0; bj < 2; ++bj)
#pragma unroll
            for (int n = 0; n < 2; ++n) bv[bj][n] = *(const LAS f32x4*)(bl + bj * 128 + 4 * n);
#pragma unroll
        for (int ai = 0; ai < 2; ++ai)
#pragma unroll
            for (int m = 0; m < 4; ++m) { const int row = row0 + ai * 128 + m * 16; const float gt = gl[ai * 128 + m * 16];
#pragma unroll
                for (int bj = 0; bj < 2; ++bj) { const float gs = gt * YSCALE; f32x4 v0 = (acc[ai][bj][m][0] * (1.f / (WSCALE * ASCALE)) + bv[bj][0]) * gs, v1 = (acc[ai][bj][m][1] * (1.f / (WSCALE * ASCALE)) + bv[bj][1]) * gs;
#pragma unroll
                    for (int t = 0; t < 4; ++t) { v0[t] = fminf(fmaxf(v0[t], -440.f), 440.f); v1[t] = fminf(fmaxf(v1[t], -440.f), 440.f); }
                    v2u wv; wv.x = pk4_fp8(v0[0], v0[1], v0[2], v0[3]); wv.y = pk4_fp8(v1[0], v1[1], v1[2], v1[3]);
                    *(v2u*)((unsigned char*)YS + (size_t)row * D + col0 + bj * 128) = wv; } }
    }
};

__device__ __forceinline__ void p12_combine(Frame& F) {
    const int gw = (int)blockIdx.x * 8 + F.wave, NGW = F.G * 8, lane = F.lane;
    for (int rp = gw; rp < T / 2; rp += NGW) {
        int sl[2][4];
#pragma unroll
        for (int k2 = 0; k2 < 2; ++k2)
#pragma unroll
            for (int k = 0; k < 4; ++k) sl[k2][k] = F.TOKSLOT[(rp * 2 + k2) * 4 + k];
        unsigned yv[2][4][4]; v2u xq[2][4];
#pragma unroll
        for (int k2 = 0; k2 < 2; ++k2)
#pragma unroll
            for (int j = 0; j < 4; ++j) { const int col = 4 * lane + 256 * j; xq[k2][j] = *(const v2u*)(F.X1 + (size_t)(rp * 2 + k2) * D + col);
#pragma unroll
                for (int k = 0; k < 4; ++k) yv[k2][j][k] = *(const unsigned*)((const unsigned char*)F.YS + (size_t)sl[k2][k] * D + col); }
#pragma unroll
        for (int k2 = 0; k2 < 2; ++k2) { const int r = rp * 2 + k2;
            const float* g2 = F.MOD + (size_t)(r >> 12) * 6144 + 5120;
            f32x4 v[4]; float ss = 0.f;
#pragma unroll
            for (int j = 0; j < 4; ++j) { const int col = 4 * lane + 256 * j; f32x4 m = (f32x4){0.f, 0.f, 0.f, 0.f};
#pragma unroll
                for (int k = 0; k < 4; ++k) { const int y = (int)yv[k2][j][k]; const f32x2 lo = __builtin_amdgcn_cvt_pk_f32_fp8(y, false), hi = __builtin_amdgcn_cvt_pk_f32_fp8(y, true); m.x += lo.x; m.y += lo.y; m.z += hi.x; m.w += hi.y; }
                v[j] = (f32x4){bflo(xq[k2][j].x), bfhi(xq[k2][j].x), bflo(xq[k2][j].y), bfhi(xq[k2][j].y)} + *(const f32x4*)(g2 + col) * (m * (1.f / YSCALE));
                ss += (v[j].x * v[j].x + v[j].y * v[j].y) + (v[j].z * v[j].z + v[j].w * v[j].w); }
            const float rs = 1.f / sqrtf(wave_sum(ss) * (1.f / D) + RMS_EPS);
#pragma unroll
            for (int j = 0; j < 4; ++j) { const int col = 4 * lane + 256 * j; *(f32x4*)(F.out + (size_t)r * D + col) = (v[j] * rs) * *(const f32x4*)(F.final_norm_w + col); } }
    }
}

constexpr int NPHASE = 13;
struct Args { const float* in[25]; float* out; unsigned char* ws; int ph_lo, ph_hi; };
__global__ void __launch_bounds__(512, 2) mk_fwd(Args args) {
    extern __shared__ __attribute__((aligned(16))) unsigned char lds[];
    Frame F;
    F.lds = (LAS unsigned char*)lds;
    F.tid = threadIdx.x; F.lane = F.tid & 63; F.wave = __builtin_amdgcn_readfirstlane(F.tid >> 6); F.G = gridDim.x;
    unsigned char* ws = args.ws;
    F.ctl = (unsigned*)(ws + WS_CTL);
    F.x = args.in[0]; F.c = args.in[1]; F.ctx = args.in[2]; F.c_ctx = args.in[3]; F.w_mod = args.in[4]; F.b_mod = args.in[5]; F.norm1_w = args.in[6]; F.norm2_w = args.in[7];
    F.w_in = args.in[8]; F.conv_w = args.in[9]; F.conv_b = args.in[10]; F.dt_bias = args.in[11]; F.a_log = args.in[12]; F.d_skip = args.in[13]; F.ssd_norm_w = args.in[14];
    F.pool_w = args.in[15]; F.pool_scale = args.in[16]; F.w_out = args.in[17]; F.router_w = args.in[18]; F.router_b = args.in[19]; F.w1 = args.in[20]; F.b1 = args.in[21];
    F.w2 = args.in[22]; F.b2 = args.in[23]; F.final_norm_w = args.in[24]; F.out = args.out;
    F.MOD = (float*)(ws + WS_MOD); F.DTRAW = (float*)(ws + WS_DTRAW); F.DT = (float*)(ws + WS_DT); F.ROWSC = (float*)(ws + WS_ROWSC); F.CHS = (float*)(ws + WS_CHS); F.X1 = (bf16*)(ws + WS_X1);
    F.TOPG = (float*)(ws + WS_TOPG); F.SLOTGATE = (float*)(ws + WS_SLOTGATE); F.TOPE = (int*)(ws + WS_TOPE); F.TOPR = (int*)(ws + WS_TOPR); F.TOKSLOT = (int*)(ws + WS_TOKSLOT);
    F.SLOTTOK = (int*)(ws + WS_SLOTTOK); F.SLOTID = (int*)(ws + WS_SLOTID); F.BB = (int*)(ws + WS_BB);
    F.WINT = (bf16*)(ws + WS_WINT); F.WOUTT = (bf16*)(ws + WS_WOUTT); F.W1T = (bf16*)(ws + WS_W1T); F.W2T = (bf16*)(ws + WS_W2T); F.A1 = (bf16*)(ws + WS_A1); F.XBCPRE = (bf16*)(ws + WS_XBCPRE);
    F.Z = (bf16*)(ws + WS_Z); F.V = (bf16*)(ws + WS_V); F.XBC = (bf16*)(ws + WS_XBC); F.CC = (bf16*)(ws + WS_CC); F.ST = (bf16*)(ws + WS_ST); F.Y = (bf16*)(ws + WS_Y); F.YB = (bf16*)(ws + WS_YB);
    F.A2 = (bf16*)(ws + WS_A2); F.H2 = (bf16*)(ws + WS_H2); F.ACT = (bf16*)(ws + WS_ACT); F.YS = (bf16*)(ws + WS_YS);
    volatile LAS unsigned* MISC = (volatile LAS unsigned*)(F.lds + MISC_OFF);
    for (int u = F.tid; u < 64; u += 512) MISC[u] = 0u;
    __syncthreads();
    const int lo = args.ph_lo, hi = args.ph_hi;
    XcdBarrier bar; bar.bar = F.ctl + CW_BAR; bar.x = 0; bar.st = nullptr;
    if (hi - lo > 1) bar = xcd_barrier_post(F.ctl + CW_BAR, MISC + 8);
#define IN(k) (lo <= (k) && (k) < hi)
#define SEAM(k) do { if (IN(k) && IN((k) + 1)) xcd_barrier(bar); } while (0)
#define BODY0 p0_prologue(F)
#define BODY1 p1_norm1(F)
#define BODY2 do { Sched1 S{(const char*)F.A1, (const char*)F.WINT, F.G, (int)blockIdx.x}; Epi1 E{F.XBCPRE, F.Z, F.V, F.DTRAW}; pg8::gemm_phase<Epi1, Sched1, false>(F.lds, D, S, E); } while (0)
#define BODY3 p3_conv(F)
#define BODY4 p4_ssd_local(F)
#define BODY5 p5_ssd_scan(F)
#define BODY6 p6_gate_pool(F)
#define BODY7 do { Sched7 S{(const char*)F.A2, (const char*)F.WOUTT, F.G, (int)blockIdx.x}; Epi7 E{F.x, F.MOD, F.X1}; pg8::gemm_phase<Epi7, Sched7, false>(F.lds, 2048, S, E); } while (0)
#define BODY8 p8_router(F)
#define BODY9 p9_slots(F)
#define BODY10 do { const int ntl = moe_tables(F); \
        SchedMoe S{(const char*)F.H2, (const char*)F.W1T, F.SLOTTOK, (const LAS int*)(F.lds + TE_OFF), ntl, 8, F.G, (int)blockIdx.x, (size_t)2048 * D, (size_t)256 * D, (size_t)D, F.lds + TBL_OFF, F.b1, 2048, 256, nullptr}; \
        Epi10 E{F.b1, F.ACT}; pg8::gemm_phase<Epi10, SchedMoe, true, true>(F.lds, D, S, E); } while (0)
#define BODY11 do { const int ntl = moe_tables(F); \
        SchedMoe S{(const char*)F.ACT, (const char*)F.W2T, F.SLOTID, (const LAS int*)(F.lds + TE_OFF), ntl, 4, F.G, (int)blockIdx.x, (size_t)D * D, (size_t)256 * D, (size_t)D, F.lds + TBL_OFF, F.b2, D, 256, F.SLOTGATE}; \
        Epi11 E{F.YS}; pg8::gemm_phase<Epi11, SchedMoe, true, true>(F.lds, D, S, E); } while (0)
#define BODY12 p12_combine(F)
#define RUN(k) do { if (IN(k)) { BODY##k; if (PROBE_PH == (k)) { xcd_barrier(bar); BODY##k; } } SEAM(k); } while (0)
    RUN(0); RUN(1); RUN(2); RUN(4); RUN(5); RUN(6); RUN(7); RUN(8); RUN(9); RUN(10); RUN(11); RUN(12);
#undef IN
#undef SEAM
}

extern "C" void kernel_launch(void* const* d_in, const int* in_sizes, int n_in, void* d_out, int out_size, void* d_ws, size_t ws_size, hipStream_t stream) {
    static int grid = 0;
    if (grid == 0) {
        if (n_in != 25 || out_size != T * D || ws_size < WS_END) { fprintf(stderr, "kernel_launch: unexpected shapes (n_in %d, out %d, ws %zu)\n", n_in, out_size, ws_size); grid = -1; return; }
        int dev = 0, cus = 0, per_cu = 0;
        if (hipGetDevice(&dev) != hipSuccess || hipDeviceGetAttribute(&cus, hipDeviceAttributeMultiprocessorCount, dev) != hipSuccess) { grid = -1; return; }
        if (hipFuncSetAttribute((const void*)mk_fwd, hipFuncAttributeMaxDynamicSharedMemorySize, LDS_BYTES) != hipSuccess) { fprintf(stderr, "kernel_launch: hipFuncSetAttribute failed\n"); grid = -1; return; }
        if (hipOccupancyMaxActiveBlocksPerMultiprocessor(&per_cu, (const void*)mk_fwd, 512, LDS_BYTES) != hipSuccess || per_cu < 1) { fprintf(stderr, "kernel_launch: occupancy query says %d\n", per_cu); }
        (void)hipGetLastError();
        grid = cus;
    }
    if (grid < 0) return;
    (void)hipMemsetAsync((char*)d_ws + WS_CTL, 0, CTL_ZERO_BYTES, stream);
    Args a{};
    for (int i = 0; i < 25; ++i) a.in[i] = (const float*)d_in[i];
    a.out = (float*)d_out; a.ws = (unsigned char*)d_ws;
#if MK_SPLIT
    for (int p = 0; p < NPHASE; ++p) { a.ph_lo = p; a.ph_hi = p + 1; hipLaunchKernelGGL(mk_fwd, dim3(grid), dim3(512), LDS_BYTES, stream, a); }
#else
    a.ph_lo = 0; a.ph_hi = NPHASE; hipLaunchKernelGGL(mk_fwd, dim3(grid), dim3(512), LDS_BYTES, stream, a);
#endif
}
```

```cpp
#include <hip/hip_runtime.h>
#include <cstdio>
#include <cstdint>

#ifndef MK_SPLIT
#define MK_SPLIT 0
#endif

#ifndef PROBE_PH
#define PROBE_PH -1
#endif

#define GAS __attribute__((address_space(1)))
#define LAS __attribute__((address_space(3)))
typedef unsigned short bf16;
typedef unsigned v4u __attribute__((ext_vector_type(4)));
typedef unsigned v2u __attribute__((ext_vector_type(2)));
typedef float f32x4 __attribute__((ext_vector_type(4)));
typedef float f32x2 __attribute__((ext_vector_type(2)));
typedef short bf16x8 __attribute__((ext_vector_type(8)));
typedef short s16x4 __attribute__((ext_vector_type(4)));
#define RLX_AGENT __ATOMIC_RELAXED, __HIP_MEMORY_SCOPE_AGENT
#define LDS_WAIT() asm volatile("s_waitcnt lgkmcnt(0)" ::: "memory")
#define VM_WAIT() asm volatile("s_waitcnt vmcnt(0)" ::: "memory")

__device__ __forceinline__ unsigned f2bf(float f) { unsigned u = __builtin_bit_cast(unsigned, f); return (u + 0x7fffu + ((u >> 16) & 1u)) >> 16; }
typedef __bf16 nbf16x2 __attribute__((ext_vector_type(2)));
__device__ __forceinline__ unsigned pk2(float lo, float hi) { const f32x2 v = {lo, hi}; return __builtin_bit_cast(unsigned, __builtin_convertvector(v, nbf16x2)); }
constexpr float YOSCALE = 16.f;
constexpr float STSCALE = 32.f;
constexpr float YSCALE = 8.f;
constexpr float ASCALE = 4.f;
constexpr float WSCALE = 32.f;
__device__ __forceinline__ unsigned pk4_fp8(float a, float b, float c, float d) { int r = __builtin_amdgcn_cvt_pk_fp8_f32(a, b, 0, false); r = __builtin_amdgcn_cvt_pk_fp8_f32(c, d, r, true); return (unsigned)r; }
__device__ __forceinline__ float bflo(unsigned w) { return __builtin_bit_cast(float, w << 16); }
__device__ __forceinline__ float bfhi(unsigned w) { return __builtin_bit_cast(float, w & 0xffff0000u); }
__device__ __forceinline__ float silu_f(float v) { return v * __builtin_amdgcn_rcpf(1.f + __builtin_amdgcn_exp2f(-1.44269504f * v)); }
__device__ __forceinline__ float wave_sum(float v) {
#pragma unroll
    for (int o = 1; o < 64; o <<= 1) v += __shfl_xor(v, o);
    return v;
}

constexpr int D = 1024, NB = 8, SEQ = 4096, CTXL = 256, T = NB * SEQ, TC = NB * CTXL, RTOT = T + TC;
constexpr int CONV_CH = 2560, SSD_W = 1536, NH = 24, HDIM = 64, NGRP = 4, HPG = 6, NST = 128, CHUNK = 128;
constexpr int NCC = (CTXL + SEQ) / CHUNK;
constexpr int IN_COLS = 4656, N1 = 4864;
constexpr int NE = 32, TOPK = 4, DFF = 1024;
constexpr int MAX_TILES = (T * TOPK) / 256 + NE;
constexpr int MAX_SLOTS = MAX_TILES * 256;
constexpr float RMS_EPS = 1e-6f;

constexpr size_t MiB = 1u << 20;
constexpr size_t WS_CTL = 0, CTL_ZERO_BYTES = 1 * MiB;
constexpr size_t WS_MOD = 1 * MiB;
constexpr size_t WS_TOPE = 2 * MiB, WS_TOPG = WS_TOPE + 512 * 1024, WS_TOPR = WS_TOPG + 512 * 1024, WS_TOKSLOT = WS_TOPR + 512 * 1024;
constexpr size_t WS_SLOTTOK = 4 * MiB, WS_SLOTGATE = WS_SLOTTOK + 576 * 1024, WS_BB = WS_SLOTGATE + 576 * 1024, WS_CHS = WS_BB + 64 * 1024, WS_SLOTID = WS_CHS + 64 * 1024;
constexpr size_t WS_DTRAW = 6 * MiB;
constexpr size_t WS_DT = 15 * MiB;
constexpr size_t WS_ROWSC = 22 * MiB;
constexpr size_t WS_WINT = 32 * MiB, WS_WOUTT = 42 * MiB, WS_W1T = 46 * MiB, WS_W2T = 174 * MiB;
constexpr size_t WS_A = 240 * MiB;
constexpr size_t WS_A1 = WS_A, WS_CC = WS_A, WS_XBCPRE = WS_A + 68 * MiB, WS_Z = WS_A + 238 * MiB, WS_V = WS_A + 334 * MiB, WS_XBC = WS_A;
constexpr size_t WS_ST = WS_A + 366 * MiB, WS_Y = WS_A + 570 * MiB, WS_YB = WS_A + 666 * MiB;
constexpr size_t WS_A2 = WS_XBCPRE, WS_X1 = WS_A + 366 * MiB, WS_H2 = WS_A + 494 * MiB, WS_ACT = WS_A, WS_YS = WS_A + 494 * MiB;
constexpr size_t WS_END = WS_A + 766 * MiB;
static_assert(WS_END <= 1024 * MiB, "workspace map");
static_assert((size_t)RTOT * D * 2 <= 68 * MiB && (size_t)RTOT * CONV_CH * 2 <= 170 * MiB && (size_t)MAX_SLOTS * D * 2 <= 272 * MiB, "workspace map sizes");
static_assert((size_t)NB * NCC * NH * 2 * 8192 * 2 <= 204 * MiB, "ST size");
constexpr int CW_TMO = 0, CW_GCOUNT = 64  , CW_BAR = 4096;

constexpr int LDS_BYTES = 163840;
constexpr int MISC_OFF = LDS_BYTES - 256;
constexpr int TE_OFF = 131072;
constexpr int MOE_CNT_OFF = TE_OFF + 4096;
constexpr int TBL_OFF = TE_OFF + 8192;

namespace pg8 {
constexpr int BM = 256, BK = 64, HALF = 128, HTB = HALF * BK * 2, STAGE_BYTES = 8 * HTB, NXCD = 8, WGM = 8;
__host__ __device__ __forceinline__ int lds_byte(int r, int c) { const int st = (r >> 4) * 2 + (c >> 5), rr = r & 15, cc = c & 31, ob = rr * 64 + cc * 2; return st * 1024 + (ob ^ (((ob >> 9) & 1) << 5)); }
__host__ __device__ __forceinline__ void stage_rc(int b, int& R, int& C) { const int st = b / 1024, sb = b % 1024, swz = sb ^ (((sb >> 9) & 1) << 5); R = (st >> 1) * 16 + swz / 64; C = (st & 1) * 32 + (swz % 64) / 2; }
__host__ __device__ __forceinline__ int perm32(int rho) { const int n = rho >> 4, i = rho & 15; return 8 * (i >> 2) + 4 * n + (i & 3); }
struct Unit { int pm, pn, e; };
__device__ __forceinline__ unsigned cvt_pk_bf16(float lo, float hi) { unsigned r; asm volatile("v_cvt_pk_bf16_f32 %0, %1, %2" : "=v"(r) : "v"(lo), "v"(hi)); return r; }

__device__ __forceinline__ void static_map(int wgid, int nM, int nN, int& pm, int& pn) {
    const int nwg = nM * nN;
    { const int q = nwg / NXCD, r = nwg % NXCD, xcd = wgid % NXCD, off = wgid / NXCD; wgid = (xcd < r ? xcd * (q + 1) : r * (q + 1) + (xcd - r) * q) + off; }
    const int nig = WGM * nN, gid = wgid / nig, fm = gid * WGM, gsz = (nM - fm) < WGM ? (nM - fm) : WGM;
    pm = fm + ((wgid % nig) % gsz); pn = (wgid % nig) / gsz;
}

typedef int i32x8 __attribute__((ext_vector_type(8)));
typedef int v4i_t __attribute__((ext_vector_type(4)));
template <class Epi, class Sched, bool GATHER, bool FP8 = false, bool ALIGN_EPI = true>
__device__ __forceinline__ void gemm_phase(LAS unsigned char* lds, const int K, const Sched& S, const Epi& E) {
    int tid = threadIdx.x; asm volatile("" : "+v"(tid));
    const int wid = __builtin_amdgcn_readfirstlane(tid >> 6), lane = tid & 63, wr = wid >> 2, wc = wid & 3, fr = lane & 15, fq = lane >> 4;
    constexpr int ES = FP8 ? 1 : 2, KOFF = FP8 ? 16 : 1024;
    const int nt = K / (FP8 ? 2 * BK : BK);
    unsigned voffB[2]; int RA[2], CA[2];
#pragma unroll
    for (int i = 0; i < 2; ++i) { int R, C; stage_rc(tid * 16 + i * 8192, R, C); const int Rb = Epi::PERM ? ((R & ~31) + perm32(R & 31)) : R;
        RA[i] = R; CA[i] = C; voffB[i] = (unsigned)(Rb * K * ES + C * 2); }
    const size_t kstep = (size_t)(BK * 2);
    const size_t hstep = (size_t)HALF * K * ES;
    const unsigned ldsw = (unsigned)wid * 1024u;
    const int aoff = lds_byte(wr * 64 + fr, fq * (FP8 ? 16 : 8)), boff = lds_byte(wc * 32 + fr, fq * (FP8 ? 16 : 8));
#define PG8_SA(b, h) (((b) * 2 + (h)) * HTB)
#define PG8_SB(b, h) ((4 + (b) * 2 + (h)) * HTB)
#define PG8_STAGE(bufoff, gbase, voff) do { _Pragma("unroll") for (int _i = 0; _i < 2; ++_i) \
        __builtin_amdgcn_global_load_lds((const unsigned*)((const char*)(gbase) + (voff)[_i]), (LAS unsigned*)(lds + (bufoff) + ldsw + _i * 8192), 16, 0, 0); } while (0)
#define PG8_LDA(dst, b, h) do { _Pragma("unroll") for (int m = 0; m < 4; ++m) _Pragma("unroll") for (int k = 0; k < 2; ++k) dst[m][k] = *(const LAS bf16x8*)(lds + PG8_SA(b, h) + aoff + m * 2048 + k * KOFF); } while (0)
#define PG8_LDB(dst, b, h) do { _Pragma("unroll") for (int n = 0; n < 2; ++n) _Pragma("unroll") for (int k = 0; k < 2; ++k) dst[n][k] = *(const LAS bf16x8*)(lds + PG8_SB(b, h) + boff + n * 2048 + k * KOFF); } while (0)
#define PG8_CAT(lo, hi) __builtin_shufflevector(__builtin_bit_cast(v4i_t, lo), __builtin_bit_cast(v4i_t, hi), 0, 1, 2, 3, 4, 5, 6, 7)
#define PG8_MMA(ai, bj, At, Bt) do { __builtin_amdgcn_s_setprio(1); \
        if constexpr (FP8) { _Pragma("unroll") for (int m = 0; m < 4; ++m) _Pragma("unroll") for (int n = 0; n < 2; ++n) \
            acc[ai][bj][m][n] = __builtin_amdgcn_mfma_scale_f32_16x16x128_f8f6f4(PG8_CAT(Bt[n][0], Bt[n][1]), PG8_CAT(At[m][0], At[m][1]), acc[ai][bj][m][n], 0, 0, 0, 0x7f7f7f7f, 0, 0x7f7f7f7f); } \
        else { _Pragma("unroll") for (int m = 0; m < 4; ++m) _Pragma("unroll") for (int n = 0; n < 2; ++n) _Pragma("unroll") for (int k = 0; k < 2; ++k) \
            acc[ai][bj][m][n] = __builtin_amdgcn_mfma_f32_16x16x32_bf16(Bt[n][k], At[m][k], acc[ai][bj][m][n], 0, 0, 0); } \
        __builtin_amdgcn_s_setprio(0); } while (0)
#define PG8_WAIT_V(n) asm volatile("s_waitcnt vmcnt(" #n ")" ::: "memory")
#define PG8_WAIT_L(n) asm volatile("s_waitcnt lgkmcnt(" #n ")" ::: "memory")
#define PG8_BAR __builtin_amdgcn_s_barrier()
#define PG8_SCHED __builtin_amdgcn_sched_barrier(0)
#define PG8_AOFFS(U, dst) do { \
        if constexpr (GATHER) { int t_ = tid, R_, C_; asm volatile("" : "+v"(t_)); stage_rc(t_ * 16, R_, C_);     \
            const int* st_ = S.row_table(U) + R_; _Pragma("unroll") for (int _h = 0; _h < 2; ++_h) _Pragma("unroll") for (int _i = 0; _i < 2; ++_i) \
            dst[_h][_i] = (unsigned)st_[_h * HALF + _i * 64] * (unsigned)(K * ES) + (unsigned)(C_ * 2); } \
        else { _Pragma("unroll") for (int _h = 0; _h < 2; ++_h) _Pragma("unroll") for (int _i = 0; _i < 2; ++_i) dst[_h][_i] = (unsigned)((_h * HALF + RA[_i]) * K * ES + CA[_i] * 2); } } while (0)
#define PG8_AOFFS_NEXT(dst) do { if constexpr (false) { int t_ = tid, R_, C_; asm volatile("" : "+v"(t_)); stage_rc(t_ * 16, R_, C_); \
            const LAS int* st_ = (const LAS int*)(S.tb + ((ui + 1) % 3) * 1024) + R_; _Pragma("unroll") for (int _h = 0; _h < 2; ++_h) _Pragma("unroll") for (int _i = 0; _i < 2; ++_i) \
            dst[_h][_i] = (unsigned)st_[_h * HALF + _i * 64] * (unsigned)(K * ES) + (unsigned)(C_ * 2); } else { PG8_AOFFS(nxt, dst); } } while (0)
    Unit cur, nxt; int ui = 0;
    if (!S.next(0, cur)) return;
    f32x4 acc[2][2][4][2];
#pragma unroll
    for (int a = 0; a < 2; ++a)
#pragma unroll
        for (int b = 0; b < 2; ++b)
#pragma unroll
            for (int m = 0; m < 4; ++m)
#pragma unroll
                for (int n = 0; n < 2; ++n) acc[a][b][m][n] = (f32x4){0.f, 0.f, 0.f, 0.f};
    bf16x8 At[4][2], B0[2][2], B1[2][2];
    unsigned oc[2][2];
    const char* cA = S.a_base(cur); const char* cB = S.b_base(cur);
    PG8_AOFFS(cur, oc);
#define PG8_TABLES(U, buf) do { if constexpr (Sched::TBL) { LAS unsigned char* tb_ = S.tb + (buf) * 1024;   \
        if (wid < 4) { if (S.tab2(U)) __builtin_amdgcn_global_load_lds((const unsigned*)(S.tab2(U) + 64 * wid + lane), (LAS unsigned*)(tb_ + 6144 + wid * 256), 4, 0, 0); } \
        else { __builtin_amdgcn_global_load_lds((const unsigned*)(S.tab1(U) + 64 * (wid - 4) + lane), (LAS unsigned*)(tb_ + 3072 + (wid - 4) * 256), 4, 0, 0); } } } while (0)
    PG8_TABLES(cur, 0);
    PG8_STAGE(PG8_SB(0, 0), cB, voffB); PG8_STAGE(PG8_SB(0, 1), cB + hstep, voffB); PG8_STAGE(PG8_SA(0, 0), cA, oc[0]); PG8_STAGE(PG8_SA(0, 1), cA, oc[1]);
    if (wr == 1) PG8_BAR;
    PG8_WAIT_V(2); PG8_BAR;
    PG8_STAGE(PG8_SB(1, 0), cB + kstep, voffB); PG8_STAGE(PG8_SA(1, 0), cA + kstep, oc[0]); PG8_STAGE(PG8_SB(1, 1), cB + hstep + kstep, voffB);
    PG8_WAIT_V(6); PG8_BAR;
    for (;;) {
        const bool has_next = S.next(ui + 1, nxt);
        const char* nA = has_next ? S.a_base(nxt) : cA; const char* nB = has_next ? S.b_base(nxt) : cB;
        if (has_next) { PG8_TABLES(nxt, (ui + 1) % 3); }
        for (int t = 0; t < nt; t += 2) {
            const bool last = (t == nt - 2);
            const char* a1 = cA + (size_t)(t + 1) * kstep;
            const char* a2 = last ? nA : cA + (size_t)(t + 2) * kstep; const char* b2 = last ? nB : cB + (size_t)(t + 2) * kstep;
            const char* a3 = a2 + kstep; const char* b3 = b2 + kstep;
            PG8_LDB(B0, 0, 0); PG8_LDB(B1, 0, 1); PG8_SCHED; PG8_LDA(At, 0, 0); PG8_STAGE(PG8_SA(1, 1), a1, oc[1]);
            PG8_WAIT_V(8); PG8_WAIT_L(0); PG8_BAR; PG8_MMA(0, 0, At, B0); PG8_MMA(0, 1, At, B1); PG8_BAR; PG8_SCHED;
            if (last && has_next) { PG8_AOFFS_NEXT(oc); }
            PG8_LDA(At, 0, 1); PG8_STAGE(PG8_SB(0, 0), b2, voffB); PG8_STAGE(PG8_SB(0, 1), b2 + hstep, voffB); PG8_STAGE(PG8_SA(0, 0), a2, oc[0]);
            PG8_WAIT_V(8); PG8_WAIT_L(0); PG8_BAR; PG8_MMA(1, 0, At, B0); PG8_MMA(1, 1, At, B1); PG8_BAR; PG8_SCHED;
            PG8_LDB(B0, 1, 0); PG8_LDB(B1, 1, 1); PG8_SCHED; PG8_LDA(At, 1, 0); PG8_STAGE(PG8_SA(0, 1), a2, oc[1]);
            PG8_WAIT_V(8); PG8_WAIT_L(0); PG8_BAR; PG8_MMA(0, 0, At, B0); PG8_MMA(0, 1, At, B1); PG8_BAR; PG8_SCHED;
            PG8_LDA(At, 1, 1); PG8_STAGE(PG8_SB(1, 0), b3, voffB); PG8_STAGE(PG8_SB(1, 1), b3 + hstep, voffB); PG8_STAGE(PG8_SA(1, 0), a3, oc[0]);
            PG8_WAIT_V(8); PG8_WAIT_L(0); PG8_BAR; PG8_MMA(1, 0, At, B0); PG8_MMA(1, 1, At, B1); PG8_BAR; PG8_SCHED;
        }
        if constexpr (ALIGN_EPI) { if (wr == 0) PG8_BAR; }
        if constexpr (Sched::TBL) E(acc, cur, wr, wc, fr, fq, S.tb + (ui % 3) * 1024); else E(acc, cur, wr, wc, fr, fq);
        if (!has_next) break;
#pragma unroll
        for (int a = 0; a < 2; ++a)
#pragma unroll
            for (int b = 0; b < 2; ++b)
#pragma unroll
                for (int m = 0; m < 4; ++m)
#pragma unroll
                    for (int n = 0; n < 2; ++n) acc[a][b][m][n] = (f32x4){0.f, 0.f, 0.f, 0.f};
        cur = nxt; cA = nA; cB = nB; ++ui;
        if constexpr (ALIGN_EPI) { if (wr == 1) PG8_BAR; }
    }
    PG8_WAIT_V(0);
    if constexpr (!ALIGN_EPI) { if (wr == 0) PG8_BAR; }
    PG8_BAR;
#undef PG8_SA
#undef PG8_SB
#undef PG8_STAGE
#undef PG8_LDA
#undef PG8_LDB
#undef PG8_MMA
#undef PG8_WAIT_V
#undef PG8_WAIT_L
#undef PG8_BAR
#undef PG8_SCHED
#undef PG8_AOFFS
#undef PG8_AOFFS_NEXT
#undef PG8_TABLES
#undef PG8_CAT
}
}

#define XB_TMO      128
#define XB_XCNT(j)  (256  + 64 * (j))
#define XB_XSUB(j)  (1280 + 64 * (j))
#define XB_XGEN(j)  (2304 + 64 * (j))
#define XB_TOP      3328
#define XB_TOPGEN   3392
#define XCD_BAR_WORDS 3456
#define XB_SPIN_CAP (1u << 18)
__device__ __forceinline__ unsigned xb_ld(unsigned* p)              { return __hip_atomic_load(p, __ATOMIC_RELAXED, __HIP_MEMORY_SCOPE_AGENT); }
__device__ __forceinline__ unsigned xb_add(unsigned* p, unsigned v) { return __hip_atomic_fetch_add(p, v, __ATOMIC_RELAXED, __HIP_MEMORY_SCOPE_AGENT); }
__device__ __forceinline__ unsigned xb_xcc_id() { return (unsigned)__builtin_amdgcn_s_getreg((3 << 11) | 20) & 0xFu; }
#define XB_SPIN(cond, bar) do { unsigned _sp = 0; while (cond) { __builtin_amdgcn_s_sleep(1); \
    if ((++_sp & 255u) == 0u) { if (xb_ld(&(bar)[XB_TMO])) break; if (_sp > XB_SPIN_CAP) { atomicAdd(&(bar)[XB_TMO], 1u); break; } } } } while (0)
struct XcdBarrier { unsigned* bar; unsigned x; volatile LAS unsigned* st; };
__device__ __forceinline__ XcdBarrier xcd_barrier_post(unsigned* bar, volatile LAS unsigned* st) {
    XcdBarrier b; b.bar = bar; b.x = xb_xcc_id(); b.st = st;
    if (threadIdx.x == 0) (void)xb_add(&bar[XB_XCNT(b.x)], 1u);
    return b;
}
__device__ __forceinline__ void xcd_barrier_complete(unsigned* bar, unsigned x, unsigned& nloc, unsigned& nx) {
    const unsigned G = gridDim.x * gridDim.y * gridDim.z;
    unsigned sum, cnt, mine, sp = 0u;
    for (;;) {
        sum = 0u; cnt = 0u; mine = 0u;
#pragma unroll
        for (unsigned j = 0; j < 16; ++j) { const unsigned c = xb_ld(&bar[XB_XCNT(j)]); sum += c; cnt += (c > 0u) ? 1u : 0u; mine = (j == x) ? c : mine; }
        if (sum == G) break;
        __builtin_amdgcn_s_sleep(1);
        if ((++sp & 255u) == 0u) { if (xb_ld(&bar[XB_TMO])) break; if (sp > XB_SPIN_CAP) { atomicAdd(&bar[XB_TMO], 1u); break; } }
    }
    nloc = mine > 0u ? mine : 1u; nx = cnt > 0u ? cnt : 1u;
}
__device__ __forceinline__ void xcd_barrier(const XcdBarrier& b) {
    asm volatile("s_waitcnt vmcnt(0)" ::: "memory");
    __syncthreads();
    if (threadIdx.x == 0) {
        unsigned* bar = b.bar;
        __builtin_amdgcn_s_waitcnt(0);
        unsigned nloc = b.st[0], nx = b.st[1];
        if (nloc == 0u) { xcd_barrier_complete(bar, b.x, nloc, nx); b.st[0] = nloc; b.st[1] = nx; }
        const unsigned old = xb_add(&bar[XB_XSUB(b.x)], 1u);
        const unsigned gen = old / nloc;
        if (old + 1u == (gen + 1u) * nloc) {
            __builtin_amdgcn_fence(__ATOMIC_RELEASE, "agent");
            asm volatile("s_waitcnt vmcnt(0)" ::: "memory");
            const unsigned og = xb_add(&bar[XB_TOP], 1u);
            const unsigned tg = og / nx;
            if (og + 1u == (tg + 1u) * nx) xb_add(&bar[XB_TOPGEN], 1u);
            else XB_SPIN(xb_ld(&bar[XB_TOPGEN]) == tg, bar);
            __builtin_amdgcn_fence(__ATOMIC_ACQUIRE, "agent");
            xb_add(&bar[XB_XGEN(b.x)], 1u);
            asm volatile("s_waitcnt vmcnt(0)" ::: "memory");
        } else {
            XB_SPIN(xb_ld(&bar[XB_XGEN(b.x)]) == gen, bar);
            __builtin_amdgcn_fence(__ATOMIC_ACQUIRE, "agent");
            asm volatile("s_waitcnt vmcnt(0)" ::: "memory");
        }
    }
    __syncthreads();
}

struct Frame {
    LAS unsigned char* lds;
    unsigned* ctl;
    int tid, lane, wave, G;
    const float *x, *c, *ctx, *c_ctx, *w_mod, *b_mod, *norm1_w, *norm2_w, *w_in, *conv_w, *conv_b, *dt_bias, *a_log, *d_skip, *ssd_norm_w, *pool_w, *pool_scale, *w_out, *router_w, *router_b, *w1, *b1, *w2, *b2, *final_norm_w;
    float* out;
    float *MOD, *DTRAW, *DT, *ROWSC, *CHS, *TOPG, *SLOTGATE;
    bf16* X1;
    int *TOPE, *TOPR, *TOKSLOT, *SLOTTOK, *SLOTID, *BB;
    bf16 *WINT, *WOUTT, *W1T, *W2T, *A1, *XBCPRE, *Z, *V, *XBC, *CC, *ST, *Y, *YB, *A2, *H2, *ACT, *YS;
};

template <class RowMap>
__device__ __forceinline__ void p0_emit(bf16* WT, int Kd, RowMap rm, int k0, int n0, int nvalid, LAS float* scr, int lane) {
    const int c = lane & 7;
#pragma unroll
    for (int j = 0; j < 4; ++j) { const int n = (lane >> 3) + 8 * j; const LAS float* s = scr + (8 * c) * 33 + n;
        v4u o; o.x = pk2(s[0 * 33], s[1 * 33]); o.y = pk2(s[2 * 33], s[3 * 33]); o.z = pk2(s[4 * 33], s[5 * 33]); o.w = pk2(s[6 * 33], s[7 * 33]);
        if (n0 + n < nvalid) *(v4u*)(WT + (size_t)rm(n0 + n) * Kd + k0 + 8 * c) = o; }
    LDS_WAIT(); asm volatile("" ::: "memory");
}
template <class RowMap>
__device__ __forceinline__ void p0_transpose_item(const float* W, int N, int nvalid, bf16* WT, int Kd, RowMap rm, LAS float* scr, int kb, int nb, int lane) {
    const int k0 = 64 * kb, n0 = 32 * nb, nn = n0 + (lane & 31); const bool ok = nn < nvalid;
    float tv[32];
#pragma unroll
    for (int i = 0; i < 32; ++i) { const int kk = 2 * i + (lane >> 5); tv[i] = ok ? W[(size_t)(k0 + kk) * N + nn] : 0.f; }
#pragma unroll
    for (int i = 0; i < 32; ++i) { const int kk = 2 * i + (lane >> 5); scr[kk * 33 + (lane & 31)] = tv[i]; }
    LDS_WAIT(); asm volatile("" ::: "memory");
    p0_emit(WT, Kd, rm, k0, n0, nvalid, scr, lane);
}
struct RmId { __device__ __forceinline__ int operator()(int n) const { return n; } };
struct RmOff { int off; __device__ __forceinline__ int operator()(int n) const { return n + off; } };
struct RmWin { __device__ __forceinline__ int operator()(int n) const { return n < 2560 ? n : (n < 2608 ? 4608 + (n - 2560) : 2560 + (n - 2608)); } };
struct RmW1 { __device__ __forceinline__ int operator()(int n) const { const int j = n >> 1; return 256 * (j >> 7) + 128 * (n & 1) + (j & 127); } };

__device__ __forceinline__ void p0_prologue(Frame& F) {
    if ((int)blockIdx.x < 96) {
        LAS float* sc = (LAS float*)F.lds;
        LAS float* part = (LAS float*)(F.lds + 36864);
        for (int idx = F.tid; idx < 9 * 1024; idx += 512) { const int r = idx >> 10, k = idx & 1023; const float v = (r < 8) ? F.c[r * 1024 + k] : F.c_ctx[k]; sc[idx] = silu_f(v); }
        __syncthreads();
        const int n = 64 * (int)blockIdx.x + F.lane, kb = 128 * F.wave;
        float acc[9];
#pragma unroll
        for (int r = 0; r < 9; ++r) acc[r] = 0.f;
#pragma unroll 8
        for (int k = 0; k < 128; ++k) { const float wv = F.w_mod[(size_t)(kb + k) * 6144 + n];
#pragma unroll
            for (int r = 0; r < 9; ++r) acc[r] += sc[r * 1024 + kb + k] * wv; }
#pragma unroll
        for (int r = 0; r < 9; ++r) part[(F.wave * 9 + r) * 64 + F.lane] = acc[r];
        __syncthreads();
        for (int idx = F.tid; idx < 9 * 64; idx += 512) { const int r = idx >> 6, col = idx & 63; float s = 0.f;
#pragma unroll
            for (int w = 0; w < 8; ++w) s += part[(w * 9 + r) * 64 + col];
            F.MOD[r * 6144 + 64 * (int)blockIdx.x + col] = s + F.b_mod[64 * (int)blockIdx.x + col]; }
        __syncthreads();
    }
    LAS float* scr = (LAS float*)(F.lds + F.wave * 16384);
    const int gw = (int)blockIdx.x * 8 + F.wave, NGW = F.G * 8, lane = F.lane;
    constexpr int I_POOL = 16 * 4 * 4, I_PAD = N1 - IN_COLS;
    for (int r = NGW - 1 - gw; r < I_POOL + I_PAD; r += NGW) {
        if (r < I_POOL) {
            const int kb = r >> 4, g = (r >> 2) & 3, ob = r & 3, k = 64 * kb + lane, o0 = 32 * ob;
            float acc[32];
#pragma unroll
            for (int o = 0; o < 32; ++o) acc[o] = 0.f;
            const float* arow = F.w_in + (size_t)k * IN_COLS + 4144 + g * 128;
            for (int i = 0; i < 128; ++i) { const float a = arow[i]; const float* pw = F.pool_w + (size_t)(g * 128 + i) * 128 + o0;
#pragma unroll
                for (int o = 0; o < 32; ++o) acc[o] += a * pw[o]; }
#pragma unroll
            for (int o = 0; o < 32; ++o) scr[lane * 33 + o] = acc[o] * F.pool_scale[g * 128 + o0 + o];
            LDS_WAIT(); asm volatile("" ::: "memory");
            p0_emit(F.WINT, D, RmOff{4096 + g * 128}, 64 * kb, o0, 1 << 30, scr, lane);
        } else { v4u z = {0u, 0u, 0u, 0u}; v4u* p = (v4u*)(F.WINT + (size_t)(IN_COLS + (r - I_POOL)) * D); p[lane] = z; p[lane + 64] = z; }
    }
    constexpr int I_WIN = 16 * 130, I_WOUT = 32 * 32, I_W1 = 32 * 16 * 64, I_W2 = 32 * 16 * 32, NI = I_WIN + I_WOUT + I_W1 + I_W2;
    const bool wdeal = (F.G == 256);
    const int blk = (int)blockIdx.x;
#define P0_ITEM(k) (wdeal ? ((k) < 20 ? (k) * 2048 + gw : ((k) < 27 ? (blk >= 96 ? 40960 + ((k) - 20) * 1280 + (gw - 768) : -1) : ((k) < 30 ? ((blk >= 96 && blk < 198) ? 49920 + ((k) - 27) * 816 + (gw - 768) : -1) : -1))) : (k) * NGW + gw)
    const int nrounds = wdeal ? 30 : (NI + NGW - 1) / NGW;
    struct It { const float* src; bf16* dst; int N, nvalid, Kd, kind, k0, n0; };
#define P0_DECODE(it, I) do { int r_ = (it); \
        if (r_ < I_WIN) { I.src = F.w_in; I.dst = F.WINT; I.N = IN_COLS; I.nvalid = 4144; I.Kd = D; I.kind = 1; I.k0 = 64 * (r_ / 130); I.n0 = 32 * (r_ % 130); } \
        else if ((r_ -= I_WIN) < I_WOUT) { I.src = F.w_out; I.dst = F.WOUTT; I.N = D; I.nvalid = D; I.Kd = 2048; I.kind = 0; I.k0 = 64 * (r_ >> 5); I.n0 = 32 * (r_ & 31); } \
        else if ((r_ -= I_WOUT) < I_W1) { const int e_ = r_ >> 10, q_ = r_ & 1023; I.src = F.w1 + (size_t)e_ * D * 2048; I.dst = (bf16*)((unsigned char*)F.W1T + (size_t)e_ * 2048 * D); I.N = 2048; I.nvalid = 2048; I.Kd = D; I.kind = 2; I.k0 = 64 * (q_ >> 6); I.n0 = 32 * (q_ & 63); } \
        else { r_ -= I_W1; const int e_ = r_ >> 9, q_ = r_ & 511; I.src = F.w2 + (size_t)e_ * D * D; I.dst = (bf16*)((unsigned char*)F.W2T + (size_t)e_ * D * D); I.N = D; I.nvalid = D; I.Kd = D; I.kind = 3; I.k0 = 64 * (q_ >> 5); I.n0 = 32 * (q_ & 31); } } while (0)
#define P0_LOAD(I, tv) do { int nn_ = I.n0 + (lane & 31); nn_ = nn_ < I.nvalid ? nn_ : I.nvalid - 1; const float* sp_ = I.src + (size_t)(I.k0 + (lane >> 5)) * I.N + nn_; \
        _Pragma("unroll") for (int i_ = 0; i_ < 32; ++i_) { const float* q_ = sp_ + (size_t)(2 * i_) * I.N; asm volatile("global_load_dword %0, %1, off" : "=v"(tv[i_]) : "v"(q_) : "memory"); } } while (0)
#define P0_NEXT(itv) do { itv = -1; for (; kr < nrounds && itv < 0; ++kr) { const int it_ = P0_ITEM(kr); if (it_ >= 0 && it_ < NI) itv = it_; } } while (0)
#define P0_PROCESS(I, tv) do { \
        _Pragma("unroll") for (int i = 0; i < 32; ++i) { const int kk = 2 * i + (lane >> 5); scr[kk * 33 + (lane & 31)] = tv[i]; } \
        LDS_WAIT(); asm volatile("" ::: "memory"); \
        { const int c = lane & 7; \
          _Pragma("unroll") for (int j = 0; j < 4; ++j) { const int n = (lane >> 3) + 8 * j; const LAS float* sq = scr + (8 * c) * 33 + n; \
            const int ng = I.n0 + n; const int row = (I.kind == 0 || I.kind == 3) ? ng : (I.kind == 1 ? RmWin{}(ng) : RmW1{}(ng)); \
            if (I.kind >= 2) { v2u o; o.x = pk4_fp8(sq[0 * 33] * WSCALE, sq[1 * 33] * WSCALE, sq[2 * 33] * WSCALE, sq[3 * 33] * WSCALE); o.y = pk4_fp8(sq[4 * 33] * WSCALE, sq[5 * 33] * WSCALE, sq[6 * 33] * WSCALE, sq[7 * 33] * WSCALE); \
                *(v2u*)((unsigned char*)I.dst + (size_t)row * I.Kd + I.k0 + 8 * c) = o; } \
            else { v4u o; o.x = pk2(sq[0 * 33], sq[1 * 33]); o.y = pk2(sq[2 * 33], sq[3 * 33]); o.z = pk2(sq[4 * 33], sq[5 * 33]); o.w = pk2(sq[6 * 33], sq[7 * 33]); \
                if (ng < I.nvalid) *(v4u*)(I.dst + (size_t)row * I.Kd + I.k0 + 8 * c) = o; } } \
          LDS_WAIT(); asm volatile("" ::: "memory"); } } while (0)
    It ia{}, ib{}; float ta[32], tb[32]; int ita = -1, itb = -1; int kr = 0;
    P0_NEXT(ita);
    if (ita >= 0) { P0_DECODE(ita, ia); P0_LOAD(ia, ta); }
    while (ita >= 0) {
        P0_NEXT(itb);
        if (itb >= 0) { P0_DECODE(itb, ib); P0_LOAD(ib, tb); asm volatile("s_waitcnt vmcnt(32)" ::: "memory"); } else { asm volatile("s_waitcnt vmcnt(0)" ::: "memory"); }
        __builtin_amdgcn_sched_barrier(0);
        P0_PROCESS(ia, ta);
        if (itb < 0) break;
        P0_NEXT(ita);
        if (ita >= 0) { P0_DECODE(ita, ia); P0_LOAD(ia, ta); asm volatile("s_waitcnt vmcnt(32)" ::: "memory"); } else { asm volatile("s_waitcnt vmcnt(0)" ::: "memory"); }
        __builtin_amdgcn_sched_barrier(0);
        P0_PROCESS(ib, tb);
    }
#undef P0_NEXT
#undef P0_PROCESS
#undef P0_ITEM
#undef P0_DECODE
#undef P0_LOAD
}

__device__ __forceinline__ void p1_norm1(Frame& F) {
    const int gw = (int)blockIdx.x * 8 + F.wave, NGW = F.G * 8, lane = F.lane;
    const int per = (RTOT + NGW - 1) / NGW;
    for (int k0 = 0; k0 < per; k0 += 4) {
        f32x4 v[4][4];
#pragma unroll
        for (int k = 0; k < 4; ++k) { int r = gw + (k0 + k) * NGW; r = (k0 + k < per && r < RTOT) ? r : gw; const float* xr = (r < T) ? F.x + (size_t)r * D : F.ctx + (size_t)(r - T) * D;
#pragma unroll
            for (int j = 0; j < 4; ++j) v[k][j] = *(const f32x4*)(xr + 4 * lane + 256 * j); }
#pragma unroll
        for (int k = 0; k < 4; ++k) { const int r = gw + (k0 + k) * NGW; if (k0 + k < per && r < RTOT) {
            const float* mod = F.MOD + (size_t)((r < T) ? (r >> 12) : 8) * 6144;
            float ss = 0.f;
#pragma unroll
            for (int j = 0; j < 4; ++j) ss += (v[k][j].x * v[k][j].x + v[k][j].y * v[k][j].y) + (v[k][j].z * v[k][j].z + v[k][j].w * v[k][j].w);
            const float rs = __builtin_amdgcn_rsqf(wave_sum(ss) * (1.f / D) + RMS_EPS);
#pragma unroll
            for (int j = 0; j < 4; ++j) { const int col = 4 * lane + 256 * j;
                const f32x4 w = *(const f32x4*)(F.norm1_w + col), sh = *(const f32x4*)(mod + col), sc = *(const f32x4*)(mod + 1024 + col);
                const f32x4 h = (v[k][j] * rs) * w * (sc + 1.f) + sh;
                v2u o; o.x = pk2(h.x, h.y); o.y = pk2(h.z, h.w);
                *(v2u*)(F.A1 + (size_t)r * D + col) = o; } } }
    }
}

struct Sched1 {   static constexpr bool TBL = false;
    const char* A; const char* Bt; int G, c;
    __device__ __forceinline__ bool next(int i, pg8::Unit& u) const {
        const int L = i * G + c; if (L >= 2432 + 88) return false;
        if (L < 2432) pg8::static_map(L, 128, 19, u.pm, u.pn);
        else { const int Lc = L - 2432, j = Lc >> 3; u.pm = 128 + (Lc & 7); u.pn = j < 10 ? j : 18; }
        u.e = 0; return true; }
    __device__ __forceinline__ const char* a_base(const pg8::Unit& u) const { return A + (size_t)u.pm * 256 * D * 2; }
    __device__ __forceinline__ const char* b_base(const pg8::Unit& u) const { return Bt + (size_t)u.pn * 256 * D * 2; }
    __device__ __forceinline__ const int* row_table(const pg8::Unit&) const { return nullptr; }
};
struct Epi1 {
    static constexpr bool PERM = true;
    bf16 *XBCPRE, *Z, *V; float* DTRAW;
    __device__ __forceinline__ void operator()(const f32x4 (&acc)[2][2][4][2], const pg8::Unit& u, int wr, int wc, int fr, int fq) const {
        const int row0 = u.pm * 256 + wr * 64 + fr;
        if (u.pn < 18) {
            bf16* base; int ldc, colt;
            if (u.pn < 10) { base = XBCPRE; ldc = CONV_CH; colt = u.pn * 256; } else if (u.pn < 16) { base = Z; ldc = SSD_W; colt = (u.pn - 10) * 256; } else { base = V; ldc = 512; colt = (u.pn - 16) * 256; }
            const int col0 = colt + wc * 32 + 8 * fq;
#pragma unroll
            for (int ai = 0; ai < 2; ++ai)
#pragma unroll
                for (int m = 0; m < 4; ++m) { bf16* rowp = base + (size_t)(row0 + ai * 128 + m * 16) * ldc + col0;
#pragma unroll
                    for (int bj = 0; bj < 2; ++bj) { const f32x4 v0 = acc[ai][bj][m][0], v1 = acc[ai][bj][m][1];
                        v4u w; w.x = pg8::cvt_pk_bf16(v0[0], v0[1]); w.y = pg8::cvt_pk_bf16(v0[2], v0[3]); w.z = pg8::cvt_pk_bf16(v1[0], v1[1]); w.w = pg8::cvt_pk_bf16(v1[2], v1[3]);
                        *(v4u*)(rowp + bj * 128) = w; } }
        } else if (wc < 2) {
            const int col0 = wc * 32 + 8 * fq;
#pragma unroll
            for (int ai = 0; ai < 2; ++ai)
#pragma unroll
                for (int m = 0; m < 4; ++m) { float* rowp = DTRAW + (size_t)(row0 + ai * 128 + m * 16) * 64 + col0;
                    *(f32x4*)(rowp) = acc[ai][0][m][0]; *(f32x4*)(rowp + 4) = acc[ai][0][m][1]; }
        }
    }
};

__device__ __forceinline__ void p3_conv(Frame& F) {
    const int gt = (int)blockIdx.x * 512 + F.tid, NT_ = F.G * 512;
    constexpr int RPT = 16, NTASK = (RTOT / RPT) * 320;
    for (int task = gt; task < NTASK; task += NT_) {
        const int rt = task / 320, cg = task - rt * 320, r0 = rt * RPT, ch = cg * 8;
        int slo, shi; if (r0 < T) { slo = r0 & ~(SEQ - 1); shi = slo + SEQ; } else { slo = T + ((r0 - T) & ~(CTXL - 1)); shi = slo + CTXL; }
        const v4u zero = {0u, 0u, 0u, 0u};
        v4u win[RPT + 4];
#pragma unroll
        for (int j = 0; j < RPT + 4; ++j) { const int r = r0 - 2 + j; win[j] = (r >= slo && r < shi) ? *(const v4u*)(F.XBCPRE + (size_t)r * CONV_CH + ch) : zero; }
        float w[5][8], bias[8];
#pragma unroll
        for (int j = 0; j < 5; ++j) { const f32x4 a = *(const f32x4*)(F.conv_w + j * CONV_CH + ch), b = *(const f32x4*)(F.conv_w + j * CONV_CH + ch + 4);
            w[j][0] = a.x; w[j][1] = a.y; w[j][2] = a.z; w[j][3] = a.w; w[j][4] = b.x; w[j][5] = b.y; w[j][6] = b.z; w[j][7] = b.w; }
        { const f32x4 a = *(const f32x4*)(F.conv_b + ch), b = *(const f32x4*)(F.conv_b + ch + 4); bias[0] = a.x; bias[1] = a.y; bias[2] = a.z; bias[3] = a.w; bias[4] = b.x; bias[5] = b.y; bias[6] = b.z; bias[7] = b.w; }
#pragma unroll
        for (int i = 0; i < RPT; ++i) {
            float o[8];
#pragma unroll
            for (int e = 0; e < 8; ++e) o[e] = bias[e];
#pragma unroll
            for (int j = 0; j < 5; ++j) { const v4u q = win[i + j];
                o[0] += w[j][0] * bflo(q.x); o[1] += w[j][1] * bfhi(q.x); o[2] += w[j][2] * bflo(q.y); o[3] += w[j][3] * bfhi(q.y);
                o[4] += w[j][4] * bflo(q.z); o[5] += w[j][5] * bfhi(q.z); o[6] += w[j][6] * bflo(q.w); o[7] += w[j][7] * bfhi(q.w); }
            v4u ov; ov.x = pk2(silu_f(o[0]), silu_f(o[1])); ov.y = pk2(silu_f(o[2]), silu_f(o[3])); ov.z = pk2(silu_f(o[4]), silu_f(o[5])); ov.w = pk2(silu_f(o[6]), silu_f(o[7]));
            *(v4u*)(F.XBC + (size_t)(r0 + i) * CONV_CH + ch) = ov;
        }
    }
    for (int idx = gt; idx < RTOT * 48; idx += NT_) { const int r = idx / 48, j = idx - r * 48; const float v = F.DTRAW[(size_t)r * 64 + j] + F.dt_bias[j];
        F.DT[idx] = v > 20.f ? v : log1pf(__expf(v)); }
}

__device__ __forceinline__ bf16x8 frag_row(const LAS unsigned char* base, int rs, int row, int k0, int q) { return *(const LAS bf16x8*)(base + row * rs + (k0 + 8 * q) * 2); }
__device__ __forceinline__ bf16x8 frag_tr(const LAS unsigned char* base, int rs, int k0, int c0, int lane) {
    const int g = lane >> 4, qq = (lane & 15) >> 2, p = lane & 3;
    const LAS unsigned char* a = base + (k0 + 8 * g + qq) * rs + c0 * 2 + 8 * p;
    const s16x4 lo = __builtin_amdgcn_ds_read_tr16_b64_v4i16((LAS s16x4*)a);
    const s16x4 hi = __builtin_amdgcn_ds_read_tr16_b64_v4i16((LAS s16x4*)(a + 4 * rs));
    bf16x8 r; r[0] = lo[0]; r[1] = lo[1]; r[2] = lo[2]; r[3] = lo[3]; r[4] = hi[0]; r[5] = hi[1]; r[6] = hi[2]; r[7] = hi[3]; return r;
}
__device__ __forceinline__ f32x4 mfma16(bf16x8 a, bf16x8 b, f32x4 c) { return __builtin_amdgcn_mfma_f32_16x16x32_bf16(a, b, c, 0, 0, 0); }
__device__ __forceinline__ float wave_incl_scan(float v, int lane) {
#pragma unroll
    for (int o = 1; o < 64; o <<= 1) { const float t = __shfl_up(v, o); if (lane >= o) v += t; }
    return v;
}

__device__ __forceinline__ float silu_fast(float v) { return v * __builtin_amdgcn_rcpf(1.f + __builtin_amdgcn_exp2f(-1.44269504f * v)); }
__device__ __forceinline__ float softplus_f(float v) { return v > 20.f ? v : log1pf(__expf(v)); }
__device__ __forceinline__ void p4_scan(Frame& F, LAS float* Te, volatile LAS float* TOT, int d, int h, float raw0, float raw1, int lane, size_t chs_idx, float* rowsc) {
    const int s0 = d ? 127 - 2 * lane : 2 * lane, s1 = d ? s0 - 1 : s0 + 1;
    const float bias = F.dt_bias[d * NH + h];
    const float dt0 = softplus_f(raw0 + bias), dt1 = softplus_f(raw1 + bias);
    const float A2 = __expf(F.a_log[d * NH + h]) * 1.44269504f;
    const float a0 = -A2 * dt0, a1 = -A2 * dt1;
    const float incl = wave_incl_scan(a0 + a1, lane);
    const float c1 = incl, c0 = incl - a1, tot = __shfl(incl, 63);
    Te[d * 128 + s0] = c0; Te[d * 128 + s1] = c1;
    Te[(2 + d) * 128 + s0] = c0 - __builtin_amdgcn_logf(dt0); Te[(2 + d) * 128 + s1] = c1 - __builtin_amdgcn_logf(dt1);
    if (lane == 63) { F.CHS[chs_idx] = tot; *TOT = tot; }
    if (rowsc) { rowsc[s0] = __builtin_amdgcn_exp2f(c0); rowsc[s1] = __builtin_amdgcn_exp2f(c1); }
}
__device__ __forceinline__ v4u conv_piece(const v4u& r0, const v4u& r1, const v4u& r2, const v4u& r3, const v4u& r4, const float (&w)[5][8], const float (&bias)[8]) {
    float o[8];
#pragma unroll
    for (int e = 0; e < 8; ++e) o[e] = bias[e];
    const v4u rr[5] = {r0, r1, r2, r3, r4};
#pragma unroll
    for (int j = 0; j < 5; ++j) { const v4u q = rr[j];
        o[0] += w[j][0] * bflo(q.x); o[1] += w[j][1] * bfhi(q.x); o[2] += w[j][2] * bflo(q.y); o[3] += w[j][3] * bfhi(q.y);
        o[4] += w[j][4] * bflo(q.z); o[5] += w[j][5] * bfhi(q.z); o[6] += w[j][6] * bflo(q.w); o[7] += w[j][7] * bfhi(q.w); }
    v4u ov; ov.x = pk2(silu_fast(o[0]), silu_fast(o[1])); ov.y = pk2(silu_fast(o[2]), silu_fast(o[3])); ov.z = pk2(silu_fast(o[4]), silu_fast(o[5])); ov.w = pk2(silu_fast(o[6]), silu_fast(o[7]));
    return ov;
}
__device__ __forceinline__ void p4_states(Frame& F, const bf16x8 (&braw)[4], const LAS float* Te, const volatile LAS float* TOT2, const LAS unsigned char* Xs, size_t st_base, int w, int lane) {
    constexpr int RSX = 144;
    const int i16 = lane & 15, q4 = lane >> 4;
#pragma unroll
    for (int d = 0; d < 2; ++d) {
        const float tot = TOT2[d];
        f32x4 sa[4];
#pragma unroll
        for (int pt = 0; pt < 4; ++pt) sa[pt] = (f32x4){0.f, 0.f, 0.f, 0.f};
#pragma unroll
        for (int ks = 0; ks < 4; ++ks) {
            const LAS float* cp = Te + (2 + d) * 128 + 32 * ks + 8 * q4;
            const f32x4 c0 = *(const LAS f32x4*)cp, c1 = *(const LAS f32x4*)(cp + 4);
            float wv[8];
#pragma unroll
            for (int j = 0; j < 4; ++j) { wv[j] = __builtin_amdgcn_exp2f(tot - c0[j]); wv[4 + j] = __builtin_amdgcn_exp2f(tot - c1[j]); }
            const v4u bu = __builtin_bit_cast(v4u, braw[ks]); v4u su;
            su.x = pk2(bflo(bu.x) * wv[0], bfhi(bu.x) * wv[1]); su.y = pk2(bflo(bu.y) * wv[2], bfhi(bu.y) * wv[3]);
            su.z = pk2(bflo(bu.z) * wv[4], bfhi(bu.z) * wv[5]); su.w = pk2(bflo(bu.w) * wv[6], bfhi(bu.w) * wv[7]);
            const bf16x8 bs = __builtin_bit_cast(bf16x8, su);
#pragma unroll
            for (int pt = 0; pt < 4; ++pt) sa[pt] = mfma16(bs, frag_tr(Xs, RSX, 32 * ks, 16 * pt, lane), sa[pt]); }
        unsigned char* sp = (unsigned char*)F.ST + st_base + ((size_t)d * HDIM + i16) * NST + 16 * w + 4 * q4;
#pragma unroll
        for (int pt = 0; pt < 4; ++pt) { float c[4];
#pragma unroll
            for (int r = 0; r < 4; ++r) c[r] = fminf(fmaxf(sa[pt][r] * STSCALE, -440.f), 440.f);
            *(unsigned*)(sp + (size_t)16 * pt * NST) = pk4_fp8(c[0], c[1], c[2], c[3]); }
    }
}
__device__ __forceinline__ void p4_ssd_local(Frame& F) {
    constexpr int RS = 272, RSX = 144;
    constexpr int O_C = 0, O_B = 34816, O_M = 69632, O_X = 104448  , O_T = 141312  , O_CW = 153600  ;
    static_assert(O_CW + 9216 <= MISC_OFF, "P4 LDS map");
    LAS unsigned char* L = F.lds;
    LAS float* TAB = (LAS float*)(L + O_T);
    LAS float* CW = (LAS float*)(L + O_CW);
    volatile LAS float* TOT = (volatile LAS float*)(L + MISC_OFF + 64);
    volatile LAS float* DSK = (volatile LAS float*)(L + MISC_OFF + 128);
    const int tid = F.tid, w = F.wave;
    const int lb = 64 * (w & 1), sb = 32 * (w >> 1);
    const v4u zero4 = {0u, 0u, 0u, 0u};
    constexpr int NLAT = NB * 32 * NGRP, NCTX = NB * 2 * NGRP * HPG;
    int g_staged = -1;
    for (int v = (int)blockIdx.x; v < NLAT + NCTX; v += F.G) {
        const bool lat = v < NLAT;
        int tid_l = tid; asm volatile("" : "+v"(tid_l));
        const int lane_l = tid_l & 63, lane = lane_l, i16 = lane & 15, q4 = lane >> 4;
        const int p32 = tid_l & 31, rg = tid_l >> 5;
        const int xpc = tid_l & 7, rg2 = tid_l >> 3;
        int b, g, cc, r0, e_lo, e_hi; bool lo_ok, hi_ok;
        if (lat) { b = v >> 7; const int c = (v >> 2) & 31; g = v & 3; cc = c + 2; r0 = b * SEQ + c * CHUNK; lo_ok = c > 0; hi_ok = c < 31; e_lo = 0; e_hi = HPG; }
        else { const int q = v - NLAT; const int e = q % HPG; int t = q / HPG; g = t & 3; t >>= 2; cc = t & 1; b = t >> 1; r0 = T + b * CTXL + cc * CHUNK; lo_ok = cc > 0; hi_ok = cc < 1; e_lo = e; e_hi = e + 1; }
        const int rmin = lo_ok ? -2 : 0, rmax = hi_ok ? 129 : 127;
        const int chBC = SSD_W + (p32 >> 4) * (NGRP * NST) + g * NST + 8 * (p32 & 15);
        v4u raw[12];
#pragma unroll
        for (int j = 0; j < 12; ++j) { const int rr = 8 * rg - 2 + j; const int rc = rr < rmin ? rmin : (rr > rmax ? rmax : rr);
            const v4u t = *(const v4u*)(F.XBCPRE + (size_t)(r0 + rc) * CONV_CH + chBC); raw[j] = (rr == rc) ? t : zero4; }
        if (g != g_staged) {
            if (tid < HPG) DSK[tid] = F.d_skip[g * HPG + tid];
            float cwv[5];
#pragma unroll
            for (int q = 0; q < 5; ++q) { int idx = tid + 512 * q; idx = idx < HPG * 6 * 64 ? idx : HPG * 6 * 64 - 1; const int e_ = idx / 384, rem = idx - e_ * 384, j = rem >> 6, chl = rem & 63; const int ch = (g * HPG + e_) * HDIM + chl;
                const int jj = j < 5 ? j : 0; const float a = F.conv_w[jj * CONV_CH + ch], bq = F.conv_b[ch]; cwv[q] = (j < 5) ? a : bq; }
#pragma unroll
            for (int q = 0; q < 5; ++q) { const int idx = tid + 512 * q; if (idx < HPG * 6 * 64) CW[idx] = cwv[q]; }
            g_staged = g;
        }
        {
            float cw[5][8], cbias[8];
#pragma unroll
            for (int j = 0; j < 5; ++j) { const f32x4 a = *(const f32x4*)(F.conv_w + j * CONV_CH + chBC), bq = *(const f32x4*)(F.conv_w + j * CONV_CH + chBC + 4);
                cw[j][0] = a.x; cw[j][1] = a.y; cw[j][2] = a.z; cw[j][3] = a.w; cw[j][4] = bq.x; cw[j][5] = bq.y; cw[j][6] = bq.z; cw[j][7] = bq.w; }
            { const f32x4 a = *(const f32x4*)(F.conv_b + chBC), bq = *(const f32x4*)(F.conv_b + chBC + 4); cbias[0] = a.x; cbias[1] = a.y; cbias[2] = a.z; cbias[3] = a.w; cbias[4] = bq.x; cbias[5] = bq.y; cbias[6] = bq.z; cbias[7] = bq.w; }
            LAS unsigned char* dst = L + ((p32 >> 4) ? O_C : O_B) + (8 * rg) * RS + (p32 & 15) * 16;
#pragma unroll
            for (int i = 0; i < 8; ++i) { const v4u o = conv_piece(raw[i], raw[i + 1], raw[i + 2], raw[i + 3], raw[i + 4], cw, cbias);
                *(LAS v4u*)(dst + i * RS) = o;
                if (lat && (p32 >> 4)) *(v4u*)(F.CC + (size_t)(r0 + 8 * rg + i) * 512 + g * NST + 8 * (p32 & 15)) = o; }
        }
        v4u xraw[6];
#pragma unroll
        for (int j = 0; j < 6; ++j) { const int rr = 2 * rg2 - 2 + j; const int rc = rr < rmin ? rmin : (rr > rmax ? rmax : rr);
            xraw[j] = *(const v4u*)(F.XBCPRE + (size_t)(r0 + rc) * CONV_CH + (g * HPG + e_lo) * HDIM + 8 * xpc); }
        float pdt[2][2];
#pragma unroll
        for (int ii = 0; ii < 2; ++ii) { const int idx = (w + 8 * ii) < 12 ? (w + 8 * ii) : 11; const int e_ = idx % 6, d_ = idx / 6, h_ = g * HPG + e_; const int s0 = d_ ? 127 - 2 * lane_l : 2 * lane_l, s1 = d_ ? s0 - 1 : s0 + 1;
            pdt[ii][0] = F.DTRAW[(size_t)(r0 + s0) * 64 + d_ * NH + h_]; pdt[ii][1] = F.DTRAW[(size_t)(r0 + s1) * 64 + d_ * NH + h_]; }
#pragma unroll
        for (int ii = 0; ii < 2; ++ii) { const int idx = w + 8 * ii; const int e = idx % 6, d = idx / 6, h = g * HPG + e;
            if (idx < 12 && e >= e_lo && e < e_hi)
                p4_scan(F, TAB + e * 512, TOT + e * 2 + d, d, h, pdt[ii][0], pdt[ii][1], lane_l, ((size_t)(b * NCC + cc) * NH + h) * 2 + d, lat ? F.ROWSC + ((size_t)(b * 2 + d) * NH + h) * SEQ + (cc - 2) * CHUNK : nullptr); }
        __syncthreads();
        f32x4 cb[2][4];
        if (lat) {
#pragma unroll
            for (int ts = 0; ts < 2; ++ts)
#pragma unroll
                for (int tl = 0; tl < 4; ++tl) cb[ts][tl] = (f32x4){0.f, 0.f, 0.f, 0.f};
#pragma unroll
            for (int ks = 0; ks < 4; ++ks) { bf16x8 af[2], bfr[4];
#pragma unroll
                for (int ts = 0; ts < 2; ++ts) af[ts] = frag_row(L + O_B, RS, sb + 16 * ts + i16, 32 * ks, q4);
#pragma unroll
                for (int tl = 0; tl < 4; ++tl) bfr[tl] = frag_row(L + O_C, RS, lb + 16 * tl + i16, 32 * ks, q4);
#pragma unroll
                for (int ts = 0; ts < 2; ++ts)
#pragma unroll
                    for (int tl = 0; tl < 4; ++tl) cb[ts][tl] = mfma16(af[ts], bfr[tl], cb[ts][tl]); }
        }
        bf16x8 braw[4];
#pragma unroll
        for (int ks = 0; ks < 4; ++ks) braw[ks] = frag_tr(L + O_B, RS, 32 * ks, 16 * w, lane);
        for (int e = e_lo; e < e_hi; ++e) {
            const int h = g * HPG + e;
            const LAS float* Te = TAB + e * 512;
            LAS unsigned char* Xs = L + O_X + (e & 1) * 18432;
            LAS unsigned char* Ms = L + ((e & 1) ? O_C : O_M);
            {
                const LAS float* cwp = CW + (e * 6) * 64 + 8 * xpc;
#pragma unroll
                for (int i = 0; i < 2; ++i) {
                    f32x4 oa = *(const LAS f32x4*)(cwp + 5 * 64), ob = *(const LAS f32x4*)(cwp + 5 * 64 + 4);
#pragma unroll
                    for (int j = 0; j < 5; ++j) { const f32x4 wa = *(const LAS f32x4*)(cwp + j * 64), wb = *(const LAS f32x4*)(cwp + j * 64 + 4);
                        const int rr = 2 * rg2 - 2 + i + j; const v4u q = (rr >= rmin && rr <= rmax) ? xraw[i + j] : zero4;
                        oa.x += wa.x * bflo(q.x); oa.y += wa.y * bfhi(q.x); oa.z += wa.z * bflo(q.y); oa.w += wa.w * bfhi(q.y);
                        ob.x += wb.x * bflo(q.z); ob.y += wb.y * bfhi(q.z); ob.z += wb.z * bflo(q.w); ob.w += wb.w * bfhi(q.w); }
                    v4u ov; ov.x = pk2(silu_fast(oa.x), silu_fast(oa.y)); ov.y = pk2(silu_fast(oa.z), silu_fast(oa.w)); ov.z = pk2(silu_fast(ob.x), silu_fast(ob.y)); ov.w = pk2(silu_fast(ob.z), silu_fast(ob.w));
                    *(LAS v4u*)(Xs + (2 * rg2 + i) * RSX + xpc * 16) = ov; }
            }
            if (e + 1 < e_hi) {
#pragma unroll
                for (int j = 0; j < 6; ++j) { const int rr = 2 * rg2 - 2 + j; const int rc = rr < rmin ? rmin : (rr > rmax ? rmax : rr);
                    xraw[j] = *(const v4u*)(F.XBCPRE + (size_t)(r0 + rc) * CONV_CH + (h + 1) * HDIM + 8 * xpc); }
            }
            if (lat) {
                const float Dh = DSK[e];
#pragma unroll
                for (int tl = 0; tl < 4; ++tl) { const int l = lb + 16 * tl + i16; const int lt_abs = 4 * (w & 1) + tl; const float af_l = Te[l], rb_l = Te[128 + l];
#pragma unroll
                    for (int ts = 0; ts < 2; ++ts) { const int s0 = sb + 16 * ts + 4 * q4; const int st_abs = 2 * (w >> 1) + ts;
                        float m[4];
                        if (st_abs < lt_abs) {
                            const f32x4 acs = *(const LAS f32x4*)(Te + 256 + s0);
#pragma unroll
                            for (int r = 0; r < 4; ++r) m[r] = cb[ts][tl][r] * __builtin_amdgcn_exp2f(af_l - acs[r]);
                        } else if (st_abs > lt_abs) {
                            const f32x4 rbs = *(const LAS f32x4*)(Te + 384 + s0);
#pragma unroll
                            for (int r = 0; r < 4; ++r) m[r] = cb[ts][tl][r] * __builtin_amdgcn_exp2f(rb_l - rbs[r]);
                        } else {
                            const f32x4 acs = *(const LAS f32x4*)(Te + 256 + s0), rbs = *(const LAS f32x4*)(Te + 384 + s0);
#pragma unroll
                            for (int r = 0; r < 4; ++r) { const int sidx = s0 + r;
                                const float wf = (sidx <= l) ? __builtin_amdgcn_exp2f(af_l - acs[r]) : 0.f;
                                const float wb = (sidx >= l) ? __builtin_amdgcn_exp2f(rb_l - rbs[r]) : 0.f;
                                m[r] = cb[ts][tl][r] * (wf + wb) + ((sidx == l) ? Dh : 0.f); }
                        }
                        v2u o; o.x = pk2(m[0], m[1]); o.y = pk2(m[2], m[3]);
                        *(LAS v2u*)(Ms + l * RS + s0 * 2) = o; } }
            }
            __syncthreads();
            if (lat) {
                f32x4 ya[4];
#pragma unroll
                for (int pt = 0; pt < 4; ++pt) ya[pt] = (f32x4){0.f, 0.f, 0.f, 0.f};
#pragma unroll
                for (int ks = 0; ks < 4; ++ks) { const bf16x8 bm = frag_row(Ms, RS, 16 * w + i16, 32 * ks, q4);
#pragma unroll
                    for (int pt = 0; pt < 4; ++pt) ya[pt] = mfma16(frag_tr(Xs, RSX, 32 * ks, 16 * pt, lane), bm, ya[pt]); }
                bf16* yp = F.Y + (size_t)(r0 + 16 * w + i16) * SSD_W + h * HDIM + 4 * q4;
#pragma unroll
                for (int pt = 0; pt < 4; ++pt) { v2u o; o.x = pk2(ya[pt][0], ya[pt][1]); o.y = pk2(ya[pt][2], ya[pt][3]); *(v2u*)(yp + 16 * pt) = o; }
            }
            p4_states(F, braw, Te, TOT + e * 2, Xs, (((size_t)(b * NCC + cc) * NH + h) * 2) * HDIM * NST, w, lane);
        }
        __syncthreads();
    }
}

__device__ __forceinline__ void p5_ssd_scan(Frame& F) {
    constexpr int RS = 272, O_RS = 4 * 34816;
    LAS unsigned char* L = F.lds;
    LAS float* RSB = (LAS float*)(L + O_RS);
    const int tid = F.tid, lane = F.lane, w = F.wave, i16 = lane & 15, q4 = lane >> 4;
    const int d = w >> 2, ps = w & 3, t8 = tid & 255;
    for (int u = (int)blockIdx.x; u < NB * NH; u += F.G) {
        const int b = u / NH, h = u - b * NH, g = h / HPG;
        float S[32];
#pragma unroll
        for (int k = 0; k < 32; ++k) S[k] = 0.f;
        v4u creg[8]; float rsreg = 0.f;
#pragma unroll
        for (int k = 0; k < 8; ++k) creg[k] = (v4u){0u, 0u, 0u, 0u};
        for (int j = 0; j < NCC; ++j) {
            const int cc = d == 0 ? j : (j < 2 ? 1 - j : 35 - j);
            LAS unsigned char* Cb = L + ((j & 1) * 2 + d) * 34816;
            if (j >= 2) {
#pragma unroll
                for (int k = 0; k < 8; ++k) { const int pc = t8 + 256 * k, row = pc >> 4, ch = pc & 15; *(LAS v4u*)(Cb + row * RS + ch * 16) = creg[k]; }
                if (t8 < 128) RSB[((j & 1) * 2 + d) * 128 + t8] = rsreg;
            }
            __syncthreads();
            if (j + 1 >= 2 && j + 1 < NCC) {
                const int cn = d == 0 ? j + 1 : 34 - j;
                const size_t rown = (size_t)b * SEQ + (size_t)(cn - 2) * CHUNK;
#pragma unroll
                for (int k = 0; k < 8; ++k) { const int pc = t8 + 256 * k, row = pc >> 4, ch = pc & 15; creg[k] = *(const v4u*)(F.CC + (rown + row) * 512 + g * NST + ch * 8); }
                if (t8 < 128) rsreg = F.ROWSC[((size_t)(b * 2 + d) * NH + h) * SEQ + (cn - 2) * CHUNK + t8];
            }
            const size_t sidx = ((size_t)(b * NCC + cc) * NH + h) * 2 + d;
            const unsigned char* stp = (const unsigned char*)F.ST + (sidx * HDIM + 16 * ps + i16) * NST + 8 * q4;
            v2u stv[4];
#pragma unroll
            for (int ks = 0; ks < 4; ++ks) stv[ks] = *(const v2u*)(stp + 32 * ks);
            const float decay = __builtin_amdgcn_exp2f(F.CHS[sidx]);
            if (j >= 2) {
                bf16x8 sf[4];
#pragma unroll
                for (int ks = 0; ks < 4; ++ks) { v4u t; t.x = pk2(S[ks * 8 + 0], S[ks * 8 + 1]); t.y = pk2(S[ks * 8 + 2], S[ks * 8 + 3]); t.z = pk2(S[ks * 8 + 4], S[ks * 8 + 5]); t.w = pk2(S[ks * 8 + 6], S[ks * 8 + 7]); sf[ks] = __builtin_bit_cast(bf16x8, t); }
                const size_t rowb = (size_t)b * SEQ + (size_t)(cc - 2) * CHUNK;
                const LAS float* rsl = RSB + ((j & 1) * 2 + d) * 128;
                const int c = cc - 2; const bool first = (d == 0) ? (c <= 15) : (c >= 16);
                unsigned yold[8];
                unsigned char* yo = (unsigned char*)F.YB + (rowb + i16) * SSD_W + h * HDIM + 16 * ps + 4 * q4;
                if (!first) {
#pragma unroll
                    for (int lt = 0; lt < 8; ++lt) yold[lt] = *(const unsigned*)(yo + (size_t)16 * lt * SSD_W);
                }
#pragma unroll
                for (int lt = 0; lt < 8; ++lt) {
                    f32x4 a = (f32x4){0.f, 0.f, 0.f, 0.f};
#pragma unroll
                    for (int ks = 0; ks < 4; ++ks) a = mfma16(sf[ks], frag_row(Cb, RS, 16 * lt + i16, 32 * ks, q4), a);
                    const float sc = rsl[16 * lt + i16] * YOSCALE;
                    float o[4] = {a[0] * sc, a[1] * sc, a[2] * sc, a[3] * sc};
                    if (!first) { const f32x2 lo = __builtin_amdgcn_cvt_pk_f32_fp8((int)yold[lt], false), hi = __builtin_amdgcn_cvt_pk_f32_fp8((int)yold[lt], true); o[0] += lo.x; o[1] += lo.y; o[2] += hi.x; o[3] += hi.y; }
#pragma unroll
                    for (int r = 0; r < 4; ++r) o[r] = fminf(fmaxf(o[r], -440.f), 440.f);
                    *(unsigned*)(yo + (size_t)16 * lt * SSD_W) = pk4_fp8(o[0], o[1], o[2], o[3]);
                }
            }
#pragma unroll
            for (int ks = 0; ks < 4; ++ks) { const v2u t = stv[ks];
                const f32x2 a0 = __builtin_amdgcn_cvt_pk_f32_fp8((int)t.x, false), a1 = __builtin_amdgcn_cvt_pk_f32_fp8((int)t.x, true), a2 = __builtin_amdgcn_cvt_pk_f32_fp8((int)t.y, false), a3 = __builtin_amdgcn_cvt_pk_f32_fp8((int)t.y, true);
                S[ks * 8 + 0] = decay * S[ks * 8 + 0] + a0.x * (1.f / STSCALE); S[ks * 8 + 1] = decay * S[ks * 8 + 1] + a0.y * (1.f / STSCALE);
                S[ks * 8 + 2] = decay * S[ks * 8 + 2] + a1.x * (1.f / STSCALE); S[ks * 8 + 3] = decay * S[ks * 8 + 3] + a1.y * (1.f / STSCALE);
                S[ks * 8 + 4] = decay * S[ks * 8 + 4] + a2.x * (1.f / STSCALE); S[ks * 8 + 5] = decay * S[ks * 8 + 5] + a2.y * (1.f / STSCALE);
                S[ks * 8 + 6] = decay * S[ks * 8 + 6] + a3.x * (1.f / STSCALE); S[ks * 8 + 7] = decay * S[ks * 8 + 7] + a3.y * (1.f / STSCALE); }
        }
        __syncthreads();
    }
}

__device__ __forceinline__ void p6_gate_pool(Frame& F) {
    LAS unsigned char* L = F.lds;
    const int tid = F.tid, lane = F.lane, w = F.wave;
    for (int gr = (int)blockIdx.x; gr < T / 64; gr += F.G) {
        const int rb = gr * 64;
        v4u pv[8];
#pragma unroll
        for (int k = 0; k < 8; ++k) { const int pc = tid + 512 * k, row = pc >> 6, ch = pc & 63; pv[k] = *(const v4u*)(F.V + (size_t)(rb + row) * 512 + ch * 8); }
#pragma unroll
        for (int k = 0; k < 8; ++k) { const int pc = tid + 512 * k, row = pc >> 6, ch = pc & 63; *(LAS v4u*)(L + row * 1024 + ch * 16) = pv[k]; }
        for (int rr = 0; rr < 8; rr += 2) {
            v4u ya[2][3], zz[2][3]; v2u yb[2][3];
#pragma unroll
            for (int k = 0; k < 2; ++k) { const int r = rb + 8 * w + rr + k;
#pragma unroll
                for (int j = 0; j < 3; ++j) { const int col = 8 * (lane + 64 * j);
                    ya[k][j] = *(const v4u*)(F.Y + (size_t)r * SSD_W + col); yb[k][j] = *(const v2u*)((const unsigned char*)F.YB + (size_t)r * SSD_W + col); zz[k][j] = *(const v4u*)(F.Z + (size_t)r * SSD_W + col); } }
#pragma unroll
            for (int k = 0; k < 2; ++k) { const int r = rb + 8 * w + rr + k;
                float v[24]; float ss = 0.f;
#pragma unroll
                for (int j = 0; j < 3; ++j) {
                    const unsigned yaw[4] = {ya[k][j].x, ya[k][j].y, ya[k][j].z, ya[k][j].w}, zw[4] = {zz[k][j].x, zz[k][j].y, zz[k][j].z, zz[k][j].w};
                    const f32x2 yo2[4] = {__builtin_amdgcn_cvt_pk_f32_fp8((int)yb[k][j].x, false), __builtin_amdgcn_cvt_pk_f32_fp8((int)yb[k][j].x, true), __builtin_amdgcn_cvt_pk_f32_fp8((int)yb[k][j].y, false), __builtin_amdgcn_cvt_pk_f32_fp8((int)yb[k][j].y, true)};
#pragma unroll
                    for (int e = 0; e < 4; ++e) { const float y0 = bflo(yaw[e]) + yo2[e].x * (1.f / YOSCALE), y1 = bfhi(yaw[e]) + yo2[e].y * (1.f / YOSCALE);
                        const float g0 = y0 * silu_f(bflo(zw[e])), g1 = y1 * silu_f(bfhi(zw[e])); v[j * 8 + 2 * e] = g0; v[j * 8 + 2 * e + 1] = g1; ss += g0 * g0 + g1 * g1; } }
                const float rs = __builtin_amdgcn_rsqf(wave_sum(ss) * (1.f / SSD_W) + RMS_EPS);
#pragma unroll
                for (int j = 0; j < 3; ++j) { const int col = 8 * (lane + 64 * j);
                    const f32x4 w0 = *(const f32x4*)(F.ssd_norm_w + col), w1 = *(const f32x4*)(F.ssd_norm_w + col + 4);
                    v4u o; o.x = pk2(v[j * 8 + 0] * rs * w0.x, v[j * 8 + 1] * rs * w0.y); o.y = pk2(v[j * 8 + 2] * rs * w0.z, v[j * 8 + 3] * rs * w0.w);
                    o.z = pk2(v[j * 8 + 4] * rs * w1.x, v[j * 8 + 5] * rs * w1.y); o.w = pk2(v[j * 8 + 6] * rs * w1.z, v[j * 8 + 7] * rs * w1.w);
                    *(v4u*)(F.A2 + (size_t)r * 2048 + col) = o; } }
        }
        __syncthreads();
        {
            const int cg = tid & 63, tb = tid >> 6, hw = 1 << (cg >> 4);
            const LAS unsigned char* colp = L + cg * 16;
#pragma unroll 2
            for (int tt = 0; tt < 8; ++tt) { const int t = tb * 8 + tt; const int lo = t - hw < 0 ? 0 : t - hw, hi = t + hw > 64 ? 64 : t + hw;
                float s[8];
#pragma unroll
                for (int e = 0; e < 8; ++e) s[e] = 0.f;
                for (int q = lo; q < hi; ++q) { const v4u x = *(const LAS v4u*)(colp + q * 1024);
                    s[0] += bflo(x.x); s[1] += bfhi(x.x); s[2] += bflo(x.y); s[3] += bfhi(x.y); s[4] += bflo(x.z); s[5] += bfhi(x.z); s[6] += bflo(x.w); s[7] += bfhi(x.w); }
                const v4u x = *(const LAS v4u*)(colp + t * 1024); const float inv = 1.f / (float)(hi - lo);
                v4u o; o.x = pk2(s[0] * inv - bflo(x.x), s[1] * inv - bfhi(x.x)); o.y = pk2(s[2] * inv - bflo(x.y), s[3] * inv - bfhi(x.y));
                o.z = pk2(s[4] * inv - bflo(x.z), s[5] * inv - bfhi(x.z)); o.w = pk2(s[6] * inv - bflo(x.w), s[7] * inv - bfhi(x.w));
                *(v4u*)(F.A2 + (size_t)(rb + t) * 2048 + SSD_W + cg * 8) = o; }
        }
        __syncthreads();
    }
}

struct Sched7 {
    static constexpr bool TBL = false;
    const char* A; const char* Bt; int G, c;
    __device__ __forceinline__ bool next(int i, pg8::Unit& u) const { const int L = i * G + c; if (L >= 512) return false; pg8::static_map(L, 128, 4, u.pm, u.pn); u.e = 0; return true; }
    __device__ __forceinline__ const char* a_base(const pg8::Unit& u) const { return A + (size_t)u.pm * 256 * 2048 * 2; }
    __device__ __forceinline__ const char* b_base(const pg8::Unit& u) const { return Bt + (size_t)u.pn * 256 * 2048 * 2; }
    __device__ __forceinline__ const int* row_table(const pg8::Unit&) const { return nullptr; }
};
struct Epi7 {
    static constexpr bool PERM = false;
    const float* x; const float* MOD; bf16* X1;
    __device__ __forceinline__ void operator()(const f32x4 (&acc)[2][2][4][2], const pg8::Unit& u, int wr, int wc, int fr, int fq) const {
        const int row0 = u.pm * 256 + wr * 64 + fr, col0 = u.pn * 256 + wc * 32 + 4 * fq;
        const float* g1 = MOD + (size_t)(u.pm >> 4) * 6144 + 2048;
        f32x4 gv[2][2];
#pragma unroll
        for (int bj = 0; bj < 2; ++bj)
#pragma unroll
            for (int n = 0; n < 2; ++n) gv[bj][n] = *(const f32x4*)(g1 + col0 + bj * 128 + n * 16);
#pragma unroll
        for (int ai = 0; ai < 2; ++ai)
#pragma unroll
            for (int m = 0; m < 4; ++m) { const size_t off = (size_t)(row0 + ai * 128 + m * 16) * D + col0;
#pragma unroll
                for (int bj = 0; bj < 2; ++bj)
#pragma unroll
                    for (int n = 0; n < 2; ++n) { const f32x4 xv = *(const f32x4*)(x + off + bj * 128 + n * 16); const f32x4 o = xv + gv[bj][n] * acc[ai][bj][m][n]; v2u ov; ov.x = pk2(o.x, o.y); ov.y = pk2(o.z, o.w); *(v2u*)(X1 + off + bj * 128 + n * 16) = ov; } }
    }
};

__device__ __forceinline__ void p8_router(Frame& F) {
    LAS unsigned char* L = F.lds;
    LAS float* H2F = (LAS float*)L;
    constexpr int HP = 1028;
    LAS float* PART = (LAS float*)(L + 16 * HP * 4);
    LAS unsigned* HIST = (LAS unsigned*)(L + 16 * HP * 4 + 16384);
    const int tid = F.tid, lane = F.lane, w = F.wave, i16 = lane & 15, q4 = lane >> 4;
    if (tid < 32) HIST[tid] = 0u;
    float rw0[32], rw1[32];
#pragma unroll
    for (int kk = 0; kk < 32; ++kk) { const int k = 128 * w + 4 * kk + q4; rw0[kk] = F.router_w[k * 32 + i16]; rw1[kk] = F.router_w[k * 32 + 16 + i16]; }
    __syncthreads();
    for (int gi = (int)blockIdx.x; gi < T / 16; gi += F.G) {
        const int rbase = gi * 16;
#pragma unroll
        for (int rr = 0; rr < 2; ++rr) {
            const int r16 = 2 * w + rr, r = rbase + r16;
            const bf16* xr = F.X1 + (size_t)r * D; const float* mod = F.MOD + (size_t)(r >> 12) * 6144;
            f32x4 v[4]; float ss = 0.f;
#pragma unroll
            for (int j = 0; j < 4; ++j) { const v2u xq = *(const v2u*)(xr + 4 * lane + 256 * j); v[j] = (f32x4){bflo(xq.x), bfhi(xq.x), bflo(xq.y), bfhi(xq.y)}; ss += (v[j].x * v[j].x + v[j].y * v[j].y) + (v[j].z * v[j].z + v[j].w * v[j].w); }
            const float rs = __builtin_amdgcn_rsqf(wave_sum(ss) * (1.f / D) + RMS_EPS);
#pragma unroll
            for (int j = 0; j < 4; ++j) { const int col = 4 * lane + 256 * j;
                const f32x4 wv = *(const f32x4*)(F.norm2_w + col), sh = *(const f32x4*)(mod + 3072 + col), sc = *(const f32x4*)(mod + 4096 + col);
                const f32x4 hh = (v[j] * rs) * wv * (sc + 1.f) + sh;
                *(LAS f32x4*)(H2F + r16 * HP + col) = hh;
                *(unsigned*)((unsigned char*)F.H2 + (size_t)r * D + col) = pk4_fp8(hh.x, hh.y, hh.z, hh.w); }
        }
        __syncthreads();
        {
            f32x4 a0 = (f32x4){0.f, 0.f, 0.f, 0.f}, a1 = a0;
#pragma unroll
            for (int kk = 0; kk < 32; ++kk) { const int k = 128 * w + 4 * kk + q4;
                const float av = H2F[i16 * HP + k];
                a0 = __builtin_amdgcn_mfma_f32_16x16x4f32(av, rw0[kk], a0, 0, 0, 0); a1 = __builtin_amdgcn_mfma_f32_16x16x4f32(av, rw1[kk], a1, 0, 0, 0); }
#pragma unroll
            for (int r = 0; r < 4; ++r) { PART[(w * 16 + 4 * q4 + r) * 32 + i16] = a0[r]; PART[(w * 16 + 4 * q4 + r) * 32 + 16 + i16] = a1[r]; }
        }
        __syncthreads();
        {
            const int row = tid >> 5, e = tid & 31;
            float lg = F.router_b[e];
#pragma unroll
            for (int ww = 0; ww < 8; ++ww) lg += PART[(ww * 16 + row) * 32 + e];
            float tv[4]; int ti[4];
#pragma unroll
            for (int k = 0; k < 4; ++k) { float bv = lg; int bi = e;
#pragma unroll
                for (int o = 1; o < 32; o <<= 1) { const float ov = __shfl_xor(bv, o); const int oi = __shfl_xor(bi, o); if (ov > bv || (ov == bv && oi < bi)) { bv = ov; bi = oi; } }
                tv[k] = bv; ti[k] = bi; if (e == bi) lg = -INFINITY; }
            if (e == 0) {
                const float e1 = __expf(tv[1] - tv[0]), e2 = __expf(tv[2] - tv[0]), e3 = __expf(tv[3] - tv[0]); const float inv = 1.f / (1.f + e1 + e2 + e3);
                const float gt[4] = {inv, e1 * inv, e2 * inv, e3 * inv};
                const int tok = rbase + row;
#pragma unroll
                for (int k = 0; k < 4; ++k) { const unsigned lr = atomicAdd((unsigned*)&HIST[ti[k]], 1u); F.TOPE[tok * 4 + k] = ti[k]; F.TOPG[tok * 4 + k] = gt[k]; F.TOPR[tok * 4 + k] = (int)lr; }
            }
        }
        __syncthreads();
    }
    if (tid < 32) { const unsigned base = __hip_atomic_fetch_add(F.ctl + CW_GCOUNT + tid, HIST[tid], RLX_AGENT); F.BB[(int)blockIdx.x * 32 + tid] = (int)base; }
}

__device__ __forceinline__ int moe_tables(Frame& F) {
    LAS int* TE = (LAS int*)(F.lds + TE_OFF);
    LAS int* MC = (LAS int*)(F.lds + MOE_CNT_OFF);
    __syncthreads();
    if (F.tid == 0) { int ps = 0;
        for (int e = 0; e < NE; ++e) { const int c = (int)__hip_atomic_load(F.ctl + CW_GCOUNT + e, RLX_AGENT); MC[e] = c; MC[32 + e] = ps; const int nt = (c + 255) >> 8; for (int t = 0; t < nt; ++t) TE[(ps >> 8) + t] = e; ps += nt << 8; }
        MC[64] = ps >> 8; }
    __syncthreads();
    return MC[64];
}
__device__ __forceinline__ void p9_slots(Frame& F) {
    (void)moe_tables(F);
    const LAS int* MC = (const LAS int*)(F.lds + MOE_CNT_OFF);
    const int gt = (int)blockIdx.x * 512 + F.tid, NT_ = F.G * 512;
    for (int a = gt; a < T * TOPK; a += NT_) { const int tok = a >> 2, e = F.TOPE[a], blk = (tok >> 4) % F.G;
        const int slot = MC[32 + e] + F.BB[blk * 32 + e] + F.TOPR[a];
        F.SLOTTOK[slot] = tok; F.SLOTGATE[slot] = F.TOPG[a]; F.TOKSLOT[a] = slot; }
    for (int i = gt; i < MAX_SLOTS; i += NT_) F.SLOTID[i] = i;
    if ((int)blockIdx.x < NE) { const int e = (int)blockIdx.x, c = MC[e], ps = MC[32 + e], pe = ps + (((c + 255) >> 8) << 8);
        for (int s = ps + c + F.tid; s < pe; s += 512) { F.SLOTTOK[s] = 0; F.SLOTGATE[s] = 0.f; } }
}

struct SchedMoe {
    static constexpr bool TBL = true;
    const char* A; const char* W; const int* slot_tok; const LAS int* TE; int nM, nN, G, c; size_t wbytes  , tilebytes  , arowbytes;
    LAS unsigned char* tb;
    const float* f0; int f0_e, f0_n;
    const float* f1;
    __device__ __forceinline__ bool next(int i, pg8::Unit& u) const { const int L = i * G + c; if (L >= nM * nN) return false; pg8::static_map(L, nM, nN, u.pm, u.pn); u.e = TE[u.pm]; return true; }
    __device__ __forceinline__ const char* a_base(const pg8::Unit&) const { return A; }
    __device__ __forceinline__ const char* b_base(const pg8::Unit& u) const { return W + (size_t)u.e * wbytes + (size_t)u.pn * tilebytes; }
    __device__ __forceinline__ const int* row_table(const pg8::Unit& u) const { return slot_tok + u.pm * 256; }
    __device__ __forceinline__ const int* tab0(const pg8::Unit& u) const { return slot_tok + u.pm * 256; }
    __device__ __forceinline__ const float* tab1(const pg8::Unit& u) const { return f0 + (size_t)u.e * f0_e + u.pn * f0_n; }
    __device__ __forceinline__ const float* tab2(const pg8::Unit& u) const { return f1 ? f1 + u.pm * 256 : nullptr; }
};
struct Epi10 {
    static constexpr bool PERM = true;
    const float* b1; bf16* ACT;
    __device__ __forceinline__ void operator()(const f32x4 (&acc)[2][2][4][2], const pg8::Unit& u, int wr, int wc, int fr, int fq, const LAS unsigned char* tbuf) const {
        const int row0 = u.pm * 256 + wr * 64 + fr, j0 = u.pn * 128 + wc * 32 + 8 * fq;
        const LAS float* bp = (const LAS float*)(tbuf + 3072) + 2 * (wc * 32 + 8 * fq);
        const f32x4 q0 = *(const LAS f32x4*)bp, q1 = *(const LAS f32x4*)(bp + 4), q2 = *(const LAS f32x4*)(bp + 8), q3 = *(const LAS f32x4*)(bp + 12);
        const float bg[8] = {q0.x, q0.z, q1.x, q1.z, q2.x, q2.z, q3.x, q3.z}, bu[8] = {q0.y, q0.w, q1.y, q1.w, q2.y, q2.w, q3.y, q3.w};
#pragma unroll
        for (int ai = 0; ai < 2; ++ai)
#pragma unroll
            for (int m = 0; m < 4; ++m) { float o[8];
#pragma unroll
                for (int n = 0; n < 2; ++n)
#pragma unroll
                    for (int t = 0; t < 4; ++t) { const float hg = acc[ai][0][m][n][t] * (1.f / WSCALE) + bg[4 * n + t], hu = acc[ai][1][m][n][t] * (1.f / WSCALE) + bu[4 * n + t];
                        const float gp = fminf(hg, 7.f), up = fminf(fmaxf(hu, -7.f), 7.f);
                        o[4 * n + t] = gp * __builtin_amdgcn_rcpf(1.f + __builtin_amdgcn_exp2f(-1.702f * 1.44269504f * gp)) * (up + 1.f); }
                v2u wv; wv.x = pk4_fp8(o[0] * ASCALE, o[1] * ASCALE, o[2] * ASCALE, o[3] * ASCALE); wv.y = pk4_fp8(o[4] * ASCALE, o[5] * ASCALE, o[6] * ASCALE, o[7] * ASCALE);
                *(v2u*)((unsigned char*)ACT + (size_t)(row0 + ai * 128 + m * 16) * DFF + j0) = wv; }
    }
};
struct Epi11 {
    static constexpr bool PERM = true;
    bf16* YS;
    __device__ __forceinline__ void operator()(const f32x4 (&acc)[2][2][4][2], const pg8::Unit& u, int wr, int wc, int fr, int fq, const LAS unsigned char* tbuf) const {
        const int row0 = u.pm * 256 + wr * 64 + fr, col0 = u.pn * 256 + wc * 32 + 8 * fq;
        const LAS float* bl = (const LAS float*)(tbuf + 3072) + wc * 32 + 8 * fq; const LAS float* gl = (const LAS float*)(tbuf + 6144) + wr * 64 + fr;
        f32x4 bv[2][2];
#pragma unroll
        for (int bj = 0; bj < 2; ++bj)
#pragma unroll
            for (int n = 0; n < 2; ++n) bv[bj][n] = *(const LAS f32x4*)(bl + bj * 128 + 4 * n);
#pragma unroll
        for (int ai = 0; ai < 2; ++ai)
#pragma unroll
            for (int m = 0; m < 4; ++m) { const int row = row0 + ai * 128 + m * 16; const float gt = gl[ai * 128 + m * 16];
#pragma unroll
                for (int bj = 0; bj < 2; ++bj) { const float gs = gt * YSCALE; f32x4 v0 = (acc[ai][bj][m][0] * (1.f / (WSCALE * ASCALE)) + bv[bj][0]) * gs, v1 = (acc[ai][bj][m][1] * (1.f / (WSCALE * ASCALE)) + bv[bj][1]) * gs;
#pragma unroll
                    for (int t = 0; t < 4; ++t) { v0[t] = fminf(fmaxf(v0[t], -440.f), 440.f); v1[t] = fminf(fmaxf(v1[t], -440.f), 440.f); }
                    v2u wv; wv.x = pk4_fp8(v0[0], v0[1], v0[2], v0[3]); wv.y = pk4_fp8(v1[0], v1[1], v1[2], v1[3]);
                    *(v2u*)((unsigned char*)YS + (size_t)row * D + col0 + bj * 128) = wv; } }
    }
};

__device__ __forceinline__ void p12_combine(Frame& F) {
    const int gw = (int)blockIdx.x * 8 + F.wave, NGW = F.G * 8, lane = F.lane;
    for (int rp = gw; rp < T / 2; rp += NGW) {
        int sl[2][4];
#pragma unroll
        for (int k2 = 0; k2 < 2; ++k2)
#pragma unroll
            for (int k = 0; k < 4; ++k) sl[k2][k] = F.TOKSLOT[(rp * 2 + k2) * 4 + k];
        unsigned yv[2][4][4]; v2u xq[2][4];
#pragma unroll
        for (int k2 = 0; k2 < 2; ++k2)
#pragma unroll
            for (int j = 0; j < 4; ++j) { const int col = 4 * lane + 256 * j; xq[k2][j] = *(const v2u*)(F.X1 + (size_t)(rp * 2 + k2) * D + col);
#pragma unroll
                for (int k = 0; k < 4; ++k) yv[k2][j][k] = *(const unsigned*)((const unsigned char*)F.YS + (size_t)sl[k2][k] * D + col); }
#pragma unroll
        for (int k2 = 0; k2 < 2; ++k2) { const int r = rp * 2 + k2;
            const float* g2 = F.MOD + (size_t)(r >> 12) * 6144 + 5120;
            f32x4 v[4]; float ss = 0.f;
#pragma unroll
            for (int j = 0; j < 4; ++j) { const int col = 4 * lane + 256 * j; f32x4 m = (f32x4){0.f, 0.f, 0.f, 0.f};
#pragma unroll
                for (int k = 0; k < 4; ++k) { const int y = (int)yv[k2][j][k]; const f32x2 lo = __builtin_amdgcn_cvt_pk_f32_fp8(y, false), hi = __builtin_amdgcn_cvt_pk_f32_fp8(y, true); m.x += lo.x; m.y += lo.y; m.z += hi.x; m.w += hi.y; }
                v[j] = (f32x4){bflo(xq[k2][j].x), bfhi(xq[k2][j].x), bflo(xq[k2][j].y), bfhi(xq[k2][j].y)} + *(const f32x4*)(g2 + col) * (m * (1.f / YSCALE));
                ss += (v[j].x * v[j].x + v[j].y * v[j].y) + (v[j].z * v[j].z + v[j].w * v[j].w); }
            const float rs = __builtin_amdgcn_rsqf(wave_sum(ss) * (1.f / D) + RMS_EPS);
#pragma unroll
            for (int j = 0; j < 4; ++j) { const int col = 4 * lane + 256 * j; *(f32x4*)(F.out + (size_t)r * D + col) = (v[j] * rs) * *(const f32x4*)(F.final_norm_w + col); } }
    }
}

constexpr int NPHASE = 13;
struct Args { const float* in[25]; float* out; unsigned char* ws; int ph_lo, ph_hi; };
__global__ void __launch_bounds__(512, 2) mk_fwd(Args args) {
    extern __shared__ __attribute__((aligned(16))) unsigned char lds[];
    Frame F;
    F.lds = (LAS unsigned char*)lds;
    F.tid = threadIdx.x; F.lane = F.tid & 63; F.wave = __builtin_amdgcn_readfirstlane(F.tid >> 6); F.G = gridDim.x;
    unsigned char* ws = args.ws;
    F.ctl = (unsigned*)(ws + WS_CTL);
    F.x = args.in[0]; F.c = args.in[1]; F.ctx = args.in[2]; F.c_ctx = args.in[3]; F.w_mod = args.in[4]; F.b_mod = args.in[5]; F.norm1_w = args.in[6]; F.norm2_w = args.in[7];
    F.w_in = args.in[8]; F.conv_w = args.in[9]; F.conv_b = args.in[10]; F.dt_bias = args.in[11]; F.a_log = args.in[12]; F.d_skip = args.in[13]; F.ssd_norm_w = args.in[14];
    F.pool_w = args.in[15]; F.pool_scale = args.in[16]; F.w_out = args.in[17]; F.router_w = args.in[18]; F.router_b = args.in[19]; F.w1 = args.in[20]; F.b1 = args.in[21];
    F.w2 = args.in[22]; F.b2 = args.in[23]; F.final_norm_w = args.in[24]; F.out = args.out;
    F.MOD = (float*)(ws + WS_MOD); F.DTRAW = (float*)(ws + WS_DTRAW); F.DT = (float*)(ws + WS_DT); F.ROWSC = (float*)(ws + WS_ROWSC); F.CHS = (float*)(ws + WS_CHS); F.X1 = (bf16*)(ws + WS_X1);
    F.TOPG = (float*)(ws + WS_TOPG); F.SLOTGATE = (float*)(ws + WS_SLOTGATE); F.TOPE = (int*)(ws + WS_TOPE); F.TOPR = (int*)(ws + WS_TOPR); F.TOKSLOT = (int*)(ws + WS_TOKSLOT);
    F.SLOTTOK = (int*)(ws + WS_SLOTTOK); F.SLOTID = (int*)(ws + WS_SLOTID); F.BB = (int*)(ws + WS_BB);
    F.WINT = (bf16*)(ws + WS_WINT); F.WOUTT = (bf16*)(ws + WS_WOUTT); F.W1T = (bf16*)(ws + WS_W1T); F.W2T = (bf16*)(ws + WS_W2T); F.A1 = (bf16*)(ws + WS_A1); F.XBCPRE = (bf16*)(ws + WS_XBCPRE);
    F.Z = (bf16*)(ws + WS_Z); F.V = (bf16*)(ws + WS_V); F.XBC = (bf16*)(ws + WS_XBC); F.CC = (bf16*)(ws + WS_CC); F.ST = (bf16*)(ws + WS_ST); F.Y = (bf16*)(ws + WS_Y); F.YB = (bf16*)(ws + WS_YB);
    F.A2 = (bf16*)(ws + WS_A2); F.H2 = (bf16*)(ws + WS_H2); F.ACT = (bf16*)(ws + WS_ACT); F.YS = (bf16*)(ws + WS_YS);
    volatile LAS unsigned* MISC = (volatile LAS unsigned*)(F.lds + MISC_OFF);
    for (int u = F.tid; u < 64; u += 512) MISC[u] = 0u;
    __syncthreads();
    const int lo = args.ph_lo, hi = args.ph_hi;
    XcdBarrier bar; bar.bar = F.ctl + CW_BAR; bar.x = 0; bar.st = nullptr;
    if (hi - lo > 1) bar = xcd_barrier_post(F.ctl + CW_BAR, MISC + 8);
#define IN(k) (lo <= (k) && (k) < hi)
#define SEAM(k) do { if (IN(k) && IN((k) + 1)) xcd_barrier(bar); } while (0)
#define BODY0 p0_prologue(F)
#define BODY1 p1_norm1(F)
#define BODY2 do { Sched1 S{(const char*)F.A1, (const char*)F.WINT, F.G, (int)blockIdx.x}; Epi1 E{F.XBCPRE, F.Z, F.V, F.DTRAW}; pg8::gemm_phase<Epi1, Sched1, false>(F.lds, D, S, E); } while (0)
#define BODY3 p3_conv(F)
#define BODY4 p4_ssd_local(F)
#define BODY5 p5_ssd_scan(F)
#define BODY6 p6_gate_pool(F)
#define BODY7 do { Sched7 S{(const char*)F.A2, (const char*)F.WOUTT, F.G, (int)blockIdx.x}; Epi7 E{F.x, F.MOD, F.X1}; pg8::gemm_phase<Epi7, Sched7, false>(F.lds, 2048, S, E); } while (0)
#define BODY8 p8_router(F)
#define BODY9 p9_slots(F)
#define BODY10 do { const int ntl = moe_tables(F); \
        SchedMoe S{(const char*)F.H2, (const char*)F.W1T, F.SLOTTOK, (const LAS int*)(F.lds + TE_OFF), ntl, 8, F.G, (int)blockIdx.x, (size_t)2048 * D, (size_t)256 * D, (size_t)D, F.lds + TBL_OFF, F.b1, 2048, 256, nullptr}; \
        Epi10 E{F.b1, F.ACT}; pg8::gemm_phase<Epi10, SchedMoe, true, true>(F.lds, D, S, E); } while (0)
#define BODY11 do { const int ntl = moe_tables(F); \
        SchedMoe S{(const char*)F.ACT, (const char*)F.W2T, F.SLOTID, (const LAS int*)(F.lds + TE_OFF), ntl, 4, F.G, (int)blockIdx.x, (size_t)D * D, (size_t)256 * D, (size_t)D, F.lds + TBL_OFF, F.b2, D, 256, F.SLOTGATE}; \
        Epi11 E{F.YS}; pg8::gemm_phase<Epi11, SchedMoe, true, true>(F.lds, D, S, E); } while (0)
#define BODY12 p12_combine(F)
#define RUN(k) do { if (IN(k)) { BODY##k; if (PROBE_PH == (k)) { xcd_barrier(bar); BODY##k; } } SEAM(k); } while (0)
    RUN(0); RUN(1); RUN(2); RUN(4); RUN(5); RUN(6); RUN(7); RUN(8); RUN(9); RUN(10); RUN(11); RUN(12);
#undef IN
#undef SEAM
}

extern "C" void kernel_launch(void* const* d_in, const int* in_sizes, int n_in, void* d_out, int out_size, void* d_ws, size_t ws_size, hipStream_t stream) {
    static int grid = 0;
    if (grid == 0) {
        if (n_in != 25 || out_size != T * D || ws_size < WS_END) { fprintf(stderr, "kernel_launch: unexpected shapes (n_in %d, out %d, ws %zu)\n", n_in, out_size, ws_size); grid = -1; return; }
        int dev = 0, cus = 0, per_cu = 0;
        if (hipGetDevice(&dev) != hipSuccess || hipDeviceGetAttribute(&cus, hipDeviceAttributeMultiprocessorCount, dev) != hipSuccess) { grid = -1; return; }
        if (hipFuncSetAttribute((const void*)mk_fwd, hipFuncAttributeMaxDynamicSharedMemorySize, LDS_BYTES) != hipSuccess) { fprintf(stderr, "kernel_launch: hipFuncSetAttribute failed\n"); grid = -1; return; }
        if (hipOccupancyMaxActiveBlocksPerMultiprocessor(&per_cu, (const void*)mk_fwd, 512, LDS_BYTES) != hipSuccess || per_cu < 1) { fprintf(stderr, "kernel_launch: occupancy query says %d\n", per_cu); }
        (void)hipGetLastError();
        grid = cus;
    }
    if (grid < 0) return;
    (void)hipMemsetAsync((char*)d_ws + WS_CTL, 0, CTL_ZERO_BYTES, stream);
    Args a{};
    for (int i = 0; i < 25; ++i) a.in[i] = (const float*)d_in[i];
    a.out = (float*)d_out; a.ws = (unsigned char*)d_ws;
#if MK_SPLIT
    for (int p = 0; p < NPHASE; ++p) { a.ph_lo = p; a.ph_hi = p + 1; hipLaunchKernelGGL(mk_fwd, dim3(grid), dim3(512), LDS_BYTES, stream, a); }
#else
    a.ph_lo = 0; a.ph_hi = NPHASE; hipLaunchKernelGGL(mk_fwd, dim3(grid), dim3(512), LDS_BYTES, stream, a);
#endif
}
```

```cpp
#include <hip/hip_runtime.h>
#include <cstdio>
#include <cstdint>

#ifndef MK_SPLIT
#define MK_SPLIT 0
#endif

#ifndef PROBE_PH
#define PROBE_PH -1
#endif

#define GAS __attribute__((address_space(1)))
#define LAS __attribute__((address_space(3)))
typedef unsigned short bf16;
typedef unsigned v4u __attribute__((ext_vector_type(4)));
typedef unsigned v2u __attribute__((ext_vector_type(2)));
typedef float f32x4 __attribute__((ext_vector_type(4)));
typedef float f32x2 __attribute__((ext_vector_type(2)));
typedef short bf16x8 __attribute__((ext_vector_type(8)));
typedef short s16x4 __attribute__((ext_vector_type(4)));
#define RLX_AGENT __ATOMIC_RELAXED, __HIP_MEMORY_SCOPE_AGENT
#define LDS_WAIT() asm volatile("s_waitcnt lgkmcnt(0)" ::: "memory")
#define VM_WAIT() asm volatile("s_waitcnt vmcnt(0)" ::: "memory")

__device__ __forceinline__ unsigned f2bf(float f) { unsigned u = __builtin_bit_cast(unsigned, f); return (u + 0x7fffu + ((u >> 16) & 1u)) >> 16; }
typedef __bf16 nbf16x2 __attribute__((ext_vector_type(2)));
__device__ __forceinline__ unsigned pk2(float lo, float hi) { const f32x2 v = {lo, hi}; return __builtin_bit_cast(unsigned, __builtin_convertvector(v, nbf16x2)); }
constexpr float A2SCALE = 4.f;
constexpr float YOSCALE = 16.f;
constexpr float STSCALE = 32.f;
constexpr float YSCALE = 8.f;
constexpr float ASCALE = 4.f;
constexpr float WSCALE = 32.f;
__device__ __forceinline__ unsigned pk4_fp8(float a, float b, float c, float d) { int r = __builtin_amdgcn_cvt_pk_fp8_f32(a, b, 0, false); r = __builtin_amdgcn_cvt_pk_fp8_f32(c, d, r, true); return (unsigned)r; }
__device__ __forceinline__ float bflo(unsigned w) { return __builtin_bit_cast(float, w << 16); }
__device__ __forceinline__ float bfhi(unsigned w) { return __builtin_bit_cast(float, w & 0xffff0000u); }
__device__ __forceinline__ float silu_f(float v) { return v * __builtin_amdgcn_rcpf(1.f + __builtin_amdgcn_exp2f(-1.44269504f * v)); }
__device__ __forceinline__ float wave_sum(float v) {
#pragma unroll
    for (int o = 1; o < 64; o <<= 1) v += __shfl_xor(v, o);
    return v;
}

constexpr int D = 1024, NB = 8, SEQ = 4096, CTXL = 256, T = NB * SEQ, TC = NB * CTXL, RTOT = T + TC;
constexpr int CONV_CH = 2560, SSD_W = 1536, NH = 24, HDIM = 64, NGRP = 4, HPG = 6, NST = 128, CHUNK = 128;
constexpr int NCC = (CTXL + SEQ) / CHUNK;
constexpr int IN_COLS = 4656, N1 = 4864;
constexpr int NE = 32, TOPK = 4, DFF = 1024;
constexpr int MAX_TILES = (T * TOPK) / 256 + NE;
constexpr int MAX_SLOTS = MAX_TILES * 256;
constexpr float RMS_EPS = 1e-6f;

constexpr size_t MiB = 1u << 20;
constexpr size_t WS_CTL = 0, CTL_ZERO_BYTES = 1 * MiB;
constexpr size_t WS_MOD = 1 * MiB;
constexpr size_t WS_TOPE = 2 * MiB, WS_TOPG = WS_TOPE + 512 * 1024, WS_TOPR = WS_TOPG + 512 * 1024, WS_TOKSLOT = WS_TOPR + 512 * 1024;
constexpr size_t WS_SLOTTOK = 4 * MiB, WS_SLOTGATE = WS_SLOTTOK + 576 * 1024, WS_BB = WS_SLOTGATE + 576 * 1024, WS_CHS = WS_BB + 64 * 1024, WS_SLOTID = WS_CHS + 64 * 1024;
constexpr size_t WS_DTRAW = 6 * MiB;
constexpr size_t WS_ROWID = 21 * MiB + 512 * 1024;
constexpr size_t WS_DT = 15 * MiB;
constexpr size_t WS_ROWSC = 22 * MiB;
constexpr size_t WS_WINT = 32 * MiB, WS_WOUTT = 42 * MiB, WS_W1T = 46 * MiB, WS_W2T = 174 * MiB;
constexpr size_t WS_A = 240 * MiB;
constexpr size_t WS_A1 = WS_A, WS_CC = WS_A, WS_XBCPRE = WS_A + 68 * MiB, WS_Z = WS_A + 238 * MiB, WS_V = WS_A + 334 * MiB, WS_XBC = WS_A;
constexpr size_t WS_ST = WS_A + 366 * MiB, WS_Y = WS_A + 570 * MiB, WS_YB = WS_A + 666 * MiB;
constexpr size_t WS_A2 = WS_XBCPRE, WS_X1 = WS_A + 366 * MiB, WS_H2 = WS_A + 494 * MiB, WS_ACT = WS_A, WS_YS = WS_A + 494 * MiB;
constexpr size_t WS_END = WS_A + 766 * MiB;
static_assert(WS_END <= 1024 * MiB, "workspace map");
static_assert((size_t)RTOT * D * 2 <= 68 * MiB && (size_t)RTOT * CONV_CH * 2 <= 170 * MiB && (size_t)MAX_SLOTS * D * 2 <= 272 * MiB, "workspace map sizes");
static_assert((size_t)NB * NCC * NH * 2 * 8192 * 2 <= 204 * MiB, "ST size");
constexpr int CW_TMO = 0, CW_GCOUNT = 64  , CW_BAR = 4096;

constexpr int LDS_BYTES = 163840;
constexpr int MISC_OFF = LDS_BYTES - 256;
constexpr int TE_OFF = 131072;
constexpr int MOE_CNT_OFF = TE_OFF + 4096;
constexpr int TBL_OFF = TE_OFF + 8192;

namespace pg8 {
constexpr int BM = 256, BK = 64, HALF = 128, HTB = HALF * BK * 2, STAGE_BYTES = 8 * HTB, NXCD = 8, WGM = 8;
__host__ __device__ __forceinline__ int lds_byte(int r, int c) { const int st = (r >> 4) * 2 + (c >> 5), rr = r & 15, cc = c & 31, ob = rr * 64 + cc * 2; return st * 1024 + (ob ^ (((ob >> 9) & 1) << 5)); }
__host__ __device__ __forceinline__ void stage_rc(int b, int& R, int& C) { const int st = b / 1024, sb = b % 1024, swz = sb ^ (((sb >> 9) & 1) << 5); R = (st >> 1) * 16 + swz / 64; C = (st & 1) * 32 + (swz % 64) / 2; }
__host__ __device__ __forceinline__ int perm32(int rho) { const int n = rho >> 4, i = rho & 15; return 8 * (i >> 2) + 4 * n + (i & 3); }
struct Unit { int pm, pn, e; };
__device__ __forceinline__ unsigned cvt_pk_bf16(float lo, float hi) { unsigned r; asm volatile("v_cvt_pk_bf16_f32 %0, %1, %2" : "=v"(r) : "v"(lo), "v"(hi)); return r; }

__device__ __forceinline__ void static_map(int wgid, int nM, int nN, int& pm, int& pn) {
    const int nwg = nM * nN;
    { const int q = nwg / NXCD, r = nwg % NXCD, xcd = wgid % NXCD, off = wgid / NXCD; wgid = (xcd < r ? xcd * (q + 1) : r * (q + 1) + (xcd - r) * q) + off; }
    const int nig = WGM * nN, gid = wgid / nig, fm = gid * WGM, gsz = (nM - fm) < WGM ? (nM - fm) : WGM;
    pm = fm + ((wgid % nig) % gsz); pn = (wgid % nig) / gsz;
}

typedef int i32x8 __attribute__((ext_vector_type(8)));
typedef int v4i_t __attribute__((ext_vector_type(4)));
template <class Epi, class Sched, bool GATHER, bool FP8 = false, bool ALIGN_EPI = true>
__device__ __forceinline__ void gemm_phase(LAS unsigned char* lds, const int K, const Sched& S, const Epi& E) {
    int tid = threadIdx.x; asm volatile("" : "+v"(tid));
    const int wid = __builtin_amdgcn_readfirstlane(tid >> 6), lane = tid & 63, wr = wid >> 2, wc = wid & 3, fr = lane & 15, fq = lane >> 4;
    constexpr int ES = FP8 ? 1 : 2, KOFF = FP8 ? 16 : 1024;
    const int nt = K / (FP8 ? 2 * BK : BK);
    unsigned voffB[2]; int RA[2], CA[2];
#pragma unroll
    for (int i = 0; i < 2; ++i) { int R, C; stage_rc(tid * 16 + i * 8192, R, C); const int Rb = Epi::PERM ? ((R & ~31) + perm32(R & 31)) : R;
        RA[i] = R; CA[i] = C; voffB[i] = (unsigned)(Rb * K * ES + C * 2); }
    const size_t kstep = (size_t)(BK * 2);
    const size_t hstep = (size_t)HALF * K * ES;
    const unsigned ldsw = (unsigned)wid * 1024u;
    const int aoff = lds_byte(wr * 64 + fr, fq * (FP8 ? 16 : 8)), boff = lds_byte(wc * 32 + fr, fq * (FP8 ? 16 : 8));
#define PG8_SA(b, h) (((b) * 2 + (h)) * HTB)
#define PG8_SB(b, h) ((4 + (b) * 2 + (h)) * HTB)
#define PG8_STAGE(bufoff, gbase, voff) do { _Pragma("unroll") for (int _i = 0; _i < 2; ++_i) \
        __builtin_amdgcn_global_load_lds((const unsigned*)((const char*)(gbase) + (voff)[_i]), (LAS unsigned*)(lds + (bufoff) + ldsw + _i * 8192), 16, 0, 0); } while (0)
#define PG8_LDA(dst, b, h) do { _Pragma("unroll") for (int m = 0; m < 4; ++m) _Pragma("unroll") for (int k = 0; k < 2; ++k) dst[m][k] = *(const LAS bf16x8*)(lds + PG8_SA(b, h) + aoff + m * 2048 + k * KOFF); } while (0)
#define PG8_LDB(dst, b, h) do { _Pragma("unroll") for (int n = 0; n < 2; ++n) _Pragma("unroll") for (int k = 0; k < 2; ++k) dst[n][k] = *(const LAS bf16x8*)(lds + PG8_SB(b, h) + boff + n * 2048 + k * KOFF); } while (0)
#define PG8_CAT(lo, hi) __builtin_shufflevector(__builtin_bit_cast(v4i_t, lo), __builtin_bit_cast(v4i_t, hi), 0, 1, 2, 3, 4, 5, 6, 7)
#define PG8_MMA(ai, bj, At, Bt) do { __builtin_amdgcn_s_setprio(1); \
        if constexpr (FP8) { _Pragma("unroll") for (int m = 0; m < 4; ++m) _Pragma("unroll") for (int n = 0; n < 2; ++n) \
            acc[ai][bj][m][n] = __builtin_amdgcn_mfma_scale_f32_16x16x128_f8f6f4(PG8_CAT(Bt[n][0], Bt[n][1]), PG8_CAT(At[m][0], At[m][1]), acc[ai][bj][m][n], 0, 0, 0, 0x7f7f7f7f, 0, 0x7f7f7f7f); } \
        else { _Pragma("unroll") for (int m = 0; m < 4; ++m) _Pragma("unroll") for (int n = 0; n < 2; ++n) _Pragma("unroll") for (int k = 0; k < 2; ++k) \
            acc[ai][bj][m][n] = __builtin_amdgcn_mfma_f32_16x16x32_bf16(Bt[n][k], At[m][k], acc[ai][bj][m][n], 0, 0, 0); } \
        __builtin_amdgcn_s_setprio(0); } while (0)
#define PG8_WAIT_V(n) asm volatile("s_waitcnt vmcnt(" #n ")" ::: "memory")
#define PG8_WAIT_L(n) asm volatile("s_waitcnt lgkmcnt(" #n ")" ::: "memory")
#define PG8_BAR __builtin_amdgcn_s_barrier()
#define PG8_SCHED __builtin_amdgcn_sched_barrier(0)
#define PG8_AOFFS(U, dst) do { \
        if constexpr (GATHER) { int t_ = tid, R_, C_; asm volatile("" : "+v"(t_)); stage_rc(t_ * 16, R_, C_);     \
            const int* st_ = S.row_table(U) + R_; _Pragma("unroll") for (int _h = 0; _h < 2; ++_h) _Pragma("unroll") for (int _i = 0; _i < 2; ++_i) \
            dst[_h][_i] = (unsigned)st_[_h * HALF + _i * 64] * (unsigned)(K * ES) + (unsigned)(C_ * 2); } \
        else { _Pragma("unroll") for (int _h = 0; _h < 2; ++_h) _Pragma("unroll") for (int _i = 0; _i < 2; ++_i) dst[_h][_i] = (unsigned)((_h * HALF + RA[_i]) * K * ES + CA[_i] * 2); } } while (0)
#define PG8_AOFFS_NEXT(dst) do { if constexpr (false) { int t_ = tid, R_, C_; asm volatile("" : "+v"(t_)); stage_rc(t_ * 16, R_, C_); \
            const LAS int* st_ = (const LAS int*)(S.tb + ((ui + 1) % 3) * 1024) + R_; _Pragma("unroll") for (int _h = 0; _h < 2; ++_h) _Pragma("unroll") for (int _i = 0; _i < 2; ++_i) \
            dst[_h][_i] = (unsigned)st_[_h * HALF + _i * 64] * (unsigned)(K * ES) + (unsigned)(C_ * 2); } else { PG8_AOFFS(nxt, dst); } } while (0)
    Unit cur, nxt; int ui = 0;
    if (!S.next(0, cur)) return;
    f32x4 acc[2][2][4][2];
#pragma unroll
    for (int a = 0; a < 2; ++a)
#pragma unroll
        for (int b = 0; b < 2; ++b)
#pragma unroll
            for (int m = 0; m < 4; ++m)
#pragma unroll
                for (int n = 0; n < 2; ++n) acc[a][b][m][n] = (f32x4){0.f, 0.f, 0.f, 0.f};
    bf16x8 At[4][2], B0[2][2], B1[2][2];
    unsigned oc[2][2];
    const char* cA = S.a_base(cur); const char* cB = S.b_base(cur);
    PG8_AOFFS(cur, oc);
#define PG8_TABLES(U, buf) do { if constexpr (Sched::TBL) { LAS unsigned char* tb_ = S.tb + (buf) * 1024;   \
        if (wid < 4) { if (S.tab2(U)) __builtin_amdgcn_global_load_lds((const unsigned*)(S.tab2(U) + 64 * wid + lane), (LAS unsigned*)(tb_ + 6144 + wid * 256), 4, 0, 0); } \
        else { __builtin_amdgcn_global_load_lds((const unsigned*)(S.tab1(U) + 64 * (wid - 4) + lane), (LAS unsigned*)(tb_ + 3072 + (wid - 4) * 256), 4, 0, 0); } } } while (0)
    PG8_TABLES(cur, 0);
    PG8_STAGE(PG8_SB(0, 0), cB, voffB); PG8_STAGE(PG8_SB(0, 1), cB + hstep, voffB); PG8_STAGE(PG8_SA(0, 0), cA, oc[0]); PG8_STAGE(PG8_SA(0, 1), cA, oc[1]);
    if (wr == 1) PG8_BAR;
    PG8_WAIT_V(2); PG8_BAR;
    PG8_STAGE(PG8_SB(1, 0), cB + kstep, voffB); PG8_STAGE(PG8_SA(1, 0), cA + kstep, oc[0]); PG8_STAGE(PG8_SB(1, 1), cB + hstep + kstep, voffB);
    PG8_WAIT_V(6); PG8_BAR;
    for (;;) {
        const bool has_next = S.next(ui + 1, nxt);
        const char* nA = has_next ? S.a_base(nxt) : cA; const char* nB = has_next ? S.b_base(nxt) : cB;
        if (has_next) { PG8_TABLES(nxt, (ui + 1) % 3); }
        for (int t = 0; t < nt; t += 2) {
            const bool last = (t == nt - 2);
            const char* a1 = cA + (size_t)(t + 1) * kstep;
            const char* a2 = last ? nA : cA + (size_t)(t + 2) * kstep; const char* b2 = last ? nB : cB + (size_t)(t + 2) * kstep;
            const char* a3 = a2 + kstep; const char* b3 = b2 + kstep;
            PG8_LDB(B0, 0, 0); PG8_LDB(B1, 0, 1); PG8_SCHED; PG8_LDA(At, 0, 0); PG8_STAGE(PG8_SA(1, 1), a1, oc[1]);
            PG8_WAIT_V(8); PG8_WAIT_L(0); PG8_BAR; PG8_MMA(0, 0, At, B0); PG8_MMA(0, 1, At, B1); PG8_BAR; PG8_SCHED;
            if (last && has_next) { PG8_AOFFS_NEXT(oc); }
            PG8_LDA(At, 0, 1); PG8_STAGE(PG8_SB(0, 0), b2, voffB); PG8_STAGE(PG8_SB(0, 1), b2 + hstep, voffB); PG8_STAGE(PG8_SA(0, 0), a2, oc[0]);
            PG8_WAIT_V(8); PG8_WAIT_L(0); PG8_BAR; PG8_MMA(1, 0, At, B0); PG8_MMA(1, 1, At, B1); PG8_BAR; PG8_SCHED;
            PG8_LDB(B0, 1, 0); PG8_LDB(B1, 1, 1); PG8_SCHED; PG8_LDA(At, 1, 0); PG8_STAGE(PG8_SA(0, 1), a2, oc[1]);
            PG8_WAIT_V(8); PG8_WAIT_L(0); PG8_BAR; PG8_MMA(0, 0, At, B0); PG8_MMA(0, 1, At, B1); PG8_BAR; PG8_SCHED;
            PG8_LDA(At, 1, 1); PG8_STAGE(PG8_SB(1, 0), b3, voffB); PG8_STAGE(PG8_SB(1, 1), b3 + hstep, voffB); PG8_STAGE(PG8_SA(1, 0), a3, oc[0]);
            PG8_WAIT_V(8); PG8_WAIT_L(0); PG8_BAR; PG8_MMA(1, 0, At, B0); PG8_MMA(1, 1, At, B1); PG8_BAR; PG8_SCHED;
        }
        if constexpr (ALIGN_EPI) { if (wr == 0) PG8_BAR; }
        if constexpr (Sched::TBL) E(acc, cur, wr, wc, fr, fq, S.tb + (ui % 3) * 1024); else E(acc, cur, wr, wc, fr, fq);
        if (!has_next) break;
#pragma unroll
        for (int a = 0; a < 2; ++a)
#pragma unroll
            for (int b = 0; b < 2; ++b)
#pragma unroll
                for (int m = 0; m < 4; ++m)
#pragma unroll
                    for (int n = 0; n < 2; ++n) acc[a][b][m][n] = (f32x4){0.f, 0.f, 0.f, 0.f};
        cur = nxt; cA = nA; cB = nB; ++ui;
        if constexpr (ALIGN_EPI) { if (wr == 1) PG8_BAR; }
    }
    PG8_WAIT_V(0);
    if constexpr (!ALIGN_EPI) { if (wr == 0) PG8_BAR; }
    PG8_BAR;
#undef PG8_SA
#undef PG8_SB
#undef PG8_STAGE
#undef PG8_LDA
#undef PG8_LDB
#undef PG8_MMA
#undef PG8_WAIT_V
#undef PG8_WAIT_L
#undef PG8_BAR
#undef PG8_SCHED
#undef PG8_AOFFS
#undef PG8_AOFFS_NEXT
#undef PG8_TABLES
#undef PG8_CAT
}
}

#define XB_TMO      128
#define XB_XCNT(j)  (256  + 64 * (j))
#define XB_XSUB(j)  (1280 + 64 * (j))
#define XB_XGEN(j)  (2304 + 64 * (j))
#define XB_TOP      3328
#define XB_TOPGEN   3392
#define XCD_BAR_WORDS 3456
#define XB_SPIN_CAP (1u << 18)
__device__ __forceinline__ unsigned xb_ld(unsigned* p)              { return __hip_atomic_load(p, __ATOMIC_RELAXED, __HIP_MEMORY_SCOPE_AGENT); }
__device__ __forceinline__ unsigned xb_add(unsigned* p, unsigned v) { return __hip_atomic_fetch_add(p, v, __ATOMIC_RELAXED, __HIP_MEMORY_SCOPE_AGENT); }
__device__ __forceinline__ unsigned xb_xcc_id() { return (unsigned)__builtin_amdgcn_s_getreg((3 << 11) | 20) & 0xFu; }
#define XB_SPIN(cond, bar) do { unsigned _sp = 0; while (cond) { __builtin_amdgcn_s_sleep(1); \
    if ((++_sp & 255u) == 0u) { if (xb_ld(&(bar)[XB_TMO])) break; if (_sp > XB_SPIN_CAP) { atomicAdd(&(bar)[XB_TMO], 1u); break; } } } } while (0)
struct XcdBarrier { unsigned* bar; unsigned x; volatile LAS unsigned* st; };
__device__ __forceinline__ XcdBarrier xcd_barrier_post(unsigned* bar, volatile LAS unsigned* st) {
    XcdBarrier b; b.bar = bar; b.x = xb_xcc_id(); b.st = st;
    if (threadIdx.x == 0) (void)xb_add(&bar[XB_XCNT(b.x)], 1u);
    return b;
}
__device__ __forceinline__ void xcd_barrier_complete(unsigned* bar, unsigned x, unsigned& nloc, unsigned& nx) {
    const unsigned G = gridDim.x * gridDim.y * gridDim.z;
    unsigned sum, cnt, mine, sp = 0u;
    for (;;) {
        sum = 0u; cnt = 0u; mine = 0u;
#pragma unroll
        for (unsigned j = 0; j < 16; ++j) { const unsigned c = xb_ld(&bar[XB_XCNT(j)]); sum += c; cnt += (c > 0u) ? 1u : 0u; mine = (j == x) ? c : mine; }
        if (sum == G) break;
        __builtin_amdgcn_s_sleep(1);
        if ((++sp & 255u) == 0u) { if (xb_ld(&bar[XB_TMO])) break; if (sp > XB_SPIN_CAP) { atomicAdd(&bar[XB_TMO], 1u); break; } }
    }
    nloc = mine > 0u ? mine : 1u; nx = cnt > 0u ? cnt : 1u;
}
__device__ __forceinline__ void xcd_barrier(const XcdBarrier& b) {
    asm volatile("s_waitcnt vmcnt(0)" ::: "memory");
    __syncthreads();
    if (threadIdx.x == 0) {
        unsigned* bar = b.bar;
        __builtin_amdgcn_s_waitcnt(0);
        unsigned nloc = b.st[0], nx = b.st[1];
        if (nloc == 0u) { xcd_barrier_complete(bar, b.x, nloc, nx); b.st[0] = nloc; b.st[1] = nx; }
        const unsigned old = xb_add(&bar[XB_XSUB(b.x)], 1u);
        const unsigned gen = old / nloc;
        if (old + 1u == (gen + 1u) * nloc) {
            __builtin_amdgcn_fence(__ATOMIC_RELEASE, "agent");
            asm volatile("s_waitcnt vmcnt(0)" ::: "memory");
            const unsigned og = xb_add(&bar[XB_TOP], 1u);
            const unsigned tg = og / nx;
            if (og + 1u == (tg + 1u) * nx) xb_add(&bar[XB_TOPGEN], 1u);
            else XB_SPIN(xb_ld(&bar[XB_TOPGEN]) == tg, bar);
            __builtin_amdgcn_fence(__ATOMIC_ACQUIRE, "agent");
            xb_add(&bar[XB_XGEN(b.x)], 1u);
            asm volatile("s_waitcnt vmcnt(0)" ::: "memory");
        } else {
            XB_SPIN(xb_ld(&bar[XB_XGEN(b.x)]) == gen, bar);
            __builtin_amdgcn_fence(__ATOMIC_ACQUIRE, "agent");
            asm volatile("s_waitcnt vmcnt(0)" ::: "memory");
        }
    }
    __syncthreads();
}

struct Frame {
    LAS unsigned char* lds;
    unsigned* ctl;
    int tid, lane, wave, G;
    const float *x, *c, *ctx, *c_ctx, *w_mod, *b_mod, *norm1_w, *norm2_w, *w_in, *conv_w, *conv_b, *dt_bias, *a_log, *d_skip, *ssd_norm_w, *pool_w, *pool_scale, *w_out, *router_w, *router_b, *w1, *b1, *w2, *b2, *final_norm_w;
    float* out;
    float *MOD, *DTRAW, *DT, *ROWSC, *CHS, *TOPG, *SLOTGATE;
    bf16* X1;
    int *TOPE, *TOPR, *TOKSLOT, *SLOTTOK, *SLOTID, *ROWID, *BB;
    bf16 *WINT, *WOUTT, *W1T, *W2T, *A1, *XBCPRE, *Z, *V, *XBC, *CC, *ST, *Y, *YB, *A2, *H2, *ACT, *YS;
};

template <class RowMap>
__device__ __forceinline__ void p0_emit(bf16* WT, int Kd, RowMap rm, int k0, int n0, int nvalid, LAS float* scr, int lane) {
    const int c = lane & 7;
#pragma unroll
    for (int j = 0; j < 4; ++j) { const int n = (lane >> 3) + 8 * j; const LAS float* s = scr + (8 * c) * 33 + n;
        v4u o; o.x = pk2(s[0 * 33], s[1 * 33]); o.y = pk2(s[2 * 33], s[3 * 33]); o.z = pk2(s[4 * 33], s[5 * 33]); o.w = pk2(s[6 * 33], s[7 * 33]);
        if (n0 + n < nvalid) *(v4u*)(WT + (size_t)rm(n0 + n) * Kd + k0 + 8 * c) = o; }
    LDS_WAIT(); asm volatile("" ::: "memory");
}
template <class RowMap>
__device__ __forceinline__ void p0_transpose_item(const float* W, int N, int nvalid, bf16* WT, int Kd, RowMap rm, LAS float* scr, int kb, int nb, int lane) {
    const int k0 = 64 * kb, n0 = 32 * nb, nn = n0 + (lane & 31); const bool ok = nn < nvalid;
    float tv[32];
#pragma unroll
    for (int i = 0; i < 32; ++i) { const int kk = 2 * i + (lane >> 5); tv[i] = ok ? W[(size_t)(k0 + kk) * N + nn] : 0.f; }
#pragma unroll
    for (int i = 0; i < 32; ++i) { const int kk = 2 * i + (lane >> 5); scr[kk * 33 + (lane & 31)] = tv[i]; }
    LDS_WAIT(); asm volatile("" ::: "memory");
    p0_emit(WT, Kd, rm, k0, n0, nvalid, scr, lane);
}
struct RmId { __device__ __forceinline__ int operator()(int n) const { return n; } };
struct RmOff { int off; __device__ __forceinline__ int operator()(int n) const { return n + off; } };
struct RmWin { __device__ __forceinline__ int operator()(int n) const { return n < 2560 ? n : (n < 2608 ? 4608 + (n - 2560) : 2560 + (n - 2608)); } };
struct RmW1 { __device__ __forceinline__ int operator()(int n) const { const int j = n >> 1; return 256 * (j >> 7) + 128 * (n & 1) + (j & 127); } };

__device__ __forceinline__ void p0_prologue(Frame& F) {
    if ((int)blockIdx.x < 96) {
        LAS float* sc = (LAS float*)F.lds;
        LAS float* part = (LAS float*)(F.lds + 36864);
        for (int idx = F.tid; idx < 9 * 1024; idx += 512) { const int r = idx >> 10, k = idx & 1023; const float v = (r < 8) ? F.c[r * 1024 + k] : F.c_ctx[k]; sc[idx] = silu_f(v); }
        __syncthreads();
        const int n = 64 * (int)blockIdx.x + F.lane, kb = 128 * F.wave;
        float acc[9];
#pragma unroll
        for (int r = 0; r < 9; ++r) acc[r] = 0.f;
#pragma unroll 8
        for (int k = 0; k < 128; ++k) { const float wv = F.w_mod[(size_t)(kb + k) * 6144 + n];
#pragma unroll
            for (int r = 0; r < 9; ++r) acc[r] += sc[r * 1024 + kb + k] * wv; }
#pragma unroll
        for (int r = 0; r < 9; ++r) part[(F.wave * 9 + r) * 64 + F.lane] = acc[r];
        __syncthreads();
        for (int idx = F.tid; idx < 9 * 64; idx += 512) { const int r = idx >> 6, col = idx & 63; float s = 0.f;
#pragma unroll
            for (int w = 0; w < 8; ++w) s += part[(w * 9 + r) * 64 + col];
            F.MOD[r * 6144 + 64 * (int)blockIdx.x + col] = s + F.b_mod[64 * (int)blockIdx.x + col]; }
        __syncthreads();
    }
    LAS float* scr = (LAS float*)(F.lds + F.wave * 16384);
    const int gw = (int)blockIdx.x * 8 + F.wave, NGW = F.G * 8, lane = F.lane;
    constexpr int I_POOL = 16 * 4 * 4, I_PAD = N1 - IN_COLS;
    for (int r = NGW - 1 - gw; r < I_POOL + I_PAD; r += NGW) {
        if (r < I_POOL) {
            const int kb = r >> 4, g = (r >> 2) & 3, ob = r & 3, k = 64 * kb + lane, o0 = 32 * ob;
            float acc[32];
#pragma unroll
            for (int o = 0; o < 32; ++o) acc[o] = 0.f;
            const float* arow = F.w_in + (size_t)k * IN_COLS + 4144 + g * 128;
            for (int i = 0; i < 128; ++i) { const float a = arow[i]; const float* pw = F.pool_w + (size_t)(g * 128 + i) * 128 + o0;
#pragma unroll
                for (int o = 0; o < 32; ++o) acc[o] += a * pw[o]; }
#pragma unroll
            for (int o = 0; o < 32; ++o) scr[lane * 33 + o] = acc[o] * F.pool_scale[g * 128 + o0 + o];
            LDS_WAIT(); asm volatile("" ::: "memory");
            p0_emit(F.WINT, D, RmOff{4096 + g * 128}, 64 * kb, o0, 1 << 30, scr, lane);
        } else { v4u z = {0u, 0u, 0u, 0u}; v4u* p = (v4u*)(F.WINT + (size_t)(IN_COLS + (r - I_POOL)) * D); p[lane] = z; p[lane + 64] = z; }
    }
    for (int i = (int)blockIdx.x * 512 + F.tid; i < T; i += F.G * 512) F.ROWID[i] = i;
    constexpr int I_WIN = 16 * 130, I_WOUT = 32 * 32, I_W1 = 32 * 16 * 64, I_W2 = 32 * 16 * 32, NI = I_WIN + I_WOUT + I_W1 + I_W2;
    const bool wdeal = (F.G == 256);
    const int blk = (int)blockIdx.x;
#define P0_ITEM(k) (wdeal ? ((k) < 20 ? (k) * 2048 + gw : ((k) < 27 ? (blk >= 96 ? 40960 + ((k) - 20) * 1280 + (gw - 768) : -1) : ((k) < 30 ? ((blk >= 96 && blk < 198) ? 49920 + ((k) - 27) * 816 + (gw - 768) : -1) : -1))) : (k) * NGW + gw)
    const int nrounds = wdeal ? 30 : (NI + NGW - 1) / NGW;
    struct It { const float* src; bf16* dst; int N, nvalid, Kd, kind, k0, n0; };
#define P0_DECODE(it, I) do { int r_ = (it); \
        if (r_ < I_WIN) { I.src = F.w_in; I.dst = F.WINT; I.N = IN_COLS; I.nvalid = 4144; I.Kd = D; I.kind = 1; I.k0 = 64 * (r_ / 130); I.n0 = 32 * (r_ % 130); } \
        else if ((r_ -= I_WIN) < I_WOUT) { I.src = F.w_out; I.dst = F.WOUTT; I.N = D; I.nvalid = D; I.Kd = 2048; I.kind = 3; I.k0 = 64 * (r_ >> 5); I.n0 = 32 * (r_ & 31); } \
        else if ((r_ -= I_WOUT) < I_W1) { const int e_ = r_ >> 10, q_ = r_ & 1023; I.src = F.w1 + (size_t)e_ * D * 2048; I.dst = (bf16*)((unsigned char*)F.W1T + (size_t)e_ * 2048 * D); I.N = 2048; I.nvalid = 2048; I.Kd = D; I.kind = 2; I.k0 = 64 * (q_ >> 6); I.n0 = 32 * (q_ & 63); } \
        else { r_ -= I_W1; const int e_ = r_ >> 9, q_ = r_ & 511; I.src = F.w2 + (size_t)e_ * D * D; I.dst = (bf16*)((unsigned char*)F.W2T + (size_t)e_ * D * D); I.N = D; I.nvalid = D; I.Kd = D; I.kind = 3; I.k0 = 64 * (q_ >> 5); I.n0 = 32 * (q_ & 31); } } while (0)
#define P0_LOAD(I, tv) do { int nn_ = I.n0 + (lane & 31); nn_ = nn_ < I.nvalid ? nn_ : I.nvalid - 1; const float* sp_ = I.src + (size_t)(I.k0 + (lane >> 5)) * I.N + nn_; \
        _Pragma("unroll") for (int i_ = 0; i_ < 32; ++i_) { const float* q_ = sp_ + (size_t)(2 * i_) * I.N; asm volatile("global_load_dword %0, %1, off" : "=v"(tv[i_]) : "v"(q_) : "memory"); } } while (0)
#define P0_NEXT(itv) do { itv = -1; for (; kr < nrounds && itv < 0; ++kr) { const int it_ = P0_ITEM(kr); if (it_ >= 0 && it_ < NI) itv = it_; } } while (0)
#define P0_PROCESS(I, tv) do { \
        _Pragma("unroll") for (int i = 0; i < 32; ++i) { const int kk = 2 * i + (lane >> 5); scr[kk * 33 + (lane & 31)] = tv[i]; } \
        LDS_WAIT(); asm volatile("" ::: "memory"); \
        { const int c = lane & 7; \
          _Pragma("unroll") for (int j = 0; j < 4; ++j) { const int n = (lane >> 3) + 8 * j; const LAS float* sq = scr + (8 * c) * 33 + n; \
            const int ng = I.n0 + n; const int row = (I.kind == 0 || I.kind == 3) ? ng : (I.kind == 1 ? RmWin{}(ng) : RmW1{}(ng)); \
            if (I.kind >= 2) { v2u o; o.x = pk4_fp8(sq[0 * 33] * WSCALE, sq[1 * 33] * WSCALE, sq[2 * 33] * WSCALE, sq[3 * 33] * WSCALE); o.y = pk4_fp8(sq[4 * 33] * WSCALE, sq[5 * 33] * WSCALE, sq[6 * 33] * WSCALE, sq[7 * 33] * WSCALE); \
                *(v2u*)((unsigned char*)I.dst + (size_t)row * I.Kd + I.k0 + 8 * c) = o; } \
            else { v4u o; o.x = pk2(sq[0 * 33], sq[1 * 33]); o.y = pk2(sq[2 * 33], sq[3 * 33]); o.z = pk2(sq[4 * 33], sq[5 * 33]); o.w = pk2(sq[6 * 33], sq[7 * 33]); \
                if (ng < I.nvalid) *(v4u*)(I.dst + (size_t)row * I.Kd + I.k0 + 8 * c) = o; } } \
          LDS_WAIT(); asm volatile("" ::: "memory"); } } while (0)
    It ia{}, ib{}; float ta[32], tb[32]; int ita = -1, itb = -1; int kr = 0;
    P0_NEXT(ita);
    if (ita >= 0) { P0_DECODE(ita, ia); P0_LOAD(ia, ta); }
    while (ita >= 0) {
        P0_NEXT(itb);
        if (itb >= 0) { P0_DECODE(itb, ib); P0_LOAD(ib, tb); asm volatile("s_waitcnt vmcnt(32)" ::: "memory"); } else { asm volatile("s_waitcnt vmcnt(0)" ::: "memory"); }
        __builtin_amdgcn_sched_barrier(0);
        P0_PROCESS(ia, ta);
        if (itb < 0) break;
        P0_NEXT(ita);
        if (ita >= 0) { P0_DECODE(ita, ia); P0_LOAD(ia, ta); asm volatile("s_waitcnt vmcnt(32)" ::: "memory"); } else { asm volatile("s_waitcnt vmcnt(0)" ::: "memory"); }
        __builtin_amdgcn_sched_barrier(0);
        P0_PROCESS(ib, tb);
    }
#undef P0_NEXT
#undef P0_PROCESS
#undef P0_ITEM
#undef P0_DECODE
#undef P0_LOAD
}

__device__ __forceinline__ void p1_norm1(Frame& F) {
    const int gw = (int)blockIdx.x * 8 + F.wave, NGW = F.G * 8, lane = F.lane;
    const int per = (RTOT + NGW - 1) / NGW;
    for (int k0 = 0; k0 < per; k0 += 4) {
        f32x4 v[4][4];
#pragma unroll
        for (int k = 0; k < 4; ++k) { int r = gw + (k0 + k) * NGW; r = (k0 + k < per && r < RTOT) ? r : gw; const float* xr = (r < T) ? F.x + (size_t)r * D : F.ctx + (size_t)(r - T) * D;
#pragma unroll
            for (int j = 0; j < 4; ++j) v[k][j] = *(const f32x4*)(xr + 4 * lane + 256 * j); }
#pragma unroll
        for (int k = 0; k < 4; ++k) { const int r = gw + (k0 + k) * NGW; if (k0 + k < per && r < RTOT) {
            const float* mod = F.MOD + (size_t)((r < T) ? (r >> 12) : 8) * 6144;
            float ss = 0.f;
#pragma unroll
            for (int j = 0; j < 4; ++j) ss += (v[k][j].x * v[k][j].x + v[k][j].y * v[k][j].y) + (v[k][j].z * v[k][j].z + v[k][j].w * v[k][j].w);
            const float rs = __builtin_amdgcn_rsqf(wave_sum(ss) * (1.f / D) + RMS_EPS);
#pragma unroll
            for (int j = 0; j < 4; ++j) { const int col = 4 * lane + 256 * j;
                const f32x4 w = *(const f32x4*)(F.norm1_w + col), sh = *(const f32x4*)(mod + col), sc = *(const f32x4*)(mod + 1024 + col);
                const f32x4 h = (v[k][j] * rs) * w * (sc + 1.f) + sh;
                v2u o; o.x = pk2(h.x, h.y); o.y = pk2(h.z, h.w);
                *(v2u*)(F.A1 + (size_t)r * D + col) = o; } } }
    }
}

struct Sched1 {   static constexpr bool TBL = false;
    const char* A; const char* Bt; int G, c;
    __device__ __forceinline__ bool next(int i, pg8::Unit& u) const {
        const int L = i * G + c; if (L >= 2432 + 88) return false;
        if (L < 2432) pg8::static_map(L, 128, 19, u.pm, u.pn);
        else { const int Lc = L - 2432, j = Lc >> 3; u.pm = 128 + (Lc & 7); u.pn = j < 10 ? j : 18; }
        u.e = 0; return true; }
    __device__ __forceinline__ const char* a_base(const pg8::Unit& u) const { return A + (size_t)u.pm * 256 * D * 2; }
    __device__ __forceinline__ const char* b_base(const pg8::Unit& u) const { return Bt + (size_t)u.pn * 256 * D * 2; }
    __device__ __forceinline__ const int* row_table(const pg8::Unit&) const { return nullptr; }
};
struct Epi1 {
    static constexpr bool PERM = true;
    bf16 *XBCPRE, *Z, *V; float* DTRAW;
    __device__ __forceinline__ void operator()(const f32x4 (&acc)[2][2][4][2], const pg8::Unit& u, int wr, int wc, int fr, int fq) const {
        const int row0 = u.pm * 256 + wr * 64 + fr;
        if (u.pn < 18) {
            bf16* base; int ldc, colt;
            if (u.pn < 10) { base = XBCPRE; ldc = CONV_CH; colt = u.pn * 256; } else if (u.pn < 16) { base = Z; ldc = SSD_W; colt = (u.pn - 10) * 256; } else { base = V; ldc = 512; colt = (u.pn - 16) * 256; }
            const int col0 = colt + wc * 32 + 8 * fq;
#pragma unroll
            for (int ai = 0; ai < 2; ++ai)
#pragma unroll
                for (int m = 0; m < 4; ++m) { bf16* rowp = base + (size_t)(row0 + ai * 128 + m * 16) * ldc + col0;
#pragma unroll
                    for (int bj = 0; bj < 2; ++bj) { const f32x4 v0 = acc[ai][bj][m][0], v1 = acc[ai][bj][m][1];
                        v4u w; w.x = pg8::cvt_pk_bf16(v0[0], v0[1]); w.y = pg8::cvt_pk_bf16(v0[2], v0[3]); w.z = pg8::cvt_pk_bf16(v1[0], v1[1]); w.w = pg8::cvt_pk_bf16(v1[2], v1[3]);
                        *(v4u*)(rowp + bj * 128) = w; } }
        } else if (wc < 2) {
            const int col0 = wc * 32 + 8 * fq;
#pragma unroll
            for (int ai = 0; ai < 2; ++ai)
#pragma unroll
                for (int m = 0; m < 4; ++m) { float* rowp = DTRAW + (size_t)(row0 + ai * 128 + m * 16) * 64 + col0;
                    *(f32x4*)(rowp) = acc[ai][0][m][0]; *(f32x4*)(rowp + 4) = acc[ai][0][m][1]; }
        }
    }
};

__device__ __forceinline__ void p3_conv(Frame& F) {
    const int gt = (int)blockIdx.x * 512 + F.tid, NT_ = F.G * 512;
    constexpr int RPT = 16, NTASK = (RTOT / RPT) * 320;
    for (int task = gt; task < NTASK; task += NT_) {
        const int rt = task / 320, cg = task - rt * 320, r0 = rt * RPT, ch = cg * 8;
        int slo, shi; if (r0 < T) { slo = r0 & ~(SEQ - 1); shi = slo + SEQ; } else { slo = T + ((r0 - T) & ~(CTXL - 1)); shi = slo + CTXL; }
        const v4u zero = {0u, 0u, 0u, 0u};
        v4u win[RPT + 4];
#pragma unroll
        for (int j = 0; j < RPT + 4; ++j) { const int r = r0 - 2 + j; win[j] = (r >= slo && r < shi) ? *(const v4u*)(F.XBCPRE + (size_t)r * CONV_CH + ch) : zero; }
        float w[5][8], bias[8];
#pragma unroll
        for (int j = 0; j < 5; ++j) { const f32x4 a = *(const f32x4*)(F.conv_w + j * CONV_CH + ch), b = *(const f32x4*)(F.conv_w + j * CONV_CH + ch + 4);
            w[j][0] = a.x; w[j][1] = a.y; w[j][2] = a.z; w[j][3] = a.w; w[j][4] = b.x; w[j][5] = b.y; w[j][6] = b.z; w[j][7] = b.w; }
        { const f32x4 a = *(const f32x4*)(F.conv_b + ch), b = *(const f32x4*)(F.conv_b + ch + 4); bias[0] = a.x; bias[1] = a.y; bias[2] = a.z; bias[3] = a.w; bias[4] = b.x; bias[5] = b.y; bias[6] = b.z; bias[7] = b.w; }
#pragma unroll
        for (int i = 0; i < RPT; ++i) {
            float o[8];
#pragma unroll
            for (int e = 0; e < 8; ++e) o[e] = bias[e];
#pragma unroll
            for (int j = 0; j < 5; ++j) { const v4u q = win[i + j];
                o[0] += w[j][0] * bflo(q.x); o[1] += w[j][1] * bfhi(q.x); o[2] += w[j][2] * bflo(q.y); o[3] += w[j][3] * bfhi(q.y);
                o[4] += w[j][4] * bflo(q.z); o[5] += w[j][5] * bfhi(q.z); o[6] += w[j][6] * bflo(q.w); o[7] += w[j][7] * bfhi(q.w); }
            v4u ov; ov.x = pk2(silu_f(o[0]), silu_f(o[1])); ov.y = pk2(silu_f(o[2]), silu_f(o[3])); ov.z = pk2(silu_f(o[4]), silu_f(o[5])); ov.w = pk2(silu_f(o[6]), silu_f(o[7]));
            *(v4u*)(F.XBC + (size_t)(r0 + i) * CONV_CH + ch) = ov;
        }
    }
    for (int idx = gt; idx < RTOT * 48; idx += NT_) { const int r = idx / 48, j = idx - r * 48; const float v = F.DTRAW[(size_t)r * 64 + j] + F.dt_bias[j];
        F.DT[idx] = v > 20.f ? v : log1pf(__expf(v)); }
}

__device__ __forceinline__ bf16x8 frag_row(const LAS unsigned char* base, int rs, int row, int k0, int q) { return *(const LAS bf16x8*)(base + row * rs + (k0 + 8 * q) * 2); }
__device__ __forceinline__ bf16x8 frag_tr(const LAS unsigned char* base, int rs, int k0, int c0, int lane) {
    const int g = lane >> 4, qq = (lane & 15) >> 2, p = lane & 3;
    const LAS unsigned char* a = base + (k0 + 8 * g + qq) * rs + c0 * 2 + 8 * p;
    const s16x4 lo = __builtin_amdgcn_ds_read_tr16_b64_v4i16((LAS s16x4*)a);
    const s16x4 hi = __builtin_amdgcn_ds_read_tr16_b64_v4i16((LAS s16x4*)(a + 4 * rs));
    bf16x8 r; r[0] = lo[0]; r[1] = lo[1]; r[2] = lo[2]; r[3] = lo[3]; r[4] = hi[0]; r[5] = hi[1]; r[6] = hi[2]; r[7] = hi[3]; return r;
}
__device__ __forceinline__ f32x4 mfma16(bf16x8 a, bf16x8 b, f32x4 c) { return __builtin_amdgcn_mfma_f32_16x16x32_bf16(a, b, c, 0, 0, 0); }
__device__ __forceinline__ float wave_incl_scan(float v, int lane) {
#pragma unroll
    for (int o = 1; o < 64; o <<= 1) { const float t = __shfl_up(v, o); if (lane >= o) v += t; }
    return v;
}

__device__ __forceinline__ float silu_fast(float v) { return v * __builtin_amdgcn_rcpf(1.f + __builtin_amdgcn_exp2f(-1.44269504f * v)); }
__device__ __forceinline__ float softplus_f(float v) { return v > 20.f ? v : log1pf(__expf(v)); }
__device__ __forceinline__ void p4_scan(Frame& F, LAS float* Te, volatile LAS float* TOT, int d, int h, float raw0, float raw1, int lane, size_t chs_idx, float* rowsc) {
    const int s0 = d ? 127 - 2 * lane : 2 * lane, s1 = d ? s0 - 1 : s0 + 1;
    const float bias = F.dt_bias[d * NH + h];
    const float dt0 = softplus_f(raw0 + bias), dt1 = softplus_f(raw1 + bias);
    const float A2 = __expf(F.a_log[d * NH + h]) * 1.44269504f;
    const float a0 = -A2 * dt0, a1 = -A2 * dt1;
    const float incl = wave_incl_scan(a0 + a1, lane);
    const float c1 = incl, c0 = incl - a1, tot = __shfl(incl, 63);
    Te[d * 128 + s0] = c0; Te[d * 128 + s1] = c1;
    Te[(2 + d) * 128 + s0] = c0 - __builtin_amdgcn_logf(dt0); Te[(2 + d) * 128 + s1] = c1 - __builtin_amdgcn_logf(dt1);
    if (lane == 63) { F.CHS[chs_idx] = tot; *TOT = tot; }
    if (rowsc) { rowsc[s0] = __builtin_amdgcn_exp2f(c0); rowsc[s1] = __builtin_amdgcn_exp2f(c1); }
}
__device__ __forceinline__ v4u conv_piece(const v4u& r0, const v4u& r1, const v4u& r2, const v4u& r3, const v4u& r4, const float (&w)[5][8], const float (&bias)[8]) {
    float o[8];
#pragma unroll
    for (int e = 0; e < 8; ++e) o[e] = bias[e];
    const v4u rr[5] = {r0, r1, r2, r3, r4};
#pragma unroll
    for (int j = 0; j < 5; ++j) { const v4u q = rr[j];
        o[0] += w[j][0] * bflo(q.x); o[1] += w[j][1] * bfhi(q.x); o[2] += w[j][2] * bflo(q.y); o[3] += w[j][3] * bfhi(q.y);
        o[4] += w[j][4] * bflo(q.z); o[5] += w[j][5] * bfhi(q.z); o[6] += w[j][6] * bflo(q.w); o[7] += w[j][7] * bfhi(q.w); }
    v4u ov; ov.x = pk2(silu_fast(o[0]), silu_fast(o[1])); ov.y = pk2(silu_fast(o[2]), silu_fast(o[3])); ov.z = pk2(silu_fast(o[4]), silu_fast(o[5])); ov.w = pk2(silu_fast(o[6]), silu_fast(o[7]));
    return ov;
}
__device__ __forceinline__ void p4_states(Frame& F, const bf16x8 (&braw)[4], const LAS float* Te, const volatile LAS float* TOT2, const LAS unsigned char* Xs, size_t st_base, int w, int lane) {
    constexpr int RSX = 144;
    const int i16 = lane & 15, q4 = lane >> 4;
#pragma unroll
    for (int d = 0; d < 2; ++d) {
        const float tot = TOT2[d];
        f32x4 sa[4];
#pragma unroll
        for (int pt = 0; pt < 4; ++pt) sa[pt] = (f32x4){0.f, 0.f, 0.f, 0.f};
#pragma unroll
        for (int ks = 0; ks < 4; ++ks) {
            const LAS float* cp = Te + (2 + d) * 128 + 32 * ks + 8 * q4;
            const f32x4 c0 = *(const LAS f32x4*)cp, c1 = *(const LAS f32x4*)(cp + 4);
            float wv[8];
#pragma unroll
            for (int j = 0; j < 4; ++j) { wv[j] = __builtin_amdgcn_exp2f(tot - c0[j]); wv[4 + j] = __builtin_amdgcn_exp2f(tot - c1[j]); }
            const v4u bu = __builtin_bit_cast(v4u, braw[ks]); v4u su;
            su.x = pk2(bflo(bu.x) * wv[0], bfhi(bu.x) * wv[1]); su.y = pk2(bflo(bu.y) * wv[2], bfhi(bu.y) * wv[3]);
            su.z = pk2(bflo(bu.z) * wv[4], bfhi(bu.z) * wv[5]); su.w = pk2(bflo(bu.w) * wv[6], bfhi(bu.w) * wv[7]);
            const bf16x8 bs = __builtin_bit_cast(bf16x8, su);
#pragma unroll
            for (int pt = 0; pt < 4; ++pt) sa[pt] = mfma16(bs, frag_tr(Xs, RSX, 32 * ks, 16 * pt, lane), sa[pt]); }
        unsigned char* sp = (unsigned char*)F.ST + st_base + ((size_t)d * HDIM + i16) * NST + 16 * w + 4 * q4;
#pragma unroll
        for (int pt = 0; pt < 4; ++pt) { float c[4];
#pragma unroll
            for (int r = 0; r < 4; ++r) c[r] = fminf(fmaxf(sa[pt][r] * STSCALE, -440.f), 440.f);
            *(unsigned*)(sp + (size_t)16 * pt * NST) = pk4_fp8(c[0], c[1], c[2], c[3]); }
    }
}
__device__ __forceinline__ void p4_ssd_local(Frame& F) {
    constexpr int RS = 272, RSX = 144;
    constexpr int O_C = 0, O_B = 34816, O_M = 69632, O_X = 104448  , O_T = 141312  , O_CW = 153600  ;
    static_assert(O_CW + 9216 <= MISC_OFF, "P4 LDS map");
    LAS unsigned char* L = F.lds;
    LAS float* TAB = (LAS float*)(L + O_T);
    LAS float* CW = (LAS float*)(L + O_CW);
    volatile LAS float* TOT = (volatile LAS float*)(L + MISC_OFF + 64);
    volatile LAS float* DSK = (volatile LAS float*)(L + MISC_OFF + 128);
    const int tid = F.tid, w = F.wave;
    const int lb = 64 * (w & 1), sb = 32 * (w >> 1);
    const v4u zero4 = {0u, 0u, 0u, 0u};
    constexpr int NLAT = NB * 32 * NGRP, NCTX = NB * 2 * NGRP * HPG;
    int g_staged = -1;
    for (int v = (int)blockIdx.x; v < NLAT + NCTX; v += F.G) {
        const bool lat = v < NLAT;
        int tid_l = tid; asm volatile("" : "+v"(tid_l));
        const int lane_l = tid_l & 63, lane = lane_l, i16 = lane & 15, q4 = lane >> 4;
        const int p32 = tid_l & 31, rg = tid_l >> 5;
        const int xpc = tid_l & 7, rg2 = tid_l >> 3;
        int b, g, cc, r0, e_lo, e_hi; bool lo_ok, hi_ok;
        if (lat) { b = v >> 7; const int c = (v >> 2) & 31; g = v & 3; cc = c + 2; r0 = b * SEQ + c * CHUNK; lo_ok = c > 0; hi_ok = c < 31; e_lo = 0; e_hi = HPG; }
        else { const int q = v - NLAT; const int e = q % HPG; int t = q / HPG; g = t & 3; t >>= 2; cc = t & 1; b = t >> 1; r0 = T + b * CTXL + cc * CHUNK; lo_ok = cc > 0; hi_ok = cc < 1; e_lo = e; e_hi = e + 1; }
        const int rmin = lo_ok ? -2 : 0, rmax = hi_ok ? 129 : 127;
        const int chBC = SSD_W + (p32 >> 4) * (NGRP * NST) + g * NST + 8 * (p32 & 15);
        v4u raw[12];
#pragma unroll
        for (int j = 0; j < 12; ++j) { const int rr = 8 * rg - 2 + j; const int rc = rr < rmin ? rmin : (rr > rmax ? rmax : rr);
            const v4u t = *(const v4u*)(F.XBCPRE + (size_t)(r0 + rc) * CONV_CH + chBC); raw[j] = (rr == rc) ? t : zero4; }
        if (g != g_staged) {
            if (tid < HPG) DSK[tid] = F.d_skip[g * HPG + tid];
            float cwv[5];
#pragma unroll
            for (int q = 0; q < 5; ++q) { int idx = tid + 512 * q; idx = idx < HPG * 6 * 64 ? idx : HPG * 6 * 64 - 1; const int e_ = idx / 384, rem = idx - e_ * 384, j = rem >> 6, chl = rem & 63; const int ch = (g * HPG + e_) * HDIM + chl;
                const int jj = j < 5 ? j : 0; const float a = F.conv_w[jj * CONV_CH + ch], bq = F.conv_b[ch]; cwv[q] = (j < 5) ? a : bq; }
#pragma unroll
            for (int q = 0; q < 5; ++q) { const int idx = tid + 512 * q; if (idx < HPG * 6 * 64) CW[idx] = cwv[q]; }
            g_staged = g;
        }
        {
            float cw[5][8], cbias[8];
#pragma unroll
            for (int j = 0; j < 5; ++j) { const f32x4 a = *(const f32x4*)(F.conv_w + j * CONV_CH + chBC), bq = *(const f32x4*)(F.conv_w + j * CONV_CH + chBC + 4);
                cw[j][0] = a.x; cw[j][1] = a.y; cw[j][2] = a.z; cw[j][3] = a.w; cw[j][4] = bq.x; cw[j][5] = bq.y; cw[j][6] = bq.z; cw[j][7] = bq.w; }
            { const f32x4 a = *(const f32x4*)(F.conv_b + chBC), bq = *(const f32x4*)(F.conv_b + chBC + 4); cbias[0] = a.x; cbias[1] = a.y; cbias[2] = a.z; cbias[3] = a.w; cbias[4] = bq.x; cbias[5] = bq.y; cbias[6] = bq.z; cbias[7] = bq.w; }
            LAS unsigned char* dst = L + ((p32 >> 4) ? O_C : O_B) + (8 * rg) * RS + (p32 & 15) * 16;
#pragma unroll
            for (int i = 0; i < 8; ++i) { const v4u o = conv_piece(raw[i], raw[i + 1], raw[i + 2], raw[i + 3], raw[i + 4], cw, cbias);
                *(LAS v4u*)(dst + i * RS) = o;
                if (lat && (p32 >> 4)) *(v4u*)(F.CC + (size_t)(r0 + 8 * rg + i) * 512 + g * NST + 8 * (p32 & 15)) = o; }
        }
        v4u xraw[6];
#pragma unroll
        for (int j = 0; j < 6; ++j) { const int rr = 2 * rg2 - 2 + j; const int rc = rr < rmin ? rmin : (rr > rmax ? rmax : rr);
            xraw[j] = *(const v4u*)(F.XBCPRE + (size_t)(r0 + rc) * CONV_CH + (g * HPG + e_lo) * HDIM + 8 * xpc); }
        float pdt[2][2];
#pragma unroll
        for (int ii = 0; ii < 2; ++ii) { const int idx = (w + 8 * ii) < 12 ? (w + 8 * ii) : 11; const int e_ = idx % 6, d_ = idx / 6, h_ = g * HPG + e_; const int s0 = d_ ? 127 - 2 * lane_l : 2 * lane_l, s1 = d_ ? s0 - 1 : s0 + 1;
            pdt[ii][0] = F.DTRAW[(size_t)(r0 + s0) * 64 + d_ * NH + h_]; pdt[ii][1] = F.DTRAW[(size_t)(r0 + s1) * 64 + d_ * NH + h_]; }
#pragma unroll
        for (int ii = 0; ii < 2; ++ii) { const int idx = w + 8 * ii; const int e = idx % 6, d = idx / 6, h = g * HPG + e;
            if (idx < 12 && e >= e_lo && e < e_hi)
                p4_scan(F, TAB + e * 512, TOT + e * 2 + d, d, h, pdt[ii][0], pdt[ii][1], lane_l, ((size_t)(b * NCC + cc) * NH + h) * 2 + d, lat ? F.ROWSC + ((size_t)(b * 2 + d) * NH + h) * SEQ + (cc - 2) * CHUNK : nullptr); }
        __syncthreads();
        f32x4 cb[2][4];
        if (lat) {
#pragma unroll
            for (int ts = 0; ts < 2; ++ts)
#pragma unroll
                for (int tl = 0; tl < 4; ++tl) cb[ts][tl] = (f32x4){0.f, 0.f, 0.f, 0.f};
#pragma unroll
            for (int ks = 0; ks < 4; ++ks) { bf16x8 af[2], bfr[4];
#pragma unroll
                for (int ts = 0; ts < 2; ++ts) af[ts] = frag_row(L + O_B, RS, sb + 16 * ts + i16, 32 * ks, q4);
#pragma unroll
                for (int tl = 0; tl < 4; ++tl) bfr[tl] = frag_row(L + O_C, RS, lb + 16 * tl + i16, 32 * ks, q4);
#pragma unroll
                for (int ts = 0; ts < 2; ++ts)
#pragma unroll
                    for (int tl = 0; tl < 4; ++tl) cb[ts][tl] = mfma16(af[ts], bfr[tl], cb[ts][tl]); }
        }
        bf16x8 braw[4];
#pragma unroll
        for (int ks = 0; ks < 4; ++ks) braw[ks] = frag_tr(L + O_B, RS, 32 * ks, 16 * w, lane);
        for (int e = e_lo; e < e_hi; ++e) {
            const int h = g * HPG + e;
            const LAS float* Te = TAB + e * 512;
            LAS unsigned char* Xs = L + O_X + (e & 1) * 18432;
            LAS unsigned char* Ms = L + ((e & 1) ? O_C : O_M);
            {
                const LAS float* cwp = CW + (e * 6) * 64 + 8 * xpc;
#pragma unroll
                for (int i = 0; i < 2; ++i) {
                    f32x4 oa = *(const LAS f32x4*)(cwp + 5 * 64), ob = *(const LAS f32x4*)(cwp + 5 * 64 + 4);
#pragma unroll
                    for (int j = 0; j < 5; ++j) { const f32x4 wa = *(const LAS f32x4*)(cwp + j * 64), wb = *(const LAS f32x4*)(cwp + j * 64 + 4);
                        const int rr = 2 * rg2 - 2 + i + j; const v4u q = (rr >= rmin && rr <= rmax) ? xraw[i + j] : zero4;
                        oa.x += wa.x * bflo(q.x); oa.y += wa.y * bfhi(q.x); oa.z += wa.z * bflo(q.y); oa.w += wa.w * bfhi(q.y);
                        ob.x += wb.x * bflo(q.z); ob.y += wb.y * bfhi(q.z); ob.z += wb.z * bflo(q.w); ob.w += wb.w * bfhi(q.w); }
                    v4u ov; ov.x = pk2(silu_fast(oa.x), silu_fast(oa.y)); ov.y = pk2(silu_fast(oa.z), silu_fast(oa.w)); ov.z = pk2(silu_fast(ob.x), silu_fast(ob.y)); ov.w = pk2(silu_fast(ob.z), silu_fast(ob.w));
                    *(LAS v4u*)(Xs + (2 * rg2 + i) * RSX + xpc * 16) = ov; }
            }
            if (e + 1 < e_hi) {
#pragma unroll
                for (int j = 0; j < 6; ++j) { const int rr = 2 * rg2 - 2 + j; const int rc = rr < rmin ? rmin : (rr > rmax ? rmax : rr);
                    xraw[j] = *(const v4u*)(F.XBCPRE + (size_t)(r0 + rc) * CONV_CH + (h + 1) * HDIM + 8 * xpc); }
            }
            if (lat) {
                const float Dh = DSK[e];
#pragma unroll
                for (int tl = 0; tl < 4; ++tl) { const int l = lb + 16 * tl + i16; const int lt_abs = 4 * (w & 1) + tl; const float af_l = Te[l], rb_l = Te[128 + l];
#pragma unroll
                    for (int ts = 0; ts < 2; ++ts) { const int s0 = sb + 16 * ts + 4 * q4; const int st_abs = 2 * (w >> 1) + ts;
                        float m[4];
                        if (st_abs < lt_abs) {
                            const f32x4 acs = *(const LAS f32x4*)(Te + 256 + s0);
#pragma unroll
                            for (int r = 0; r < 4; ++r) m[r] = cb[ts][tl][r] * __builtin_amdgcn_exp2f(af_l - acs[r]);
                        } else if (st_abs > lt_abs) {
                            const f32x4 rbs = *(const LAS f32x4*)(Te + 384 + s0);
#pragma unroll
                            for (int r = 0; r < 4; ++r) m[r] = cb[ts][tl][r] * __builtin_amdgcn_exp2f(rb_l - rbs[r]);
                        } else {
                            const f32x4 acs = *(const LAS f32x4*)(Te + 256 + s0), rbs = *(const LAS f32x4*)(Te + 384 + s0);
#pragma unroll
                            for (int r = 0; r < 4; ++r) { const int sidx = s0 + r;
                                const float wf = (sidx <= l) ? __builtin_amdgcn_exp2f(af_l - acs[r]) : 0.f;
                                const float wb = (sidx >= l) ? __builtin_amdgcn_exp2f(rb_l - rbs[r]) : 0.f;
                                m[r] = cb[ts][tl][r] * (wf + wb) + ((sidx == l) ? Dh : 0.f); }
                        }
                        v2u o; o.x = pk2(m[0], m[1]); o.y = pk2(m[2], m[3]);
                        *(LAS v2u*)(Ms + l * RS + s0 * 2) = o; } }
            }
            __syncthreads();
            if (lat) {
                f32x4 ya[4];
#pragma unroll
                for (int pt = 0; pt < 4; ++pt) ya[pt] = (f32x4){0.f, 0.f, 0.f, 0.f};
#pragma unroll
                for (int ks = 0; ks < 4; ++ks) { const bf16x8 bm = frag_row(Ms, RS, 16 * w + i16, 32 * ks, q4);
#pragma unroll
                    for (int pt = 0; pt < 4; ++pt) ya[pt] = mfma16(frag_tr(Xs, RSX, 32 * ks, 16 * pt, lane), bm, ya[pt]); }
                bf16* yp = F.Y + (size_t)(r0 + 16 * w + i16) * SSD_W + h * HDIM + 4 * q4;
#pragma unroll
                for (int pt = 0; pt < 4; ++pt) { v2u o; o.x = pk2(ya[pt][0], ya[pt][1]); o.y = pk2(ya[pt][2], ya[pt][3]); *(v2u*)(yp + 16 * pt) = o; }
            }
            p4_states(F, braw, Te, TOT + e * 2, Xs, (((size_t)(b * NCC + cc) * NH + h) * 2) * HDIM * NST, w, lane);
        }
        __syncthreads();
    }
}

__device__ __forceinline__ void p5_ssd_scan(Frame& F) {
    constexpr int RS = 272, O_RS = 4 * 34816;
    LAS unsigned char* L = F.lds;
    LAS float* RSB = (LAS float*)(L + O_RS);
    const int tid = F.tid, lane = F.lane, w = F.wave, i16 = lane & 15, q4 = lane >> 4;
    const int d = w >> 2, ps = w & 3, t8 = tid & 255;
    for (int u = (int)blockIdx.x; u < NB * NH; u += F.G) {
        const int b = u / NH, h = u - b * NH, g = h / HPG;
        float S[32];
#pragma unroll
        for (int k = 0; k < 32; ++k) S[k] = 0.f;
        v4u creg[8]; float rsreg = 0.f;
#pragma unroll
        for (int k = 0; k < 8; ++k) creg[k] = (v4u){0u, 0u, 0u, 0u};
        for (int j = 0; j < NCC; ++j) {
            const int cc = d == 0 ? j : (j < 2 ? 1 - j : 35 - j);
            LAS unsigned char* Cb = L + ((j & 1) * 2 + d) * 34816;
            if (j >= 2) {
#pragma unroll
                for (int k = 0; k < 8; ++k) { const int pc = t8 + 256 * k, row = pc >> 4, ch = pc & 15; *(LAS v4u*)(Cb + row * RS + ch * 16) = creg[k]; }
                if (t8 < 128) RSB[((j & 1) * 2 + d) * 128 + t8] = rsreg;
            }
            __syncthreads();
            if (j + 1 >= 2 && j + 1 < NCC) {
                const int cn = d == 0 ? j + 1 : 34 - j;
                const size_t rown = (size_t)b * SEQ + (size_t)(cn - 2) * CHUNK;
#pragma unroll
                for (int k = 0; k < 8; ++k) { const int pc = t8 + 256 * k, row = pc >> 4, ch = pc & 15; creg[k] = *(const v4u*)(F.CC + (rown + row) * 512 + g * NST + ch * 8); }
                if (t8 < 128) rsreg = F.ROWSC[((size_t)(b * 2 + d) * NH + h) * SEQ + (cn - 2) * CHUNK + t8];
            }
            const size_t sidx = ((size_t)(b * NCC + cc) * NH + h) * 2 + d;
            const unsigned char* stp = (const unsigned char*)F.ST + (sidx * HDIM + 16 * ps + i16) * NST + 8 * q4;
            v2u stv[4];
#pragma unroll
            for (int ks = 0; ks < 4; ++ks) stv[ks] = *(const v2u*)(stp + 32 * ks);
            const float decay = __builtin_amdgcn_exp2f(F.CHS[sidx]);
            if (j >= 2) {
                bf16x8 sf[4];
#pragma unroll
                for (int ks = 0; ks < 4; ++ks) { v4u t; t.x = pk2(S[ks * 8 + 0], S[ks * 8 + 1]); t.y = pk2(S[ks * 8 + 2], S[ks * 8 + 3]); t.z = pk2(S[ks * 8 + 4], S[ks * 8 + 5]); t.w = pk2(S[ks * 8 + 6], S[ks * 8 + 7]); sf[ks] = __builtin_bit_cast(bf16x8, t); }
                const size_t rowb = (size_t)b * SEQ + (size_t)(cc - 2) * CHUNK;
                const LAS float* rsl = RSB + ((j & 1) * 2 + d) * 128;
                const int c = cc - 2; const bool first = (d == 0) ? (c <= 15) : (c >= 16);
                unsigned yold[8];
                unsigned char* yo = (unsigned char*)F.YB + (rowb + i16) * SSD_W + h * HDIM + 16 * ps + 4 * q4;
                if (!first) {
#pragma unroll
                    for (int lt = 0; lt < 8; ++lt) yold[lt] = *(const unsigned*)(yo + (size_t)16 * lt * SSD_W);
                }
#pragma unroll
                for (int lt = 0; lt < 8; ++lt) {
                    f32x4 a = (f32x4){0.f, 0.f, 0.f, 0.f};
#pragma unroll
                    for (int ks = 0; ks < 4; ++ks) a = mfma16(sf[ks], frag_row(Cb, RS, 16 * lt + i16, 32 * ks, q4), a);
                    const float sc = rsl[16 * lt + i16] * YOSCALE;
                    float o[4] = {a[0] * sc, a[1] * sc, a[2] * sc, a[3] * sc};
                    if (!first) { const f32x2 lo = __builtin_amdgcn_cvt_pk_f32_fp8((int)yold[lt], false), hi = __builtin_amdgcn_cvt_pk_f32_fp8((int)yold[lt], true); o[0] += lo.x; o[1] += lo.y; o[2] += hi.x; o[3] += hi.y; }
#pragma unroll
                    for (int r = 0; r < 4; ++r) o[r] = fminf(fmaxf(o[r], -440.f), 440.f);
                    *(unsigned*)(yo + (size_t)16 * lt * SSD_W) = pk4_fp8(o[0], o[1], o[2], o[3]);
                }
            }
#pragma unroll
            for (int ks = 0; ks < 4; ++ks) { const v2u t = stv[ks];
                const f32x2 a0 = __builtin_amdgcn_cvt_pk_f32_fp8((int)t.x, false), a1 = __builtin_amdgcn_cvt_pk_f32_fp8((int)t.x, true), a2 = __builtin_amdgcn_cvt_pk_f32_fp8((int)t.y, false), a3 = __builtin_amdgcn_cvt_pk_f32_fp8((int)t.y, true);
                S[ks * 8 + 0] = decay * S[ks * 8 + 0] + a0.x * (1.f / STSCALE); S[ks * 8 + 1] = decay * S[ks * 8 + 1] + a0.y * (1.f / STSCALE);
                S[ks * 8 + 2] = decay * S[ks * 8 + 2] + a1.x * (1.f / STSCALE); S[ks * 8 + 3] = decay * S[ks * 8 + 3] + a1.y * (1.f / STSCALE);
                S[ks * 8 + 4] = decay * S[ks * 8 + 4] + a2.x * (1.f / STSCALE); S[ks * 8 + 5] = decay * S[ks * 8 + 5] + a2.y * (1.f / STSCALE);
                S[ks * 8 + 6] = decay * S[ks * 8 + 6] + a3.x * (1.f / STSCALE); S[ks * 8 + 7] = decay * S[ks * 8 + 7] + a3.y * (1.f / STSCALE); }
        }
        __syncthreads();
    }
}

__device__ __forceinline__ void p6_gate_pool(Frame& F) {
    LAS unsigned char* L = F.lds;
    const int tid = F.tid, lane = F.lane, w = F.wave;
    for (int gr = (int)blockIdx.x; gr < T / 64; gr += F.G) {
        const int rb = gr * 64;
        v4u pv[8];
#pragma unroll
        for (int k = 0; k < 8; ++k) { const int pc = tid + 512 * k, row = pc >> 6, ch = pc & 63; pv[k] = *(const v4u*)(F.V + (size_t)(rb + row) * 512 + ch * 8); }
#pragma unroll
        for (int k = 0; k < 8; ++k) { const int pc = tid + 512 * k, row = pc >> 6, ch = pc & 63; *(LAS v4u*)(L + row * 1024 + ch * 16) = pv[k]; }
        for (int rr = 0; rr < 8; rr += 2) {
            v4u ya[2][3], zz[2][3]; v2u yb[2][3];
#pragma unroll
            for (int k = 0; k < 2; ++k) { const int r = rb + 8 * w + rr + k;
#pragma unroll
                for (int j = 0; j < 3; ++j) { const int col = 8 * (lane + 64 * j);
                    ya[k][j] = *(const v4u*)(F.Y + (size_t)r * SSD_W + col); yb[k][j] = *(const v2u*)((const unsigned char*)F.YB + (size_t)r * SSD_W + col); zz[k][j] = *(const v4u*)(F.Z + (size_t)r * SSD_W + col); } }
#pragma unroll
            for (int k = 0; k < 2; ++k) { const int r = rb + 8 * w + rr + k;
                float v[24]; float ss = 0.f;
#pragma unroll
                for (int j = 0; j < 3; ++j) {
                    const unsigned yaw[4] = {ya[k][j].x, ya[k][j].y, ya[k][j].z, ya[k][j].w}, zw[4] = {zz[k][j].x, zz[k][j].y, zz[k][j].z, zz[k][j].w};
                    const f32x2 yo2[4] = {__builtin_amdgcn_cvt_pk_f32_fp8((int)yb[k][j].x, false), __builtin_amdgcn_cvt_pk_f32_fp8((int)yb[k][j].x, true), __builtin_amdgcn_cvt_pk_f32_fp8((int)yb[k][j].y, false), __builtin_amdgcn_cvt_pk_f32_fp8((int)yb[k][j].y, true)};
#pragma unroll
                    for (int e = 0; e < 4; ++e) { const float y0 = bflo(yaw[e]) + yo2[e].x * (1.f / YOSCALE), y1 = bfhi(yaw[e]) + yo2[e].y * (1.f / YOSCALE);
                        const float g0 = y0 * silu_f(bflo(zw[e])), g1 = y1 * silu_f(bfhi(zw[e])); v[j * 8 + 2 * e] = g0; v[j * 8 + 2 * e + 1] = g1; ss += g0 * g0 + g1 * g1; } }
                const float rs = __builtin_amdgcn_rsqf(wave_sum(ss) * (1.f / SSD_W) + RMS_EPS);
#pragma unroll
                for (int j = 0; j < 3; ++j) { const int col = 8 * (lane + 64 * j);
                    const f32x4 w0 = *(const f32x4*)(F.ssd_norm_w + col), w1 = *(const f32x4*)(F.ssd_norm_w + col + 4);
                    const float rq = rs * A2SCALE; float q[8] = {v[j * 8 + 0] * rq * w0.x, v[j * 8 + 1] * rq * w0.y, v[j * 8 + 2] * rq * w0.z, v[j * 8 + 3] * rq * w0.w, v[j * 8 + 4] * rq * w1.x, v[j * 8 + 5] * rq * w1.y, v[j * 8 + 6] * rq * w1.z, v[j * 8 + 7] * rq * w1.w};
#pragma unroll
                    for (int e = 0; e < 8; ++e) q[e] = fminf(fmaxf(q[e], -440.f), 440.f);
                    v2u o; o.x = pk4_fp8(q[0], q[1], q[2], q[3]); o.y = pk4_fp8(q[4], q[5], q[6], q[7]);
                    *(v2u*)((unsigned char*)F.A2 + (size_t)r * 2048 + col) = o; } }
        }
        __syncthreads();
        {
            const int cg = tid & 63, tb = tid >> 6, hw = 1 << (cg >> 4);
            const LAS unsigned char* colp = L + cg * 16;
#pragma unroll 2
            for (int tt = 0; tt < 8; ++tt) { const int t = tb * 8 + tt; const int lo = t - hw < 0 ? 0 : t - hw, hi = t + hw > 64 ? 64 : t + hw;
                float s[8];
#pragma unroll
                for (int e = 0; e < 8; ++e) s[e] = 0.f;
                for (int q = lo; q < hi; ++q) { const v4u x = *(const LAS v4u*)(colp + q * 1024);
                    s[0] += bflo(x.x); s[1] += bfhi(x.x); s[2] += bflo(x.y); s[3] += bfhi(x.y); s[4] += bflo(x.z); s[5] += bfhi(x.z); s[6] += bflo(x.w); s[7] += bfhi(x.w); }
                const v4u x = *(const LAS v4u*)(colp + t * 1024); const float inv = 1.f / (float)(hi - lo);
                float q[8] = {s[0] * inv - bflo(x.x), s[1] * inv - bfhi(x.x), s[2] * inv - bflo(x.y), s[3] * inv - bfhi(x.y), s[4] * inv - bflo(x.z), s[5] * inv - bfhi(x.z), s[6] * inv - bflo(x.w), s[7] * inv - bfhi(x.w)};
#pragma unroll
                for (int e = 0; e < 8; ++e) q[e] = fminf(fmaxf(q[e] * A2SCALE, -440.f), 440.f);
                v2u o; o.x = pk4_fp8(q[0], q[1], q[2], q[3]); o.y = pk4_fp8(q[4], q[5], q[6], q[7]);
                *(v2u*)((unsigned char*)F.A2 + (size_t)(rb + t) * 2048 + SSD_W + cg * 8) = o; }
        }
        __syncthreads();
    }
}

struct Sched7 {
    static constexpr bool TBL = false;
    const char* A; const char* Bt; const int* rowid; int G, c;
    __device__ __forceinline__ bool next(int i, pg8::Unit& u) const { const int L = i * G + c; if (L >= 512) return false; pg8::static_map(L, 128, 4, u.pm, u.pn); u.e = 0; return true; }
    __device__ __forceinline__ const char* a_base(const pg8::Unit&) const { return A; }
    __device__ __forceinline__ const char* b_base(const pg8::Unit& u) const { return Bt + (size_t)u.pn * 256 * 2048; }
    __device__ __forceinline__ const int* row_table(const pg8::Unit& u) const { return rowid + u.pm * 256; }
};
struct Epi7 {
    static constexpr bool PERM = false;
    const float* x; const float* MOD; bf16* X1;
    __device__ __forceinline__ void operator()(const f32x4 (&acc)[2][2][4][2], const pg8::Unit& u, int wr, int wc, int fr, int fq) const {
        const int row0 = u.pm * 256 + wr * 64 + fr, col0 = u.pn * 256 + wc * 32 + 4 * fq;
        const float* g1 = MOD + (size_t)(u.pm >> 4) * 6144 + 2048;
        f32x4 gv[2][2];
#pragma unroll
        for (int bj = 0; bj < 2; ++bj)
#pragma unroll
            for (int n = 0; n < 2; ++n) gv[bj][n] = *(const f32x4*)(g1 + col0 + bj * 128 + n * 16);
#pragma unroll
        for (int ai = 0; ai < 2; ++ai)
#pragma unroll
            for (int m = 0; m < 4; ++m) { const size_t off = (size_t)(row0 + ai * 128 + m * 16) * D + col0;
#pragma unroll
                for (int bj = 0; bj < 2; ++bj)
#pragma unroll
                    for (int n = 0; n < 2; ++n) { const f32x4 xv = *(const f32x4*)(x + off + bj * 128 + n * 16); const f32x4 o = xv + gv[bj][n] * (acc[ai][bj][m][n] * (1.f / (WSCALE * A2SCALE))); v2u ov; ov.x = pk2(o.x, o.y); ov.y = pk2(o.z, o.w); *(v2u*)(X1 + off + bj * 128 + n * 16) = ov; } }
    }
};

__device__ __forceinline__ void p8_router(Frame& F) {
    LAS unsigned char* L = F.lds;
    LAS float* H2F = (LAS float*)L;
    constexpr int HP = 1028;
    LAS float* PART = (LAS float*)(L + 16 * HP * 4);
    LAS unsigned* HIST = (LAS unsigned*)(L + 16 * HP * 4 + 16384);
    const int tid = F.tid, lane = F.lane, w = F.wave, i16 = lane & 15, q4 = lane >> 4;
    if (tid < 32) HIST[tid] = 0u;
    float rw0[32], rw1[32];
#pragma unroll
    for (int kk = 0; kk < 32; ++kk) { const int k = 128 * w + 4 * kk + q4; rw0[kk] = F.router_w[k * 32 + i16]; rw1[kk] = F.router_w[k * 32 + 16 + i16]; }
    __syncthreads();
    for (int gi = (int)blockIdx.x; gi < T / 16; gi += F.G) {
        const int rbase = gi * 16;
#pragma unroll
        for (int rr = 0; rr < 2; ++rr) {
            const int r16 = 2 * w + rr, r = rbase + r16;
            const bf16* xr = F.X1 + (size_t)r * D; const float* mod = F.MOD + (size_t)(r >> 12) * 6144;
            f32x4 v[4]; float ss = 0.f;
#pragma unroll
            for (int j = 0; j < 4; ++j) { const v2u xq = *(const v2u*)(xr + 4 * lane + 256 * j); v[j] = (f32x4){bflo(xq.x), bfhi(xq.x), bflo(xq.y), bfhi(xq.y)}; ss += (v[j].x * v[j].x + v[j].y * v[j].y) + (v[j].z * v[j].z + v[j].w * v[j].w); }
            const float rs = __builtin_amdgcn_rsqf(wave_sum(ss) * (1.f / D) + RMS_EPS);
#pragma unroll
            for (int j = 0; j < 4; ++j) { const int col = 4 * lane + 256 * j;
                const f32x4 wv = *(const f32x4*)(F.norm2_w + col), sh = *(const f32x4*)(mod + 3072 + col), sc = *(const f32x4*)(mod + 4096 + col);
                const f32x4 hh = (v[j] * rs) * wv * (sc + 1.f) + sh;
                *(LAS f32x4*)(H2F + r16 * HP + col) = hh;
                *(unsigned*)((unsigned char*)F.H2 + (size_t)r * D + col) = pk4_fp8(hh.x, hh.y, hh.z, hh.w); }
        }
        __syncthreads();
        {
            f32x4 a0 = (f32x4){0.f, 0.f, 0.f, 0.f}, a1 = a0;
#pragma unroll
            for (int kk = 0; kk < 32; ++kk) { const int k = 128 * w + 4 * kk + q4;
                const float av = H2F[i16 * HP + k];
                a0 = __builtin_amdgcn_mfma_f32_16x16x4f32(av, rw0[kk], a0, 0, 0, 0); a1 = __builtin_amdgcn_mfma_f32_16x16x4f32(av, rw1[kk], a1, 0, 0, 0); }
#pragma unroll
            for (int r = 0; r < 4; ++r) { PART[(w * 16 + 4 * q4 + r) * 32 + i16] = a0[r]; PART[(w * 16 + 4 * q4 + r) * 32 + 16 + i16] = a1[r]; }
        }
        __syncthreads();
        {
            const int row = tid >> 5, e = tid & 31;
            float lg = F.router_b[e];
#pragma unroll
            for (int ww = 0; ww < 8; ++ww) lg += PART[(ww * 16 + row) * 32 + e];
            float tv[4]; int ti[4];
#pragma unroll
            for (int k = 0; k < 4; ++k) { float bv = lg; int bi = e;
#pragma unroll
                for (int o = 1; o < 32; o <<= 1) { const float ov = __shfl_xor(bv, o); const int oi = __shfl_xor(bi, o); if (ov > bv || (ov == bv && oi < bi)) { bv = ov; bi = oi; } }
                tv[k] = bv; ti[k] = bi; if (e == bi) lg = -INFINITY; }
            if (e == 0) {
                const float e1 = __expf(tv[1] - tv[0]), e2 = __expf(tv[2] - tv[0]), e3 = __expf(tv[3] - tv[0]); const float inv = 1.f / (1.f + e1 + e2 + e3);
                const float gt[4] = {inv, e1 * inv, e2 * inv, e3 * inv};
                const int tok = rbase + row;
#pragma unroll
                for (int k = 0; k < 4; ++k) { const unsigned lr = atomicAdd((unsigned*)&HIST[ti[k]], 1u); F.TOPE[tok * 4 + k] = ti[k]; F.TOPG[tok * 4 + k] = gt[k]; F.TOPR[tok * 4 + k] = (int)lr; }
            }
        }
        __syncthreads();
    }
    if (tid < 32) { const unsigned base = __hip_atomic_fetch_add(F.ctl + CW_GCOUNT + tid, HIST[tid], RLX_AGENT); F.BB[(int)blockIdx.x * 32 + tid] = (int)base; }
}

__device__ __forceinline__ int moe_tables(Frame& F) {
    LAS int* TE = (LAS int*)(F.lds + TE_OFF);
    LAS int* MC = (LAS int*)(F.lds + MOE_CNT_OFF);
    __syncthreads();
    if (F.tid == 0) { int ps = 0;
        for (int e = 0; e < NE; ++e) { const int c = (int)__hip_atomic_load(F.ctl + CW_GCOUNT + e, RLX_AGENT); MC[e] = c; MC[32 + e] = ps; const int nt = (c + 255) >> 8; for (int t = 0; t < nt; ++t) TE[(ps >> 8) + t] = e; ps += nt << 8; }
        MC[64] = ps >> 8; }
    __syncthreads();
    return MC[64];
}
__device__ __forceinline__ void p9_slots(Frame& F) {
    (void)moe_tables(F);
    const LAS int* MC = (const LAS int*)(F.lds + MOE_CNT_OFF);
    const int gt = (int)blockIdx.x * 512 + F.tid, NT_ = F.G * 512;
    for (int a = gt; a < T * TOPK; a += NT_) { const int tok = a >> 2, e = F.TOPE[a], blk = (tok >> 4) % F.G;
        const int slot = MC[32 + e] + F.BB[blk * 32 + e] + F.TOPR[a];
        F.SLOTTOK[slot] = tok; F.SLOTGATE[slot] = F.TOPG[a]; F.TOKSLOT[a] = slot; }
    for (int i = gt; i < MAX_SLOTS; i += NT_) F.SLOTID[i] = i;
    if ((int)blockIdx.x < NE) { const int e = (int)blockIdx.x, c = MC[e], ps = MC[32 + e], pe = ps + (((c + 255) >> 8) << 8);
        for (int s = ps + c + F.tid; s < pe; s += 512) { F.SLOTTOK[s] = 0; F.SLOTGATE[s] = 0.f; } }
}

struct SchedMoe {
    static constexpr bool TBL = true;
    const char* A; const char* W; const int* slot_tok; const LAS int* TE; int nM, nN, G, c; size_t wbytes  , tilebytes  , arowbytes;
    LAS unsigned char* tb;
    const float* f0; int f0_e, f0_n;
    const float* f1;
    __device__ __forceinline__ bool next(int i, pg8::Unit& u) const { const int L = i * G + c; if (L >= nM * nN) return false; pg8::static_map(L, nM, nN, u.pm, u.pn); u.e = TE[u.pm]; return true; }
    __device__ __forceinline__ const char* a_base(const pg8::Unit&) const { return A; }
    __device__ __forceinline__ const char* b_base(const pg8::Unit& u) const { return W + (size_t)u.e * wbytes + (size_t)u.pn * tilebytes; }
    __device__ __forceinline__ const int* row_table(const pg8::Unit& u) const { return slot_tok + u.pm * 256; }
    __device__ __forceinline__ const int* tab0(const pg8::Unit& u) const { return slot_tok + u.pm * 256; }
    __device__ __forceinline__ const float* tab1(const pg8::Unit& u) const { return f0 + (size_t)u.e * f0_e + u.pn * f0_n; }
    __device__ __forceinline__ const float* tab2(const pg8::Unit& u) const { return f1 ? f1 + u.pm * 256 : nullptr; }
};
struct Epi10 {
    static constexpr bool PERM = true;
    const float* b1; bf16* ACT;
    __device__ __forceinline__ void operator()(const f32x4 (&acc)[2][2][4][2], const pg8::Unit& u, int wr, int wc, int fr, int fq, const LAS unsigned char* tbuf) const {
        const int row0 = u.pm * 256 + wr * 64 + fr, j0 = u.pn * 128 + wc * 32 + 8 * fq;
        const LAS float* bp = (const LAS float*)(tbuf + 3072) + 2 * (wc * 32 + 8 * fq);
        const f32x4 q0 = *(const LAS f32x4*)bp, q1 = *(const LAS f32x4*)(bp + 4), q2 = *(const LAS f32x4*)(bp + 8), q3 = *(const LAS f32x4*)(bp + 12);
        const float bg[8] = {q0.x, q0.z, q1.x, q1.z, q2.x, q2.z, q3.x, q3.z}, bu[8] = {q0.y, q0.w, q1.y, q1.w, q2.y, q2.w, q3.y, q3.w};
#pragma unroll
        for (int ai = 0; ai < 2; ++ai)
#pragma unroll
            for (int m = 0; m < 4; ++m) { float o[8];
#pragma unroll
                for (int n = 0; n < 2; ++n)
#pragma unroll
                    for (int t = 0; t < 4; ++t) { const float hg = acc[ai][0][m][n][t] * (1.f / WSCALE) + bg[4 * n + t], hu = acc[ai][1][m][n][t] * (1.f / WSCALE) + bu[4 * n + t];
                        const float gp = fminf(hg, 7.f), up = fminf(fmaxf(hu, -7.f), 7.f);
                        o[4 * n + t] = gp * __builtin_amdgcn_rcpf(1.f + __builtin_amdgcn_exp2f(-1.702f * 1.44269504f * gp)) * (up + 1.f); }
                v2u wv; wv.x = pk4_fp8(o[0] * ASCALE, o[1] * ASCALE, o[2] * ASCALE, o[3] * ASCALE); wv.y = pk4_fp8(o[4] * ASCALE, o[5] * ASCALE, o[6] * ASCALE, o[7] * ASCALE);
                *(v2u*)((unsigned char*)ACT + (size_t)(row0 + ai * 128 + m * 16) * DFF + j0) = wv; }
    }
};
struct Epi11 {
    static constexpr bool PERM = true;
    bf16* YS;
    __device__ __forceinline__ void operator()(const f32x4 (&acc)[2][2][4][2], const pg8::Unit& u, int wr, int wc, int fr, int fq, const LAS unsigned char* tbuf) const {
        const int row0 = u.pm * 256 + wr * 64 + fr, col0 = u.pn * 256 + wc * 32 + 8 * fq;
        const LAS float* bl = (const LAS float*)(tbuf + 3072) + wc * 32 + 8 * fq; const LAS float* gl = (const LAS float*)(tbuf + 6144) + wr * 64 + fr;
        f32x4 bv[2][2];
#pragma unroll
        for (int bj = 0; bj < 2; ++bj)
#pragma unroll
            for (int n = 0; n < 2; ++n) bv[bj][n] = *(const LAS f32x4*)(bl + bj * 128 + 4 * n);
#pragma unroll
        for (int ai = 0; ai < 2; ++ai)
#pragma unroll
            for (int m = 0; m < 4; ++m) { const int row = row0 + ai * 128 + m * 16; const float gt = gl[ai * 128 + m * 16];
#pragma unroll
                for (int bj = 0; bj < 2; ++bj) { const float gs = gt * YSCALE; f32x4 v0 = (acc[ai][bj][m][0] * (1.f / (WSCALE * ASCALE)) + bv[bj][0]) * gs, v1 = (acc[ai][bj][m][1] * (1.f / (WSCALE * ASCALE)) + bv[bj][1]) * gs;
#pragma unroll
                    for (int t = 0; t < 4; ++t) { v0[t] = fminf(fmaxf(v0[t], -440.f), 440.f); v1[t] = fminf(fmaxf(v1[t], -440.f), 440.f); }
                    v2u wv; wv.x = pk4_fp8(v0[0], v0[1], v0[2], v0[3]); wv.y = pk4_fp8(v1[0], v1[1], v1[2], v1[3]);
                    *(v2u*)((unsigned char*)YS + (size_t)row * D + col0 + bj * 128) = wv; } }
    }
};

__device__ __forceinline__ void p12_combine(Frame& F) {
    const int gw = (int)blockIdx.x * 8 + F.wave, NGW = F.G * 8, lane = F.lane;
    for (int rp = gw; rp < T / 2; rp += NGW) {
        int sl[2][4];
#pragma unroll
        for (int k2 = 0; k2 < 2; ++k2)
#pragma unroll
            for (int k = 0; k < 4; ++k) sl[k2][k] = F.TOKSLOT[(rp * 2 + k2) * 4 + k];
        unsigned yv[2][4][4]; v2u xq[2][4];
#pragma unroll
        for (int k2 = 0; k2 < 2; ++k2)
#pragma unroll
            for (int j = 0; j < 4; ++j) { const int col = 4 * lane + 256 * j; xq[k2][j] = *(const v2u*)(F.X1 + (size_t)(rp * 2 + k2) * D + col);
#pragma unroll
                for (int k = 0; k < 4; ++k) yv[k2][j][k] = *(const unsigned*)((const unsigned char*)F.YS + (size_t)sl[k2][k] * D + col); }
#pragma unroll
        for (int k2 = 0; k2 < 2; ++k2) { const int r = rp * 2 + k2;
            const float* g2 = F.MOD + (size_t)(r >> 12) * 6144 + 5120;
            f32x4 v[4]; float ss = 0.f;
#pragma unroll
            for (int j = 0; j < 4; ++j) { const int col = 4 * lane + 256 * j; f32x4 m = (f32x4){0.f, 0.f, 0.f, 0.f};
#pragma unroll
                for (int k = 0; k < 4; ++k) { const int y = (int)yv[k2][j][k]; const f32x2 lo = __builtin_amdgcn_cvt_pk_f32_fp8(y, false), hi = __builtin_amdgcn_cvt_pk_f32_fp8(y, true); m.x += lo.x; m.y += lo.y; m.z += hi.x; m.w += hi.y; }
                v[j] = (f32x4){bflo(xq[k2][j].x), bfhi(xq[k2][j].x), bflo(xq[k2][j].y), bfhi(xq[k2][j].y)} + *(const f32x4*)(g2 + col) * (m * (1.f / YSCALE));
                ss += (v[j].x * v[j].x + v[j].y * v[j].y) + (v[j].z * v[j].z + v[j].w * v[j].w); }
            const float rs = __builtin_amdgcn_rsqf(wave_sum(ss) * (1.f / D) + RMS_EPS);
#pragma unroll
            for (int j = 0; j < 4; ++j) { const int col = 4 * lane + 256 * j; *(f32x4*)(F.out + (size_t)r * D + col) = (v[j] * rs) * *(const f32x4*)(F.final_norm_w + col); } }
    }
}

constexpr int NPHASE = 13;
struct Args { const float* in[25]; float* out; unsigned char* ws; int ph_lo, ph_hi; };
__global__ void __launch_bounds__(512, 2) mk_fwd(Args args) {
    extern __shared__ __attribute__((aligned(16))) unsigned char lds[];
    Frame F;
    F.lds = (LAS unsigned char*)lds;
    F.tid = threadIdx.x; F.lane = F.tid & 63; F.wave = __builtin_amdgcn_readfirstlane(F.tid >> 6); F.G = gridDim.x;
    unsigned char* ws = args.ws;
    F.ctl = (unsigned*)(ws + WS_CTL);
    F.x = args.in[0]; F.c = args.in[1]; F.ctx = args.in[2]; F.c_ctx = args.in[3]; F.w_mod = args.in[4]; F.b_mod = args.in[5]; F.norm1_w = args.in[6]; F.norm2_w = args.in[7];
    F.w_in = args.in[8]; F.conv_w = args.in[9]; F.conv_b = args.in[10]; F.dt_bias = args.in[11]; F.a_log = args.in[12]; F.d_skip = args.in[13]; F.ssd_norm_w = args.in[14];
    F.pool_w = args.in[15]; F.pool_scale = args.in[16]; F.w_out = args.in[17]; F.router_w = args.in[18]; F.router_b = args.in[19]; F.w1 = args.in[20]; F.b1 = args.in[21];
    F.w2 = args.in[22]; F.b2 = args.in[23]; F.final_norm_w = args.in[24]; F.out = args.out;
    F.MOD = (float*)(ws + WS_MOD); F.DTRAW = (float*)(ws + WS_DTRAW); F.DT = (float*)(ws + WS_DT); F.ROWSC = (float*)(ws + WS_ROWSC); F.CHS = (float*)(ws + WS_CHS); F.X1 = (bf16*)(ws + WS_X1);
    F.TOPG = (float*)(ws + WS_TOPG); F.SLOTGATE = (float*)(ws + WS_SLOTGATE); F.TOPE = (int*)(ws + WS_TOPE); F.TOPR = (int*)(ws + WS_TOPR); F.TOKSLOT = (int*)(ws + WS_TOKSLOT);
    F.SLOTTOK = (int*)(ws + WS_SLOTTOK); F.SLOTID = (int*)(ws + WS_SLOTID); F.ROWID = (int*)(ws + WS_ROWID); F.BB = (int*)(ws + WS_BB);
    F.WINT = (bf16*)(ws + WS_WINT); F.WOUTT = (bf16*)(ws + WS_WOUTT); F.W1T = (bf16*)(ws + WS_W1T); F.W2T = (bf16*)(ws + WS_W2T); F.A1 = (bf16*)(ws + WS_A1); F.XBCPRE = (bf16*)(ws + WS_XBCPRE);
    F.Z = (bf16*)(ws + WS_Z); F.V = (bf16*)(ws + WS_V); F.XBC = (bf16*)(ws + WS_XBC); F.CC = (bf16*)(ws + WS_CC); F.ST = (bf16*)(ws + WS_ST); F.Y = (bf16*)(ws + WS_Y); F.YB = (bf16*)(ws + WS_YB);
    F.A2 = (bf16*)(ws + WS_A2); F.H2 = (bf16*)(ws + WS_H2); F.ACT = (bf16*)(ws + WS_ACT); F.YS = (bf16*)(ws + WS_YS);
    volatile LAS unsigned* MISC = (volatile LAS unsigned*)(F.lds + MISC_OFF);
    for (int u = F.tid; u < 64; u += 512) MISC[u] = 0u;
    __syncthreads();
    const int lo = args.ph_lo, hi = args.ph_hi;
    XcdBarrier bar; bar.bar = F.ctl + CW_BAR; bar.x = 0; bar.st = nullptr;
    if (hi - lo > 1) bar = xcd_barrier_post(F.ctl + CW_BAR, MISC + 8);
#define IN(k) (lo <= (k) && (k) < hi)
#define SEAM(k) do { if (IN(k) && IN((k) + 1)) xcd_barrier(bar); } while (0)
#define BODY0 p0_prologue(F)
#define BODY1 p1_norm1(F)
#define BODY2 do { Sched1 S{(const char*)F.A1, (const char*)F.WINT, F.G, (int)blockIdx.x}; Epi1 E{F.XBCPRE, F.Z, F.V, F.DTRAW}; pg8::gemm_phase<Epi1, Sched1, false>(F.lds, D, S, E); } while (0)
#define BODY3 p3_conv(F)
#define BODY4 p4_ssd_local(F)
#define BODY5 p5_ssd_scan(F)
#define BODY6 p6_gate_pool(F)
#define BODY7 do { Sched7 S{(const char*)F.A2, (const char*)F.WOUTT, F.ROWID, F.G, (int)blockIdx.x}; Epi7 E{F.x, F.MOD, F.X1}; pg8::gemm_phase<Epi7, Sched7, true, true>(F.lds, 2048, S, E); } while (0)
#define BODY8 p8_router(F)
#define BODY9 p9_slots(F)
#define BODY10 do { const int ntl = moe_tables(F); \
        SchedMoe S{(const char*)F.H2, (const char*)F.W1T, F.SLOTTOK, (const LAS int*)(F.lds + TE_OFF), ntl, 8, F.G, (int)blockIdx.x, (size_t)2048 * D, (size_t)256 * D, (size_t)D, F.lds + TBL_OFF, F.b1, 2048, 256, nullptr}; \
        Epi10 E{F.b1, F.ACT}; pg8::gemm_phase<Epi10, SchedMoe, true, true>(F.lds, D, S, E); } while (0)
#define BODY11 do { const int ntl = moe_tables(F); \
        SchedMoe S{(const char*)F.ACT, (const char*)F.W2T, F.SLOTID, (const LAS int*)(F.lds + TE_OFF), ntl, 4, F.G, (int)blockIdx.x, (size_t)D * D, (size_t)256 * D, (size_t)D, F.lds + TBL_OFF, F.b2, D, 256, F.SLOTGATE}; \
        Epi11 E{F.YS}; pg8::gemm_phase<Epi11, SchedMoe, true, true>(F.lds, D, S, E); } while (0)
#define BODY12 p12_combine(F)
#define RUN(k) do { if (IN(k)) { BODY##k; if (PROBE_PH == (k)) { xcd_barrier(bar); BODY##k; } } SEAM(k); } while (0)
    RUN(0); RUN(1); RUN(2); RUN(4); RUN(5); RUN(6); RUN(7); RUN(8); RUN(9); RUN(10); RUN(11); RUN(12);
#undef IN
#undef SEAM
}

extern "C" void kernel_launch(void* const* d_in, const int* in_sizes, int n_in, void* d_out, int out_size, void* d_ws, size_t ws_size, hipStream_t stream) {
    static int grid = 0;
    if (grid == 0) {
        if (n_in != 25 || out_size != T * D || ws_size < WS_END) { fprintf(stderr, "kernel_launch: unexpected shapes (n_in %d, out %d, ws %zu)\n", n_in, out_size, ws_size); grid = -1; return; }
        int dev = 0, cus = 0, per_cu = 0;
        if (hipGetDevice(&dev) != hipSuccess || hipDeviceGetAttribute(&cus, hipDeviceAttributeMultiprocessorCount, dev) != hipSuccess) { grid = -1; return; }
        if (hipFuncSetAttribute((const void*)mk_fwd, hipFuncAttributeMaxDynamicSharedMemorySize, LDS_BYTES) != hipSuccess) { fprintf(stderr, "kernel_launch: hipFuncSetAttribute failed\n"); grid = -1; return; }
        if (hipOccupancyMaxActiveBlocksPerMultiprocessor(&per_cu, (const void*)mk_fwd, 512, LDS_BYTES) != hipSuccess || per_cu < 1) { fprintf(stderr, "kernel_launch: occupancy query says %d\n", per_cu); }
        (void)hipGetLastError();
        grid = cus;
    }
    if (grid < 0) return;
    (void)hipMemsetAsync((char*)d_ws + WS_CTL, 0, CTL_ZERO_BYTES, stream);
    Args a{};
    for (int i = 0; i < 25; ++i) a.in[i] = (const float*)d_in[i];
    a.out = (float*)d_out; a.ws = (unsigned char*)d_ws;
#if MK_SPLIT
    for (int p = 0; p < NPHASE; ++p) { a.ph_lo = p; a.ph_hi = p + 1; hipLaunchKernelGGL(mk_fwd, dim3(grid), dim3(512), LDS_BYTES, stream, a); }
#else
    a.ph_lo = 0; a.ph_hi = NPHASE; hipLaunchKernelGGL(mk_fwd, dim3(grid), dim3(512), LDS_BYTES, stream, a);
#endif
}
```

```cpp
#include <hip/hip_runtime.h>
#include <cstdio>
#include <cstdint>

#ifndef MK_SPLIT
#define MK_SPLIT 0
#endif

#ifndef PROBE_PH
#define PROBE_PH -1
#endif

#define GAS __attribute__((address_space(1)))
#define LAS __attribute__((address_space(3)))
typedef unsigned short bf16;
typedef unsigned v4u __attribute__((ext_vector_type(4)));
typedef unsigned v2u __attribute__((ext_vector_type(2)));
typedef float f32x4 __attribute__((ext_vector_type(4)));
typedef float f32x2 __attribute__((ext_vector_type(2)));
typedef short bf16x8 __attribute__((ext_vector_type(8)));
typedef short s16x4 __attribute__((ext_vector_type(4)));
#define RLX_AGENT __ATOMIC_RELAXED, __HIP_MEMORY_SCOPE_AGENT
#define LDS_WAIT() asm volatile("s_waitcnt lgkmcnt(0)" ::: "memory")
#define VM_WAIT() asm volatile("s_waitcnt vmcnt(0)" ::: "memory")

__device__ __forceinline__ unsigned f2bf(float f) { unsigned u = __builtin_bit_cast(unsigned, f); return (u + 0x7fffu + ((u >> 16) & 1u)) >> 16; }
typedef __bf16 nbf16x2 __attribute__((ext_vector_type(2)));
__device__ __forceinline__ unsigned pk2(float lo, float hi) { const f32x2 v = {lo, hi}; return __builtin_bit_cast(unsigned, __builtin_convertvector(v, nbf16x2)); }
constexpr float A2SCALE = 4.f;
constexpr float YOSCALE = 16.f;
constexpr float STSCALE = 32.f;
constexpr float YSCALE = 8.f;
constexpr float ASCALE = 4.f;
constexpr float WSCALE = 32.f;
__device__ __forceinline__ unsigned pk4_fp8(float a, float b, float c, float d) { int r = __builtin_amdgcn_cvt_pk_fp8_f32(a, b, 0, false); r = __builtin_amdgcn_cvt_pk_fp8_f32(c, d, r, true); return (unsigned)r; }
__device__ __forceinline__ float bflo(unsigned w) { return __builtin_bit_cast(float, w << 16); }
__device__ __forceinline__ float bfhi(unsigned w) { return __builtin_bit_cast(float, w & 0xffff0000u); }
__device__ __forceinline__ float silu_f(float v) { return v * __builtin_amdgcn_rcpf(1.f + __builtin_amdgcn_exp2f(-1.44269504f * v)); }
__device__ __forceinline__ float wave_sum(float v) {
#pragma unroll
    for (int o = 1; o < 64; o <<= 1) v += __shfl_xor(v, o);
    return v;
}

constexpr int D = 1024, NB = 8, SEQ = 4096, CTXL = 256, T = NB * SEQ, TC = NB * CTXL, RTOT = T + TC;
constexpr int CONV_CH = 2560, SSD_W = 1536, NH = 24, HDIM = 64, NGRP = 4, HPG = 6, NST = 128, CHUNK = 128;
constexpr int NCC = (CTXL + SEQ) / CHUNK;
constexpr int IN_COLS = 4656, N1 = 4864;
constexpr int NE = 32, TOPK = 4, DFF = 1024;
constexpr int MAX_TILES = (T * TOPK) / 256 + NE;
constexpr int MAX_SLOTS = MAX_TILES * 256;
constexpr float RMS_EPS = 1e-6f;

constexpr size_t MiB = 1u << 20;
constexpr size_t WS_CTL = 0, CTL_ZERO_BYTES = 1 * MiB;
constexpr size_t WS_MOD = 1 * MiB;
constexpr size_t WS_TOPE = 2 * MiB, WS_TOPG = WS_TOPE + 512 * 1024, WS_TOPR = WS_TOPG + 512 * 1024, WS_TOKSLOT = WS_TOPR + 512 * 1024;
constexpr size_t WS_SLOTTOK = 4 * MiB, WS_SLOTGATE = WS_SLOTTOK + 576 * 1024, WS_BB = WS_SLOTGATE + 576 * 1024, WS_CHS = WS_BB + 64 * 1024, WS_SLOTID = WS_CHS + 64 * 1024;
constexpr size_t WS_DTRAW = 6 * MiB;
constexpr size_t WS_ROWID = 21 * MiB + 512 * 1024;
constexpr size_t WS_DT = 15 * MiB;
constexpr size_t WS_ROWSC = 22 * MiB;
constexpr size_t WS_WINT = 32 * MiB, WS_WOUTT = 42 * MiB, WS_W1T = 46 * MiB, WS_W2T = 174 * MiB;
constexpr size_t WS_A = 240 * MiB;
constexpr size_t WS_A1 = WS_A, WS_CC = WS_A, WS_XBCPRE = WS_A + 68 * MiB, WS_Z = WS_A + 238 * MiB, WS_V = WS_A + 334 * MiB, WS_XBC = WS_A;
constexpr size_t WS_ST = WS_A + 366 * MiB, WS_Y = WS_A + 570 * MiB, WS_YB = WS_A + 666 * MiB;
constexpr size_t WS_A2 = WS_XBCPRE, WS_X1 = WS_A + 366 * MiB, WS_H2 = WS_A + 494 * MiB, WS_ACT = WS_A, WS_YS = WS_A + 494 * MiB;
constexpr size_t WS_END = WS_A + 766 * MiB;
static_assert(WS_END <= 1024 * MiB, "workspace map");
static_assert((size_t)RTOT * D * 2 <= 68 * MiB && (size_t)RTOT * CONV_CH * 2 <= 170 * MiB && (size_t)MAX_SLOTS * D * 2 <= 272 * MiB, "workspace map sizes");
static_assert((size_t)NB * NCC * NH * 2 * 8192 * 2 <= 204 * MiB, "ST size");
constexpr int CW_TMO = 0, CW_GCOUNT = 64  , CW_BAR = 4096;

constexpr int LDS_BYTES = 163840;
constexpr int MISC_OFF = LDS_BYTES - 256;
constexpr int TE_OFF = 131072;
constexpr int MOE_CNT_OFF = TE_OFF + 4096;
constexpr int TBL_OFF = TE_OFF + 8192;

namespace pg8 {
constexpr int BM = 256, BK = 64, HALF = 128, HTB = HALF * BK * 2, STAGE_BYTES = 8 * HTB, NXCD = 8, WGM = 8;
__host__ __device__ __forceinline__ int lds_byte(int r, int c) { const int st = (r >> 4) * 2 + (c >> 5), rr = r & 15, cc = c & 31, ob = rr * 64 + cc * 2; return st * 1024 + (ob ^ (((ob >> 9) & 1) << 5)); }
__host__ __device__ __forceinline__ void stage_rc(int b, int& R, int& C) { const int st = b / 1024, sb = b % 1024, swz = sb ^ (((sb >> 9) & 1) << 5); R = (st >> 1) * 16 + swz / 64; C = (st & 1) * 32 + (swz % 64) / 2; }
__host__ __device__ __forceinline__ int perm32(int rho) { const int n = rho >> 4, i = rho & 15; return 8 * (i >> 2) + 4 * n + (i & 3); }
struct Unit { int pm, pn, e; };
__device__ __forceinline__ unsigned cvt_pk_bf16(float lo, float hi) { unsigned r; asm volatile("v_cvt_pk_bf16_f32 %0, %1, %2" : "=v"(r) : "v"(lo), "v"(hi)); return r; }

__device__ __forceinline__ void static_map(int wgid, int nM, int nN, int& pm, int& pn) {
    const int nwg = nM * nN;
    { const int q = nwg / NXCD, r = nwg % NXCD, xcd = wgid % NXCD, off = wgid / NXCD; wgid = (xcd < r ? xcd * (q + 1) : r * (q + 1) + (xcd - r) * q) + off; }
    const int nig = WGM * nN, gid = wgid / nig, fm = gid * WGM, gsz = (nM - fm) < WGM ? (nM - fm) : WGM;
    pm = fm + ((wgid % nig) % gsz); pn = (wgid % nig) / gsz;
}

typedef int i32x8 __attribute__((ext_vector_type(8)));
typedef int v4i_t __attribute__((ext_vector_type(4)));
template <class Epi, class Sched, bool GATHER, bool FP8 = false, bool ALIGN_EPI = true>
__device__ __forceinline__ void gemm_phase(LAS unsigned char* lds, const int K, const Sched& S, const Epi& E) {
    int tid = threadIdx.x; asm volatile("" : "+v"(tid));
    const int wid = __builtin_amdgcn_readfirstlane(tid >> 6), lane = tid & 63, wr = wid >> 2, wc = wid & 3, fr = lane & 15, fq = lane >> 4;
    constexpr int ES = FP8 ? 1 : 2, KOFF = FP8 ? 16 : 1024;
    const int nt = K / (FP8 ? 2 * BK : BK);
    unsigned voffB[2]; int RA[2], CA[2];
#pragma unroll
    for (int i = 0; i < 2; ++i) { int R, C; stage_rc(tid * 16 + i * 8192, R, C); const int Rb = Epi::PERM ? ((R & ~31) + perm32(R & 31)) : R;
        RA[i] = R; CA[i] = C; voffB[i] = (unsigned)(Rb * K * ES + C * 2); }
    const size_t kstep = (size_t)(BK * 2);
    const size_t hstep = (size_t)HALF * K * ES;
    const unsigned ldsw = (unsigned)wid * 1024u;
    const int aoff = lds_byte(wr * 64 + fr, fq * (FP8 ? 16 : 8)), boff = lds_byte(wc * 32 + fr, fq * (FP8 ? 16 : 8));
#define PG8_SA(b, h) (((b) * 2 + (h)) * HTB)
#define PG8_SB(b, h) ((4 + (b) * 2 + (h)) * HTB)
#define PG8_STAGE(bufoff, gbase, voff) do { _Pragma("unroll") for (int _i = 0; _i < 2; ++_i) \
        __builtin_amdgcn_global_load_lds((const unsigned*)((const char*)(gbase) + (voff)[_i]), (LAS unsigned*)(lds + (bufoff) + ldsw + _i * 8192), 16, 0, 0); } while (0)
#define PG8_LDA(dst, b, h) do { _Pragma("unroll") for (int m = 0; m < 4; ++m) _Pragma("unroll") for (int k = 0; k < 2; ++k) dst[m][k] = *(const LAS bf16x8*)(lds + PG8_SA(b, h) + aoff + m * 2048 + k * KOFF); } while (0)
#define PG8_LDB(dst, b, h) do { _Pragma("unroll") for (int n = 0; n < 2; ++n) _Pragma("unroll") for (int k = 0; k < 2; ++k) dst[n][k] = *(const LAS bf16x8*)(lds + PG8_SB(b, h) + boff + n * 2048 + k * KOFF); } while (0)
#define PG8_CAT(lo, hi) __builtin_shufflevector(__builtin_bit_cast(v4i_t, lo), __builtin_bit_cast(v4i_t, hi), 0, 1, 2, 3, 4, 5, 6, 7)
#define PG8_MMA(ai, bj, At, Bt) do { __builtin_amdgcn_s_setprio(1); \
        if constexpr (FP8) { _Pragma("unroll") for (int m = 0; m < 4; ++m) _Pragma("unroll") for (int n = 0; n < 2; ++n) \
            acc[ai][bj][m][n] = __builtin_amdgcn_mfma_scale_f32_16x16x128_f8f6f4(PG8_CAT(Bt[n][0], Bt[n][1]), PG8_CAT(At[m][0], At[m][1]), acc[ai][bj][m][n], 0, 0, 0, 0x7f7f7f7f, 0, 0x7f7f7f7f); } \
        else { _Pragma("unroll") for (int m = 0; m < 4; ++m) _Pragma("unroll") for (int n = 0; n < 2; ++n) _Pragma("unroll") for (int k = 0; k < 2; ++k) \
            acc[ai][bj][m][n] = __builtin_amdgcn_mfma_f32_16x16x32_bf16(Bt[n][k], At[m][k], acc[ai][bj][m][n], 0, 0, 0); } \
        __builtin_amdgcn_s_setprio(0); } while (0)
#define PG8_WAIT_V(n) asm volatile("s_waitcnt vmcnt(" #n ")" ::: "memory")
#define PG8_WAIT_L(n) asm volatile("s_waitcnt lgkmcnt(" #n ")" ::: "memory")
#define PG8_BAR __builtin_amdgcn_s_barrier()
#define PG8_SCHED __builtin_amdgcn_sched_barrier(0)
#define PG8_AOFFS(U, dst) do { \
        if constexpr (GATHER) { int t_ = tid, R_, C_; asm volatile("" : "+v"(t_)); stage_rc(t_ * 16, R_, C_);     \
            const int* st_ = S.row_table(U) + R_; _Pragma("unroll") for (int _h = 0; _h < 2; ++_h) _Pragma("unroll") for (int _i = 0; _i < 2; ++_i) \
            dst[_h][_i] = (unsigned)st_[_h * HALF + _i * 64] * (unsigned)(K * ES) + (unsigned)(C_ * 2); } \
        else { _Pragma("unroll") for (int _h = 0; _h < 2; ++_h) _Pragma("unroll") for (int _i = 0; _i < 2; ++_i) dst[_h][_i] = (unsigned)((_h * HALF + RA[_i]) * K * ES + CA[_i] * 2); } } while (0)
#define PG8_AOFFS_NEXT(dst) do { if constexpr (false) { int t_ = tid, R_, C_; asm volatile("" : "+v"(t_)); stage_rc(t_ * 16, R_, C_); \
            const LAS int* st_ = (const LAS int*)(S.tb + ((ui + 1) % 3) * 1024) + R_; _Pragma("unroll") for (int _h = 0; _h < 2; ++_h) _Pragma("unroll") for (int _i = 0; _i < 2; ++_i) \
            dst[_h][_i] = (unsigned)st_[_h * HALF + _i * 64] * (unsigned)(K * ES) + (unsigned)(C_ * 2); } else { PG8_AOFFS(nxt, dst); } } while (0)
    Unit cur, nxt; int ui = 0;
    if (!S.next(0, cur)) return;
    f32x4 acc[2][2][4][2];
#pragma unroll
    for (int a = 0; a < 2; ++a)
#pragma unroll
        for (int b = 0; b < 2; ++b)
#pragma unroll
            for (int m = 0; m < 4; ++m)
#pragma unroll
                for (int n = 0; n < 2; ++n) acc[a][b][m][n] = (f32x4){0.f, 0.f, 0.f, 0.f};
    bf16x8 At[4][2], B0[2][2], B1[2][2];
    unsigned oc[2][2];
    const char* cA = S.a_base(cur); const char* cB = S.b_base(cur);
    PG8_AOFFS(cur, oc);
#define PG8_TABLES(U, buf) do { if constexpr (Sched::TBL) { LAS unsigned char* tb_ = S.tb + (buf) * 1024;   \
        if (wid < 4) { if (S.tab2(U)) __builtin_amdgcn_global_load_lds((const unsigned*)(S.tab2(U) + 64 * wid + lane), (LAS unsigned*)(tb_ + 6144 + wid * 256), 4, 0, 0); } \
        else { __builtin_amdgcn_global_load_lds((const unsigned*)(S.tab1(U) + 64 * (wid - 4) + lane), (LAS unsigned*)(tb_ + 3072 + (wid - 4) * 256), 4, 0, 0); } } } while (0)
    PG8_TABLES(cur, 0);
    PG8_STAGE(PG8_SB(0, 0), cB, voffB); PG8_STAGE(PG8_SB(0, 1), cB + hstep, voffB); PG8_STAGE(PG8_SA(0, 0), cA, oc[0]); PG8_STAGE(PG8_SA(0, 1), cA, oc[1]);
    if (wr == 1) PG8_BAR;
    PG8_WAIT_V(2); PG8_BAR;
    PG8_STAGE(PG8_SB(1, 0), cB + kstep, voffB); PG8_STAGE(PG8_SA(1, 0), cA + kstep, oc[0]); PG8_STAGE(PG8_SB(1, 1), cB + hstep + kstep, voffB);
    PG8_WAIT_V(6); PG8_BAR;
    for (;;) {
        const bool has_next = S.next(ui + 1, nxt);
        const char* nA = has_next ? S.a_base(nxt) : cA; const char* nB = has_next ? S.b_base(nxt) : cB;
        if (has_next) { PG8_TABLES(nxt, (ui + 1) % 3); }
        for (int t = 0; t < nt; t += 2) {
            const bool last = (t == nt - 2);
            const char* a1 = cA + (size_t)(t + 1) * kstep;
            const char* a2 = last ? nA : cA + (size_t)(t + 2) * kstep; const char* b2 = last ? nB : cB + (size_t)(t + 2) * kstep;
            const char* a3 = a2 + kstep; const char* b3 = b2 + kstep;
            PG8_LDB(B0, 0, 0); PG8_LDB(B1, 0, 1); PG8_SCHED; PG8_LDA(At, 0, 0); PG8_STAGE(PG8_SA(1, 1), a1, oc[1]);
            PG8_WAIT_V(8); PG8_WAIT_L(0); PG8_BAR; PG8_MMA(0, 0, At, B0); PG8_MMA(0, 1, At, B1); PG8_BAR; PG8_SCHED;
            if (last && has_next) { PG8_AOFFS_NEXT(oc); }
            PG8_LDA(At, 0, 1); PG8_STAGE(PG8_SB(0, 0), b2, voffB); PG8_STAGE(PG8_SB(0, 1), b2 + hstep, voffB); PG8_STAGE(PG8_SA(0, 0), a2, oc[0]);
            PG8_WAIT_V(8); PG8_WAIT_L(0); PG8_BAR; PG8_MMA(1, 0, At, B0); PG8_MMA(1, 1, At, B1); PG8_BAR; PG8_SCHED;
            PG8_LDB(B0, 1, 0); PG8_LDB(B1, 1, 1); PG8_SCHED; PG8_LDA(At, 1, 0); PG8_STAGE(PG8_SA(0, 1), a2, oc[1]);
            PG8_WAIT_V(8); PG8_WAIT_L(0); PG8_BAR; PG8_MMA(0, 0, At, B0); PG8_MMA(0, 1, At, B1); PG8_BAR; PG8_SCHED;
            PG8_LDA(At, 1, 1); PG8_STAGE(PG8_SB(1, 0), b3, voffB); PG8_STAGE(PG8_SB(1, 1), b3 + hstep, voffB); PG8_STAGE(PG8_SA(1, 0), a3, oc[0]);
            PG8_WAIT_V(8); PG8_WAIT_L(0); PG8_BAR; PG8_MMA(1, 0, At, B0); PG8_MMA(1, 1, At, B1); PG8_BAR; PG8_SCHED;
        }
        if constexpr (ALIGN_EPI) { if (wr == 0) PG8_BAR; }
        if constexpr (Sched::TBL) E(acc, cur, wr, wc, fr, fq, S.tb + (ui % 3) * 1024); else E(acc, cur, wr, wc, fr, fq);
        if (!has_next) break;
#pragma unroll
        for (int a = 0; a < 2; ++a)
#pragma unroll
            for (int b = 0; b < 2; ++b)
#pragma unroll
                for (int m = 0; m < 4; ++m)
#pragma unroll
                    for (int n = 0; n < 2; ++n) acc[a][b][m][n] = (f32x4){0.f, 0.f, 0.f, 0.f};
        cur = nxt; cA = nA; cB = nB; ++ui;
        if constexpr (ALIGN_EPI) { if (wr == 1) PG8_BAR; }
    }
    PG8_WAIT_V(0);
    if constexpr (!ALIGN_EPI) { if (wr == 0) PG8_BAR; }
    PG8_BAR;
#undef PG8_SA
#undef PG8_SB
#undef PG8_STAGE
#undef PG8_LDA
#undef PG8_LDB
#undef PG8_MMA
#undef PG8_WAIT_V
#undef PG8_WAIT_L
#undef PG8_BAR
#undef PG8_SCHED
#undef PG8_AOFFS
#undef PG8_AOFFS_NEXT
#undef PG8_TABLES
#undef PG8_CAT
}
}

#define XB_TMO      128
#define XB_XCNT(j)  (256  + 64 * (j))
#define XB_XSUB(j)  (1280 + 64 * (j))
#define XB_XGEN(j)  (2304 + 64 * (j))
#define XB_TOP      3328
#define XB_TOPGEN   3392
#define XCD_BAR_WORDS 3456
#define XB_SPIN_CAP (1u << 18)
__device__ __forceinline__ unsigned xb_ld(unsigned* p)              { return __hip_atomic_load(p, __ATOMIC_RELAXED, __HIP_MEMORY_SCOPE_AGENT); }
__device__ __forceinline__ unsigned xb_add(unsigned* p, unsigned v) { return __hip_atomic_fetch_add(p, v, __ATOMIC_RELAXED, __HIP_MEMORY_SCOPE_AGENT); }
__device__ __forceinline__ unsigned xb_xcc_id() { return (unsigned)__builtin_amdgcn_s_getreg((3 << 11) | 20) & 0xFu; }
#define XB_SPIN(cond, bar) do { unsigned _sp = 0; while (cond) { __builtin_amdgcn_s_sleep(1); \
    if ((++_sp & 255u) == 0u) { if (xb_ld(&(bar)[XB_TMO])) break; if (_sp > XB_SPIN_CAP) { atomicAdd(&(bar)[XB_TMO], 1u); break; } } } } while (0)
struct XcdBarrier { unsigned* bar; unsigned x; volatile LAS unsigned* st; };
__device__ __forceinline__ XcdBarrier xcd_barrier_post(unsigned* bar, volatile LAS unsigned* st) {
    XcdBarrier b; b.bar = bar; b.x = xb_xcc_id(); b.st = st;
    if (threadIdx.x == 0) (void)xb_add(&bar[XB_XCNT(b.x)], 1u);
    return b;
}
__device__ __forceinline__ void xcd_barrier_complete(unsigned* bar, unsigned x, unsigned& nloc, unsigned& nx) {
    const unsigned G = gridDim.x * gridDim.y * gridDim.z;
    unsigned sum, cnt, mine, sp = 0u;
    for (;;) {
        sum = 0u; cnt = 0u; mine = 0u;
#pragma unroll
        for (unsigned j = 0; j < 16; ++j) { const unsigned c = xb_ld(&bar[XB_XCNT(j)]); sum += c; cnt += (c > 0u) ? 1u : 0u; mine = (j == x) ? c : mine; }
        if (sum == G) break;
        __builtin_amdgcn_s_sleep(1);
        if ((++sp & 255u) == 0u) { if (xb_ld(&bar[XB_TMO])) break; if (sp > XB_SPIN_CAP) { atomicAdd(&bar[XB_TMO], 1u); break; } }
    }
    nloc = mine > 0u ? mine : 1u; nx = cnt > 0u ? cnt : 1u;
}
__device__ __forceinline__ void xcd_barrier(const XcdBarrier& b) {
    asm volatile("s_waitcnt vmcnt(0)" ::: "memory");
    __syncthreads();
    if (threadIdx.x == 0) {
        unsigned* bar = b.bar;
        __builtin_amdgcn_s_waitcnt(0);
        unsigned nloc = b.st[0], nx = b.st[1];
        if (nloc == 0u) { xcd_barrier_complete(bar, b.x, nloc, nx); b.st[0] = nloc; b.st[1] = nx; }
        const unsigned old = xb_add(&bar[XB_XSUB(b.x)], 1u);
        const unsigned gen = old / nloc;
        if (old + 1u == (gen + 1u) * nloc) {
            __builtin_amdgcn_fence(__ATOMIC_RELEASE, "agent");
            asm volatile("s_waitcnt vmcnt(0)" ::: "memory");
            const unsigned og = xb_add(&bar[XB_TOP], 1u);
            const unsigned tg = og / nx;
            if (og + 1u == (tg + 1u) * nx) xb_add(&bar[XB_TOPGEN], 1u);
            else XB_SPIN(xb_ld(&bar[XB_TOPGEN]) == tg, bar);
            __builtin_amdgcn_fence(__ATOMIC_ACQUIRE, "agent");
            xb_add(&bar[XB_XGEN(b.x)], 1u);
            asm volatile("s_waitcnt vmcnt(0)" ::: "memory");
        } else {
            XB_SPIN(xb_ld(&bar[XB_XGEN(b.x)]) == gen, bar);
            __builtin_amdgcn_fence(__ATOMIC_ACQUIRE, "agent");
            asm volatile("s_waitcnt vmcnt(0)" ::: "memory");
        }
    }
    __syncthreads();
}

struct Frame {
    LAS unsigned char* lds;
    unsigned* ctl;
    int tid, lane, wave, G;
    const float *x, *c, *ctx, *c_ctx, *w_mod, *b_mod, *norm1_w, *norm2_w, *w_in, *conv_w, *conv_b, *dt_bias, *a_log, *d_skip, *ssd_norm_w, *pool_w, *pool_scale, *w_out, *router_w, *router_b, *w1, *b1, *w2, *b2, *final_norm_w;
    float* out;
    float *MOD, *DTRAW, *DT, *ROWSC, *CHS, *TOPG, *SLOTGATE;
    bf16* X1;
    int *TOPE, *TOPR, *TOKSLOT, *SLOTTOK, *SLOTID, *ROWID, *BB;
    bf16 *WINT, *WOUTT, *W1T, *W2T, *A1, *XBCPRE, *Z, *V, *XBC, *CC, *ST, *Y, *YB, *A2, *H2, *ACT, *YS;
};

template <class RowMap>
__device__ __forceinline__ void p0_emit(bf16* WT, int Kd, RowMap rm, int k0, int n0, int nvalid, LAS float* scr, int lane) {
    const int c = lane & 7;
#pragma unroll
    for (int j = 0; j < 4; ++j) { const int n = (lane >> 3) + 8 * j; const LAS float* s = scr + (8 * c) * 33 + n;
        v4u o; o.x = pk2(s[0 * 33], s[1 * 33]); o.y = pk2(s[2 * 33], s[3 * 33]); o.z = pk2(s[4 * 33], s[5 * 33]); o.w = pk2(s[6 * 33], s[7 * 33]);
        if (n0 + n < nvalid) *(v4u*)(WT + (size_t)rm(n0 + n) * Kd + k0 + 8 * c) = o; }
    LDS_WAIT(); asm volatile("" ::: "memory");
}
template <class RowMap>
__device__ __forceinline__ void p0_transpose_item(const float* W, int N, int nvalid, bf16* WT, int Kd, RowMap rm, LAS float* scr, int kb, int nb, int lane) {
    const int k0 = 64 * kb, n0 = 32 * nb, nn = n0 + (lane & 31); const bool ok = nn < nvalid;
    float tv[32];
#pragma unroll
    for (int i = 0; i < 32; ++i) { const int kk = 2 * i + (lane >> 5); tv[i] = ok ? W[(size_t)(k0 + kk) * N + nn] : 0.f; }
#pragma unroll
    for (int i = 0; i < 32; ++i) { const int kk = 2 * i + (lane >> 5); scr[kk * 33 + (lane & 31)] = tv[i]; }
    LDS_WAIT(); asm volatile("" ::: "memory");
    p0_emit(WT, Kd, rm, k0, n0, nvalid, scr, lane);
}
struct RmId { __device__ __forceinline__ int operator()(int n) const { return n; } };
struct RmOff { int off; __device__ __forceinline__ int operator()(int n) const { return n + off; } };
struct RmWin { __device__ __forceinline__ int operator()(int n) const { return n < 2560 ? n : (n < 2608 ? 4608 + (n - 2560) : 2560 + (n - 2608)); } };
struct RmW1 { __device__ __forceinline__ int operator()(int n) const { const int j = n >> 1; return 256 * (j >> 7) + 128 * (n & 1) + (j & 127); } };

__device__ __forceinline__ void p0_prologue(Frame& F) {
    if ((int)blockIdx.x < 96) {
        LAS float* sc = (LAS float*)F.lds;
        LAS float* part = (LAS float*)(F.lds + 36864);
        for (int idx = F.tid; idx < 9 * 1024; idx += 512) { const int r = idx >> 10, k = idx & 1023; const float v = (r < 8) ? F.c[r * 1024 + k] : F.c_ctx[k]; sc[idx] = silu_f(v); }
        __syncthreads();
        const int n = 64 * (int)blockIdx.x + F.lane, kb = 128 * F.wave;
        float acc[9];
#pragma unroll
        for (int r = 0; r < 9; ++r) acc[r] = 0.f;
#pragma unroll 8
        for (int k = 0; k < 128; ++k) { const float wv = F.w_mod[(size_t)(kb + k) * 6144 + n];
#pragma unroll
            for (int r = 0; r < 9; ++r) acc[r] += sc[r * 1024 + kb + k] * wv; }
#pragma unroll
        for (int r = 0; r < 9; ++r) part[(F.wave * 9 + r) * 64 + F.lane] = acc[r];
        __syncthreads();
        for (int idx = F.tid; idx < 9 * 64; idx += 512) { const int r = idx >> 6, col = idx & 63; float s = 0.f;
#pragma unroll
            for (int w = 0; w < 8; ++w) s += part[(w * 9 + r) * 64 + col];
            F.MOD[r * 6144 + 64 * (int)blockIdx.x + col] = s + F.b_mod[64 * (int)blockIdx.x + col]; }
        __syncthreads();
    }
    LAS float* scr = (LAS float*)(F.lds + F.wave * 16384);
    const int gw = (int)blockIdx.x * 8 + F.wave, NGW = F.G * 8, lane = F.lane;
    constexpr int I_POOL = 16 * 4 * 4, I_PAD = N1 - IN_COLS;
    for (int r = NGW - 1 - gw; r < I_POOL + I_PAD; r += NGW) {
        if (r < I_POOL) {
            const int kb = r >> 4, g = (r >> 2) & 3, ob = r & 3, k = 64 * kb + lane, o0 = 32 * ob;
            float acc[32];
#pragma unroll
            for (int o = 0; o < 32; ++o) acc[o] = 0.f;
            const float* arow = F.w_in + (size_t)k * IN_COLS + 4144 + g * 128;
            for (int i = 0; i < 128; ++i) { const float a = arow[i]; const float* pw = F.pool_w + (size_t)(g * 128 + i) * 128 + o0;
#pragma unroll
                for (int o = 0; o < 32; ++o) acc[o] += a * pw[o]; }
#pragma unroll
            for (int o = 0; o < 32; ++o) scr[lane * 33 + o] = acc[o] * F.pool_scale[g * 128 + o0 + o];
            LDS_WAIT(); asm volatile("" ::: "memory");
            p0_emit(F.WINT, D, RmOff{4096 + g * 128}, 64 * kb, o0, 1 << 30, scr, lane);
        } else { v4u z = {0u, 0u, 0u, 0u}; v4u* p = (v4u*)(F.WINT + (size_t)(IN_COLS + (r - I_POOL)) * D); p[lane] = z; p[lane + 64] = z; }
    }
    for (int i = (int)blockIdx.x * 512 + F.tid; i < T; i += F.G * 512) F.ROWID[i] = i;
    constexpr int I_WIN = 16 * 130, I_WOUT = 32 * 32, I_W1 = 32 * 16 * 64, I_W2 = 32 * 16 * 32, NI = I_WIN + I_WOUT + I_W1 + I_W2;
    const bool wdeal = (F.G == 256);
    const int blk = (int)blockIdx.x;
#define P0_ITEM(k) (wdeal ? ((k) < 20 ? 2 * (((k) >> 1) * 2048 + gw) + ((k) & 1) : ((k) < 28 ? (blk >= 96 ? 2 * (20480 + (((k) - 20) >> 1) * 1280 + (gw - 768)) + ((k) & 1) : -1) : ((k) < 30 ? ((blk >= 96 && blk < 198) ? 2 * (25600 + (gw - 768)) + ((k) & 1) : -1) : -1))) : 2 * (((k) >> 1) * NGW + gw) + ((k) & 1))
    const int nrounds = wdeal ? 30 : 2 * ((NI / 2 + NGW - 1) / NGW);
    struct It { const float* src; bf16* dst; int N, nvalid, Kd, kind, k0, n0; };
#define P0_DECODE(it, I) do { int r_ = (it); \
        if (r_ < I_WIN) { I.src = F.w_in; I.dst = F.WINT; I.N = IN_COLS; I.nvalid = 4144; I.Kd = D; I.kind = 1; I.k0 = 64 * (r_ / 130); I.n0 = 32 * (r_ % 130); } \
        else if ((r_ -= I_WIN) < I_WOUT) { const int hf_ = r_ & 1, q_ = r_ >> 1; I.src = F.w_out; I.dst = F.WOUTT; I.N = D; I.nvalid = D; I.Kd = 2048; I.kind = 3; I.k0 = 64 * (2 * (q_ >> 5) + hf_); I.n0 = 32 * (q_ & 31); } \
        else if ((r_ -= I_WOUT) < I_W1) { const int hf_ = r_ & 1, p_ = r_ >> 1, e_ = p_ >> 9, q_ = p_ & 511; I.src = F.w1 + (size_t)e_ * D * 2048; I.dst = (bf16*)((unsigned char*)F.W1T + (size_t)e_ * 2048 * D); I.N = 2048; I.nvalid = 2048; I.Kd = D; I.kind = 2; I.k0 = 64 * (2 * (q_ >> 6) + hf_); I.n0 = 32 * (q_ & 63); } \
        else { r_ -= I_W1; const int hf_ = r_ & 1, p_ = r_ >> 1, e_ = p_ >> 8, q_ = p_ & 255; I.src = F.w2 + (size_t)e_ * D * D; I.dst = (bf16*)((unsigned char*)F.W2T + (size_t)e_ * D * D); I.N = D; I.nvalid = D; I.Kd = D; I.kind = 3; I.k0 = 64 * (2 * (q_ >> 5) + hf_); I.n0 = 32 * (q_ & 31); } } while (0)
#define P0_LOAD(I, tv) do { int nn_ = I.n0 + (lane & 31); nn_ = nn_ < I.nvalid ? nn_ : I.nvalid - 1; const float* sp_ = I.src + (size_t)(I.k0 + (lane >> 5)) * I.N + nn_; \
        _Pragma("unroll") for (int i_ = 0; i_ < 32; ++i_) { const float* q_ = sp_ + (size_t)(2 * i_) * I.N; asm volatile("global_load_dword %0, %1, off" : "=v"(tv[i_]) : "v"(q_) : "memory"); } } while (0)
#define P0_NEXT(itv) do { itv = -1; for (; kr < nrounds && itv < 0; ++kr) { const int it_ = P0_ITEM(kr); if (it_ >= 0 && it_ < NI) itv = it_; } } while (0)
#define P0_PROCESS(I, tv) do { \
        _Pragma("unroll") for (int i = 0; i < 32; ++i) { const int kk = 2 * i + (lane >> 5); scr[kk * 33 + (lane & 31)] = tv[i]; } \
        LDS_WAIT(); asm volatile("" ::: "memory"); \
        { const int c = lane & 7; \
          _Pragma("unroll") for (int j = 0; j < 4; ++j) { const int n = (lane >> 3) + 8 * j; const LAS float* sq = scr + (8 * c) * 33 + n; \
            const int ng = I.n0 + n; const int row = (I.kind == 0 || I.kind == 3) ? ng : (I.kind == 1 ? RmWin{}(ng) : RmW1{}(ng)); \
            if (I.kind >= 2) { v2u o; o.x = pk4_fp8(sq[0 * 33] * WSCALE, sq[1 * 33] * WSCALE, sq[2 * 33] * WSCALE, sq[3 * 33] * WSCALE); o.y = pk4_fp8(sq[4 * 33] * WSCALE, sq[5 * 33] * WSCALE, sq[6 * 33] * WSCALE, sq[7 * 33] * WSCALE); \
                *(v2u*)((unsigned char*)I.dst + (size_t)row * I.Kd + I.k0 + 8 * c) = o; } \
            else { v4u o; o.x = pk2(sq[0 * 33], sq[1 * 33]); o.y = pk2(sq[2 * 33], sq[3 * 33]); o.z = pk2(sq[4 * 33], sq[5 * 33]); o.w = pk2(sq[6 * 33], sq[7 * 33]); \
                if (ng < I.nvalid) *(v4u*)(I.dst + (size_t)row * I.Kd + I.k0 + 8 * c) = o; } } \
          LDS_WAIT(); asm volatile("" ::: "memory"); } } while (0)
    It ia{}, ib{}; float ta[32], tb[32]; int ita = -1, itb = -1; int kr = 0;
    P0_NEXT(ita);
    if (ita >= 0) { P0_DECODE(ita, ia); P0_LOAD(ia, ta); }
    while (ita >= 0) {
        P0_NEXT(itb);
        if (itb >= 0) { P0_DECODE(itb, ib); P0_LOAD(ib, tb); asm volatile("s_waitcnt vmcnt(32)" ::: "memory"); } else { asm volatile("s_waitcnt vmcnt(0)" ::: "memory"); }
        __builtin_amdgcn_sched_barrier(0);
        P0_PROCESS(ia, ta);
        if (itb < 0) break;
        P0_NEXT(ita);
        if (ita >= 0) { P0_DECODE(ita, ia); P0_LOAD(ia, ta); asm volatile("s_waitcnt vmcnt(32)" ::: "memory"); } else { asm volatile("s_waitcnt vmcnt(0)" ::: "memory"); }
        __builtin_amdgcn_sched_barrier(0);
        P0_PROCESS(ib, tb);
    }
#undef P0_NEXT
#undef P0_PROCESS
#undef P0_ITEM
#undef P0_DECODE
#undef P0_LOAD
}

__device__ __forceinline__ void p1_norm1(Frame& F) {
    const int gw = (int)blockIdx.x * 8 + F.wave, NGW = F.G * 8, lane = F.lane;
    const int per = (RTOT + NGW - 1) / NGW;
    const int rbeg = gw * per, rend = (rbeg + per < RTOT) ? rbeg + per : RTOT;
    int mb_cur = -1; f32x4 wsc[4], shv[4];
    for (int r0 = rbeg; r0 < rend; r0 += 4) {
        f32x4 v[4][4];
#pragma unroll
        for (int k = 0; k < 4; ++k) { const int r = (r0 + k < rend) ? r0 + k : rbeg; const float* xr = (r < T) ? F.x + (size_t)r * D : F.ctx + (size_t)(r - T) * D;
#pragma unroll
            for (int j = 0; j < 4; ++j) v[k][j] = *(const f32x4*)(xr + 4 * lane + 256 * j); }
#pragma unroll
        for (int k = 0; k < 4; ++k) { const int r = r0 + k; if (r < rend) {
            const int mb = (r < T) ? (r >> 12) : 8;
            if (mb != mb_cur) { const float* mod = F.MOD + (size_t)mb * 6144; mb_cur = mb;
#pragma unroll
                for (int j = 0; j < 4; ++j) { const int col = 4 * lane + 256 * j; wsc[j] = *(const f32x4*)(F.norm1_w + col) * (*(const f32x4*)(mod + 1024 + col) + 1.f); shv[j] = *(const f32x4*)(mod + col); } }
            float ss = 0.f;
#pragma unroll
            for (int j = 0; j < 4; ++j) ss += (v[k][j].x * v[k][j].x + v[k][j].y * v[k][j].y) + (v[k][j].z * v[k][j].z + v[k][j].w * v[k][j].w);
            const float rs = __builtin_amdgcn_rsqf(wave_sum(ss) * (1.f / D) + RMS_EPS);
#pragma unroll
            for (int j = 0; j < 4; ++j) { const int col = 4 * lane + 256 * j;
                const f32x4 h = (v[k][j] * rs) * wsc[j] + shv[j];
                v2u o; o.x = pk2(h.x, h.y); o.y = pk2(h.z, h.w);
                *(v2u*)(F.A1 + (size_t)r * D + col) = o; } } }
    }
}

struct Sched1 {   static constexpr bool TBL = false;
    const char* A; const char* Bt; int G, c;
    __device__ __forceinline__ bool next(int i, pg8::Unit& u) const {
        const int L = i * G + c; if (L >= 2432 + 88) return false;
        if (L < 2432) pg8::static_map(L, 128, 19, u.pm, u.pn);
        else { const int Lc = L - 2432, j = Lc >> 3; u.pm = 128 + (Lc & 7); u.pn = j < 10 ? j : 18; }
        u.e = 0; return true; }
    __device__ __forceinline__ const char* a_base(const pg8::Unit& u) const { return A + (size_t)u.pm * 256 * D * 2; }
    __device__ __forceinline__ const char* b_base(const pg8::Unit& u) const { return Bt + (size_t)u.pn * 256 * D * 2; }
    __device__ __forceinline__ const int* row_table(const pg8::Unit&) const { return nullptr; }
};
struct Epi1 {
    static constexpr bool PERM = true;
    bf16 *XBCPRE, *Z, *V; float* DTRAW;
    __device__ __forceinline__ void operator()(const f32x4 (&acc)[2][2][4][2], const pg8::Unit& u, int wr, int wc, int fr, int fq) const {
        const int row0 = u.pm * 256 + wr * 64 + fr;
        if (u.pn < 18) {
            bf16* base; int ldc, colt;
            if (u.pn < 10) { base = XBCPRE; ldc = CONV_CH; colt = u.pn * 256; } else if (u.pn < 16) { base = Z; ldc = SSD_W; colt = (u.pn - 10) * 256; } else { base = V; ldc = 512; colt = (u.pn - 16) * 256; }
            const int col0 = colt + wc * 32 + 8 * fq;
#pragma unroll
            for (int ai = 0; ai < 2; ++ai)
#pragma unroll
                for (int m = 0; m < 4; ++m) { bf16* rowp = base + (size_t)(row0 + ai * 128 + m * 16) * ldc + col0;
#pragma unroll
                    for (int bj = 0; bj < 2; ++bj) { const f32x4 v0 = acc[ai][bj][m][0], v1 = acc[ai][bj][m][1];
                        v4u w; w.x = pg8::cvt_pk_bf16(v0[0], v0[1]); w.y = pg8::cvt_pk_bf16(v0[2], v0[3]); w.z = pg8::cvt_pk_bf16(v1[0], v1[1]); w.w = pg8::cvt_pk_bf16(v1[2], v1[3]);
                        *(v4u*)(rowp + bj * 128) = w; } }
        } else if (wc < 2) {
            const int col0 = wc * 32 + 8 * fq;
#pragma unroll
            for (int ai = 0; ai < 2; ++ai)
#pragma unroll
                for (int m = 0; m < 4; ++m) { float* rowp = DTRAW + (size_t)(row0 + ai * 128 + m * 16) * 64 + col0;
                    *(f32x4*)(rowp) = acc[ai][0][m][0]; *(f32x4*)(rowp + 4) = acc[ai][0][m][1]; }
        }
    }
};

__device__ __forceinline__ bf16x8 frag_row(const LAS unsigned char* base, int rs, int row, int k0, int q) { return *(const LAS bf16x8*)(base + row * rs + (k0 + 8 * q) * 2); }
__device__ __forceinline__ bf16x8 frag_tr(const LAS unsigned char* base, int rs, int k0, int c0, int lane) {
    const int g = lane >> 4, qq = (lane & 15) >> 2, p = lane & 3;
    const LAS unsigned char* a = base + (k0 + 8 * g + qq) * rs + c0 * 2 + 8 * p;
    const s16x4 lo = __builtin_amdgcn_ds_read_tr16_b64_v4i16((LAS s16x4*)a);
    const s16x4 hi = __builtin_amdgcn_ds_read_tr16_b64_v4i16((LAS s16x4*)(a + 4 * rs));
    bf16x8 r; r[0] = lo[0]; r[1] = lo[1]; r[2] = lo[2]; r[3] = lo[3]; r[4] = hi[0]; r[5] = hi[1]; r[6] = hi[2]; r[7] = hi[3]; return r;
}
__device__ __forceinline__ f32x4 mfma16(bf16x8 a, bf16x8 b, f32x4 c) { return __builtin_amdgcn_mfma_f32_16x16x32_bf16(a, b, c, 0, 0, 0); }
__device__ __forceinline__ float wave_incl_scan(float v, int lane) {
#pragma unroll
    for (int o = 1; o < 64; o <<= 1) { const float t = __shfl_up(v, o); if (lane >= o) v += t; }
    return v;
}

__device__ __forceinline__ float silu_fast(float v) { return v * __builtin_amdgcn_rcpf(1.f + __builtin_amdgcn_exp2f(-1.44269504f * v)); }
__device__ __forceinline__ float softplus_f(float v) { return v > 20.f ? v : log1pf(__expf(v)); }
__device__ __forceinline__ void p4_scan(Frame& F, LAS float* Te, volatile LAS float* TOT, int d, int h, float raw0, float raw1, int lane, size_t chs_idx, float* rowsc) {
    const int s0 = d ? 127 - 2 * lane : 2 * lane, s1 = d ? s0 - 1 : s0 + 1;
    const float bias = F.dt_bias[d * NH + h];
    const float dt0 = softplus_f(raw0 + bias), dt1 = softplus_f(raw1 + bias);
    const float A2 = __expf(F.a_log[d * NH + h]) * 1.44269504f;
    const float a0 = -A2 * dt0, a1 = -A2 * dt1;
    const float incl = wave_incl_scan(a0 + a1, lane);
    const float c1 = incl, c0 = incl - a1, tot = __shfl(incl, 63);
    Te[d * 128 + s0] = c0; Te[d * 128 + s1] = c1;
    Te[(2 + d) * 128 + s0] = c0 - __builtin_amdgcn_logf(dt0); Te[(2 + d) * 128 + s1] = c1 - __builtin_amdgcn_logf(dt1);
    if (lane == 63) { F.CHS[chs_idx] = tot; *TOT = tot; }
    if (rowsc) { rowsc[s0] = __builtin_amdgcn_exp2f(c0); rowsc[s1] = __builtin_amdgcn_exp2f(c1); }
}
__device__ __forceinline__ v4u conv_piece(const v4u& r0, const v4u& r1, const v4u& r2, const v4u& r3, const v4u& r4, const float (&w)[5][8], const float (&bias)[8]) {
    float o[8];
#pragma unroll
    for (int e = 0; e < 8; ++e) o[e] = bias[e];
    const v4u rr[5] = {r0, r1, r2, r3, r4};
#pragma unroll
    for (int j = 0; j < 5; ++j) { const v4u q = rr[j];
        o[0] += w[j][0] * bflo(q.x); o[1] += w[j][1] * bfhi(q.x); o[2] += w[j][2] * bflo(q.y); o[3] += w[j][3] * bfhi(q.y);
        o[4] += w[j][4] * bflo(q.z); o[5] += w[j][5] * bfhi(q.z); o[6] += w[j][6] * bflo(q.w); o[7] += w[j][7] * bfhi(q.w); }
    v4u ov; ov.x = pk2(silu_fast(o[0]), silu_fast(o[1])); ov.y = pk2(silu_fast(o[2]), silu_fast(o[3])); ov.z = pk2(silu_fast(o[4]), silu_fast(o[5])); ov.w = pk2(silu_fast(o[6]), silu_fast(o[7]));
    return ov;
}
__device__ __forceinline__ void p4_states(Frame& F, const bf16x8 (&braw)[4], const LAS float* Te, const volatile LAS float* TOT2, const LAS unsigned char* Xs, size_t st_base, int w, int lane) {
    constexpr int RSX = 144;
    const int i16 = lane & 15, q4 = lane >> 4;
#pragma unroll
    for (int d = 0; d < 2; ++d) {
        const float tot = TOT2[d];
        f32x4 sa[4];
#pragma unroll
        for (int pt = 0; pt < 4; ++pt) sa[pt] = (f32x4){0.f, 0.f, 0.f, 0.f};
#pragma unroll
        for (int ks = 0; ks < 4; ++ks) {
            const LAS float* cp = Te + (2 + d) * 128 + 32 * ks + 8 * q4;
            const f32x4 c0 = *(const LAS f32x4*)cp, c1 = *(const LAS f32x4*)(cp + 4);
            float wv[8];
#pragma unroll
            for (int j = 0; j < 4; ++j) { wv[j] = __builtin_amdgcn_exp2f(tot - c0[j]); wv[4 + j] = __builtin_amdgcn_exp2f(tot - c1[j]); }
            const v4u bu = __builtin_bit_cast(v4u, braw[ks]); v4u su;
            su.x = pk2(bflo(bu.x) * wv[0], bfhi(bu.x) * wv[1]); su.y = pk2(bflo(bu.y) * wv[2], bfhi(bu.y) * wv[3]);
            su.z = pk2(bflo(bu.z) * wv[4], bfhi(bu.z) * wv[5]); su.w = pk2(bflo(bu.w) * wv[6], bfhi(bu.w) * wv[7]);
            const bf16x8 bs = __builtin_bit_cast(bf16x8, su);
#pragma unroll
            for (int pt = 0; pt < 4; ++pt) sa[pt] = mfma16(bs, frag_tr(Xs, RSX, 32 * ks, 16 * pt, lane), sa[pt]); }
        unsigned char* sp = (unsigned char*)F.ST + st_base + ((size_t)d * HDIM + i16) * NST + 16 * w + 4 * q4;
#pragma unroll
        for (int pt = 0; pt < 4; ++pt) { float c[4];
#pragma unroll
            for (int r = 0; r < 4; ++r) c[r] = fminf(fmaxf(sa[pt][r] * STSCALE, -440.f), 440.f);
            *(unsigned*)(sp + (size_t)16 * pt * NST) = pk4_fp8(c[0], c[1], c[2], c[3]); }
    }
}
__device__ __forceinline__ void p4_ssd_local(Frame& F) {
    constexpr int RS = 272, RSX = 144;
    constexpr int O_C = 0, O_B = 34816, O_M = 69632, O_X = 104448  , O_T = 141312  , O_CW = 153600  ;
    static_assert(O_CW + 9216 <= MISC_OFF, "P4 LDS map");
    LAS unsigned char* L = F.lds;
    LAS float* TAB = (LAS float*)(L + O_T);
    LAS float* CW = (LAS float*)(L + O_CW);
    volatile LAS float* TOT = (volatile LAS float*)(L + MISC_OFF + 64);
    volatile LAS float* DSK = (volatile LAS float*)(L + MISC_OFF + 128);
    const int tid = F.tid, w = F.wave;
    const int lb = 64 * (w & 1), sb = 32 * (w >> 1);
    const v4u zero4 = {0u, 0u, 0u, 0u};
    constexpr int NLAT = NB * 32 * NGRP, NCTX = NB * 2 * NGRP * HPG;
    int g_staged = -1;
    for (int v = (int)blockIdx.x; v < NLAT + NCTX; v += F.G) {
        const bool lat = v < NLAT;
        int tid_l = tid; asm volatile("" : "+v"(tid_l));
        const int lane_l = tid_l & 63, lane = lane_l, i16 = lane & 15, q4 = lane >> 4;
        const int p32 = tid_l & 31, rg = tid_l >> 5;
        const int xpc = tid_l & 7, rg2 = tid_l >> 3;
        int b, g, cc, r0, e_lo, e_hi; bool lo_ok, hi_ok;
        if (lat) { b = v >> 7; const int c = (v >> 2) & 31; g = v & 3; cc = c + 2; r0 = b * SEQ + c * CHUNK; lo_ok = c > 0; hi_ok = c < 31; e_lo = 0; e_hi = HPG; }
        else { const int q = v - NLAT; const int e = q % HPG; int t = q / HPG; g = t & 3; t >>= 2; cc = t & 1; b = t >> 1; r0 = T + b * CTXL + cc * CHUNK; lo_ok = cc > 0; hi_ok = cc < 1; e_lo = e; e_hi = e + 1; }
        const int rmin = lo_ok ? -2 : 0, rmax = hi_ok ? 129 : 127;
        const int chBC = SSD_W + (p32 >> 4) * (NGRP * NST) + g * NST + 8 * (p32 & 15);
        v4u raw[12];
#pragma unroll
        for (int j = 0; j < 12; ++j) { const int rr = 8 * rg - 2 + j; const int rc = rr < rmin ? rmin : (rr > rmax ? rmax : rr);
            const v4u t = *(const v4u*)(F.XBCPRE + (size_t)(r0 + rc) * CONV_CH + chBC); raw[j] = (rr == rc) ? t : zero4; }
        if (g != g_staged) {
            if (tid < HPG) DSK[tid] = F.d_skip[g * HPG + tid];
            float cwv[5];
#pragma unroll
            for (int q = 0; q < 5; ++q) { int idx = tid + 512 * q; idx = idx < HPG * 6 * 64 ? idx : HPG * 6 * 64 - 1; const int e_ = idx / 384, rem = idx - e_ * 384, j = rem >> 6, chl = rem & 63; const int ch = (g * HPG + e_) * HDIM + chl;
                const int jj = j < 5 ? j : 0; const float a = F.conv_w[jj * CONV_CH + ch], bq = F.conv_b[ch]; cwv[q] = (j < 5) ? a : bq; }
#pragma unroll
            for (int q = 0; q < 5; ++q) { const int idx = tid + 512 * q; if (idx < HPG * 6 * 64) CW[idx] = cwv[q]; }
            g_staged = g;
        }
        {
            float cw[5][8], cbias[8];
#pragma unroll
            for (int j = 0; j < 5; ++j) { const f32x4 a = *(const f32x4*)(F.conv_w + j * CONV_CH + chBC), bq = *(const f32x4*)(F.conv_w + j * CONV_CH + chBC + 4);
                cw[j][0] = a.x; cw[j][1] = a.y; cw[j][2] = a.z; cw[j][3] = a.w; cw[j][4] = bq.x; cw[j][5] = bq.y; cw[j][6] = bq.z; cw[j][7] = bq.w; }
            { const f32x4 a = *(const f32x4*)(F.conv_b + chBC), bq = *(const f32x4*)(F.conv_b + chBC + 4); cbias[0] = a.x; cbias[1] = a.y; cbias[2] = a.z; cbias[3] = a.w; cbias[4] = bq.x; cbias[5] = bq.y; cbias[6] = bq.z; cbias[7] = bq.w; }
            LAS unsigned char* dst = L + ((p32 >> 4) ? O_C : O_B) + (8 * rg) * RS + (p32 & 15) * 16;
#pragma unroll
            for (int i = 0; i < 8; ++i) { const v4u o = conv_piece(raw[i], raw[i + 1], raw[i + 2], raw[i + 3], raw[i + 4], cw, cbias);
                *(LAS v4u*)(dst + i * RS) = o;
                if (lat && (p32 >> 4)) *(v4u*)(F.CC + (size_t)(r0 + 8 * rg + i) * 512 + g * NST + 8 * (p32 & 15)) = o; }
        }
        v4u xraw[6];
#pragma unroll
        for (int j = 0; j < 6; ++j) { const int rr = 2 * rg2 - 2 + j; const int rc = rr < rmin ? rmin : (rr > rmax ? rmax : rr);
            xraw[j] = *(const v4u*)(F.XBCPRE + (size_t)(r0 + rc) * CONV_CH + (g * HPG + e_lo) * HDIM + 8 * xpc); }
        float pdt[2][2];
#pragma unroll
        for (int ii = 0; ii < 2; ++ii) { const int idx = (w + 8 * ii) < 12 ? (w + 8 * ii) : 11; const int e_ = idx % 6, d_ = idx / 6, h_ = g * HPG + e_; const int s0 = d_ ? 127 - 2 * lane_l : 2 * lane_l, s1 = d_ ? s0 - 1 : s0 + 1;
            pdt[ii][0] = F.DTRAW[(size_t)(r0 + s0) * 64 + d_ * NH + h_]; pdt[ii][1] = F.DTRAW[(size_t)(r0 + s1) * 64 + d_ * NH + h_]; }
#pragma unroll
        for (int ii = 0; ii < 2; ++ii) { const int idx = w + 8 * ii; const int e = idx % 6, d = idx / 6, h = g * HPG + e;
            if (idx < 12 && e >= e_lo && e < e_hi)
                p4_scan(F, TAB + e * 512, TOT + e * 2 + d, d, h, pdt[ii][0], pdt[ii][1], lane_l, ((size_t)(b * NCC + cc) * NH + h) * 2 + d, lat ? F.ROWSC + ((size_t)(b * 2 + d) * NH + h) * SEQ + (cc - 2) * CHUNK : nullptr); }
        __syncthreads();
        f32x4 cb[2][4];
        if (lat) {
#pragma unroll
            for (int ts = 0; ts < 2; ++ts)
#pragma unroll
                for (int tl = 0; tl < 4; ++tl) cb[ts][tl] = (f32x4){0.f, 0.f, 0.f, 0.f};
#pragma unroll
            for (int ks = 0; ks < 4; ++ks) { bf16x8 af[2], bfr[4];
#pragma unroll
                for (int ts = 0; ts < 2; ++ts) af[ts] = frag_row(L + O_B, RS, sb + 16 * ts + i16, 32 * ks, q4);
#pragma unroll
                for (int tl = 0; tl < 4; ++tl) bfr[tl] = frag_row(L + O_C, RS, lb + 16 * tl + i16, 32 * ks, q4);
#pragma unroll
                for (int ts = 0; ts < 2; ++ts)
#pragma unroll
                    for (int tl = 0; tl < 4; ++tl) cb[ts][tl] = mfma16(af[ts], bfr[tl], cb[ts][tl]); }
        }
        bf16x8 braw[4];
#pragma unroll
        for (int ks = 0; ks < 4; ++ks) braw[ks] = frag_tr(L + O_B, RS, 32 * ks, 16 * w, lane);
        for (int e = e_lo; e < e_hi; ++e) {
            const int h = g * HPG + e;
            const LAS float* Te = TAB + e * 512;
            LAS unsigned char* Xs = L + O_X + (e & 1) * 18432;
            LAS unsigned char* Ms = L + ((e & 1) ? O_C : O_M);
            {
                const LAS float* cwp = CW + (e * 6) * 64 + 8 * xpc;
#pragma unroll
                for (int i = 0; i < 2; ++i) {
                    f32x4 oa = *(const LAS f32x4*)(cwp + 5 * 64), ob = *(const LAS f32x4*)(cwp + 5 * 64 + 4);
#pragma unroll
                    for (int j = 0; j < 5; ++j) { const f32x4 wa = *(const LAS f32x4*)(cwp + j * 64), wb = *(const LAS f32x4*)(cwp + j * 64 + 4);
                        const int rr = 2 * rg2 - 2 + i + j; const v4u q = (rr >= rmin && rr <= rmax) ? xraw[i + j] : zero4;
                        oa.x += wa.x * bflo(q.x); oa.y += wa.y * bfhi(q.x); oa.z += wa.z * bflo(q.y); oa.w += wa.w * bfhi(q.y);
                        ob.x += wb.x * bflo(q.z); ob.y += wb.y * bfhi(q.z); ob.z += wb.z * bflo(q.w); ob.w += wb.w * bfhi(q.w); }
                    v4u ov; ov.x = pk2(silu_fast(oa.x), silu_fast(oa.y)); ov.y = pk2(silu_fast(oa.z), silu_fast(oa.w)); ov.z = pk2(silu_fast(ob.x), silu_fast(ob.y)); ov.w = pk2(silu_fast(ob.z), silu_fast(ob.w));
                    *(LAS v4u*)(Xs + (2 * rg2 + i) * RSX + xpc * 16) = ov; }
            }
            if (e + 1 < e_hi) {
#pragma unroll
                for (int j = 0; j < 6; ++j) { const int rr = 2 * rg2 - 2 + j; const int rc = rr < rmin ? rmin : (rr > rmax ? rmax : rr);
                    xraw[j] = *(const v4u*)(F.XBCPRE + (size_t)(r0 + rc) * CONV_CH + (h + 1) * HDIM + 8 * xpc); }
            }
            if (lat) {
                const float Dh = DSK[e];
#pragma unroll
                for (int tl = 0; tl < 4; ++tl) { const int l = lb + 16 * tl + i16; const int lt_abs = 4 * (w & 1) + tl; const float af_l = Te[l], rb_l = Te[128 + l];
#pragma unroll
                    for (int ts = 0; ts < 2; ++ts) { const int s0 = sb + 16 * ts + 4 * q4; const int st_abs = 2 * (w >> 1) + ts;
                        float m[4];
                        if (st_abs < lt_abs) {
                            const f32x4 acs = *(const LAS f32x4*)(Te + 256 + s0);
#pragma unroll
                            for (int r = 0; r < 4; ++r) m[r] = cb[ts][tl][r] * __builtin_amdgcn_exp2f(af_l - acs[r]);
                        } else if (st_abs > lt_abs) {
                            const f32x4 rbs = *(const LAS f32x4*)(Te + 384 + s0);
#pragma unroll
                            for (int r = 0; r < 4; ++r) m[r] = cb[ts][tl][r] * __builtin_amdgcn_exp2f(rb_l - rbs[r]);
                        } else {
                            const f32x4 acs = *(const LAS f32x4*)(Te + 256 + s0), rbs = *(const LAS f32x4*)(Te + 384 + s0);
#pragma unroll
                            for (int r = 0; r < 4; ++r) { const int sidx = s0 + r;
                                const float wf = (sidx <= l) ? __builtin_amdgcn_exp2f(af_l - acs[r]) : 0.f;
                                const float wb = (sidx >= l) ? __builtin_amdgcn_exp2f(rb_l - rbs[r]) : 0.f;
                                m[r] = cb[ts][tl][r] * (wf + wb) + ((sidx == l) ? Dh : 0.f); }
                        }
                        v2u o; o.x = pk2(m[0], m[1]); o.y = pk2(m[2], m[3]);
                        *(LAS v2u*)(Ms + l * RS + s0 * 2) = o; } }
            }
            __syncthreads();
            if (lat) {
                f32x4 ya[4];
#pragma unroll
                for (int pt = 0; pt < 4; ++pt) ya[pt] = (f32x4){0.f, 0.f, 0.f, 0.f};
#pragma unroll
                for (int ks = 0; ks < 4; ++ks) { const bf16x8 bm = frag_row(Ms, RS, 16 * w + i16, 32 * ks, q4);
#pragma unroll
                    for (int pt = 0; pt < 4; ++pt) ya[pt] = mfma16(frag_tr(Xs, RSX, 32 * ks, 16 * pt, lane), bm, ya[pt]); }
                bf16* yp = F.Y + (size_t)(r0 + 16 * w + i16) * SSD_W + h * HDIM + 4 * q4;
#pragma unroll
                for (int pt = 0; pt < 4; ++pt) { v2u o; o.x = pk2(ya[pt][0], ya[pt][1]); o.y = pk2(ya[pt][2], ya[pt][3]); *(v2u*)(yp + 16 * pt) = o; }
            }
            p4_states(F, braw, Te, TOT + e * 2, Xs, (((size_t)(b * NCC + cc) * NH + h) * 2) * HDIM * NST, w, lane);
        }
        __syncthreads();
    }
}

__device__ __forceinline__ void p5_ssd_scan(Frame& F) {
    constexpr int RS = 272, O_RS = 4 * 34816;
    LAS unsigned char* L = F.lds;
    LAS float* RSB = (LAS float*)(L + O_RS);
    const int tid = F.tid, lane = F.lane, w = F.wave, i16 = lane & 15, q4 = lane >> 4;
    const int d = w >> 2, ps = w & 3, t8 = tid & 255;
    for (int u = (int)blockIdx.x; u < NB * NH; u += F.G) {
        const int b = u / NH, h = u - b * NH, g = h / HPG;
        float S[32];
#pragma unroll
        for (int k = 0; k < 32; ++k) S[k] = 0.f;
        v4u creg[8]; float rsreg = 0.f;
#pragma unroll
        for (int k = 0; k < 8; ++k) creg[k] = (v4u){0u, 0u, 0u, 0u};
        for (int j = 0; j < NCC; ++j) {
            const int cc = d == 0 ? j : (j < 2 ? 1 - j : 35 - j);
            LAS unsigned char* Cb = L + ((j & 1) * 2 + d) * 34816;
            if (j >= 2) {
#pragma unroll
                for (int k = 0; k < 8; ++k) { const int pc = t8 + 256 * k, row = pc >> 4, ch = pc & 15; *(LAS v4u*)(Cb + row * RS + ch * 16) = creg[k]; }
                if (t8 < 128) RSB[((j & 1) * 2 + d) * 128 + t8] = rsreg;
            }
            __syncthreads();
            if (j + 1 >= 2 && j + 1 < NCC) {
                const int cn = d == 0 ? j + 1 : 34 - j;
                const size_t rown = (size_t)b * SEQ + (size_t)(cn - 2) * CHUNK;
#pragma unroll
                for (int k = 0; k < 8; ++k) { const int pc = t8 + 256 * k, row = pc >> 4, ch = pc & 15; creg[k] = *(const v4u*)(F.CC + (rown + row) * 512 + g * NST + ch * 8); }
                if (t8 < 128) rsreg = F.ROWSC[((size_t)(b * 2 + d) * NH + h) * SEQ + (cn - 2) * CHUNK + t8];
            }
            const size_t sidx = ((size_t)(b * NCC + cc) * NH + h) * 2 + d;
            const unsigned char* stp = (const unsigned char*)F.ST + (sidx * HDIM + 16 * ps + i16) * NST + 8 * q4;
            v2u stv[4];
#pragma unroll
            for (int ks = 0; ks < 4; ++ks) stv[ks] = *(const v2u*)(stp + 32 * ks);
            const float decay = __builtin_amdgcn_exp2f(F.CHS[sidx]);
            if (j >= 2) {
                bf16x8 sf[4];
#pragma unroll
                for (int ks = 0; ks < 4; ++ks) { v4u t; t.x = pk2(S[ks * 8 + 0], S[ks * 8 + 1]); t.y = pk2(S[ks * 8 + 2], S[ks * 8 + 3]); t.z = pk2(S[ks * 8 + 4], S[ks * 8 + 5]); t.w = pk2(S[ks * 8 + 6], S[ks * 8 + 7]); sf[ks] = __builtin_bit_cast(bf16x8, t); }
                const size_t rowb = (size_t)b * SEQ + (size_t)(cc - 2) * CHUNK;
                const LAS float* rsl = RSB + ((j & 1) * 2 + d) * 128;
                const int c = cc - 2; const bool first = (d == 0) ? (c <= 15) : (c >= 16);
                unsigned yold[8];
                unsigned char* yo = (unsigned char*)F.YB + (rowb + i16) * SSD_W + h * HDIM + 16 * ps + 4 * q4;
                if (!first) {
#pragma unroll
                    for (int lt = 0; lt < 8; ++lt) yold[lt] = *(const unsigned*)(yo + (size_t)16 * lt * SSD_W);
                }
#pragma unroll
                for (int lt = 0; lt < 8; ++lt) {
                    f32x4 a = (f32x4){0.f, 0.f, 0.f, 0.f};
#pragma unroll
                    for (int ks = 0; ks < 4; ++ks) a = mfma16(sf[ks], frag_row(Cb, RS, 16 * lt + i16, 32 * ks, q4), a);
                    const float sc = rsl[16 * lt + i16] * YOSCALE;
                    float o[4] = {a[0] * sc, a[1] * sc, a[2] * sc, a[3] * sc};
                    if (!first) { const f32x2 lo = __builtin_amdgcn_cvt_pk_f32_fp8((int)yold[lt], false), hi = __builtin_amdgcn_cvt_pk_f32_fp8((int)yold[lt], true); o[0] += lo.x; o[1] += lo.y; o[2] += hi.x; o[3] += hi.y; }
#pragma unroll
                    for (int r = 0; r < 4; ++r) o[r] = fminf(fmaxf(o[r], -440.f), 440.f);
                    *(unsigned*)(yo + (size_t)16 * lt * SSD_W) = pk4_fp8(o[0], o[1], o[2], o[3]);
                }
            }
#pragma unroll
            for (int ks = 0; ks < 4; ++ks) { const v2u t = stv[ks];
                const f32x2 a0 = __builtin_amdgcn_cvt_pk_f32_fp8((int)t.x, false), a1 = __builtin_amdgcn_cvt_pk_f32_fp8((int)t.x, true), a2 = __builtin_amdgcn_cvt_pk_f32_fp8((int)t.y, false), a3 = __builtin_amdgcn_cvt_pk_f32_fp8((int)t.y, true);
                S[ks * 8 + 0] = decay * S[ks * 8 + 0] + a0.x * (1.f / STSCALE); S[ks * 8 + 1] = decay * S[ks * 8 + 1] + a0.y * (1.f / STSCALE);
                S[ks * 8 + 2] = decay * S[ks * 8 + 2] + a1.x * (1.f / STSCALE); S[ks * 8 + 3] = decay * S[ks * 8 + 3] + a1.y * (1.f / STSCALE);
                S[ks * 8 + 4] = decay * S[ks * 8 + 4] + a2.x * (1.f / STSCALE); S[ks * 8 + 5] = decay * S[ks * 8 + 5] + a2.y * (1.f / STSCALE);
                S[ks * 8 + 6] = decay * S[ks * 8 + 6] + a3.x * (1.f / STSCALE); S[ks * 8 + 7] = decay * S[ks * 8 + 7] + a3.y * (1.f / STSCALE); }
        }
        __syncthreads();
    }
}

__device__ __forceinline__ void p6_gate_pool(Frame& F) {
    LAS unsigned char* L = F.lds;
    const int tid = F.tid, lane = F.lane, w = F.wave;
    f32x4 nw[3][2];
#pragma unroll
    for (int j = 0; j < 3; ++j) { const int col = 8 * (lane + 64 * j); nw[j][0] = *(const f32x4*)(F.ssd_norm_w + col) * A2SCALE; nw[j][1] = *(const f32x4*)(F.ssd_norm_w + col + 4) * A2SCALE; }
    for (int gr = (int)blockIdx.x; gr < T / 64; gr += F.G) {
        const int rb = gr * 64;
        v4u pv[8];
#pragma unroll
        for (int k = 0; k < 8; ++k) { const int pc = tid + 512 * k, row = pc >> 6, ch = pc & 63; pv[k] = *(const v4u*)(F.V + (size_t)(rb + row) * 512 + ch * 8); }
#pragma unroll
        for (int k = 0; k < 8; ++k) { const int pc = tid + 512 * k, row = pc >> 6, ch = pc & 63; *(LAS v4u*)(L + row * 1024 + ch * 16) = pv[k]; }
        for (int rr = 0; rr < 8; rr += 2) {
            v4u ya[2][3], zz[2][3]; v2u yb[2][3];
#pragma unroll
            for (int k = 0; k < 2; ++k) { const int r = rb + 8 * w + rr + k;
#pragma unroll
                for (int j = 0; j < 3; ++j) { const int col = 8 * (lane + 64 * j);
                    ya[k][j] = *(const v4u*)(F.Y + (size_t)r * SSD_W + col); yb[k][j] = *(const v2u*)((const unsigned char*)F.YB + (size_t)r * SSD_W + col); zz[k][j] = *(const v4u*)(F.Z + (size_t)r * SSD_W + col); } }
#pragma unroll
            for (int k = 0; k < 2; ++k) { const int r = rb + 8 * w + rr + k;
                float v[24]; float ss = 0.f;
#pragma unroll
                for (int j = 0; j < 3; ++j) {
                    const unsigned yaw[4] = {ya[k][j].x, ya[k][j].y, ya[k][j].z, ya[k][j].w}, zw[4] = {zz[k][j].x, zz[k][j].y, zz[k][j].z, zz[k][j].w};
                    const f32x2 yo2[4] = {__builtin_amdgcn_cvt_pk_f32_fp8((int)yb[k][j].x, false), __builtin_amdgcn_cvt_pk_f32_fp8((int)yb[k][j].x, true), __builtin_amdgcn_cvt_pk_f32_fp8((int)yb[k][j].y, false), __builtin_amdgcn_cvt_pk_f32_fp8((int)yb[k][j].y, true)};
#pragma unroll
                    for (int e = 0; e < 4; ++e) { const float y0 = bflo(yaw[e]) + yo2[e].x * (1.f / YOSCALE), y1 = bfhi(yaw[e]) + yo2[e].y * (1.f / YOSCALE);
                        const float g0 = y0 * silu_f(bflo(zw[e])), g1 = y1 * silu_f(bfhi(zw[e])); v[j * 8 + 2 * e] = g0; v[j * 8 + 2 * e + 1] = g1; ss += g0 * g0 + g1 * g1; } }
                const float rs = __builtin_amdgcn_rsqf(wave_sum(ss) * (1.f / SSD_W) + RMS_EPS);
#pragma unroll
                for (int j = 0; j < 3; ++j) { const int col = 8 * (lane + 64 * j);
                    const f32x4 w0 = nw[j][0], w1 = nw[j][1];
                    const float rq = rs; float q[8] = {v[j * 8 + 0] * rq * w0.x, v[j * 8 + 1] * rq * w0.y, v[j * 8 + 2] * rq * w0.z, v[j * 8 + 3] * rq * w0.w, v[j * 8 + 4] * rq * w1.x, v[j * 8 + 5] * rq * w1.y, v[j * 8 + 6] * rq * w1.z, v[j * 8 + 7] * rq * w1.w};
#pragma unroll
                    for (int e = 0; e < 8; ++e) q[e] = fminf(fmaxf(q[e], -440.f), 440.f);
                    v2u o; o.x = pk4_fp8(q[0], q[1], q[2], q[3]); o.y = pk4_fp8(q[4], q[5], q[6], q[7]);
                    *(v2u*)((unsigned char*)F.A2 + (size_t)r * 2048 + col) = o; } }
        }
        __syncthreads();
        {
            const int cg = tid & 63, tb = tid >> 6, hw = 1 << (cg >> 4);
            const LAS unsigned char* colp = L + cg * 16;
#pragma unroll 2
            for (int tt = 0; tt < 8; ++tt) { const int t = tb * 8 + tt; const int lo = t - hw < 0 ? 0 : t - hw, hi = t + hw > 64 ? 64 : t + hw;
                float s[8];
#pragma unroll
                for (int e = 0; e < 8; ++e) s[e] = 0.f;
                for (int q = lo; q < hi; ++q) { const v4u x = *(const LAS v4u*)(colp + q * 1024);
                    s[0] += bflo(x.x); s[1] += bfhi(x.x); s[2] += bflo(x.y); s[3] += bfhi(x.y); s[4] += bflo(x.z); s[5] += bfhi(x.z); s[6] += bflo(x.w); s[7] += bfhi(x.w); }
                const v4u x = *(const LAS v4u*)(colp + t * 1024); const float inv = 1.f / (float)(hi - lo);
                float q[8] = {s[0] * inv - bflo(x.x), s[1] * inv - bfhi(x.x), s[2] * inv - bflo(x.y), s[3] * inv - bfhi(x.y), s[4] * inv - bflo(x.z), s[5] * inv - bfhi(x.z), s[6] * inv - bflo(x.w), s[7] * inv - bfhi(x.w)};
#pragma unroll
                for (int e = 0; e < 8; ++e) q[e] = fminf(fmaxf(q[e] * A2SCALE, -440.f), 440.f);
                v2u o; o.x = pk4_fp8(q[0], q[1], q[2], q[3]); o.y = pk4_fp8(q[4], q[5], q[6], q[7]);
                *(v2u*)((unsigned char*)F.A2 + (size_t)(rb + t) * 2048 + SSD_W + cg * 8) = o; }
        }
        __syncthreads();
    }
}

struct Sched7 {
    static constexpr bool TBL = false;
    const char* A; const char* Bt; const int* rowid; int G, c;
    __device__ __forceinline__ bool next(int i, pg8::Unit& u) const { const int L = i * G + c; if (L >= 512) return false; pg8::static_map(L, 128, 4, u.pm, u.pn); u.e = 0; return true; }
    __device__ __forceinline__ const char* a_base(const pg8::Unit&) const { return A; }
    __device__ __forceinline__ const char* b_base(const pg8::Unit& u) const { return Bt + (size_t)u.pn * 256 * 2048; }
    __device__ __forceinline__ const int* row_table(const pg8::Unit& u) const { return rowid + u.pm * 256; }
};
struct Epi7 {
    static constexpr bool PERM = false;
    const float* x; const float* MOD; bf16* X1;
    __device__ __forceinline__ void operator()(const f32x4 (&acc)[2][2][4][2], const pg8::Unit& u, int wr, int wc, int fr, int fq) const {
        const int row0 = u.pm * 256 + wr * 64 + fr, col0 = u.pn * 256 + wc * 32 + 4 * fq;
        const float* g1 = MOD + (size_t)(u.pm >> 4) * 6144 + 2048;
        f32x4 gv[2][2];
#pragma unroll
        for (int bj = 0; bj < 2; ++bj)
#pragma unroll
            for (int n = 0; n < 2; ++n) gv[bj][n] = *(const f32x4*)(g1 + col0 + bj * 128 + n * 16);
#pragma unroll
        for (int ai = 0; ai < 2; ++ai)
#pragma unroll
            for (int m = 0; m < 4; ++m) { const size_t off = (size_t)(row0 + ai * 128 + m * 16) * D + col0;
#pragma unroll
                for (int bj = 0; bj < 2; ++bj)
#pragma unroll
                    for (int n = 0; n < 2; ++n) { const f32x4 xv = *(const f32x4*)(x + off + bj * 128 + n * 16); const f32x4 o = xv + gv[bj][n] * (acc[ai][bj][m][n] * (1.f / (WSCALE * A2SCALE))); v2u ov; ov.x = pk2(o.x, o.y); ov.y = pk2(o.z, o.w); *(v2u*)(X1 + off + bj * 128 + n * 16) = ov; } }
    }
};

__device__ __forceinline__ void p8_router(Frame& F) {
    LAS unsigned char* L = F.lds;
    LAS float* H2F = (LAS float*)L;
    constexpr int HP = 1028;
    LAS float* PART = (LAS float*)(L + 16 * HP * 4);
    LAS unsigned* HIST = (LAS unsigned*)(L + 16 * HP * 4 + 16384);
    const int tid = F.tid, lane = F.lane, w = F.wave, i16 = lane & 15, q4 = lane >> 4;
    if (tid < 32) HIST[tid] = 0u;
    float rw0[32], rw1[32];
#pragma unroll
    for (int kk = 0; kk < 32; ++kk) { const int k = 128 * w + 4 * kk + q4; rw0[kk] = F.router_w[k * 32 + i16]; rw1[kk] = F.router_w[k * 32 + 16 + i16]; }
    __syncthreads();
    for (int gi = (int)blockIdx.x; gi < T / 16; gi += F.G) {
        const int rbase = gi * 16;
#pragma unroll
        for (int rr = 0; rr < 2; ++rr) {
            const int r16 = 2 * w + rr, r = rbase + r16;
            const bf16* xr = F.X1 + (size_t)r * D; const float* mod = F.MOD + (size_t)(r >> 12) * 6144;
            f32x4 v[4]; float ss = 0.f;
#pragma unroll
            for (int j = 0; j < 4; ++j) { const v2u xq = *(const v2u*)(xr + 4 * lane + 256 * j); v[j] = (f32x4){bflo(xq.x), bfhi(xq.x), bflo(xq.y), bfhi(xq.y)}; ss += (v[j].x * v[j].x + v[j].y * v[j].y) + (v[j].z * v[j].z + v[j].w * v[j].w); }
            const float rs = __builtin_amdgcn_rsqf(wave_sum(ss) * (1.f / D) + RMS_EPS);
#pragma unroll
            for (int j = 0; j < 4; ++j) { const int col = 4 * lane + 256 * j;
                const f32x4 wv = *(const f32x4*)(F.norm2_w + col), sh = *(const f32x4*)(mod + 3072 + col), sc = *(const f32x4*)(mod + 4096 + col);
                const f32x4 hh = (v[j] * rs) * wv * (sc + 1.f) + sh;
                *(LAS f32x4*)(H2F + r16 * HP + col) = hh;
                *(unsigned*)((unsigned char*)F.H2 + (size_t)r * D + col) = pk4_fp8(hh.x, hh.y, hh.z, hh.w); }
        }
        __syncthreads();
        {
            f32x4 a0 = (f32x4){0.f, 0.f, 0.f, 0.f}, a1 = a0;
#pragma unroll
            for (int kk = 0; kk < 32; ++kk) { const int k = 128 * w + 4 * kk + q4;
                const float av = H2F[i16 * HP + k];
                a0 = __builtin_amdgcn_mfma_f32_16x16x4f32(av, rw0[kk], a0, 0, 0, 0); a1 = __builtin_amdgcn_mfma_f32_16x16x4f32(av, rw1[kk], a1, 0, 0, 0); }
#pragma unroll
            for (int r = 0; r < 4; ++r) { PART[(w * 16 + 4 * q4 + r) * 32 + i16] = a0[r]; PART[(w * 16 + 4 * q4 + r) * 32 + 16 + i16] = a1[r]; }
        }
        __syncthreads();
        {
            const int row = tid >> 5, e = tid & 31;
            float lg = F.router_b[e];
#pragma unroll
            for (int ww = 0; ww < 8; ++ww) lg += PART[(ww * 16 + row) * 32 + e];
            float tv[4]; int ti[4];
#pragma unroll
            for (int k = 0; k < 4; ++k) { float bv = lg; int bi = e;
#pragma unroll
                for (int o = 1; o < 32; o <<= 1) { const float ov = __shfl_xor(bv, o); const int oi = __shfl_xor(bi, o); if (ov > bv || (ov == bv && oi < bi)) { bv = ov; bi = oi; } }
                tv[k] = bv; ti[k] = bi; if (e == bi) lg = -INFINITY; }
            if (e == 0) {
                const float e1 = __expf(tv[1] - tv[0]), e2 = __expf(tv[2] - tv[0]), e3 = __expf(tv[3] - tv[0]); const float inv = 1.f / (1.f + e1 + e2 + e3);
                const float gt[4] = {inv, e1 * inv, e2 * inv, e3 * inv};
                const int tok = rbase + row;
#pragma unroll
                for (int k = 0; k < 4; ++k) { const unsigned lr = atomicAdd((unsigned*)&HIST[ti[k]], 1u); F.TOPE[tok * 4 + k] = ti[k]; F.TOPG[tok * 4 + k] = gt[k]; F.TOPR[tok * 4 + k] = (int)lr; }
            }
        }
        __syncthreads();
    }
    if (tid < 32) { const unsigned base = __hip_atomic_fetch_add(F.ctl + CW_GCOUNT + tid, HIST[tid], RLX_AGENT); F.BB[(int)blockIdx.x * 32 + tid] = (int)base; }
}

__device__ __forceinline__ int moe_tables(Frame& F) {
    LAS int* TE = (LAS int*)(F.lds + TE_OFF);
    LAS int* MC = (LAS int*)(F.lds + MOE_CNT_OFF);
    __syncthreads();
    if (F.tid == 0) { int ps = 0;
        for (int e = 0; e < NE; ++e) { const int c = (int)__hip_atomic_load(F.ctl + CW_GCOUNT + e, RLX_AGENT); MC[e] = c; MC[32 + e] = ps; const int nt = (c + 255) >> 8; for (int t = 0; t < nt; ++t) TE[(ps >> 8) + t] = e; ps += nt << 8; }
        MC[64] = ps >> 8; }
    __syncthreads();
    return MC[64];
}
__device__ __forceinline__ void p9_slots(Frame& F) {
    (void)moe_tables(F);
    const LAS int* MC = (const LAS int*)(F.lds + MOE_CNT_OFF);
    const int gt = (int)blockIdx.x * 512 + F.tid, NT_ = F.G * 512;
    for (int a = gt; a < T * TOPK; a += NT_) { const int tok = a >> 2, e = F.TOPE[a], blk = (tok >> 4) % F.G;
        const int slot = MC[32 + e] + F.BB[blk * 32 + e] + F.TOPR[a];
        F.SLOTTOK[slot] = tok; F.SLOTGATE[slot] = F.TOPG[a]; F.TOKSLOT[a] = slot; }
    for (int i = gt; i < MAX_SLOTS; i += NT_) F.SLOTID[i] = i;
    if ((int)blockIdx.x < NE) { const int e = (int)blockIdx.x, c = MC[e], ps = MC[32 + e], pe = ps + (((c + 255) >> 8) << 8);
        for (int s = ps + c + F.tid; s < pe; s += 512) { F.SLOTTOK[s] = 0; F.SLOTGATE[s] = 0.f; } }
}

struct SchedMoe {
    static constexpr bool TBL = true;
    const char* A; const char* W; const int* slot_tok; const LAS int* TE; int nM, nN, G, c; size_t wbytes  , tilebytes  , arowbytes;
    LAS unsigned char* tb;
    const float* f0; int f0_e, f0_n;
    const float* f1;
    __device__ __forceinline__ bool next(int i, pg8::Unit& u) const { const int L = i * G + c; if (L >= nM * nN) return false; pg8::static_map(L, nM, nN, u.pm, u.pn); u.e = TE[u.pm]; return true; }
    __device__ __forceinline__ const char* a_base(const pg8::Unit&) const { return A; }
    __device__ __forceinline__ const char* b_base(const pg8::Unit& u) const { return W + (size_t)u.e * wbytes + (size_t)u.pn * tilebytes; }
    __device__ __forceinline__ const int* row_table(const pg8::Unit& u) const { return slot_tok + u.pm * 256; }
    __device__ __forceinline__ const int* tab0(const pg8::Unit& u) const { return slot_tok + u.pm * 256; }
    __device__ __forceinline__ const float* tab1(const pg8::Unit& u) const { return f0 + (size_t)u.e * f0_e + u.pn * f0_n; }
    __device__ __forceinline__ const float* tab2(const pg8::Unit& u) const { return f1 ? f1 + u.pm * 256 : nullptr; }
};
struct Epi10 {
    static constexpr bool PERM = true;
    const float* b1; bf16* ACT;
    __device__ __forceinline__ void operator()(const f32x4 (&acc)[2][2][4][2], const pg8::Unit& u, int wr, int wc, int fr, int fq, const LAS unsigned char* tbuf) const {
        const int row0 = u.pm * 256 + wr * 64 + fr, j0 = u.pn * 128 + wc * 32 + 8 * fq;
        const LAS float* bp = (const LAS float*)(tbuf + 3072) + 2 * (wc * 32 + 8 * fq);
        const f32x4 q0 = *(const LAS f32x4*)bp, q1 = *(const LAS f32x4*)(bp + 4), q2 = *(const LAS f32x4*)(bp + 8), q3 = *(const LAS f32x4*)(bp + 12);
        const float bg[8] = {q0.x, q0.z, q1.x, q1.z, q2.x, q2.z, q3.x, q3.z}, bu[8] = {q0.y, q0.w, q1.y, q1.w, q2.y, q2.w, q3.y, q3.w};
#pragma unroll
        for (int ai = 0; ai < 2; ++ai)
#pragma unroll
            for (int m = 0; m < 4; ++m) { float o[8];
#pragma unroll
                for (int n = 0; n < 2; ++n)
#pragma unroll
                    for (int t = 0; t < 4; ++t) { const float hg = acc[ai][0][m][n][t] * (1.f / WSCALE) + bg[4 * n + t], hu = acc[ai][1][m][n][t] * (1.f / WSCALE) + bu[4 * n + t];
                        const float gp = fminf(hg, 7.f), up = fminf(fmaxf(hu, -7.f), 7.f);
                        o[4 * n + t] = gp * __builtin_amdgcn_rcpf(1.f + __builtin_amdgcn_exp2f(-1.702f * 1.44269504f * gp)) * (up + 1.f); }
                v2u wv; wv.x = pk4_fp8(o[0] * ASCALE, o[1] * ASCALE, o[2] * ASCALE, o[3] * ASCALE); wv.y = pk4_fp8(o[4] * ASCALE, o[5] * ASCALE, o[6] * ASCALE, o[7] * ASCALE);
                *(v2u*)((unsigned char*)ACT + (size_t)(row0 + ai * 128 + m * 16) * DFF + j0) = wv; }
    }
};
struct Epi11 {
    static constexpr bool PERM = true;
    bf16* YS;
    __device__ __forceinline__ void operator()(const f32x4 (&acc)[2][2][4][2], const pg8::Unit& u, int wr, int wc, int fr, int fq, const LAS unsigned char* tbuf) const {
        const int row0 = u.pm * 256 + wr * 64 + fr, col0 = u.pn * 256 + wc * 32 + 8 * fq;
        const LAS float* bl = (const LAS float*)(tbuf + 3072) + wc * 32 + 8 * fq; const LAS float* gl = (const LAS float*)(tbuf + 6144) + wr * 64 + fr;
        f32x4 bv[2][2];
#pragma unroll
        for (int bj = 0; bj < 2; ++bj)
#pragma unroll
            for (int n = 0; n < 2; ++n) bv[bj][n] = *(const LAS f32x4*)(bl + bj * 128 + 4 * n);
#pragma unroll
        for (int ai = 0; ai < 2; ++ai)
#pragma unroll
            for (int m = 0; m < 4; ++m) { const int row = row0 + ai * 128 + m * 16; const float gt = gl[ai * 128 + m * 16];
#pragma unroll
                for (int bj = 0; bj < 2; ++bj) { const float gs = gt * YSCALE; f32x4 v0 = (acc[ai][bj][m][0] * (1.f / (WSCALE * ASCALE)) + bv[bj][0]) * gs, v1 = (acc[ai][bj][m][1] * (1.f / (WSCALE * ASCALE)) + bv[bj][1]) * gs;
#pragma unroll
                    for (int t = 0; t < 4; ++t) { v0[t] = fminf(fmaxf(v0[t], -440.f), 440.f); v1[t] = fminf(fmaxf(v1[t], -440.f), 440.f); }
                    v2u wv; wv.x = pk4_fp8(v0[0], v0[1], v0[2], v0[3]); wv.y = pk4_fp8(v1[0], v1[1], v1[2], v1[3]);
                    *(v2u*)((unsigned char*)YS + (size_t)row * D + col0 + bj * 128) = wv; } }
    }
};

__device__ __forceinline__ void p12_combine(Frame& F) {
    const int gw = (int)blockIdx.x * 8 + F.wave, NGW = F.G * 8, lane = F.lane;
    for (int rb16 = gw; rb16 < T / 16; rb16 += NGW) {
        const int r0 = rb16 * 16;
        const float* g2p = F.MOD + (size_t)(r0 >> 12) * 6144 + 5120;
        f32x4 g2v[4], fw[4];
#pragma unroll
        for (int j = 0; j < 4; ++j) { const int col = 4 * lane + 256 * j; g2v[j] = *(const f32x4*)(g2p + col) * (1.f / YSCALE); fw[j] = *(const f32x4*)(F.final_norm_w + col); }
        for (int rp = 0; rp < 8; ++rp) {
            int sl[2][4];
#pragma unroll
            for (int k2 = 0; k2 < 2; ++k2)
#pragma unroll
                for (int k = 0; k < 4; ++k) sl[k2][k] = F.TOKSLOT[(r0 + rp * 2 + k2) * 4 + k];
            unsigned yv[2][4][4]; v2u xq[2][4];
#pragma unroll
            for (int k2 = 0; k2 < 2; ++k2)
#pragma unroll
                for (int j = 0; j < 4; ++j) { const int col = 4 * lane + 256 * j; xq[k2][j] = *(const v2u*)(F.X1 + (size_t)(r0 + rp * 2 + k2) * D + col);
#pragma unroll
                    for (int k = 0; k < 4; ++k) yv[k2][j][k] = *(const unsigned*)((const unsigned char*)F.YS + (size_t)sl[k2][k] * D + col); }
#pragma unroll
            for (int k2 = 0; k2 < 2; ++k2) { const int r = r0 + rp * 2 + k2;
                f32x4 v[4]; float ss = 0.f;
#pragma unroll
                for (int j = 0; j < 4; ++j) { f32x4 m = (f32x4){0.f, 0.f, 0.f, 0.f};
#pragma unroll
                    for (int k = 0; k < 4; ++k) { const int y = (int)yv[k2][j][k]; const f32x2 lo = __builtin_amdgcn_cvt_pk_f32_fp8(y, false), hi = __builtin_amdgcn_cvt_pk_f32_fp8(y, true); m.x += lo.x; m.y += lo.y; m.z += hi.x; m.w += hi.y; }
                    v[j] = (f32x4){bflo(xq[k2][j].x), bfhi(xq[k2][j].x), bflo(xq[k2][j].y), bfhi(xq[k2][j].y)} + g2v[j] * m;
                    ss += (v[j].x * v[j].x + v[j].y * v[j].y) + (v[j].z * v[j].z + v[j].w * v[j].w); }
                const float rs = __builtin_amdgcn_rsqf(wave_sum(ss) * (1.f / D) + RMS_EPS);
#pragma unroll
                for (int j = 0; j < 4; ++j) { const int col = 4 * lane + 256 * j; *(f32x4*)(F.out + (size_t)r * D + col) = (v[j] * rs) * fw[j]; } }
        }
    }
}

constexpr int NPHASE = 13;
struct Args { const float* in[25]; float* out; unsigned char* ws; int ph_lo, ph_hi; };
__global__ void __launch_bounds__(512, 2) mk_fwd(Args args) {
    extern __shared__ __attribute__((aligned(16))) unsigned char lds[];
    Frame F;
    F.lds = (LAS unsigned char*)lds;
    F.tid = threadIdx.x; F.lane = F.tid & 63; F.wave = __builtin_amdgcn_readfirstlane(F.tid >> 6); F.G = gridDim.x;
    unsigned char* ws = args.ws;
    F.ctl = (unsigned*)(ws + WS_CTL);
    F.x = args.in[0]; F.c = args.in[1]; F.ctx = args.in[2]; F.c_ctx = args.in[3]; F.w_mod = args.in[4]; F.b_mod = args.in[5]; F.norm1_w = args.in[6]; F.norm2_w = args.in[7];
    F.w_in = args.in[8]; F.conv_w = args.in[9]; F.conv_b = args.in[10]; F.dt_bias = args.in[11]; F.a_log = args.in[12]; F.d_skip = args.in[13]; F.ssd_norm_w = args.in[14];
    F.pool_w = args.in[15]; F.pool_scale = args.in[16]; F.w_out = args.in[17]; F.router_w = args.in[18]; F.router_b = args.in[19]; F.w1 = args.in[20]; F.b1 = args.in[21];
    F.w2 = args.in[22]; F.b2 = args.in[23]; F.final_norm_w = args.in[24]; F.out = args.out;
    F.MOD = (float*)(ws + WS_MOD); F.DTRAW = (float*)(ws + WS_DTRAW); F.DT = (float*)(ws + WS_DT); F.ROWSC = (float*)(ws + WS_ROWSC); F.CHS = (float*)(ws + WS_CHS); F.X1 = (bf16*)(ws + WS_X1);
    F.TOPG = (float*)(ws + WS_TOPG); F.SLOTGATE = (float*)(ws + WS_SLOTGATE); F.TOPE = (int*)(ws + WS_TOPE); F.TOPR = (int*)(ws + WS_TOPR); F.TOKSLOT = (int*)(ws + WS_TOKSLOT);
    F.SLOTTOK = (int*)(ws + WS_SLOTTOK); F.SLOTID = (int*)(ws + WS_SLOTID); F.ROWID = (int*)(ws + WS_ROWID); F.BB = (int*)(ws + WS_BB);
    F.WINT = (bf16*)(ws + WS_WINT); F.WOUTT = (bf16*)(ws + WS_WOUTT); F.W1T = (bf16*)(ws + WS_W1T); F.W2T = (bf16*)(ws + WS_W2T); F.A1 = (bf16*)(ws + WS_A1); F.XBCPRE = (bf16*)(ws + WS_XBCPRE);
    F.Z = (bf16*)(ws + WS_Z); F.V = (bf16*)(ws + WS_V); F.XBC = (bf16*)(ws + WS_XBC); F.CC = (bf16*)(ws + WS_CC); F.ST = (bf16*)(ws + WS_ST); F.Y = (bf16*)(ws + WS_Y); F.YB = (bf16*)(ws + WS_YB);
    F.A2 = (bf16*)(ws + WS_A2); F.H2 = (bf16*)(ws + WS_H2); F.ACT = (bf16*)(ws + WS_ACT); F.YS = (bf16*)(ws + WS_YS);
    volatile LAS unsigned* MISC = (volatile LAS unsigned*)(F.lds + MISC_OFF);
    for (int u = F.tid; u < 64; u += 512) MISC[u] = 0u;
    __syncthreads();
    const int lo = args.ph_lo, hi = args.ph_hi;
    XcdBarrier bar; bar.bar = F.ctl + CW_BAR; bar.x = 0; bar.st = nullptr;
    if (hi - lo > 1) bar = xcd_barrier_post(F.ctl + CW_BAR, MISC + 8);
#define IN(k) (lo <= (k) && (k) < hi)
#define SEAM(k) do { if (IN(k) && IN((k) + 1)) xcd_barrier(bar); } while (0)
#define BODY0 p0_prologue(F)
#define BODY1 p1_norm1(F)
#define BODY2 do { Sched1 S{(const char*)F.A1, (const char*)F.WINT, F.G, (int)blockIdx.x}; Epi1 E{F.XBCPRE, F.Z, F.V, F.DTRAW}; pg8::gemm_phase<Epi1, Sched1, false>(F.lds, D, S, E); } while (0)
#define BODY4 p4_ssd_local(F)
#define BODY5 p5_ssd_scan(F)
#define BODY6 p6_gate_pool(F)
#define BODY7 do { Sched7 S{(const char*)F.A2, (const char*)F.WOUTT, F.ROWID, F.G, (int)blockIdx.x}; Epi7 E{F.x, F.MOD, F.X1}; pg8::gemm_phase<Epi7, Sched7, true, true>(F.lds, 2048, S, E); } while (0)
#define BODY8 p8_router(F)
#define BODY9 p9_slots(F)
#define BODY10 do { const int ntl = moe_tables(F); \
        SchedMoe S{(const char*)F.H2, (const char*)F.W1T, F.SLOTTOK, (const LAS int*)(F.lds + TE_OFF), ntl, 8, F.G, (int)blockIdx.x, (size_t)2048 * D, (size_t)256 * D, (size_t)D, F.lds + TBL_OFF, F.b1, 2048, 256, nullptr}; \
        Epi10 E{F.b1, F.ACT}; pg8::gemm_phase<Epi10, SchedMoe, true, true>(F.lds, D, S, E); } while (0)
#define BODY11 do { const int ntl = moe_tables(F); \
        SchedMoe S{(const char*)F.ACT, (const char*)F.W2T, F.SLOTID, (const LAS int*)(F.lds + TE_OFF), ntl, 4, F.G, (int)blockIdx.x, (size_t)D * D, (size_t)256 * D, (size_t)D, F.lds + TBL_OFF, F.b2, D, 256, F.SLOTGATE}; \
        Epi11 E{F.YS}; pg8::gemm_phase<Epi11, SchedMoe, true, true>(F.lds, D, S, E); } while (0)
#define BODY12 p12_combine(F)
#define RUN(k) do { if (IN(k)) { BODY##k; if (PROBE_PH == (k)) { xcd_barrier(bar); BODY##k; } } SEAM(k); } while (0)
    RUN(0); RUN(1); RUN(2); RUN(4); RUN(5); RUN(6); RUN(7); RUN(8); RUN(9); RUN(10); RUN(11); RUN(12);
#undef IN
#undef SEAM
}

extern "C" void kernel_launch(void* const* d_in, const int* in_sizes, int n_in, void* d_out, int out_size, void* d_ws, size_t ws_size, hipStream_t stream) {
    static int grid = 0;
    if (grid == 0) {
        if (n_in != 25 || out_size != T * D || ws_size < WS_END) { fprintf(stderr, "kernel_launch: unexpected shapes (n_in %d, out %d, ws %zu)\n", n_in, out_size, ws_size); grid = -1; return; }
        int dev = 0, cus = 0, per_cu = 0;
        if (hipGetDevice(&dev) != hipSuccess || hipDeviceGetAttribute(&cus, hipDeviceAttributeMultiprocessorCount, dev) != hipSuccess) { grid = -1; return; }
        if (hipFuncSetAttribute((const void*)mk_fwd, hipFuncAttributeMaxDynamicSharedMemorySize, LDS_BYTES) != hipSuccess) { fprintf(stderr, "kernel_launch: hipFuncSetAttribute failed\n"); grid = -1; return; }
        if (hipOccupancyMaxActiveBlocksPerMultiprocessor(&per_cu, (const void*)mk_fwd, 512, LDS_BYTES) != hipSuccess || per_cu < 1) { fprintf(stderr, "kernel_launch: occupancy query says %d\n", per_cu); }
        (void)hipGetLastError();
        grid = cus;
    }
    if (grid < 0) return;
    (void)hipMemsetAsync((char*)d_ws + WS_CTL, 0, CTL_ZERO_BYTES, stream);
    Args a{};
    for (int i = 0; i < 25; ++i) a.in[i] = (const float*)d_in[i];
    a.out = (float*)d_out; a.ws = (unsigned char*)d_ws;
#if MK_SPLIT
    for (int p = 0; p < NPHASE; ++p) { a.ph_lo = p; a.ph_hi = p + 1; hipLaunchKernelGGL(mk_fwd, dim3(grid), dim3(512), LDS_BYTES, stream, a); }
#else
    a.ph_lo = 0; a.ph_hi = NPHASE; hipLaunchKernelGGL(mk_fwd, dim3(grid), dim3(512), LDS_BYTES, stream, a);
#endif
}
```

```cpp
#include <hip/hip_runtime.h>
#include <cstdio>
#include <cstdint>

#ifndef MK_SPLIT
#define MK_SPLIT 0
#endif

#ifndef PROBE_PH
#define PROBE_PH -1
#endif

#define GAS __attribute__((address_space(1)))
#define LAS __attribute__((address_space(3)))
typedef unsigned short bf16;
typedef unsigned v4u __attribute__((ext_vector_type(4)));
typedef unsigned v2u __attribute__((ext_vector_type(2)));
typedef float f32x4 __attribute__((ext_vector_type(4)));
typedef float f32x2 __attribute__((ext_vector_type(2)));
typedef short bf16x8 __attribute__((ext_vector_type(8)));
typedef short s16x4 __attribute__((ext_vector_type(4)));
#define RLX_AGENT __ATOMIC_RELAXED, __HIP_MEMORY_SCOPE_AGENT
#define LDS_WAIT() asm volatile("s_waitcnt lgkmcnt(0)" ::: "memory")
#define VM_WAIT() asm volatile("s_waitcnt vmcnt(0)" ::: "memory")

__device__ __forceinline__ unsigned f2bf(float f) { unsigned u = __builtin_bit_cast(unsigned, f); return (u + 0x7fffu + ((u >> 16) & 1u)) >> 16; }
typedef __bf16 nbf16x2 __attribute__((ext_vector_type(2)));
__device__ __forceinline__ unsigned pk2(float lo, float hi) { const f32x2 v = {lo, hi}; return __builtin_bit_cast(unsigned, __builtin_convertvector(v, nbf16x2)); }
constexpr float A2SCALE = 4.f;
constexpr float YOSCALE = 16.f;
constexpr float STSCALE = 32.f;
constexpr float YSCALE = 8.f;
constexpr float ASCALE = 4.f;
constexpr float WSCALE = 32.f;
__device__ __forceinline__ unsigned pk4_fp8(float a, float b, float c, float d) { int r = __builtin_amdgcn_cvt_pk_fp8_f32(a, b, 0, false); r = __builtin_amdgcn_cvt_pk_fp8_f32(c, d, r, true); return (unsigned)r; }
__device__ __forceinline__ float bflo(unsigned w) { return __builtin_bit_cast(float, w << 16); }
__device__ __forceinline__ float bfhi(unsigned w) { return __builtin_bit_cast(float, w & 0xffff0000u); }
__device__ __forceinline__ float silu_f(float v) { return v * __builtin_amdgcn_rcpf(1.f + __builtin_amdgcn_exp2f(-1.44269504f * v)); }
__device__ __forceinline__ float wave_sum(float v) {
#pragma unroll
    for (int o = 1; o < 64; o <<= 1) v += __shfl_xor(v, o);
    return v;
}

constexpr int D = 1024, NB = 8, SEQ = 4096, CTXL = 256, T = NB * SEQ, TC = NB * CTXL, RTOT = T + TC;
constexpr int CONV_CH = 2560, SSD_W = 1536, NH = 24, HDIM = 64, NGRP = 4, HPG = 6, NST = 128, CHUNK = 128;
constexpr int NCC = (CTXL + SEQ) / CHUNK;
constexpr int IN_COLS = 4656, N1 = 4864;
constexpr int NE = 32, TOPK = 4, DFF = 1024;
constexpr int MAX_TILES = (T * TOPK) / 256 + NE;
constexpr int MAX_SLOTS = MAX_TILES * 256;
constexpr float RMS_EPS = 1e-6f;

constexpr size_t MiB = 1u << 20;
constexpr size_t WS_CTL = 0, CTL_ZERO_BYTES = 1 * MiB;
constexpr size_t WS_MOD = 1 * MiB;
constexpr size_t WS_TOPE = 2 * MiB, WS_TOPG = WS_TOPE + 512 * 1024, WS_TOPR = WS_TOPG + 512 * 1024, WS_TOKSLOT = WS_TOPR + 512 * 1024;
constexpr size_t WS_SLOTTOK = 4 * MiB, WS_SLOTGATE = WS_SLOTTOK + 576 * 1024, WS_BB = WS_SLOTGATE + 576 * 1024, WS_CHS = WS_BB + 64 * 1024, WS_SLOTID = WS_CHS + 64 * 1024;
constexpr size_t WS_DTRAW = 6 * MiB;
constexpr size_t WS_ROWID = 21 * MiB + 512 * 1024;
constexpr size_t WS_DT = 15 * MiB;
constexpr size_t WS_ROWSC = 22 * MiB;
constexpr size_t WS_WINT = 32 * MiB, WS_WOUTT = 42 * MiB, WS_W1T = 46 * MiB, WS_W2T = 174 * MiB;
constexpr size_t WS_A = 240 * MiB;
constexpr size_t WS_A1 = WS_A, WS_CC = WS_A, WS_XBCPRE = WS_A + 68 * MiB, WS_Z = WS_A + 238 * MiB, WS_V = WS_A + 334 * MiB, WS_XBC = WS_A;
constexpr size_t WS_ST = WS_A + 366 * MiB, WS_Y = WS_A + 570 * MiB, WS_YB = WS_A + 666 * MiB;
constexpr size_t WS_A2 = WS_XBCPRE, WS_X1 = WS_A + 366 * MiB, WS_H2 = WS_A + 494 * MiB, WS_ACT = WS_A, WS_YS = WS_A + 494 * MiB;
constexpr size_t WS_END = WS_A + 766 * MiB;
static_assert(WS_END <= 1024 * MiB, "workspace map");
static_assert((size_t)RTOT * D * 2 <= 68 * MiB && (size_t)RTOT * CONV_CH * 2 <= 170 * MiB && (size_t)MAX_SLOTS * D * 2 <= 272 * MiB, "workspace map sizes");
static_assert((size_t)NB * NCC * NH * 2 * 8192 * 2 <= 204 * MiB, "ST size");
constexpr int CW_TMO = 0, CW_GCOUNT = 64  , CW_BAR = 4096;

constexpr int LDS_BYTES = 163840;
constexpr int MISC_OFF = LDS_BYTES - 256;
constexpr int TE_OFF = 131072;
constexpr int MOE_CNT_OFF = TE_OFF + 4096;
constexpr int TBL_OFF = TE_OFF + 8192;

namespace pg8 {
constexpr int BM = 256, BK = 64, HALF = 128, HTB = HALF * BK * 2, STAGE_BYTES = 8 * HTB, NXCD = 8, WGM = 8;
__host__ __device__ __forceinline__ int lds_byte(int r, int c) { const int st = (r >> 4) * 2 + (c >> 5), rr = r & 15, cc = c & 31, ob = rr * 64 + cc * 2; return st * 1024 + (ob ^ (((ob >> 9) & 1) << 5)); }
__host__ __device__ __forceinline__ void stage_rc(int b, int& R, int& C) { const int st = b / 1024, sb = b % 1024, swz = sb ^ (((sb >> 9) & 1) << 5); R = (st >> 1) * 16 + swz / 64; C = (st & 1) * 32 + (swz % 64) / 2; }
__host__ __device__ __forceinline__ int perm32(int rho) { const int n = rho >> 4, i = rho & 15; return 8 * (i >> 2) + 4 * n + (i & 3); }
struct Unit { int pm, pn, e; };
__device__ __forceinline__ unsigned cvt_pk_bf16(float lo, float hi) { unsigned r; asm volatile("v_cvt_pk_bf16_f32 %0, %1, %2" : "=v"(r) : "v"(lo), "v"(hi)); return r; }

__device__ __forceinline__ void static_map(int wgid, int nM, int nN, int& pm, int& pn) {
    const int nwg = nM * nN;
    { const int q = nwg / NXCD, r = nwg % NXCD, xcd = wgid % NXCD, off = wgid / NXCD; wgid = (xcd < r ? xcd * (q + 1) : r * (q + 1) + (xcd - r) * q) + off; }
    const int nig = WGM * nN, gid = wgid / nig, fm = gid * WGM, gsz = (nM - fm) < WGM ? (nM - fm) : WGM;
    pm = fm + ((wgid % nig) % gsz); pn = (wgid % nig) / gsz;
}

typedef int i32x8 __attribute__((ext_vector_type(8)));
typedef int v4i_t __attribute__((ext_vector_type(4)));
template <class Epi, class Sched, bool GATHER, bool FP8 = false, bool ALIGN_EPI = true>
__device__ __forceinline__ void gemm_phase(LAS unsigned char* lds, const int K, const Sched& S, const Epi& E) {
    int tid = threadIdx.x; asm volatile("" : "+v"(tid));
    const int wid = __builtin_amdgcn_readfirstlane(tid >> 6), lane = tid & 63, wr = wid >> 2, wc = wid & 3, fr = lane & 15, fq = lane >> 4;
    constexpr int ES = FP8 ? 1 : 2, KOFF = FP8 ? 16 : 1024;
    const int nt = K / (FP8 ? 2 * BK : BK);
    unsigned voffB[2]; int RA[2], CA[2];
#pragma unroll
    for (int i = 0; i < 2; ++i) { int R, C; stage_rc(tid * 16 + i * 8192, R, C); const int Rb = Epi::PERM ? ((R & ~31) + perm32(R & 31)) : R;
        RA[i] = R; CA[i] = C; voffB[i] = (unsigned)(Rb * K * ES + C * 2); }
    const size_t kstep = (size_t)(BK * 2);
    const size_t hstep = (size_t)HALF * K * ES;
    const unsigned ldsw = (unsigned)wid * 1024u;
    const int aoff = lds_byte(wr * 64 + fr, fq * (FP8 ? 16 : 8)), boff = lds_byte(wc * 32 + fr, fq * (FP8 ? 16 : 8));
#define PG8_SA(b, h) (((b) * 2 + (h)) * HTB)
#define PG8_SB(b, h) ((4 + (b) * 2 + (h)) * HTB)
#define PG8_STAGE(bufoff, gbase, voff) do { _Pragma("unroll") for (int _i = 0; _i < 2; ++_i) \
        __builtin_amdgcn_global_load_lds((const unsigned*)((const char*)(gbase) + (voff)[_i]), (LAS unsigned*)(lds + (bufoff) + ldsw + _i * 8192), 16, 0, 0); } while (0)
#define PG8_LDA(dst, b, h) do { _Pragma("unroll") for (int m = 0; m < 4; ++m) _Pragma("unroll") for (int k = 0; k < 2; ++k) dst[m][k] = *(const LAS bf16x8*)(lds + PG8_SA(b, h) + aoff + m * 2048 + k * KOFF); } while (0)
#define PG8_LDB(dst, b, h) do { _Pragma("unroll") for (int n = 0; n < 2; ++n) _Pragma("unroll") for (int k = 0; k < 2; ++k) dst[n][k] = *(const LAS bf16x8*)(lds + PG8_SB(b, h) + boff + n * 2048 + k * KOFF); } while (0)
#define PG8_CAT(lo, hi) __builtin_shufflevector(__builtin_bit_cast(v4i_t, lo), __builtin_bit_cast(v4i_t, hi), 0, 1, 2, 3, 4, 5, 6, 7)
#define PG8_MMA(ai, bj, At, Bt) do { __builtin_amdgcn_s_setprio(1); \
        if constexpr (FP8) { _Pragma("unroll") for (int m = 0; m < 4; ++m) _Pragma("unroll") for (int n = 0; n < 2; ++n) \
            acc[ai][bj][m][n] = __builtin_amdgcn_mfma_scale_f32_16x16x128_f8f6f4(PG8_CAT(Bt[n][0], Bt[n][1]), PG8_CAT(At[m][0], At[m][1]), acc[ai][bj][m][n], 0, 0, 0, 0x7f7f7f7f, 0, 0x7f7f7f7f); } \
        else { _Pragma("unroll") for (int m = 0; m < 4; ++m) _Pragma("unroll") for (int n = 0; n < 2; ++n) _Pragma("unroll") for (int k = 0; k < 2; ++k) \
            acc[ai][bj][m][n] = __builtin_amdgcn_mfma_f32_16x16x32_bf16(Bt[n][k], At[m][k], acc[ai][bj][m][n], 0, 0, 0); } \
        __builtin_amdgcn_s_setprio(0); } while (0)
#define PG8_WAIT_V(n) asm volatile("s_waitcnt vmcnt(" #n ")" ::: "memory")
#define PG8_WAIT_L(n) asm volatile("s_waitcnt lgkmcnt(" #n ")" ::: "memory")
#define PG8_BAR __builtin_amdgcn_s_barrier()
#define PG8_SCHED __builtin_amdgcn_sched_barrier(0)
#define PG8_AOFFS(U, dst) do { \
        if constexpr (GATHER) { int t_ = tid, R_, C_; asm volatile("" : "+v"(t_)); stage_rc(t_ * 16, R_, C_);     \
            const int* st_ = S.row_table(U) + R_; _Pragma("unroll") for (int _h = 0; _h < 2; ++_h) _Pragma("unroll") for (int _i = 0; _i < 2; ++_i) \
            dst[_h][_i] = (unsigned)st_[_h * HALF + _i * 64] * (unsigned)(K * ES) + (unsigned)(C_ * 2); } \
        else { _Pragma("unroll") for (int _h = 0; _h < 2; ++_h) _Pragma("unroll") for (int _i = 0; _i < 2; ++_i) dst[_h][_i] = (unsigned)((_h * HALF + RA[_i]) * K * ES + CA[_i] * 2); } } while (0)
#define PG8_AOFFS_NEXT(dst) do { if constexpr (false) { int t_ = tid, R_, C_; asm volatile("" : "+v"(t_)); stage_rc(t_ * 16, R_, C_); \
            const LAS int* st_ = (const LAS int*)(S.tb + ((ui + 1) % 3) * 1024) + R_; _Pragma("unroll") for (int _h = 0; _h < 2; ++_h) _Pragma("unroll") for (int _i = 0; _i < 2; ++_i) \
            dst[_h][_i] = (unsigned)st_[_h * HALF + _i * 64] * (unsigned)(K * ES) + (unsigned)(C_ * 2); } else { PG8_AOFFS(nxt, dst); } } while (0)
    Unit cur, nxt; int ui = 0;
    if (!S.next(0, cur)) return;
    f32x4 acc[2][2][4][2];
#pragma unroll
    for (int a = 0; a < 2; ++a)
#pragma unroll
        for (int b = 0; b < 2; ++b)
#pragma unroll
            for (int m = 0; m < 4; ++m)
#pragma unroll
                for (int n = 0; n < 2; ++n) acc[a][b][m][n] = (f32x4){0.f, 0.f, 0.f, 0.f};
    bf16x8 At[4][2], B0[2][2], B1[2][2];
    unsigned oc[2][2];
    const char* cA = S.a_base(cur); const char* cB = S.b_base(cur);
    PG8_AOFFS(cur, oc);
#define PG8_TABLES(U, buf) do { if constexpr (Sched::TBL) { LAS unsigned char* tb_ = S.tb + (buf) * 1024;   \
        if (wid < 4) { if (S.tab2(U)) __builtin_amdgcn_global_load_lds((const unsigned*)(S.tab2(U) + 64 * wid + lane), (LAS unsigned*)(tb_ + 6144 + wid * 256), 4, 0, 0); } \
        else { __builtin_amdgcn_global_load_lds((const unsigned*)(S.tab1(U) + 64 * (wid - 4) + lane), (LAS unsigned*)(tb_ + 3072 + (wid - 4) * 256), 4, 0, 0); } } } while (0)
    PG8_TABLES(cur, 0);
    PG8_STAGE(PG8_SB(0, 0), cB, voffB); PG8_STAGE(PG8_SB(0, 1), cB + hstep, voffB); PG8_STAGE(PG8_SA(0, 0), cA, oc[0]); PG8_STAGE(PG8_SA(0, 1), cA, oc[1]);
    if (wr == 1) PG8_BAR;
    PG8_WAIT_V(2); PG8_BAR;
    PG8_STAGE(PG8_SB(1, 0), cB + kstep, voffB); PG8_STAGE(PG8_SA(1, 0), cA + kstep, oc[0]); PG8_STAGE(PG8_SB(1, 1), cB + hstep + kstep, voffB);
    PG8_WAIT_V(6); PG8_BAR;
    for (;;) {
        const bool has_next = S.next(ui + 1, nxt);
        const char* nA = has_next ? S.a_base(nxt) : cA; const char* nB = has_next ? S.b_base(nxt) : cB;
        if (has_next) { PG8_TABLES(nxt, (ui + 1) % 3); }
        for (int t = 0; t < nt; t += 2) {
            const bool last = (t == nt - 2);
            const char* a1 = cA + (size_t)(t + 1) * kstep;
            const char* a2 = last ? nA : cA + (size_t)(t + 2) * kstep; const char* b2 = last ? nB : cB + (size_t)(t + 2) * kstep;
            const char* a3 = a2 + kstep; const char* b3 = b2 + kstep;
            PG8_LDB(B0, 0, 0); PG8_LDB(B1, 0, 1); PG8_SCHED; PG8_LDA(At, 0, 0); PG8_STAGE(PG8_SA(1, 1), a1, oc[1]);
            PG8_WAIT_V(8); PG8_WAIT_L(0); PG8_BAR; PG8_MMA(0, 0, At, B0); PG8_MMA(0, 1, At, B1); PG8_BAR; PG8_SCHED;
            if (last && has_next) { PG8_AOFFS_NEXT(oc); }
            PG8_LDA(At, 0, 1); PG8_STAGE(PG8_SB(0, 0), b2, voffB); PG8_STAGE(PG8_SB(0, 1), b2 + hstep, voffB); PG8_STAGE(PG8_SA(0, 0), a2, oc[0]);
            PG8_WAIT_V(8); PG8_WAIT_L(0); PG8_BAR; PG8_MMA(1, 0, At, B0); PG8_MMA(1, 1, At, B1); PG8_BAR; PG8_SCHED;
            PG8_LDB(B0, 1, 0); PG8_LDB(B1, 1, 1); PG8_SCHED; PG8_LDA(At, 1, 0); PG8_STAGE(PG8_SA(0, 1), a2, oc[1]);
            PG8_WAIT_V(8); PG8_WAIT_L(0); PG8_BAR; PG8_MMA(0, 0, At, B0); PG8_MMA(0, 1, At, B1); PG8_BAR; PG8_SCHED;
            PG8_LDA(At, 1, 1); PG8_STAGE(PG8_SB(1, 0), b3, voffB); PG8_STAGE(PG8_SB(1, 1), b3 + hstep, voffB); PG8_STAGE(PG8_SA(1, 0), a3, oc[0]);
            PG8_WAIT_V(8); PG8_WAIT_L(0); PG8_BAR; PG8_MMA(1, 0, At, B0); PG8_MMA(1, 1, At, B1); PG8_BAR; PG8_SCHED;
        }
        if constexpr (ALIGN_EPI) { if (wr == 0) PG8_BAR; }
        if constexpr (Sched::TBL) E(acc, cur, wr, wc, fr, fq, S.tb + (ui % 3) * 1024); else E(acc, cur, wr, wc, fr, fq);
        if (!has_next) break;
#pragma unroll
        for (int a = 0; a < 2; ++a)
#pragma unroll
            for (int b = 0; b < 2; ++b)
#pragma unroll
                for (int m = 0; m < 4; ++m)
#pragma unroll
                    for (int n = 0; n < 2; ++n) acc[a][b][m][n] = (f32x4){0.f, 0.f, 0.f, 0.f};
        cur = nxt; cA = nA; cB = nB; ++ui;
        if constexpr (ALIGN_EPI) { if (wr == 1) PG8_BAR; }
    }
    PG8_WAIT_V(0);
    if constexpr (!ALIGN_EPI) { if (wr == 0) PG8_BAR; }
    PG8_BAR;
#undef PG8_SA
#undef PG8_SB
#undef PG8_STAGE
#undef PG8_LDA
#undef PG8_LDB
#undef PG8_MMA
#undef PG8_WAIT_V
#undef PG8_WAIT_L
#undef PG8_BAR
#undef PG8_SCHED
#undef PG8_AOFFS
#undef PG8_AOFFS_NEXT
#undef PG8_TABLES
#undef PG8_CAT
}
}

#define XB_TMO      128
#define XB_XCNT(j)  (256  + 64 * (j))
#define XB_XSUB(j)  (1280 + 64 * (j))
#define XB_XGEN(j)  (2304 + 64 * (j))
#define XB_TOP      3328
#define XB_TOPGEN   3392
#define XCD_BAR_WORDS 3456
#define XB_SPIN_CAP (1u << 18)
__device__ __forceinline__ unsigned xb_ld(unsigned* p)              { return __hip_atomic_load(p, __ATOMIC_RELAXED, __HIP_MEMORY_SCOPE_AGENT); }
__device__ __forceinline__ unsigned xb_add(unsigned* p, unsigned v) { return __hip_atomic_fetch_add(p, v, __ATOMIC_RELAXED, __HIP_MEMORY_SCOPE_AGENT); }
__device__ __forceinline__ unsigned xb_xcc_id() { return (unsigned)__builtin_amdgcn_s_getreg((3 << 11) | 20) & 0xFu; }
#define XB_SPIN(cond, bar) do { unsigned _sp = 0; while (cond) { __builtin_amdgcn_s_sleep(1); \
    if ((++_sp & 255u) == 0u) { if (xb_ld(&(bar)[XB_TMO])) break; if (_sp > XB_SPIN_CAP) { atomicAdd(&(bar)[XB_TMO], 1u); break; } } } } while (0)
struct XcdBarrier { unsigned* bar; unsigned x; volatile LAS unsigned* st; };
__device__ __forceinline__ XcdBarrier xcd_barrier_post(unsigned* bar, volatile LAS unsigned* st) {
    XcdBarrier b; b.bar = bar; b.x = xb_xcc_id(); b.st = st;
    if (threadIdx.x == 0) (void)xb_add(&bar[XB_XCNT(b.x)], 1u);
    return b;
}
__device__ __forceinline__ void xcd_barrier_complete(unsigned* bar, unsigned x, unsigned& nloc, unsigned& nx) {
    const unsigned G = gridDim.x * gridDim.y * gridDim.z;
    unsigned sum, cnt, mine, sp = 0u;
    for (;;) {
        sum = 0u; cnt = 0u; mine = 0u;
#pragma unroll
        for (unsigned j = 0; j < 16; ++j) { const unsigned c = xb_ld(&bar[XB_XCNT(j)]); sum += c; cnt += (c > 0u) ? 1u : 0u; mine = (j == x) ? c : mine; }
        if (sum == G) break;
        __builtin_amdgcn_s_sleep(1);
        if ((++sp & 255u) == 0u) { if (xb_ld(&bar[XB_TMO])) break; if (sp > XB_SPIN_CAP) { atomicAdd(&bar[XB_TMO], 1u); break; } }
    }
    nloc = mine > 0u ? mine : 1u; nx = cnt > 0u ? cnt : 1u;
}
__device__ __forceinline__ void xcd_barrier(const XcdBarrier& b) {
    asm volatile("s_waitcnt vmcnt(0)" ::: "memory");
    __syncthreads();
    if (threadIdx.x == 0) {
        unsigned* bar = b.bar;
        __builtin_amdgcn_s_waitcnt(0);
        unsigned nloc = b.st[0], nx = b.st[1];
        if (nloc == 0u) { xcd_barrier_complete(bar, b.x, nloc, nx); b.st[0] = nloc; b.st[1] = nx; }
        const unsigned old = xb_add(&bar[XB_XSUB(b.x)], 1u);
        const unsigned gen = old / nloc;
        if (old + 1u == (gen + 1u) * nloc) {
            __builtin_amdgcn_fence(__ATOMIC_RELEASE, "agent");
            asm volatile("s_waitcnt vmcnt(0)" ::: "memory");
            const unsigned og = xb_add(&bar[XB_TOP], 1u);
            const unsigned tg = og / nx;
            if (og + 1u == (tg + 1u) * nx) xb_add(&bar[XB_TOPGEN], 1u);
            else XB_SPIN(xb_ld(&bar[XB_TOPGEN]) == tg, bar);
            __builtin_amdgcn_fence(__ATOMIC_ACQUIRE, "agent");
            xb_add(&bar[XB_XGEN(b.x)], 1u);
            asm volatile("s_waitcnt vmcnt(0)" ::: "memory");
        } else {
            XB_SPIN(xb_ld(&bar[XB_XGEN(b.x)]) == gen, bar);
            __builtin_amdgcn_fence(__ATOMIC_ACQUIRE, "agent");
            asm volatile("s_waitcnt vmcnt(0)" ::: "memory");
        }
    }
    __syncthreads();
}

struct Frame {
    LAS unsigned char* lds;
    unsigned* ctl;
    int tid, lane, wave, G;
    const float *x, *c, *ctx, *c_ctx, *w_mod, *b_mod, *norm1_w, *norm2_w, *w_in, *conv_w, *conv_b, *dt_bias, *a_log, *d_skip, *ssd_norm_w, *pool_w, *pool_scale, *w_out, *router_w, *router_b, *w1, *b1, *w2, *b2, *final_norm_w;
    float* out;
    float *MOD, *DTRAW, *DT, *ROWSC, *CHS, *TOPG, *SLOTGATE;
    bf16* X1;
    int *TOPE, *TOPR, *TOKSLOT, *SLOTTOK, *SLOTID, *ROWID, *BB;
    bf16 *WINT, *WOUTT, *W1T, *W2T, *A1, *XBCPRE, *Z, *V, *XBC, *CC, *ST, *Y, *YB, *A2, *H2, *ACT, *YS;
};

template <class RowMap>
__device__ __forceinline__ void p0_emit(bf16* WT, int Kd, RowMap rm, int k0, int n0, int nvalid, LAS float* scr, int lane) {
    const int c = lane & 7;
#pragma unroll
    for (int j = 0; j < 4; ++j) { const int n = (lane >> 3) + 8 * j; const LAS float* s = scr + (8 * c) * 33 + n;
        v4u o; o.x = pk2(s[0 * 33], s[1 * 33]); o.y = pk2(s[2 * 33], s[3 * 33]); o.z = pk2(s[4 * 33], s[5 * 33]); o.w = pk2(s[6 * 33], s[7 * 33]);
        if (n0 + n < nvalid) *(v4u*)(WT + (size_t)rm(n0 + n) * Kd + k0 + 8 * c) = o; }
    LDS_WAIT(); asm volatile("" ::: "memory");
}
template <class RowMap>
__device__ __forceinline__ void p0_transpose_item(const float* W, int N, int nvalid, bf16* WT, int Kd, RowMap rm, LAS float* scr, int kb, int nb, int lane) {
    const int k0 = 64 * kb, n0 = 32 * nb, nn = n0 + (lane & 31); const bool ok = nn < nvalid;
    float tv[32];
#pragma unroll
    for (int i = 0; i < 32; ++i) { const int kk = 2 * i + (lane >> 5); tv[i] = ok ? W[(size_t)(k0 + kk) * N + nn] : 0.f; }
#pragma unroll
    for (int i = 0; i < 32; ++i) { const int kk = 2 * i + (lane >> 5); scr[kk * 33 + (lane & 31)] = tv[i]; }
    LDS_WAIT(); asm volatile("" ::: "memory");
    p0_emit(WT, Kd, rm, k0, n0, nvalid, scr, lane);
}
struct RmId { __device__ __forceinline__ int operator()(int n) const { return n; } };
struct RmOff { int off; __device__ __forceinline__ int operator()(int n) const { return n + off; } };
struct RmWin { __device__ __forceinline__ int operator()(int n) const { return n < 2560 ? n : (n < 2608 ? 4608 + (n - 2560) : 2560 + (n - 2608)); } };
struct RmW1 { __device__ __forceinline__ int operator()(int n) const { const int j = n >> 1; return 256 * (j >> 7) + 128 * (n & 1) + (j & 127); } };

__device__ __forceinline__ void p0_prologue(Frame& F) {
    if ((int)blockIdx.x < 96) {
        LAS float* sc = (LAS float*)F.lds;
        LAS float* part = (LAS float*)(F.lds + 36864);
        for (int idx = F.tid; idx < 9 * 1024; idx += 512) { const int r = idx >> 10, k = idx & 1023; const float v = (r < 8) ? F.c[r * 1024 + k] : F.c_ctx[k]; sc[idx] = silu_f(v); }
        __syncthreads();
        const int n = 64 * (int)blockIdx.x + F.lane, kb = 128 * F.wave;
        float acc[9];
#pragma unroll
        for (int r = 0; r < 9; ++r) acc[r] = 0.f;
#pragma unroll 8
        for (int k = 0; k < 128; ++k) { const float wv = F.w_mod[(size_t)(kb + k) * 6144 + n];
#pragma unroll
            for (int r = 0; r < 9; ++r) acc[r] += sc[r * 1024 + kb + k] * wv; }
#pragma unroll
        for (int r = 0; r < 9; ++r) part[(F.wave * 9 + r) * 64 + F.lane] = acc[r];
        __syncthreads();
        for (int idx = F.tid; idx < 9 * 64; idx += 512) { const int r = idx >> 6, col = idx & 63; float s = 0.f;
#pragma unroll
            for (int w = 0; w < 8; ++w) s += part[(w * 9 + r) * 64 + col];
            F.MOD[r * 6144 + 64 * (int)blockIdx.x + col] = s + F.b_mod[64 * (int)blockIdx.x + col]; }
        __syncthreads();
    }
    LAS float* scr = (LAS float*)(F.lds + F.wave * 16384);
    const int gw = (int)blockIdx.x * 8 + F.wave, NGW = F.G * 8, lane = F.lane;
    constexpr int I_POOL = 16 * 4 * 4, I_PAD = N1 - IN_COLS;
    for (int r = NGW - 1 - gw; r < I_POOL + I_PAD; r += NGW) {
        if (r < I_POOL) {
            const int kb = r >> 4, g = (r >> 2) & 3, ob = r & 3, k = 64 * kb + lane, o0 = 32 * ob;
            float acc[32];
#pragma unroll
            for (int o = 0; o < 32; ++o) acc[o] = 0.f;
            const float* arow = F.w_in + (size_t)k * IN_COLS + 4144 + g * 128;
            for (int i = 0; i < 128; ++i) { const float a = arow[i]; const float* pw = F.pool_w + (size_t)(g * 128 + i) * 128 + o0;
#pragma unroll
                for (int o = 0; o < 32; ++o) acc[o] += a * pw[o]; }
#pragma unroll
            for (int o = 0; o < 32; ++o) scr[lane * 33 + o] = acc[o] * F.pool_scale[g * 128 + o0 + o];
            LDS_WAIT(); asm volatile("" ::: "memory");
            p0_emit(F.WINT, D, RmOff{4096 + g * 128}, 64 * kb, o0, 1 << 30, scr, lane);
        } else { v4u z = {0u, 0u, 0u, 0u}; v4u* p = (v4u*)(F.WINT + (size_t)(IN_COLS + (r - I_POOL)) * D); p[lane] = z; p[lane + 64] = z; }
    }
    for (int i = (int)blockIdx.x * 512 + F.tid; i < T; i += F.G * 512) F.ROWID[i] = i;
    constexpr int I_WIN = 16 * 130, I_WOUT = 32 * 32, I_W1 = 32 * 16 * 64, I_W2 = 32 * 16 * 32, NI = I_WIN + I_WOUT + I_W1 + I_W2;
    const bool wdeal = (F.G == 256);
    const int blk = (int)blockIdx.x;
#define P0_ITEM(k) (wdeal ? ((k) < 20 ? 2 * (((k) >> 1) * 2048 + gw) + ((k) & 1) : ((k) < 28 ? (blk >= 96 ? 2 * (20480 + (((k) - 20) >> 1) * 1280 + (gw - 768)) + ((k) & 1) : -1) : ((k) < 30 ? ((blk >= 96 && blk < 198) ? 2 * (25600 + (gw - 768)) + ((k) & 1) : -1) : -1))) : 2 * (((k) >> 1) * NGW + gw) + ((k) & 1))
    const int nrounds = wdeal ? 30 : 2 * ((NI / 2 + NGW - 1) / NGW);
    struct It { const float* src; bf16* dst; int N, nvalid, Kd, kind, k0, n0; };
#define P0_DECODE(it, I) do { int r_ = (it); \
        if (r_ < I_WIN) { I.src = F.w_in; I.dst = F.WINT; I.N = IN_COLS; I.nvalid = 4144; I.Kd = D; I.kind = 1; I.k0 = 64 * (r_ / 130); I.n0 = 32 * (r_ % 130); } \
        else if ((r_ -= I_WIN) < I_WOUT) { const int hf_ = r_ & 1, q_ = r_ >> 1; I.src = F.w_out; I.dst = F.WOUTT; I.N = D; I.nvalid = D; I.Kd = 2048; I.kind = 3; I.k0 = 64 * (2 * (q_ >> 5) + hf_); I.n0 = 32 * (q_ & 31); } \
        else if ((r_ -= I_WOUT) < I_W1) { const int hf_ = r_ & 1, p_ = r_ >> 1, e_ = p_ >> 9, q_ = p_ & 511; I.src = F.w1 + (size_t)e_ * D * 2048; I.dst = (bf16*)((unsigned char*)F.W1T + (size_t)e_ * 2048 * D); I.N = 2048; I.nvalid = 2048; I.Kd = D; I.kind = 2; I.k0 = 64 * (2 * (q_ >> 6) + hf_); I.n0 = 32 * (q_ & 63); } \
        else { r_ -= I_W1; const int hf_ = r_ & 1, p_ = r_ >> 1, e_ = p_ >> 8, q_ = p_ & 255; I.src = F.w2 + (size_t)e_ * D * D; I.dst = (bf16*)((unsigned char*)F.W2T + (size_t)e_ * D * D); I.N = D; I.nvalid = D; I.Kd = D; I.kind = 3; I.k0 = 64 * (2 * (q_ >> 5) + hf_); I.n0 = 32 * (q_ & 31); } } while (0)
#define P0_LOAD(I, tv) do { int nn_ = I.n0 + (lane & 31); nn_ = nn_ < I.nvalid ? nn_ : I.nvalid - 1; const float* sp_ = I.src + (size_t)(I.k0 + (lane >> 5)) * I.N + nn_; \
        _Pragma("unroll") for (int i_ = 0; i_ < 32; ++i_) { const float* q_ = sp_ + (size_t)(2 * i_) * I.N; asm volatile("global_load_dword %0, %1, off" : "=v"(tv[i_]) : "v"(q_) : "memory"); } } while (0)
#define P0_NEXT(itv) do { itv = -1; for (; kr < nrounds && itv < 0; ++kr) { const int it_ = P0_ITEM(kr); if (it_ >= 0 && it_ < NI) itv = it_; } } while (0)
#define P0_PROCESS(I, tv) do { \
        _Pragma("unroll") for (int i = 0; i < 32; ++i) { const int kk = 2 * i + (lane >> 5); scr[kk * 33 + (lane & 31)] = tv[i]; } \
        LDS_WAIT(); asm volatile("" ::: "memory"); \
        { const int c = lane & 7; \
          _Pragma("unroll") for (int j = 0; j < 4; ++j) { const int n = (lane >> 3) + 8 * j; const LAS float* sq = scr + (8 * c) * 33 + n; \
            const int ng = I.n0 + n; const int row = (I.kind == 0 || I.kind == 3) ? ng : (I.kind == 1 ? RmWin{}(ng) : RmW1{}(ng)); \
            if (I.kind >= 2) { v2u o; o.x = pk4_fp8(sq[0 * 33] * WSCALE, sq[1 * 33] * WSCALE, sq[2 * 33] * WSCALE, sq[3 * 33] * WSCALE); o.y = pk4_fp8(sq[4 * 33] * WSCALE, sq[5 * 33] * WSCALE, sq[6 * 33] * WSCALE, sq[7 * 33] * WSCALE); \
                *(v2u*)((unsigned char*)I.dst + (size_t)row * I.Kd + I.k0 + 8 * c) = o; } \
            else { v4u o; o.x = pk2(sq[0 * 33], sq[1 * 33]); o.y = pk2(sq[2 * 33], sq[3 * 33]); o.z = pk2(sq[4 * 33], sq[5 * 33]); o.w = pk2(sq[6 * 33], sq[7 * 33]); \
                if (ng < I.nvalid) *(v4u*)(I.dst + (size_t)row * I.Kd + I.k0 + 8 * c) = o; } } \
          LDS_WAIT(); asm volatile("" ::: "memory"); } } while (0)
    It ia{}, ib{}; float ta[32], tb[32]; int ita = -1, itb = -1; int kr = 0;
    P0_NEXT(ita);
    if (ita >= 0) { P0_DECODE(ita, ia); P0_LOAD(ia, ta); }
    while (ita >= 0) {
        P0_NEXT(itb);
        if (itb >= 0) { P0_DECODE(itb, ib); P0_LOAD(ib, tb); asm volatile("s_waitcnt vmcnt(32)" ::: "memory"); } else { asm volatile("s_waitcnt vmcnt(0)" ::: "memory"); }
        __builtin_amdgcn_sched_barrier(0);
        P0_PROCESS(ia, ta);
        if (itb < 0) break;
        P0_NEXT(ita);
        if (ita >= 0) { P0_DECODE(ita, ia); P0_LOAD(ia, ta); asm volatile("s_waitcnt vmcnt(32)" ::: "memory"); } else { asm volatile("s_waitcnt vmcnt(0)" ::: "memory"); }
        __builtin_amdgcn_sched_barrier(0);
        P0_PROCESS(ib, tb);
    }
#undef P0_NEXT
#undef P0_PROCESS
#undef P0_ITEM
#undef P0_DECODE
#undef P0_LOAD
}

__device__ __forceinline__ void p1_norm1(Frame& F) {
    const int gw = (int)blockIdx.x * 8 + F.wave, NGW = F.G * 8, lane = F.lane;
    const int per = (RTOT + NGW - 1) / NGW;
    const int rbeg = gw * per, rend = (rbeg + per < RTOT) ? rbeg + per : RTOT;
    int mb_cur = -1; f32x4 wsc[4], shv[4];
    for (int r0 = rbeg; r0 < rend; r0 += 4) {
        f32x4 v[4][4];
#pragma unroll
        for (int k = 0; k < 4; ++k) { const int r = (r0 + k < rend) ? r0 + k : rbeg; const float* xr = (r < T) ? F.x + (size_t)r * D : F.ctx + (size_t)(r - T) * D;
#pragma unroll
            for (int j = 0; j < 4; ++j) v[k][j] = *(const f32x4*)(xr + 4 * lane + 256 * j); }
#pragma unroll
        for (int k = 0; k < 4; ++k) { const int r = r0 + k; if (r < rend) {
            const int mb = (r < T) ? (r >> 12) : 8;
            if (mb != mb_cur) { const float* mod = F.MOD + (size_t)mb * 6144; mb_cur = mb;
#pragma unroll
                for (int j = 0; j < 4; ++j) { const int col = 4 * lane + 256 * j; wsc[j] = *(const f32x4*)(F.norm1_w + col) * (*(const f32x4*)(mod + 1024 + col) + 1.f); shv[j] = *(const f32x4*)(mod + col); } }
            float ss = 0.f;
#pragma unroll
            for (int j = 0; j < 4; ++j) ss += (v[k][j].x * v[k][j].x + v[k][j].y * v[k][j].y) + (v[k][j].z * v[k][j].z + v[k][j].w * v[k][j].w);
            const float rs = __builtin_amdgcn_rsqf(wave_sum(ss) * (1.f / D) + RMS_EPS);
#pragma unroll
            for (int j = 0; j < 4; ++j) { const int col = 4 * lane + 256 * j;
                const f32x4 h = (v[k][j] * rs) * wsc[j] + shv[j];
                v2u o; o.x = pk2(h.x, h.y); o.y = pk2(h.z, h.w);
                *(v2u*)(F.A1 + (size_t)r * D + col) = o; } } }
    }
}

struct Sched1 {   static constexpr bool TBL = false;
    const char* A; const char* Bt; int G, c;
    __device__ __forceinline__ bool next(int i, pg8::Unit& u) const {
        const int L = i * G + c; if (L >= 2432 + 88) return false;
        if (L < 2432) pg8::static_map(L, 128, 19, u.pm, u.pn);
        else { const int Lc = L - 2432, j = Lc >> 3; u.pm = 128 + (Lc & 7); u.pn = j < 10 ? j : 18; }
        u.e = 0; return true; }
    __device__ __forceinline__ const char* a_base(const pg8::Unit& u) const { return A + (size_t)u.pm * 256 * D * 2; }
    __device__ __forceinline__ const char* b_base(const pg8::Unit& u) const { return Bt + (size_t)u.pn * 256 * D * 2; }
    __device__ __forceinline__ const int* row_table(const pg8::Unit&) const { return nullptr; }
};
struct Epi1 {
    static constexpr bool PERM = true;
    bf16 *XBCPRE, *Z, *V; float* DTRAW;
    __device__ __forceinline__ void operator()(const f32x4 (&acc)[2][2][4][2], const pg8::Unit& u, int wr, int wc, int fr, int fq) const {
        const int row0 = u.pm * 256 + wr * 64 + fr;
        if (u.pn < 18) {
            bf16* base; int ldc, colt;
            if (u.pn < 10) { base = XBCPRE; ldc = CONV_CH; colt = u.pn * 256; } else if (u.pn < 16) { base = Z; ldc = SSD_W; colt = (u.pn - 10) * 256; } else { base = V; ldc = 512; colt = (u.pn - 16) * 256; }
            const int col0 = colt + wc * 32 + 8 * fq;
#pragma unroll
            for (int ai = 0; ai < 2; ++ai)
#pragma unroll
                for (int m = 0; m < 4; ++m) { bf16* rowp = base + (size_t)(row0 + ai * 128 + m * 16) * ldc + col0;
#pragma unroll
                    for (int bj = 0; bj < 2; ++bj) { const f32x4 v0 = acc[ai][bj][m][0], v1 = acc[ai][bj][m][1];
                        v4u w; w.x = pg8::cvt_pk_bf16(v0[0], v0[1]); w.y = pg8::cvt_pk_bf16(v0[2], v0[3]); w.z = pg8::cvt_pk_bf16(v1[0], v1[1]); w.w = pg8::cvt_pk_bf16(v1[2], v1[3]);
                        *(v4u*)(rowp + bj * 128) = w; } }
        } else if (wc < 2) {
            const int col0 = wc * 32 + 8 * fq;
#pragma unroll
            for (int ai = 0; ai < 2; ++ai)
#pragma unroll
                for (int m = 0; m < 4; ++m) { float* rowp = DTRAW + (size_t)(row0 + ai * 128 + m * 16) * 64 + col0;
                    *(f32x4*)(rowp) = acc[ai][0][m][0]; *(f32x4*)(rowp + 4) = acc[ai][0][m][1]; }
        }
    }
};

__device__ __forceinline__ bf16x8 frag_row(const LAS unsigned char* base, int rs, int row, int k0, int q) { return *(const LAS bf16x8*)(base + row * rs + (k0 + 8 * q) * 2); }
__device__ __forceinline__ bf16x8 frag_tr(const LAS unsigned char* base, int rs, int k0, int c0, int lane) {
    const int g = lane >> 4, qq = (lane & 15) >> 2, p = lane & 3;
    const LAS unsigned char* a = base + (k0 + 8 * g + qq) * rs + c0 * 2 + 8 * p;
    const s16x4 lo = __builtin_amdgcn_ds_read_tr16_b64_v4i16((LAS s16x4*)a);
    const s16x4 hi = __builtin_amdgcn_ds_read_tr16_b64_v4i16((LAS s16x4*)(a + 4 * rs));
    bf16x8 r; r[0] = lo[0]; r[1] = lo[1]; r[2] = lo[2]; r[3] = lo[3]; r[4] = hi[0]; r[5] = hi[1]; r[6] = hi[2]; r[7] = hi[3]; return r;
}
__device__ __forceinline__ f32x4 mfma16(bf16x8 a, bf16x8 b, f32x4 c) { return __builtin_amdgcn_mfma_f32_16x16x32_bf16(a, b, c, 0, 0, 0); }
__device__ __forceinline__ float wave_incl_scan(float v, int lane) {
#pragma unroll
    for (int o = 1; o < 64; o <<= 1) { const float t = __shfl_up(v, o); if (lane >= o) v += t; }
    return v;
}

__device__ __forceinline__ float silu_fast(float v) { return v * __builtin_amdgcn_rcpf(1.f + __builtin_amdgcn_exp2f(-1.44269504f * v)); }
__device__ __forceinline__ float softplus_f(float v) { return v > 20.f ? v : log1pf(__expf(v)); }
__device__ __forceinline__ void p4_scan(Frame& F, LAS float* Te, volatile LAS float* TOT, int d, int h, float raw0, float raw1, int lane, size_t chs_idx, float* rowsc) {
    const int s0 = d ? 127 - 2 * lane : 2 * lane, s1 = d ? s0 - 1 : s0 + 1;
    const float bias = F.dt_bias[d * NH + h];
    const float dt0 = softplus_f(raw0 + bias), dt1 = softplus_f(raw1 + bias);
    const float A2 = __expf(F.a_log[d * NH + h]) * 1.44269504f;
    const float a0 = -A2 * dt0, a1 = -A2 * dt1;
    const float incl = wave_incl_scan(a0 + a1, lane);
    const float c1 = incl, c0 = incl - a1, tot = __shfl(incl, 63);
    Te[d * 128 + s0] = c0; Te[d * 128 + s1] = c1;
    Te[(2 + d) * 128 + s0] = c0 - __builtin_amdgcn_logf(dt0); Te[(2 + d) * 128 + s1] = c1 - __builtin_amdgcn_logf(dt1);
    if (lane == 63) { F.CHS[chs_idx] = tot; *TOT = tot; }
    if (rowsc) { rowsc[s0] = __builtin_amdgcn_exp2f(c0); rowsc[s1] = __builtin_amdgcn_exp2f(c1); }
}
__device__ __forceinline__ v4u conv_piece(const v4u& r0, const v4u& r1, const v4u& r2, const v4u& r3, const v4u& r4, const float (&w)[5][8], const float (&bias)[8]) {
    float o[8];
#pragma unroll
    for (int e = 0; e < 8; ++e) o[e] = bias[e];
    const v4u rr[5] = {r0, r1, r2, r3, r4};
#pragma unroll
    for (int j = 0; j < 5; ++j) { const v4u q = rr[j];
        o[0] += w[j][0] * bflo(q.x); o[1] += w[j][1] * bfhi(q.x); o[2] += w[j][2] * bflo(q.y); o[3] += w[j][3] * bfhi(q.y);
        o[4] += w[j][4] * bflo(q.z); o[5] += w[j][5] * bfhi(q.z); o[6] += w[j][6] * bflo(q.w); o[7] += w[j][7] * bfhi(q.w); }
    v4u ov; ov.x = pk2(silu_fast(o[0]), silu_fast(o[1])); ov.y = pk2(silu_fast(o[2]), silu_fast(o[3])); ov.z = pk2(silu_fast(o[4]), silu_fast(o[5])); ov.w = pk2(silu_fast(o[6]), silu_fast(o[7]));
    return ov;
}
__device__ __forceinline__ void p4_states(Frame& F, const bf16x8 (&braw)[4], const LAS float* Te, const volatile LAS float* TOT2, const LAS unsigned char* Xs, size_t st_base, int w, int lane) {
    constexpr int RSX = 144;
    const int i16 = lane & 15, q4 = lane >> 4;
#pragma unroll
    for (int d = 0; d < 2; ++d) {
        const float tot = TOT2[d];
        f32x4 sa[4];
#pragma unroll
        for (int pt = 0; pt < 4; ++pt) sa[pt] = (f32x4){0.f, 0.f, 0.f, 0.f};
#pragma unroll
        for (int ks = 0; ks < 4; ++ks) {
            const LAS float* cp = Te + (2 + d) * 128 + 32 * ks + 8 * q4;
            const f32x4 c0 = *(const LAS f32x4*)cp, c1 = *(const LAS f32x4*)(cp + 4);
            float wv[8];
#pragma unroll
            for (int j = 0; j < 4; ++j) { wv[j] = __builtin_amdgcn_exp2f(tot - c0[j]); wv[4 + j] = __builtin_amdgcn_exp2f(tot - c1[j]); }
            const v4u bu = __builtin_bit_cast(v4u, braw[ks]); v4u su;
            su.x = pk2(bflo(bu.x) * wv[0], bfhi(bu.x) * wv[1]); su.y = pk2(bflo(bu.y) * wv[2], bfhi(bu.y) * wv[3]);
            su.z = pk2(bflo(bu.z) * wv[4], bfhi(bu.z) * wv[5]); su.w = pk2(bflo(bu.w) * wv[6], bfhi(bu.w) * wv[7]);
            const bf16x8 bs = __builtin_bit_cast(bf16x8, su);
#pragma unroll
            for (int pt = 0; pt < 4; ++pt) sa[pt] = mfma16(bs, frag_tr(Xs, RSX, 32 * ks, 16 * pt, lane), sa[pt]); }
        unsigned char* sp = (unsigned char*)F.ST + st_base + ((size_t)d * HDIM + i16) * NST + 16 * w + 4 * q4;
#pragma unroll
        for (int pt = 0; pt < 4; ++pt) { float c[4];
#pragma unroll
            for (int r = 0; r < 4; ++r) c[r] = fminf(fmaxf(sa[pt][r] * STSCALE, -440.f), 440.f);
            *(unsigned*)(sp + (size_t)16 * pt * NST) = pk4_fp8(c[0], c[1], c[2], c[3]); }
    }
}
__device__ __forceinline__ void p4_ssd_local(Frame& F) {
    constexpr int RS = 272, RSX = 144;
    constexpr int O_C = 0, O_B = 34816, O_M = 69632, O_X = 104448  , O_T = 141312  , O_CW = 153600  ;
    static_assert(O_CW + 9216 <= MISC_OFF, "P4 LDS map");
    LAS unsigned char* L = F.lds;
    LAS float* TAB = (LAS float*)(L + O_T);
    LAS float* CW = (LAS float*)(L + O_CW);
    volatile LAS float* TOT = (volatile LAS float*)(L + MISC_OFF + 64);
    volatile LAS float* DSK = (volatile LAS float*)(L + MISC_OFF + 128);
    const int tid = F.tid, w = F.wave;
    const int lb = 64 * (w & 1), sb = 32 * (w >> 1);
    const v4u zero4 = {0u, 0u, 0u, 0u};
    constexpr int NLAT = NB * 32 * NGRP, NCTX = NB * 2 * NGRP * HPG;
    int g_staged = -1;
    for (int v = (int)blockIdx.x; v < NLAT + NCTX; v += F.G) {
        const bool lat = v < NLAT;
        int tid_l = tid; asm volatile("" : "+v"(tid_l));
        const int lane_l = tid_l & 63, lane = lane_l, i16 = lane & 15, q4 = lane >> 4;
        const int p32 = tid_l & 31, rg = tid_l >> 5;
        const int xpc = tid_l & 7, rg2 = tid_l >> 3;
        int b, g, cc, r0, e_lo, e_hi; bool lo_ok, hi_ok;
        if (lat) { b = v >> 7; const int c = (v >> 2) & 31; g = v & 3; cc = c + 2; r0 = b * SEQ + c * CHUNK; lo_ok = c > 0; hi_ok = c < 31; e_lo = 0; e_hi = HPG; }
        else { const int q = v - NLAT; const int e = q % HPG; int t = q / HPG; g = t & 3; t >>= 2; cc = t & 1; b = t >> 1; r0 = T + b * CTXL + cc * CHUNK; lo_ok = cc > 0; hi_ok = cc < 1; e_lo = e; e_hi = e + 1; }
        const int rmin = lo_ok ? -2 : 0, rmax = hi_ok ? 129 : 127;
        const int chBC = SSD_W + (p32 >> 4) * (NGRP * NST) + g * NST + 8 * (p32 & 15);
        v4u raw[12];
#pragma unroll
        for (int j = 0; j < 12; ++j) { const int rr = 8 * rg - 2 + j; const int rc = rr < rmin ? rmin : (rr > rmax ? rmax : rr);
            const v4u t = *(const v4u*)(F.XBCPRE + (size_t)(r0 + rc) * CONV_CH + chBC); raw[j] = (rr == rc) ? t : zero4; }
        if (g != g_staged) {
            if (tid < HPG) DSK[tid] = F.d_skip[g * HPG + tid];
            float cwv[5];
#pragma unroll
            for (int q = 0; q < 5; ++q) { int idx = tid + 512 * q; idx = idx < HPG * 6 * 64 ? idx : HPG * 6 * 64 - 1; const int e_ = idx / 384, rem = idx - e_ * 384, j = rem >> 6, chl = rem & 63; const int ch = (g * HPG + e_) * HDIM + chl;
                const int jj = j < 5 ? j : 0; const float a = F.conv_w[jj * CONV_CH + ch], bq = F.conv_b[ch]; cwv[q] = (j < 5) ? a : bq; }
#pragma unroll
            for (int q = 0; q < 5; ++q) { const int idx = tid + 512 * q; if (idx < HPG * 6 * 64) CW[idx] = cwv[q]; }
            g_staged = g;
        }
        {
            float cw[5][8], cbias[8];
#pragma unroll
            for (int j = 0; j < 5; ++j) { const f32x4 a = *(const f32x4*)(F.conv_w + j * CONV_CH + chBC), bq = *(const f32x4*)(F.conv_w + j * CONV_CH + chBC + 4);
                cw[j][0] = a.x; cw[j][1] = a.y; cw[j][2] = a.z; cw[j][3] = a.w; cw[j][4] = bq.x; cw[j][5] = bq.y; cw[j][6] = bq.z; cw[j][7] = bq.w; }
            { const f32x4 a = *(const f32x4*)(F.conv_b + chBC), bq = *(const f32x4*)(F.conv_b + chBC + 4); cbias[0] = a.x; cbias[1] = a.y; cbias[2] = a.z; cbias[3] = a.w; cbias[4] = bq.x; cbias[5] = bq.y; cbias[6] = bq.z; cbias[7] = bq.w; }
            LAS unsigned char* dst = L + ((p32 >> 4) ? O_C : O_B) + (8 * rg) * RS + (p32 & 15) * 16;
#pragma unroll
            for (int i = 0; i < 8; ++i) { const v4u o = conv_piece(raw[i], raw[i + 1], raw[i + 2], raw[i + 3], raw[i + 4], cw, cbias);
                *(LAS v4u*)(dst + i * RS) = o;
                if (lat && (p32 >> 4)) *(v4u*)(F.CC + (size_t)(r0 + 8 * rg + i) * 512 + g * NST + 8 * (p32 & 15)) = o; }
        }
        v4u xraw[6];
#pragma unroll
        for (int j = 0; j < 6; ++j) { const int rr = 2 * rg2 - 2 + j; const int rc = rr < rmin ? rmin : (rr > rmax ? rmax : rr);
            xraw[j] = *(const v4u*)(F.XBCPRE + (size_t)(r0 + rc) * CONV_CH + (g * HPG + e_lo) * HDIM + 8 * xpc); }
        float pdt[2][2];
#pragma unroll
        for (int ii = 0; ii < 2; ++ii) { const int idx = (w + 8 * ii) < 12 ? (w + 8 * ii) : 11; const int e_ = idx % 6, d_ = idx / 6, h_ = g * HPG + e_; const int s0 = d_ ? 127 - 2 * lane_l : 2 * lane_l, s1 = d_ ? s0 - 1 : s0 + 1;
            pdt[ii][0] = F.DTRAW[(size_t)(r0 + s0) * 64 + d_ * NH + h_]; pdt[ii][1] = F.DTRAW[(size_t)(r0 + s1) * 64 + d_ * NH + h_]; }
#pragma unroll
        for (int ii = 0; ii < 2; ++ii) { const int idx = w + 8 * ii; const int e = idx % 6, d = idx / 6, h = g * HPG + e;
            if (idx < 12 && e >= e_lo && e < e_hi)
                p4_scan(F, TAB + e * 512, TOT + e * 2 + d, d, h, pdt[ii][0], pdt[ii][1], lane_l, ((size_t)(b * NCC + cc) * NH + h) * 2 + d, lat ? F.ROWSC + ((size_t)(b * 2 + d) * NH + h) * SEQ + (cc - 2) * CHUNK : nullptr); }
        __syncthreads();
        f32x4 cb[2][4];
        if (lat) {
#pragma unroll
            for (int ts = 0; ts < 2; ++ts)
#pragma unroll
                for (int tl = 0; tl < 4; ++tl) cb[ts][tl] = (f32x4){0.f, 0.f, 0.f, 0.f};
#pragma unroll
            for (int ks = 0; ks < 4; ++ks) { bf16x8 af[2], bfr[4];
#pragma unroll
                for (int ts = 0; ts < 2; ++ts) af[ts] = frag_row(L + O_B, RS, sb + 16 * ts + i16, 32 * ks, q4);
#pragma unroll
                for (int tl = 0; tl < 4; ++tl) bfr[tl] = frag_row(L + O_C, RS, lb + 16 * tl + i16, 32 * ks, q4);
#pragma unroll
                for (int ts = 0; ts < 2; ++ts)
#pragma unroll
                    for (int tl = 0; tl < 4; ++tl) cb[ts][tl] = mfma16(af[ts], bfr[tl], cb[ts][tl]); }
        }
        bf16x8 braw[4];
#pragma unroll
        for (int ks = 0; ks < 4; ++ks) braw[ks] = frag_tr(L + O_B, RS, 32 * ks, 16 * w, lane);
        for (int e = e_lo; e < e_hi; ++e) {
            const int h = g * HPG + e;
            const LAS float* Te = TAB + e * 512;
            LAS unsigned char* Xs = L + O_X + (e & 1) * 18432;
            LAS unsigned char* Ms = L + ((e & 1) ? O_C : O_M);
            {
                const LAS float* cwp = CW + (e * 6) * 64 + 8 * xpc;
#pragma unroll
                for (int i = 0; i < 2; ++i) {
                    f32x4 oa = *(const LAS f32x4*)(cwp + 5 * 64), ob = *(const LAS f32x4*)(cwp + 5 * 64 + 4);
#pragma unroll
                    for (int j = 0; j < 5; ++j) { const f32x4 wa = *(const LAS f32x4*)(cwp + j * 64), wb = *(const LAS f32x4*)(cwp + j * 64 + 4);
                        const int rr = 2 * rg2 - 2 + i + j; const v4u q = (rr >= rmin && rr <= rmax) ? xraw[i + j] : zero4;
                        oa.x += wa.x * bflo(q.x); oa.y += wa.y * bfhi(q.x); oa.z += wa.z * bflo(q.y); oa.w += wa.w * bfhi(q.y);
                        ob.x += wb.x * bflo(q.z); ob.y += wb.y * bfhi(q.z); ob.z += wb.z * bflo(q.w); ob.w += wb.w * bfhi(q.w); }
                    v4u ov; ov.x = pk2(silu_fast(oa.x), silu_fast(oa.y)); ov.y = pk2(silu_fast(oa.z), silu_fast(oa.w)); ov.z = pk2(silu_fast(ob.x), silu_fast(ob.y)); ov.w = pk2(silu_fast(ob.z), silu_fast(ob.w));
                    *(LAS v4u*)(Xs + (2 * rg2 + i) * RSX + xpc * 16) = ov; }
            }
            if (e + 1 < e_hi) {
#pragma unroll
                for (int j = 0; j < 6; ++j) { const int rr = 2 * rg2 - 2 + j; const int rc = rr < rmin ? rmin : (rr > rmax ? rmax : rr);
                    xraw[j] = *(const v4u*)(F.XBCPRE + (size_t)(r0 + rc) * CONV_CH + (h + 1) * HDIM + 8 * xpc); }
            }
            if (lat) {
                const float Dh = DSK[e];
#pragma unroll
                for (int tl = 0; tl < 4; ++tl) { const int l = lb + 16 * tl + i16; const int lt_abs = 4 * (w & 1) + tl; const float af_l = Te[l], rb_l = Te[128 + l];
#pragma unroll
                    for (int ts = 0; ts < 2; ++ts) { const int s0 = sb + 16 * ts + 4 * q4; const int st_abs = 2 * (w >> 1) + ts;
                        float m[4];
                        if (st_abs < lt_abs) {
                            const f32x4 acs = *(const LAS f32x4*)(Te + 256 + s0);
#pragma unroll
                            for (int r = 0; r < 4; ++r) m[r] = cb[ts][tl][r] * __builtin_amdgcn_exp2f(af_l - acs[r]);
                        } else if (st_abs > lt_abs) {
                            const f32x4 rbs = *(const LAS f32x4*)(Te + 384 + s0);
#pragma unroll
                            for (int r = 0; r < 4; ++r) m[r] = cb[ts][tl][r] * __builtin_amdgcn_exp2f(rb_l - rbs[r]);
                        } else {
                            const f32x4 acs = *(const LAS f32x4*)(Te + 256 + s0), rbs = *(const LAS f32x4*)(Te + 384 + s0);
#pragma unroll
                            for (int r = 0; r < 4; ++r) { const int sidx = s0 + r;
                                const float wf = (sidx <= l) ? __builtin_amdgcn_exp2f(af_l - acs[r]) : 0.f;
                                const float wb = (sidx >= l) ? __builtin_amdgcn_exp2f(rb_l - rbs[r]) : 0.f;
                                m[r] = cb[ts][tl][r] * (wf + wb) + ((sidx == l) ? Dh : 0.f); }
                        }
                        v2u o; o.x = pk2(m[0], m[1]); o.y = pk2(m[2], m[3]);
                        *(LAS v2u*)(Ms + l * RS + s0 * 2) = o; } }
            }
            __syncthreads();
            if (lat) {
                f32x4 ya[4];
#pragma unroll
                for (int pt = 0; pt < 4; ++pt) ya[pt] = (f32x4){0.f, 0.f, 0.f, 0.f};
#pragma unroll
                for (int ks = 0; ks < 4; ++ks) { const bf16x8 bm = frag_row(Ms, RS, 16 * w + i16, 32 * ks, q4);
#pragma unroll
                    for (int pt = 0; pt < 4; ++pt) ya[pt] = mfma16(frag_tr(Xs, RSX, 32 * ks, 16 * pt, lane), bm, ya[pt]); }
                bf16* yp = F.Y + (size_t)(r0 + 16 * w + i16) * SSD_W + h * HDIM + 4 * q4;
#pragma unroll
                for (int pt = 0; pt < 4; ++pt) { v2u o; o.x = pk2(ya[pt][0], ya[pt][1]); o.y = pk2(ya[pt][2], ya[pt][3]); *(v2u*)(yp + 16 * pt) = o; }
            }
            p4_states(F, braw, Te, TOT + e * 2, Xs, (((size_t)(b * NCC + cc) * NH + h) * 2) * HDIM * NST, w, lane);
        }
        __syncthreads();
    }
}

__device__ __forceinline__ void pool_grid_row(Frame& F, int gr) {
    LAS unsigned char* L = F.lds;
    const int tid = F.tid, rb = gr * 64;
    v4u pv[8];
#pragma unroll
    for (int k = 0; k < 8; ++k) { const int pc = tid + 512 * k, row = pc >> 6, ch = pc & 63; pv[k] = *(const v4u*)(F.V + (size_t)(rb + row) * 512 + ch * 8); }
#pragma unroll
    for (int k = 0; k < 8; ++k) { const int pc = tid + 512 * k, row = pc >> 6, ch = pc & 63; *(LAS v4u*)(L + row * 1024 + ch * 16) = pv[k]; }
    __syncthreads();
    {
        const int cg = tid & 63, tb = tid >> 6, hw = 1 << (cg >> 4);
        const LAS unsigned char* colp = L + cg * 16;
#pragma unroll 2
        for (int tt = 0; tt < 8; ++tt) { const int t = tb * 8 + tt; const int lo = t - hw < 0 ? 0 : t - hw, hi = t + hw > 64 ? 64 : t + hw;
            float sacc[8];
#pragma unroll
            for (int e = 0; e < 8; ++e) sacc[e] = 0.f;
            for (int q = lo; q < hi; ++q) { const v4u x = *(const LAS v4u*)(colp + q * 1024);
                sacc[0] += bflo(x.x); sacc[1] += bfhi(x.x); sacc[2] += bflo(x.y); sacc[3] += bfhi(x.y); sacc[4] += bflo(x.z); sacc[5] += bfhi(x.z); sacc[6] += bflo(x.w); sacc[7] += bfhi(x.w); }
            const v4u x = *(const LAS v4u*)(colp + t * 1024); const float inv = 1.f / (float)(hi - lo);
            float q[8] = {sacc[0] * inv - bflo(x.x), sacc[1] * inv - bfhi(x.x), sacc[2] * inv - bflo(x.y), sacc[3] * inv - bfhi(x.y), sacc[4] * inv - bflo(x.z), sacc[5] * inv - bfhi(x.z), sacc[6] * inv - bflo(x.w), sacc[7] * inv - bfhi(x.w)};
#pragma unroll
            for (int e = 0; e < 8; ++e) q[e] = fminf(fmaxf(q[e] * A2SCALE, -440.f), 440.f);
            v2u o; o.x = pk4_fp8(q[0], q[1], q[2], q[3]); o.y = pk4_fp8(q[4], q[5], q[6], q[7]);
            *(v2u*)((unsigned char*)F.A2 + (size_t)(rb + t) * 2048 + SSD_W + cg * 8) = o; }
    }
    __syncthreads();
}
__device__ __forceinline__ void p5_ssd_scan(Frame& F) {
    constexpr int RS = 272, O_RS = 4 * 34816;
    LAS unsigned char* L = F.lds;
    LAS float* RSB = (LAS float*)(L + O_RS);
    const int tid = F.tid, lane = F.lane, w = F.wave, i16 = lane & 15, q4 = lane >> 4;
    const int d = w >> 2, ps = w & 3, t8 = tid & 255;
    if (F.G == 256 && (int)blockIdx.x >= NB * NH) {
        for (int gr = (int)blockIdx.x - NB * NH; gr < T / 64; gr += F.G - NB * NH) pool_grid_row(F, gr);
        return;
    }
    for (int u = (int)blockIdx.x; u < NB * NH; u += F.G) {
        const int b = u / NH, h = u - b * NH, g = h / HPG;
        float S[32];
#pragma unroll
        for (int k = 0; k < 32; ++k) S[k] = 0.f;
        v4u creg[8]; float rsreg = 0.f;
#pragma unroll
        for (int k = 0; k < 8; ++k) creg[k] = (v4u){0u, 0u, 0u, 0u};
        for (int j = 0; j < NCC; ++j) {
            const int cc = d == 0 ? j : (j < 2 ? 1 - j : 35 - j);
            LAS unsigned char* Cb = L + ((j & 1) * 2 + d) * 34816;
            if (j >= 2) {
#pragma unroll
                for (int k = 0; k < 8; ++k) { const int pc = t8 + 256 * k, row = pc >> 4, ch = pc & 15; *(LAS v4u*)(Cb + row * RS + ch * 16) = creg[k]; }
                if (t8 < 128) RSB[((j & 1) * 2 + d) * 128 + t8] = rsreg;
            }
            __syncthreads();
            if (j + 1 >= 2 && j + 1 < NCC) {
                const int cn = d == 0 ? j + 1 : 34 - j;
                const size_t rown = (size_t)b * SEQ + (size_t)(cn - 2) * CHUNK;
#pragma unroll
                for (int k = 0; k < 8; ++k) { const int pc = t8 + 256 * k, row = pc >> 4, ch = pc & 15; creg[k] = *(const v4u*)(F.CC + (rown + row) * 512 + g * NST + ch * 8); }
                if (t8 < 128) rsreg = F.ROWSC[((size_t)(b * 2 + d) * NH + h) * SEQ + (cn - 2) * CHUNK + t8];
            }
            const size_t sidx = ((size_t)(b * NCC + cc) * NH + h) * 2 + d;
            const unsigned char* stp = (const unsigned char*)F.ST + (sidx * HDIM + 16 * ps + i16) * NST + 8 * q4;
            v2u stv[4];
#pragma unroll
            for (int ks = 0; ks < 4; ++ks) stv[ks] = *(const v2u*)(stp + 32 * ks);
            const float decay = __builtin_amdgcn_exp2f(F.CHS[sidx]);
            if (j >= 2) {
                bf16x8 sf[4];
#pragma unroll
                for (int ks = 0; ks < 4; ++ks) { v4u t; t.x = pk2(S[ks * 8 + 0], S[ks * 8 + 1]); t.y = pk2(S[ks * 8 + 2], S[ks * 8 + 3]); t.z = pk2(S[ks * 8 + 4], S[ks * 8 + 5]); t.w = pk2(S[ks * 8 + 6], S[ks * 8 + 7]); sf[ks] = __builtin_bit_cast(bf16x8, t); }
                const size_t rowb = (size_t)b * SEQ + (size_t)(cc - 2) * CHUNK;
                const LAS float* rsl = RSB + ((j & 1) * 2 + d) * 128;
                const int c = cc - 2; const bool first = (d == 0) ? (c <= 15) : (c >= 16);
                unsigned yold[8];
                unsigned char* yo = (unsigned char*)F.YB + (rowb + i16) * SSD_W + h * HDIM + 16 * ps + 4 * q4;
                if (!first) {
#pragma unroll
                    for (int lt = 0; lt < 8; ++lt) yold[lt] = *(const unsigned*)(yo + (size_t)16 * lt * SSD_W);
                }
#pragma unroll
                for (int lt = 0; lt < 8; ++lt) {
                    f32x4 a = (f32x4){0.f, 0.f, 0.f, 0.f};
#pragma unroll
                    for (int ks = 0; ks < 4; ++ks) a = mfma16(sf[ks], frag_row(Cb, RS, 16 * lt + i16, 32 * ks, q4), a);
                    const float sc = rsl[16 * lt + i16] * YOSCALE;
                    float o[4] = {a[0] * sc, a[1] * sc, a[2] * sc, a[3] * sc};
                    if (!first) { const f32x2 lo = __builtin_amdgcn_cvt_pk_f32_fp8((int)yold[lt], false), hi = __builtin_amdgcn_cvt_pk_f32_fp8((int)yold[lt], true); o[0] += lo.x; o[1] += lo.y; o[2] += hi.x; o[3] += hi.y; }
#pragma unroll
                    for (int r = 0; r < 4; ++r) o[r] = fminf(fmaxf(o[r], -440.f), 440.f);
                    *(unsigned*)(yo + (size_t)16 * lt * SSD_W) = pk4_fp8(o[0], o[1], o[2], o[3]);
                }
            }
#pragma unroll
            for (int ks = 0; ks < 4; ++ks) { const v2u t = stv[ks];
                const f32x2 a0 = __builtin_amdgcn_cvt_pk_f32_fp8((int)t.x, false), a1 = __builtin_amdgcn_cvt_pk_f32_fp8((int)t.x, true), a2 = __builtin_amdgcn_cvt_pk_f32_fp8((int)t.y, false), a3 = __builtin_amdgcn_cvt_pk_f32_fp8((int)t.y, true);
                S[ks * 8 + 0] = decay * S[ks * 8 + 0] + a0.x * (1.f / STSCALE); S[ks * 8 + 1] = decay * S[ks * 8 + 1] + a0.y * (1.f / STSCALE);
                S[ks * 8 + 2] = decay * S[ks * 8 + 2] + a1.x * (1.f / STSCALE); S[ks * 8 + 3] = decay * S[ks * 8 + 3] + a1.y * (1.f / STSCALE);
                S[ks * 8 + 4] = decay * S[ks * 8 + 4] + a2.x * (1.f / STSCALE); S[ks * 8 + 5] = decay * S[ks * 8 + 5] + a2.y * (1.f / STSCALE);
                S[ks * 8 + 6] = decay * S[ks * 8 + 6] + a3.x * (1.f / STSCALE); S[ks * 8 + 7] = decay * S[ks * 8 + 7] + a3.y * (1.f / STSCALE); }
        }
        __syncthreads();
    }
}

__device__ __forceinline__ void p6_gate_pool(Frame& F) {
    LAS unsigned char* L = F.lds;
    const int tid = F.tid, lane = F.lane, w = F.wave;
    f32x4 nw[3][2];
#pragma unroll
    for (int j = 0; j < 3; ++j) { const int col = 8 * (lane + 64 * j); nw[j][0] = *(const f32x4*)(F.ssd_norm_w + col) * A2SCALE; nw[j][1] = *(const f32x4*)(F.ssd_norm_w + col + 4) * A2SCALE; }
    for (int gr = (int)blockIdx.x; gr < T / 64; gr += F.G) {
        const int rb = gr * 64;
        if (F.G != 256) pool_grid_row(F, gr);
        for (int rr = 0; rr < 8; rr += 2) {
            v4u ya[2][3], zz[2][3]; v2u yb[2][3];
#pragma unroll
            for (int k = 0; k < 2; ++k) { const int r = rb + 8 * w + rr + k;
#pragma unroll
                for (int j = 0; j < 3; ++j) { const int col = 8 * (lane + 64 * j);
                    ya[k][j] = *(const v4u*)(F.Y + (size_t)r * SSD_W + col); yb[k][j] = *(const v2u*)((const unsigned char*)F.YB + (size_t)r * SSD_W + col); zz[k][j] = *(const v4u*)(F.Z + (size_t)r * SSD_W + col); } }
#pragma unroll
            for (int k = 0; k < 2; ++k) { const int r = rb + 8 * w + rr + k;
                float v[24]; float ss = 0.f;
#pragma unroll
                for (int j = 0; j < 3; ++j) {
                    const unsigned yaw[4] = {ya[k][j].x, ya[k][j].y, ya[k][j].z, ya[k][j].w}, zw[4] = {zz[k][j].x, zz[k][j].y, zz[k][j].z, zz[k][j].w};
                    const f32x2 yo2[4] = {__builtin_amdgcn_cvt_pk_f32_fp8((int)yb[k][j].x, false), __builtin_amdgcn_cvt_pk_f32_fp8((int)yb[k][j].x, true), __builtin_amdgcn_cvt_pk_f32_fp8((int)yb[k][j].y, false), __builtin_amdgcn_cvt_pk_f32_fp8((int)yb[k][j].y, true)};
#pragma unroll
                    for (int e = 0; e < 4; ++e) { const float y0 = bflo(yaw[e]) + yo2[e].x * (1.f / YOSCALE), y1 = bfhi(yaw[e]) + yo2[e].y * (1.f / YOSCALE);
                        const float g0 = y0 * silu_f(bflo(zw[e])), g1 = y1 * silu_f(bfhi(zw[e])); v[j * 8 + 2 * e] = g0; v[j * 8 + 2 * e + 1] = g1; ss += g0 * g0 + g1 * g1; } }
                const float rs = __builtin_amdgcn_rsqf(wave_sum(ss) * (1.f / SSD_W) + RMS_EPS);
#pragma unroll
                for (int j = 0; j < 3; ++j) { const int col = 8 * (lane + 64 * j);
                    const f32x4 w0 = nw[j][0], w1 = nw[j][1];
                    const float rq = rs; float q[8] = {v[j * 8 + 0] * rq * w0.x, v[j * 8 + 1] * rq * w0.y, v[j * 8 + 2] * rq * w0.z, v[j * 8 + 3] * rq * w0.w, v[j * 8 + 4] * rq * w1.x, v[j * 8 + 5] * rq * w1.y, v[j * 8 + 6] * rq * w1.z, v[j * 8 + 7] * rq * w1.w};
#pragma unroll
                    for (int e = 0; e < 8; ++e) q[e] = fminf(fmaxf(q[e], -440.f), 440.f);
                    v2u o; o.x = pk4_fp8(q[0], q[1], q[2], q[3]); o.y = pk4_fp8(q[4], q[5], q[6], q[7]);
                    *(v2u*)((unsigned char*)F.A2 + (size_t)r * 2048 + col) = o; } }
        }
    }
}

struct Sched7 {
    static constexpr bool TBL = false;
    const char* A; const char* Bt; const int* rowid; int G, c;
    __device__ __forceinline__ bool next(int i, pg8::Unit& u) const { const int L = i * G + c; if (L >= 512) return false; pg8::static_map(L, 128, 4, u.pm, u.pn); u.e = 0; return true; }
    __device__ __forceinline__ const char* a_base(const pg8::Unit&) const { return A; }
    __device__ __forceinline__ const char* b_base(const pg8::Unit& u) const { return Bt + (size_t)u.pn * 256 * 2048; }
    __device__ __forceinline__ const int* row_table(const pg8::Unit& u) const { return rowid + u.pm * 256; }
};
struct Epi7 {
    static constexpr bool PERM = false;
    const float* x; const float* MOD; bf16* X1;
    __device__ __forceinline__ void operator()(const f32x4 (&acc)[2][2][4][2], const pg8::Unit& u, int wr, int wc, int fr, int fq) const {
        const int row0 = u.pm * 256 + wr * 64 + fr, col0 = u.pn * 256 + wc * 32 + 4 * fq;
        const float* g1 = MOD + (size_t)(u.pm >> 4) * 6144 + 2048;
        f32x4 gv[2][2];
#pragma unroll
        for (int bj = 0; bj < 2; ++bj)
#pragma unroll
            for (int n = 0; n < 2; ++n) gv[bj][n] = *(const f32x4*)(g1 + col0 + bj * 128 + n * 16);
#pragma unroll
        for (int ai = 0; ai < 2; ++ai)
#pragma unroll
            for (int m = 0; m < 4; ++m) { const size_t off = (size_t)(row0 + ai * 128 + m * 16) * D + col0;
#pragma unroll
                for (int bj = 0; bj < 2; ++bj)
#pragma unroll
                    for (int n = 0; n < 2; ++n) { const f32x4 xv = *(const f32x4*)(x + off + bj * 128 + n * 16); const f32x4 o = xv + gv[bj][n] * (acc[ai][bj][m][n] * (1.f / (WSCALE * A2SCALE))); v2u ov; ov.x = pk2(o.x, o.y); ov.y = pk2(o.z, o.w); *(v2u*)(X1 + off + bj * 128 + n * 16) = ov; } }
    }
};

__device__ __forceinline__ void p8_router(Frame& F) {
    LAS unsigned char* L = F.lds;
    LAS float* H2F = (LAS float*)L;
    constexpr int HP = 1028;
    LAS float* PART = (LAS float*)(L + 16 * HP * 4);
    LAS unsigned* HIST = (LAS unsigned*)(L + 16 * HP * 4 + 16384);
    const int tid = F.tid, lane = F.lane, w = F.wave, i16 = lane & 15, q4 = lane >> 4;
    if (tid < 32) HIST[tid] = 0u;
    float rw0[32], rw1[32];
#pragma unroll
    for (int kk = 0; kk < 32; ++kk) { const int k = 128 * w + 4 * kk + q4; rw0[kk] = F.router_w[k * 32 + i16]; rw1[kk] = F.router_w[k * 32 + 16 + i16]; }
    __syncthreads();
    for (int gi = (int)blockIdx.x; gi < T / 16; gi += F.G) {
        const int rbase = gi * 16;
#pragma unroll
        for (int rr = 0; rr < 2; ++rr) {
            const int r16 = 2 * w + rr, r = rbase + r16;
            const bf16* xr = F.X1 + (size_t)r * D; const float* mod = F.MOD + (size_t)(r >> 12) * 6144;
            f32x4 v[4]; float ss = 0.f;
#pragma unroll
            for (int j = 0; j < 4; ++j) { const v2u xq = *(const v2u*)(xr + 4 * lane + 256 * j); v[j] = (f32x4){bflo(xq.x), bfhi(xq.x), bflo(xq.y), bfhi(xq.y)}; ss += (v[j].x * v[j].x + v[j].y * v[j].y) + (v[j].z * v[j].z + v[j].w * v[j].w); }
            const float rs = __builtin_amdgcn_rsqf(wave_sum(ss) * (1.f / D) + RMS_EPS);
#pragma unroll
            for (int j = 0; j < 4; ++j) { const int col = 4 * lane + 256 * j;
                const f32x4 wv = *(const f32x4*)(F.norm2_w + col), sh = *(const f32x4*)(mod + 3072 + col), sc = *(const f32x4*)(mod + 4096 + col);
                const f32x4 hh = (v[j] * rs) * wv * (sc + 1.f) + sh;
                *(LAS f32x4*)(H2F + r16 * HP + col) = hh;
                *(unsigned*)((unsigned char*)F.H2 + (size_t)r * D + col) = pk4_fp8(hh.x, hh.y, hh.z, hh.w); }
        }
        __syncthreads();
        {
            f32x4 a0 = (f32x4){0.f, 0.f, 0.f, 0.f}, a1 = a0;
#pragma unroll
            for (int kk = 0; kk < 32; ++kk) { const int k = 128 * w + 4 * kk + q4;
                const float av = H2F[i16 * HP + k];
                a0 = __builtin_amdgcn_mfma_f32_16x16x4f32(av, rw0[kk], a0, 0, 0, 0); a1 = __builtin_amdgcn_mfma_f32_16x16x4f32(av, rw1[kk], a1, 0, 0, 0); }
#pragma unroll
            for (int r = 0; r < 4; ++r) { PART[(w * 16 + 4 * q4 + r) * 32 + i16] = a0[r]; PART[(w * 16 + 4 * q4 + r) * 32 + 16 + i16] = a1[r]; }
        }
        __syncthreads();
        {
            const int row = tid >> 5, e = tid & 31;
            float lg = F.router_b[e];
#pragma unroll
            for (int ww = 0; ww < 8; ++ww) lg += PART[(ww * 16 + row) * 32 + e];
            float tv[4]; int ti[4];
#pragma unroll
            for (int k = 0; k < 4; ++k) { float bv = lg; int bi = e;
#pragma unroll
                for (int o = 1; o < 32; o <<= 1) { const float ov = __shfl_xor(bv, o); const int oi = __shfl_xor(bi, o); if (ov > bv || (ov == bv && oi < bi)) { bv = ov; bi = oi; } }
                tv[k] = bv; ti[k] = bi; if (e == bi) lg = -INFINITY; }
            if (e == 0) {
                const float e1 = __expf(tv[1] - tv[0]), e2 = __expf(tv[2] - tv[0]), e3 = __expf(tv[3] - tv[0]); const float inv = 1.f / (1.f + e1 + e2 + e3);
                const float gt[4] = {inv, e1 * inv, e2 * inv, e3 * inv};
                const int tok = rbase + row;
#pragma unroll
                for (int k = 0; k < 4; ++k) { const unsigned lr = atomicAdd((unsigned*)&HIST[ti[k]], 1u); F.TOPE[tok * 4 + k] = ti[k]; F.TOPG[tok * 4 + k] = gt[k]; F.TOPR[tok * 4 + k] = (int)lr; }
            }
        }
        __syncthreads();
    }
    if (tid < 32) { const unsigned base = __hip_atomic_fetch_add(F.ctl + CW_GCOUNT + tid, HIST[tid], RLX_AGENT); F.BB[(int)blockIdx.x * 32 + tid] = (int)base; }
}

__device__ __forceinline__ int moe_tables(Frame& F) {
    LAS int* TE = (LAS int*)(F.lds + TE_OFF);
    LAS int* MC = (LAS int*)(F.lds + MOE_CNT_OFF);
    __syncthreads();
    if (F.tid == 0) { int ps = 0;
        for (int e = 0; e < NE; ++e) { const int c = (int)__hip_atomic_load(F.ctl + CW_GCOUNT + e, RLX_AGENT); MC[e] = c; MC[32 + e] = ps; const int nt = (c + 255) >> 8; for (int t = 0; t < nt; ++t) TE[(ps >> 8) + t] = e; ps += nt << 8; }
        MC[64] = ps >> 8; }
    __syncthreads();
    return MC[64];
}
__device__ __forceinline__ void p9_slots(Frame& F) {
    (void)moe_tables(F);
    const LAS int* MC = (const LAS int*)(F.lds + MOE_CNT_OFF);
    const int gt = (int)blockIdx.x * 512 + F.tid, NT_ = F.G * 512;
    for (int a = gt; a < T * TOPK; a += NT_) { const int tok = a >> 2, e = F.TOPE[a], blk = (tok >> 4) % F.G;
        const int slot = MC[32 + e] + F.BB[blk * 32 + e] + F.TOPR[a];
        F.SLOTTOK[slot] = tok; F.SLOTGATE[slot] = F.TOPG[a]; F.TOKSLOT[a] = slot; }
    for (int i = gt; i < MAX_SLOTS; i += NT_) F.SLOTID[i] = i;
    if ((int)blockIdx.x < NE) { const int e = (int)blockIdx.x, c = MC[e], ps = MC[32 + e], pe = ps + (((c + 255) >> 8) << 8);
        for (int s = ps + c + F.tid; s < pe; s += 512) { F.SLOTTOK[s] = 0; F.SLOTGATE[s] = 0.f; } }
}

struct SchedMoe {
    static constexpr bool TBL = true;
    const char* A; const char* W; const int* slot_tok; const LAS int* TE; int nM, nN, G, c; size_t wbytes  , tilebytes  , arowbytes;
    LAS unsigned char* tb;
    const float* f0; int f0_e, f0_n;
    const float* f1;
    __device__ __forceinline__ bool next(int i, pg8::Unit& u) const { const int L = i * G + c; if (L >= nM * nN) return false; pg8::static_map(L, nM, nN, u.pm, u.pn); u.e = TE[u.pm]; return true; }
    __device__ __forceinline__ const char* a_base(const pg8::Unit&) const { return A; }
    __device__ __forceinline__ const char* b_base(const pg8::Unit& u) const { return W + (size_t)u.e * wbytes + (size_t)u.pn * tilebytes; }
    __device__ __forceinline__ const int* row_table(const pg8::Unit& u) const { return slot_tok + u.pm * 256; }
    __device__ __forceinline__ const int* tab0(const pg8::Unit& u) const { return slot_tok + u.pm * 256; }
    __device__ __forceinline__ const float* tab1(const pg8::Unit& u) const { return f0 + (size_t)u.e * f0_e + u.pn * f0_n; }
    __device__ __forceinline__ const float* tab2(const pg8::Unit& u) const { return f1 ? f1 + u.pm * 256 : nullptr; }
};
struct Epi10 {
    static constexpr bool PERM = true;
    const float* b1; bf16* ACT;
    __device__ __forceinline__ void operator()(const f32x4 (&acc)[2][2][4][2], const pg8::Unit& u, int wr, int wc, int fr, int fq, const LAS unsigned char* tbuf) const {
        const int row0 = u.pm * 256 + wr * 64 + fr, j0 = u.pn * 128 + wc * 32 + 8 * fq;
        const LAS float* bp = (const LAS float*)(tbuf + 3072) + 2 * (wc * 32 + 8 * fq);
        const f32x4 q0 = *(const LAS f32x4*)bp, q1 = *(const LAS f32x4*)(bp + 4), q2 = *(const LAS f32x4*)(bp + 8), q3 = *(const LAS f32x4*)(bp + 12);
        const float bg[8] = {q0.x, q0.z, q1.x, q1.z, q2.x, q2.z, q3.x, q3.z}, bu[8] = {q0.y, q0.w, q1.y, q1.w, q2.y, q2.w, q3.y, q3.w};
#pragma unroll
        for (int ai = 0; ai < 2; ++ai)
#pragma unroll
            for (int m = 0; m < 4; ++m) { float o[8];
#pragma unroll
                for (int n = 0; n < 2; ++n)
#pragma unroll
                    for (int t = 0; t < 4; ++t) { const float hg = acc[ai][0][m][n][t] * (1.f / WSCALE) + bg[4 * n + t], hu = acc[ai][1][m][n][t] * (1.f / WSCALE) + bu[4 * n + t];
                        const float gp = fminf(hg, 7.f), up = fminf(fmaxf(hu, -7.f), 7.f);
                        o[4 * n + t] = gp * __builtin_amdgcn_rcpf(1.f + __builtin_amdgcn_exp2f(-1.702f * 1.44269504f * gp)) * (up + 1.f); }
                v2u wv; wv.x = pk4_fp8(o[0] * ASCALE, o[1] * ASCALE, o[2] * ASCALE, o[3] * ASCALE); wv.y = pk4_fp8(o[4] * ASCALE, o[5] * ASCALE, o[6] * ASCALE, o[7] * ASCALE);
                *(v2u*)((unsigned char*)ACT + (size_t)(row0 + ai * 128 + m * 16) * DFF + j0) = wv; }
    }
};
struct Epi11 {
    static constexpr bool PERM = true;
    bf16* YS;
    __device__ __forceinline__ void operator()(const f32x4 (&acc)[2][2][4][2], const pg8::Unit& u, int wr, int wc, int fr, int fq, const LAS unsigned char* tbuf) const {
        const int row0 = u.pm * 256 + wr * 64 + fr, col0 = u.pn * 256 + wc * 32 + 8 * fq;
        const LAS float* bl = (const LAS float*)(tbuf + 3072) + wc * 32 + 8 * fq; const LAS float* gl = (const LAS float*)(tbuf + 6144) + wr * 64 + fr;
        f32x4 bv[2][2];
#pragma unroll
        for (int bj = 0; bj < 2; ++bj)
#pragma unroll
            for (int n = 0; n < 2; ++n) bv[bj][n] = *(const LAS f32x4*)(bl + bj * 128 + 4 * n);
#pragma unroll
        for (int ai = 0; ai < 2; ++ai)
#pragma unroll
            for (int m = 0; m < 4; ++m) { const int row = row0 + ai * 128 + m * 16; const float gt = gl[ai * 128 + m * 16];
#pragma unroll
                for (int bj = 0; bj < 2; ++bj) { const float gs = gt * YSCALE; f32x4 v0 = (acc[ai][bj][m][0] * (1.f / (WSCALE * ASCALE)) + bv[bj][0]) * gs, v1 = (acc[ai][bj][m][1] * (1.f / (WSCALE * ASCALE)) + bv[bj][1]) * gs;
#pragma unroll
                    for (int t = 0; t < 4; ++t) { v0[t] = fminf(fmaxf(v0[t], -440.f), 440.f); v1[t] = fminf(fmaxf(v1[t], -440.f), 440.f); }
                    v2u wv; wv.x = pk4_fp8(v0[0], v0[1], v0[2], v0[3]); wv.y = pk4_fp8(v1[0], v1[1], v1[2], v1[3]);
                    *(v2u*)((unsigned char*)YS + (size_t)row * D + col0 + bj * 128) = wv; } }
    }
};

__device__ __forceinline__ void p12_combine(Frame& F) {
    const int gw = (int)blockIdx.x * 8 + F.wave, NGW = F.G * 8, lane = F.lane;
    for (int rb16 = gw; rb16 < T / 16; rb16 += NGW) {
        const int r0 = rb16 * 16;
        const float* g2p = F.MOD + (size_t)(r0 >> 12) * 6144 + 5120;
        f32x4 g2v[4], fw[4];
#pragma unroll
        for (int j = 0; j < 4; ++j) { const int col = 4 * lane + 256 * j; g2v[j] = *(const f32x4*)(g2p + col) * (1.f / YSCALE); fw[j] = *(const f32x4*)(F.final_norm_w + col); }
        for (int rp = 0; rp < 8; ++rp) {
            int sl[2][4];
#pragma unroll
            for (int k2 = 0; k2 < 2; ++k2)
#pragma unroll
                for (int k = 0; k < 4; ++k) sl[k2][k] = F.TOKSLOT[(r0 + rp * 2 + k2) * 4 + k];
            unsigned yv[2][4][4]; v2u xq[2][4];
#pragma unroll
            for (int k2 = 0; k2 < 2; ++k2)
#pragma unroll
                for (int j = 0; j < 4; ++j) { const int col = 4 * lane + 256 * j; xq[k2][j] = *(const v2u*)(F.X1 + (size_t)(r0 + rp * 2 + k2) * D + col);
#pragma unroll
                    for (int k = 0; k < 4; ++k) yv[k2][j][k] = *(const unsigned*)((const unsigned char*)F.YS + (size_t)sl[k2][k] * D + col); }
#pragma unroll
            for (int k2 = 0; k2 < 2; ++k2) { const int r = r0 + rp * 2 + k2;
                f32x4 v[4]; float ss = 0.f;
#pragma unroll
                for (int j = 0; j < 4; ++j) { f32x4 m = (f32x4){0.f, 0.f, 0.f, 0.f};
#pragma unroll
                    for (int k = 0; k < 4; ++k) { const int y = (int)yv[k2][j][k]; const f32x2 lo = __builtin_amdgcn_cvt_pk_f32_fp8(y, false), hi = __builtin_amdgcn_cvt_pk_f32_fp8(y, true); m.x += lo.x; m.y += lo.y; m.z += hi.x; m.w += hi.y; }
                    v[j] = (f32x4){bflo(xq[k2][j].x), bfhi(xq[k2][j].x), bflo(xq[k2][j].y), bfhi(xq[k2][j].y)} + g2v[j] * m;
                    ss += (v[j].x * v[j].x + v[j].y * v[j].y) + (v[j].z * v[j].z + v[j].w * v[j].w); }
                const float rs = __builtin_amdgcn_rsqf(wave_sum(ss) * (1.f / D) + RMS_EPS);
#pragma unroll
                for (int j = 0; j < 4; ++j) { const int col = 4 * lane + 256 * j; *(f32x4*)(F.out + (size_t)r * D + col) = (v[j] * rs) * fw[j]; } }
        }
    }
}

constexpr int NPHASE = 13;
struct Args { const float* in[25]; float* out; unsigned char* ws; int ph_lo, ph_hi; };
__global__ void __launch_bounds__(512, 2) mk_fwd(Args args) {
    extern __shared__ __attribute__((aligned(16))) unsigned char lds[];
    Frame F;
    F.lds = (LAS unsigned char*)lds;
    F.tid = threadIdx.x; F.lane = F.tid & 63; F.wave = __builtin_amdgcn_readfirstlane(F.tid >> 6); F.G = gridDim.x;
    unsigned char* ws = args.ws;
    F.ctl = (unsigned*)(ws + WS_CTL);
    F.x = args.in[0]; F.c = args.in[1]; F.ctx = args.in[2]; F.c_ctx = args.in[3]; F.w_mod = args.in[4]; F.b_mod = args.in[5]; F.norm1_w = args.in[6]; F.norm2_w = args.in[7];
    F.w_in = args.in[8]; F.conv_w = args.in[9]; F.conv_b = args.in[10]; F.dt_bias = args.in[11]; F.a_log = args.in[12]; F.d_skip = args.in[13]; F.ssd_norm_w = args.in[14];
    F.pool_w = args.in[15]; F.pool_scale = args.in[16]; F.w_out = args.in[17]; F.router_w = args.in[18]; F.router_b = args.in[19]; F.w1 = args.in[20]; F.b1 = args.in[21];
    F.w2 = args.in[22]; F.b2 = args.in[23]; F.final_norm_w = args.in[24]; F.out = args.out;
    F.MOD = (float*)(ws + WS_MOD); F.DTRAW = (float*)(ws + WS_DTRAW); F.DT = (float*)(ws + WS_DT); F.ROWSC = (float*)(ws + WS_ROWSC); F.CHS = (float*)(ws + WS_CHS); F.X1 = (bf16*)(ws + WS_X1);
    F.TOPG = (float*)(ws + WS_TOPG); F.SLOTGATE = (float*)(ws + WS_SLOTGATE); F.TOPE = (int*)(ws + WS_TOPE); F.TOPR = (int*)(ws + WS_TOPR); F.TOKSLOT = (int*)(ws + WS_TOKSLOT);
    F.SLOTTOK = (int*)(ws + WS_SLOTTOK); F.SLOTID = (int*)(ws + WS_SLOTID); F.ROWID = (int*)(ws + WS_ROWID); F.BB = (int*)(ws + WS_BB);
    F.WINT = (bf16*)(ws + WS_WINT); F.WOUTT = (bf16*)(ws + WS_WOUTT); F.W1T = (bf16*)(ws + WS_W1T); F.W2T = (bf16*)(ws + WS_W2T); F.A1 = (bf16*)(ws + WS_A1); F.XBCPRE = (bf16*)(ws + WS_XBCPRE);
    F.Z = (bf16*)(ws + WS_Z); F.V = (bf16*)(ws + WS_V); F.XBC = (bf16*)(ws + WS_XBC); F.CC = (bf16*)(ws + WS_CC); F.ST = (bf16*)(ws + WS_ST); F.Y = (bf16*)(ws + WS_Y); F.YB = (bf16*)(ws + WS_YB);
    F.A2 = (bf16*)(ws + WS_A2); F.H2 = (bf16*)(ws + WS_H2); F.ACT = (bf16*)(ws + WS_ACT); F.YS = (bf16*)(ws + WS_YS);
    volatile LAS unsigned* MISC = (volatile LAS unsigned*)(F.lds + MISC_OFF);
    for (int u = F.tid; u < 64; u += 512) MISC[u] = 0u;
    __syncthreads();
    const int lo = args.ph_lo, hi = args.ph_hi;
    XcdBarrier bar; bar.bar = F.ctl + CW_BAR; bar.x = 0; bar.st = nullptr;
    if (hi - lo > 1) bar = xcd_barrier_post(F.ctl + CW_BAR, MISC + 8);
#define IN(k) (lo <= (k) && (k) < hi)
#define SEAM(k) do { if (IN(k) && IN((k) + 1)) xcd_barrier(bar); } while (0)
#define BODY0 p0_prologue(F)
#define BODY1 p1_norm1(F)
#define BODY2 do { Sched1 S{(const char*)F.A1, (const char*)F.WINT, F.G, (int)blockIdx.x}; Epi1 E{F.XBCPRE, F.Z, F.V, F.DTRAW}; pg8::gemm_phase<Epi1, Sched1, false>(F.lds, D, S, E); } while (0)
#define BODY4 p4_ssd_local(F)
#define BODY5 p5_ssd_scan(F)
#define BODY6 p6_gate_pool(F)
#define BODY7 do { Sched7 S{(const char*)F.A2, (const char*)F.WOUTT, F.ROWID, F.G, (int)blockIdx.x}; Epi7 E{F.x, F.MOD, F.X1}; pg8::gemm_phase<Epi7, Sched7, true, true>(F.lds, 2048, S, E); } while (0)
#define BODY8 p8_router(F)
#define BODY9 p9_slots(F)
#define BODY10 do { const int ntl = moe_tables(F); \
        SchedMoe S{(const char*)F.H2, (const char*)F.W1T, F.SLOTTOK, (const LAS int*)(F.lds + TE_OFF), ntl, 8, F.G, (int)blockIdx.x, (size_t)2048 * D, (size_t)256 * D, (size_t)D, F.lds + TBL_OFF, F.b1, 2048, 256, nullptr}; \
        Epi10 E{F.b1, F.ACT}; pg8::gemm_phase<Epi10, SchedMoe, true, true>(F.lds, D, S, E); } while (0)
#define BODY11 do { const int ntl = moe_tables(F); \
        SchedMoe S{(const char*)F.ACT, (const char*)F.W2T, F.SLOTID, (const LAS int*)(F.lds + TE_OFF), ntl, 4, F.G, (int)blockIdx.x, (size_t)D * D, (size_t)256 * D, (size_t)D, F.lds + TBL_OFF, F.b2, D, 256, F.SLOTGATE}; \
        Epi11 E{F.YS}; pg8::gemm_phase<Epi11, SchedMoe, true, true>(F.lds, D, S, E); } while (0)
#define BODY12 p12_combine(F)
#define RUN(k) do { if (IN(k)) { BODY##k; if (PROBE_PH == (k)) { xcd_barrier(bar); BODY##k; } } SEAM(k); } while (0)
    RUN(0); RUN(1); RUN(2); RUN(4); RUN(5); RUN(6); RUN(7); RUN(8); RUN(9); RUN(10); RUN(11); RUN(12);
#undef IN
#undef SEAM
}

extern "C" void kernel_launch(void* const* d_in, const int* in_sizes, int n_in, void* d_out, int out_size, void* d_ws, size_t ws_size, hipStream_t stream) {
    static int grid = 0;
    if (grid == 0) {
        if (n_in != 25 || out_size != T * D || ws_size < WS_END) { fprintf(stderr, "kernel_launch: unexpected shapes (n_in %d, out %d, ws %zu)\n", n_in, out_size, ws_size); grid = -1; return; }
        int dev = 0, cus = 0, per_cu = 0;
        if (hipGetDevice(&dev) != hipSuccess || hipDeviceGetAttribute(&cus, hipDeviceAttributeMultiprocessorCount, dev) != hipSuccess) { grid = -1; return; }
        if (hipFuncSetAttribute((const void*)mk_fwd, hipFuncAttributeMaxDynamicSharedMemorySize, LDS_BYTES) != hipSuccess) { fprintf(stderr, "kernel_launch: hipFuncSetAttribute failed\n"); grid = -1; return; }
        if (hipOccupancyMaxActiveBlocksPerMultiprocessor(&per_cu, (const void*)mk_fwd, 512, LDS_BYTES) != hipSuccess || per_cu < 1) { fprintf(stderr, "kernel_launch: occupancy query says %d\n", per_cu); }
        (void)hipGetLastError();
        grid = cus;
    }
    if (grid < 0) return;
    (void)hipMemsetAsync((char*)d_ws + WS_CTL, 0, CTL_ZERO_BYTES, stream);
    Args a{};
    for (int i = 0; i < 25; ++i) a.in[i] = (const float*)d_in[i];
    a.out = (float*)d_out; a.ws = (unsigned char*)d_ws;
#if MK_SPLIT
    for (int p = 0; p < NPHASE; ++p) { a.ph_lo = p; a.ph_hi = p + 1; hipLaunchKernelGGL(mk_fwd, dim3(grid), dim3(512), LDS_BYTES, stream, a); }
#else
    a.ph_lo = 0; a.ph_hi = NPHASE; hipLaunchKernelGGL(mk_fwd, dim3(grid), dim3(512), LDS_BYTES, stream, a);
#endif
}
```

```cpp
#include <hip/hip_runtime.h>
#include <cstdio>
#include <cstdint>

#ifndef MK_SPLIT
#define MK_SPLIT 0
#endif

#ifndef PROBE_PH
#define PROBE_PH -1
#endif

#define GAS __attribute__((address_space(1)))
#define LAS __attribute__((address_space(3)))
typedef unsigned short bf16;
typedef unsigned v4u __attribute__((ext_vector_type(4)));
typedef unsigned v2u __attribute__((ext_vector_type(2)));
typedef float f32x4 __attribute__((ext_vector_type(4)));
typedef float f32x2 __attribute__((ext_vector_type(2)));
typedef short bf16x8 __attribute__((ext_vector_type(8)));
typedef short s16x4 __attribute__((ext_vector_type(4)));
#define RLX_AGENT __ATOMIC_RELAXED, __HIP_MEMORY_SCOPE_AGENT
#define LDS_WAIT() asm volatile("s_waitcnt lgkmcnt(0)" ::: "memory")
#define VM_WAIT() asm volatile("s_waitcnt vmcnt(0)" ::: "memory")

__device__ __forceinline__ unsigned f2bf(float f) { unsigned u = __builtin_bit_cast(unsigned, f); return (u + 0x7fffu + ((u >> 16) & 1u)) >> 16; }
typedef __bf16 nbf16x2 __attribute__((ext_vector_type(2)));
__device__ __forceinline__ unsigned pk2(float lo, float hi) { const f32x2 v = {lo, hi}; return __builtin_bit_cast(unsigned, __builtin_convertvector(v, nbf16x2)); }
constexpr float A2SCALE = 4.f;
constexpr float YOSCALE = 16.f;
constexpr float STSCALE = 32.f;
constexpr float YSCALE = 8.f;
constexpr float ASCALE = 4.f;
constexpr float WSCALE = 32.f;
__device__ __forceinline__ unsigned pk4_fp8(float a, float b, float c, float d) { int r = __builtin_amdgcn_cvt_pk_fp8_f32(a, b, 0, false); r = __builtin_amdgcn_cvt_pk_fp8_f32(c, d, r, true); return (unsigned)r; }
__device__ __forceinline__ float bflo(unsigned w) { return __builtin_bit_cast(float, w << 16); }
__device__ __forceinline__ float bfhi(unsigned w) { return __builtin_bit_cast(float, w & 0xffff0000u); }
__device__ __forceinline__ float silu_f(float v) { return v * __builtin_amdgcn_rcpf(1.f + __builtin_amdgcn_exp2f(-1.44269504f * v)); }
__device__ __forceinline__ float wave_sum(float v) {
#pragma unroll
    for (int o = 1; o < 64; o <<= 1) v += __shfl_xor(v, o);
    return v;
}

constexpr int D = 1024, NB = 8, SEQ = 4096, CTXL = 256, T = NB * SEQ, TC = NB * CTXL, RTOT = T + TC;
constexpr int CONV_CH = 2560, SSD_W = 1536, NH = 24, HDIM = 64, NGRP = 4, HPG = 6, NST = 128, CHUNK = 128;
constexpr int NCC = (CTXL + SEQ) / CHUNK;
constexpr int IN_COLS = 4656, N1 = 4864;
constexpr int NE = 32, TOPK = 4, DFF = 1024;
constexpr int MAX_TILES = (T * TOPK) / 256 + NE;
constexpr int MAX_SLOTS = MAX_TILES * 256;
constexpr float RMS_EPS = 1e-6f;

constexpr size_t MiB = 1u << 20;
constexpr size_t WS_CTL = 0, CTL_ZERO_BYTES = 1 * MiB;
constexpr size_t WS_MOD = 1 * MiB;
constexpr size_t WS_TOPE = 2 * MiB, WS_TOPG = WS_TOPE + 512 * 1024, WS_TOPR = WS_TOPG + 512 * 1024, WS_TOKSLOT = WS_TOPR + 512 * 1024;
constexpr size_t WS_SLOTTOK = 4 * MiB, WS_SLOTGATE = WS_SLOTTOK + 576 * 1024, WS_BB = WS_SLOTGATE + 576 * 1024, WS_CHS = WS_BB + 64 * 1024, WS_SLOTID = WS_CHS + 64 * 1024;
constexpr size_t WS_DTRAW = 6 * MiB;
constexpr size_t WS_ROWID = 21 * MiB + 512 * 1024;
constexpr size_t WS_DT = 15 * MiB;
constexpr size_t WS_ROWSC = 22 * MiB;
constexpr size_t WS_WINT = 32 * MiB, WS_WOUTT = 42 * MiB, WS_W1T = 46 * MiB, WS_W2T = 174 * MiB;
constexpr size_t WS_A = 240 * MiB;
constexpr size_t WS_A1 = WS_A, WS_CC = WS_A, WS_XBCPRE = WS_A + 68 * MiB, WS_Z = WS_A + 238 * MiB, WS_V = WS_A + 334 * MiB, WS_XBC = WS_A;
constexpr size_t WS_ST = WS_A + 366 * MiB, WS_Y = WS_A + 570 * MiB, WS_YB = WS_A + 666 * MiB;
constexpr size_t WS_A2 = WS_XBCPRE, WS_X1 = WS_A + 366 * MiB, WS_H2 = WS_A + 494 * MiB, WS_ACT = WS_A, WS_YS = WS_A + 494 * MiB;
constexpr size_t WS_END = WS_A + 766 * MiB;
static_assert(WS_END <= 1024 * MiB, "workspace map");
static_assert((size_t)RTOT * D * 2 <= 68 * MiB && (size_t)RTOT * CONV_CH * 2 <= 170 * MiB && (size_t)MAX_SLOTS * D * 2 <= 272 * MiB, "workspace map sizes");
static_assert((size_t)NB * NCC * NH * 2 * 8192 * 2 <= 204 * MiB, "ST size");
constexpr int CW_TMO = 0, CW_GCOUNT = 64  , CW_BAR = 4096;

constexpr int LDS_BYTES = 163840;
constexpr int MISC_OFF = LDS_BYTES - 256;
constexpr int TE_OFF = 131072;
constexpr int MOE_CNT_OFF = TE_OFF + 4096;
constexpr int TBL_OFF = TE_OFF + 8192;

namespace pg8 {
constexpr int BM = 256, BK = 64, HALF = 128, HTB = HALF * BK * 2, STAGE_BYTES = 8 * HTB, NXCD = 8, WGM = 8;
__host__ __device__ __forceinline__ int lds_byte(int r, int c) { const int st = (r >> 4) * 2 + (c >> 5), rr = r & 15, cc = c & 31, ob = rr * 64 + cc * 2; return st * 1024 + (ob ^ (((ob >> 9) & 1) << 5)); }
__host__ __device__ __forceinline__ void stage_rc(int b, int& R, int& C) { const int st = b / 1024, sb = b % 1024, swz = sb ^ (((sb >> 9) & 1) << 5); R = (st >> 1) * 16 + swz / 64; C = (st & 1) * 32 + (swz % 64) / 2; }
__host__ __device__ __forceinline__ int perm32(int rho) { const int n = rho >> 4, i = rho & 15; return 8 * (i >> 2) + 4 * n + (i & 3); }
struct Unit { int pm, pn, e; };
__device__ __forceinline__ unsigned cvt_pk_bf16(float lo, float hi) { unsigned r; asm volatile("v_cvt_pk_bf16_f32 %0, %1, %2" : "=v"(r) : "v"(lo), "v"(hi)); return r; }

__device__ __forceinline__ void static_map(int wgid, int nM, int nN, int& pm, int& pn) {
    const int nwg = nM * nN;
    { const int q = nwg / NXCD, r = nwg % NXCD, xcd = wgid % NXCD, off = wgid / NXCD; wgid = (xcd < r ? xcd * (q + 1) : r * (q + 1) + (xcd - r) * q) + off; }
    const int nig = WGM * nN, gid = wgid / nig, fm = gid * WGM, gsz = (nM - fm) < WGM ? (nM - fm) : WGM;
    pm = fm + ((wgid % nig) % gsz); pn = (wgid % nig) / gsz;
}

typedef int i32x8 __attribute__((ext_vector_type(8)));
typedef int v4i_t __attribute__((ext_vector_type(4)));
template <class Epi, class Sched, bool GATHER, bool FP8 = false, bool ALIGN_EPI = true>
__device__ __forceinline__ void gemm_phase(LAS unsigned char* lds, const int K, const Sched& S, const Epi& E) {
    int tid = threadIdx.x; asm volatile("" : "+v"(tid));
    const int wid = __builtin_amdgcn_readfirstlane(tid >> 6), lane = tid & 63, wr = wid >> 2, wc = wid & 3, fr = lane & 15, fq = lane >> 4;
    constexpr int ES = FP8 ? 1 : 2, KOFF = FP8 ? 16 : 1024;
    const int nt = K / (FP8 ? 2 * BK : BK);
    unsigned voffB[2]; int RA[2], CA[2];
#pragma unroll
    for (int i = 0; i < 2; ++i) { int R, C; stage_rc(tid * 16 + i * 8192, R, C); const int Rb = Epi::PERM ? ((R & ~31) + perm32(R & 31)) : R;
        RA[i] = R; CA[i] = C; voffB[i] = (unsigned)(Rb * K * ES + C * 2); }
    const size_t kstep = (size_t)(BK * 2);
    const size_t hstep = (size_t)HALF * K * ES;
    const unsigned ldsw = (unsigned)wid * 1024u;
    const int aoff = lds_byte(wr * 64 + fr, fq * (FP8 ? 16 : 8)), boff = lds_byte(wc * 32 + fr, fq * (FP8 ? 16 : 8));
#define PG8_SA(b, h) (((b) * 2 + (h)) * HTB)
#define PG8_SB(b, h) ((4 + (b) * 2 + (h)) * HTB)
#define PG8_STAGE(bufoff, gbase, voff) do { _Pragma("unroll") for (int _i = 0; _i < 2; ++_i) \
        __builtin_amdgcn_global_load_lds((const unsigned*)((const char*)(gbase) + (voff)[_i]), (LAS unsigned*)(lds + (bufoff) + ldsw + _i * 8192), 16, 0, 0); } while (0)
#define PG8_LDA(dst, b, h) do { _Pragma("unroll") for (int m = 0; m < 4; ++m) _Pragma("unroll") for (int k = 0; k < 2; ++k) dst[m][k] = *(const LAS bf16x8*)(lds + PG8_SA(b, h) + aoff + m * 2048 + k * KOFF); } while (0)
#define PG8_LDB(dst, b, h) do { _Pragma("unroll") for (int n = 0; n < 2; ++n) _Pragma("unroll") for (int k = 0; k < 2; ++k) dst[n][k] = *(const LAS bf16x8*)(lds + PG8_SB(b, h) + boff + n * 2048 + k * KOFF); } while (0)
#define PG8_CAT(lo, hi) __builtin_shufflevector(__builtin_bit_cast(v4i_t, lo), __builtin_bit_cast(v4i_t, hi), 0, 1, 2, 3, 4, 5, 6, 7)
#define PG8_MMA(ai, bj, At, Bt) do { __builtin_amdgcn_s_setprio(1); \
        if constexpr (FP8) { _Pragma("unroll") for (int m = 0; m < 4; ++m) _Pragma("unroll") for (int n = 0; n < 2; ++n) \
            acc[ai][bj][m][n] = __builtin_amdgcn_mfma_scale_f32_16x16x128_f8f6f4(PG8_CAT(Bt[n][0], Bt[n][1]), PG8_CAT(At[m][0], At[m][1]), acc[ai][bj][m][n], 0, 0, 0, 0x7f7f7f7f, 0, 0x7f7f7f7f); } \
        else { _Pragma("unroll") for (int m = 0; m < 4; ++m) _Pragma("unroll") for (int n = 0; n < 2; ++n) _Pragma("unroll") for (int k = 0; k < 2; ++k) \
            acc[ai][bj][m][n] = __builtin_amdgcn_mfma_f32_16x16x32_bf16(Bt[n][k], At[m][k], acc[ai][bj][m][n], 0, 0, 0); } \
        __builtin_amdgcn_s_setprio(0); } while (0)
#define PG8_WAIT_V(n) asm volatile("s_waitcnt vmcnt(" #n ")" ::: "memory")
#define PG8_WAIT_L(n) asm volatile("s_waitcnt lgkmcnt(" #n ")" ::: "memory")
#define PG8_BAR __builtin_amdgcn_s_barrier()
#define PG8_SCHED __builtin_amdgcn_sched_barrier(0)
#define PG8_AOFFS(U, dst) do { \
        if constexpr (GATHER) { int t_ = tid, R_, C_; asm volatile("" : "+v"(t_)); stage_rc(t_ * 16, R_, C_);     \
            const int* st_ = S.row_table(U) + R_; _Pragma("unroll") for (int _h = 0; _h < 2; ++_h) _Pragma("unroll") for (int _i = 0; _i < 2; ++_i) \
            dst[_h][_i] = (unsigned)st_[_h * HALF + _i * 64] * (unsigned)(K * ES) + (unsigned)(C_ * 2); } \
        else { _Pragma("unroll") for (int _h = 0; _h < 2; ++_h) _Pragma("unroll") for (int _i = 0; _i < 2; ++_i) dst[_h][_i] = (unsigned)((_h * HALF + RA[_i]) * K * ES + CA[_i] * 2); } } while (0)
#define PG8_AOFFS_NEXT(dst) do { if constexpr (false) { int t_ = tid, R_, C_; asm volatile("" : "+v"(t_)); stage_rc(t_ * 16, R_, C_); \
            const LAS int* st_ = (const LAS int*)(S.tb + ((ui + 1) % 3) * 1024) + R_; _Pragma("unroll") for (int _h = 0; _h < 2; ++_h) _Pragma("unroll") for (int _i = 0; _i < 2; ++_i) \
            dst[_h][_i] = (unsigned)st_[_h * HALF + _i * 64] * (unsigned)(K * ES) + (unsigned)(C_ * 2); } else { PG8_AOFFS(nxt, dst); } } while (0)
    Unit cur, nxt; int ui = 0;
    if (!S.next(0, cur)) return;
    f32x4 acc[2][2][4][2];
#pragma unroll
    for (int a = 0; a < 2; ++a)
#pragma unroll
        for (int b = 0; b < 2; ++b)
#pragma unroll
            for (int m = 0; m < 4; ++m)
#pragma unroll
                for (int n = 0; n < 2; ++n) acc[a][b][m][n] = (f32x4){0.f, 0.f, 0.f, 0.f};
    bf16x8 At[4][2], B0[2][2], B1[2][2];
    unsigned oc[2][2];
    const char* cA = S.a_base(cur); const char* cB = S.b_base(cur);
    PG8_AOFFS(cur, oc);
#define PG8_TABLES(U, buf) do { if constexpr (Sched::TBL) { LAS unsigned char* tb_ = S.tb + (buf) * 1024;   \
        if (wid < 4) { if (S.tab2(U)) __builtin_amdgcn_global_load_lds((const unsigned*)(S.tab2(U) + 64 * wid + lane), (LAS unsigned*)(tb_ + 6144 + wid * 256), 4, 0, 0); } \
        else { __builtin_amdgcn_global_load_lds((const unsigned*)(S.tab1(U) + 64 * (wid - 4) + lane), (LAS unsigned*)(tb_ + 3072 + (wid - 4) * 256), 4, 0, 0); } } } while (0)
    PG8_TABLES(cur, 0);
    PG8_STAGE(PG8_SB(0, 0), cB, voffB); PG8_STAGE(PG8_SB(0, 1), cB + hstep, voffB); PG8_STAGE(PG8_SA(0, 0), cA, oc[0]); PG8_STAGE(PG8_SA(0, 1), cA, oc[1]);
    if (wr == 1) PG8_BAR;
    PG8_WAIT_V(2); PG8_BAR;
    PG8_STAGE(PG8_SB(1, 0), cB + kstep, voffB); PG8_STAGE(PG8_SA(1, 0), cA + kstep, oc[0]); PG8_STAGE(PG8_SB(1, 1), cB + hstep + kstep, voffB);
    PG8_WAIT_V(6); PG8_BAR;
    for (;;) {
        const bool has_next = S.next(ui + 1, nxt);
        const char* nA = has_next ? S.a_base(nxt) : cA; const char* nB = has_next ? S.b_base(nxt) : cB;
        if (has_next) { PG8_TABLES(nxt, (ui + 1) % 3); }
        for (int t = 0; t < nt; t += 2) {
            const bool last = (t == nt - 2);
            const char* a1 = cA + (size_t)(t + 1) * kstep;
            const char* a2 = last ? nA : cA + (size_t)(t + 2) * kstep; const char* b2 = last ? nB : cB + (size_t)(t + 2) * kstep;
            const char* a3 = a2 + kstep; const char* b3 = b2 + kstep;
            PG8_LDB(B0, 0, 0); PG8_LDB(B1, 0, 1); PG8_SCHED; PG8_LDA(At, 0, 0); PG8_STAGE(PG8_SA(1, 1), a1, oc[1]);
            PG8_WAIT_V(8); PG8_WAIT_L(0); PG8_BAR; PG8_MMA(0, 0, At, B0); PG8_MMA(0, 1, At, B1); PG8_BAR; PG8_SCHED;
            if (last && has_next) { PG8_AOFFS_NEXT(oc); }
            PG8_LDA(At, 0, 1); PG8_STAGE(PG8_SB(0, 0), b2, voffB); PG8_STAGE(PG8_SB(0, 1), b2 + hstep, voffB); PG8_STAGE(PG8_SA(0, 0), a2, oc[0]);
            PG8_WAIT_V(8); PG8_WAIT_L(0); PG8_BAR; PG8_MMA(1, 0, At, B0); PG8_MMA(1, 1, At, B1); PG8_BAR; PG8_SCHED;
            PG8_LDB(B0, 1, 0); PG8_LDB(B1, 1, 1); PG8_SCHED; PG8_LDA(At, 1, 0); PG8_STAGE(PG8_SA(0, 1), a2, oc[1]);
            PG8_WAIT_V(8); PG8_WAIT_L(0); PG8_BAR; PG8_MMA(0, 0, At, B0); PG8_MMA(0, 1, At, B1); PG8_BAR; PG8_SCHED;
            PG8_LDA(At, 1, 1); PG8_STAGE(PG8_SB(1, 0), b3, voffB); PG8_STAGE(PG8_SB(1, 1), b3 + hstep, voffB); PG8_STAGE(PG8_SA(1, 0), a3, oc[0]);
            PG8_WAIT_V(8); PG8_WAIT_L(0); PG8_BAR; PG8_MMA(1, 0, At, B0); PG8_MMA(1, 1, At, B1); PG8_BAR; PG8_SCHED;
        }
        if constexpr (ALIGN_EPI) { if (wr == 0) PG8_BAR; }
        if constexpr (Sched::TBL) E(acc, cur, wr, wc, fr, fq, S.tb + (ui % 3) * 1024); else E(acc, cur, wr, wc, fr, fq);
        if (!has_next) break;
#pragma unroll
        for (int a = 0; a < 2; ++a)
#pragma unroll
            for (int b = 0; b < 2; ++b)
#pragma unroll
                for (int m = 0; m < 4; ++m)
#pragma unroll
                    for (int n = 0; n < 2; ++n) acc[a][b][m][n] = (f32x4){0.f, 0.f, 0.f, 0.f};
        cur = nxt; cA = nA; cB = nB; ++ui;
        if constexpr (ALIGN_EPI) { if (wr == 1) PG8_BAR; }
    }
    PG8_WAIT_V(0);
    if constexpr (!ALIGN_EPI) { if (wr == 0) PG8_BAR; }
    PG8_BAR;
#undef PG8_SA
#undef PG8_SB
#undef PG8_STAGE
#undef PG8_LDA
#undef PG8_LDB
#undef PG8_MMA
#undef PG8_WAIT_V
#undef PG8_WAIT_L
#undef PG8_BAR
#undef PG8_SCHED
#undef PG8_AOFFS
#undef PG8_AOFFS_NEXT
#undef PG8_TABLES
#undef PG8_CAT
}
}

#define XB_TMO      128
#define XB_XCNT(j)  (256  + 64 * (j))
#define XB_XSUB(j)  (1280 + 64 * (j))
#define XB_XGEN(j)  (2304 + 64 * (j))
#define XB_TOP      3328
#define XB_TOPGEN   3392
#define XCD_BAR_WORDS 3456
#define XB_SPIN_CAP (1u << 18)
__device__ __forceinline__ unsigned xb_ld(unsigned* p)              { return __hip_atomic_load(p, __ATOMIC_RELAXED, __HIP_MEMORY_SCOPE_AGENT); }
__device__ __forceinline__ unsigned xb_add(unsigned* p, unsigned v) { return __hip_atomic_fetch_add(p, v, __ATOMIC_RELAXED, __HIP_MEMORY_SCOPE_AGENT); }
__device__ __forceinline__ unsigned xb_xcc_id() { return (unsigned)__builtin_amdgcn_s_getreg((3 << 11) | 20) & 0xFu; }
#define XB_SPIN(cond, bar) do { unsigned _sp = 0; while (cond) { __builtin_amdgcn_s_sleep(1); \
    if ((++_sp & 255u) == 0u) { if (xb_ld(&(bar)[XB_TMO])) break; if (_sp > XB_SPIN_CAP) { atomicAdd(&(bar)[XB_TMO], 1u); break; } } } } while (0)
struct XcdBarrier { unsigned* bar; unsigned x; volatile LAS unsigned* st; };
__device__ __forceinline__ XcdBarrier xcd_barrier_post(unsigned* bar, volatile LAS unsigned* st) {
    XcdBarrier b; b.bar = bar; b.x = xb_xcc_id(); b.st = st;
    if (threadIdx.x == 0) (void)xb_add(&bar[XB_XCNT(b.x)], 1u);
    return b;
}
__device__ __forceinline__ void xcd_barrier_complete(unsigned* bar, unsigned x, unsigned& nloc, unsigned& nx) {
    const unsigned G = gridDim.x * gridDim.y * gridDim.z;
    unsigned sum, cnt, mine, sp = 0u;
    for (;;) {
        sum = 0u; cnt = 0u; mine = 0u;
#pragma unroll
        for (unsigned j = 0; j < 16; ++j) { const unsigned c = xb_ld(&bar[XB_XCNT(j)]); sum += c; cnt += (c > 0u) ? 1u : 0u; mine = (j == x) ? c : mine; }
        if (sum == G) break;
        __builtin_amdgcn_s_sleep(1);
        if ((++sp & 255u) == 0u) { if (xb_ld(&bar[XB_TMO])) break; if (sp > XB_SPIN_CAP) { atomicAdd(&bar[XB_TMO], 1u); break; } }
    }
    nloc = mine > 0u ? mine : 1u; nx = cnt > 0u ? cnt : 1u;
}
__device__ __forceinline__ void xcd_barrier(const XcdBarrier& b) {
    asm volatile("s_waitcnt vmcnt(0)" ::: "memory");
    __syncthreads();
    if (threadIdx.x == 0) {
        unsigned* bar = b.bar;
        __builtin_amdgcn_s_waitcnt(0);
        unsigned nloc = b.st[0], nx = b.st[1];
        if (nloc == 0u) { xcd_barrier_complete(bar, b.x, nloc, nx); b.st[0] = nloc; b.st[1] = nx; }
        const unsigned old = xb_add(&bar[XB_XSUB(b.x)], 1u);
        const unsigned gen = old / nloc;
        if (old + 1u == (gen + 1u) * nloc) {
            __builtin_amdgcn_fence(__ATOMIC_RELEASE, "agent");
            asm volatile("s_waitcnt vmcnt(0)" ::: "memory");
            const unsigned og = xb_add(&bar[XB_TOP], 1u);
            const unsigned tg = og / nx;
            if (og + 1u == (tg + 1u) * nx) xb_add(&bar[XB_TOPGEN], 1u);
            else XB_SPIN(xb_ld(&bar[XB_TOPGEN]) == tg, bar);
            __builtin_amdgcn_fence(__ATOMIC_ACQUIRE, "agent");
            xb_add(&bar[XB_XGEN(b.x)], 1u);
            asm volatile("s_waitcnt vmcnt(0)" ::: "memory");
        } else {
            XB_SPIN(xb_ld(&bar[XB_XGEN(b.x)]) == gen, bar);
            __builtin_amdgcn_fence(__ATOMIC_ACQUIRE, "agent");
            asm volatile("s_waitcnt vmcnt(0)" ::: "memory");
        }
    }
    __syncthreads();
}

struct Frame {
    LAS unsigned char* lds;
    unsigned* ctl;
    int tid, lane, wave, G;
    const float *x, *c, *ctx, *c_ctx, *w_mod, *b_mod, *norm1_w, *norm2_w, *w_in, *conv_w, *conv_b, *dt_bias, *a_log, *d_skip, *ssd_norm_w, *pool_w, *pool_scale, *w_out, *router_w, *router_b, *w1, *b1, *w2, *b2, *final_norm_w;
    float* out;
    float *MOD, *DTRAW, *DT, *ROWSC, *CHS, *TOPG, *SLOTGATE;
    bf16* X1;
    int *TOPE, *TOPR, *TOKSLOT, *SLOTTOK, *SLOTID, *ROWID, *BB;
    bf16 *WINT, *WOUTT, *W1T, *W2T, *A1, *XBCPRE, *Z, *V, *XBC, *CC, *ST, *Y, *YB, *A2, *H2, *ACT, *YS;
};

template <class RowMap>
__device__ __forceinline__ void p0_emit(bf16* WT, int Kd, RowMap rm, int k0, int n0, int nvalid, LAS float* scr, int lane) {
    const int c = lane & 7;
#pragma unroll
    for (int j = 0; j < 4; ++j) { const int n = (lane >> 3) + 8 * j; const LAS float* s = scr + (8 * c) * 33 + n;
        v4u o; o.x = pk2(s[0 * 33], s[1 * 33]); o.y = pk2(s[2 * 33], s[3 * 33]); o.z = pk2(s[4 * 33], s[5 * 33]); o.w = pk2(s[6 * 33], s[7 * 33]);
        if (n0 + n < nvalid) *(v4u*)(WT + (size_t)rm(n0 + n) * Kd + k0 + 8 * c) = o; }
    LDS_WAIT(); asm volatile("" ::: "memory");
}
template <class RowMap>
__device__ __forceinline__ void p0_transpose_item(const float* W, int N, int nvalid, bf16* WT, int Kd, RowMap rm, LAS float* scr, int kb, int nb, int lane) {
    const int k0 = 64 * kb, n0 = 32 * nb, nn = n0 + (lane & 31); const bool ok = nn < nvalid;
    float tv[32];
#pragma unroll
    for (int i = 0; i < 32; ++i) { const int kk = 2 * i + (lane >> 5); tv[i] = ok ? W[(size_t)(k0 + kk) * N + nn] : 0.f; }
#pragma unroll
    for (int i = 0; i < 32; ++i) { const int kk = 2 * i + (lane >> 5); scr[kk * 33 + (lane & 31)] = tv[i]; }
    LDS_WAIT(); asm volatile("" ::: "memory");
    p0_emit(WT, Kd, rm, k0, n0, nvalid, scr, lane);
}
struct RmId { __device__ __forceinline__ int operator()(int n) const { return n; } };
struct RmOff { int off; __device__ __forceinline__ int operator()(int n) const { return n + off; } };
struct RmWin { __device__ __forceinline__ int operator()(int n) const { return n < 2560 ? n : (n < 2608 ? 4608 + (n - 2560) : 2560 + (n - 2608)); } };
struct RmW1 { __device__ __forceinline__ int operator()(int n) const { const int j = n >> 1; return 256 * (j >> 7) + 128 * (n & 1) + (j & 127); } };

constexpr int P0_I_WIN = 16 * 130, P0_I_WOUT = 32 * 32, P0_I_W1 = 32 * 16 * 64, P0_I_W2 = 32 * 16 * 32, P0_NI = P0_I_WIN + P0_I_WOUT + P0_I_W1 + P0_I_W2;
constexpr int P0_NMOVE = 16384;
template <class Deal>
__device__ __forceinline__ void p0_convert(Frame& F, const Deal& deal, int nrounds, int item_lo, int item_hi) {
    LAS float* scr = (LAS float*)(F.lds + F.wave * 16384);
    const int lane = F.lane;
    constexpr int I_WIN = P0_I_WIN, I_WOUT = P0_I_WOUT, I_W1 = P0_I_W1;
    struct It { const float* src; bf16* dst; int N, nvalid, Kd, kind, k0, n0; };
#define P0_DECODE(it, I) do { int r_ = (it); \
        if (r_ < I_WIN) { I.src = F.w_in; I.dst = F.WINT; I.N = IN_COLS; I.nvalid = 4144; I.Kd = D; I.kind = 1; I.k0 = 64 * (r_ / 130); I.n0 = 32 * (r_ % 130); } \
        else if ((r_ -= I_WIN) < I_WOUT) { const int hf_ = r_ & 1, q_ = r_ >> 1; I.src = F.w_out; I.dst = F.WOUTT; I.N = D; I.nvalid = D; I.Kd = 2048; I.kind = 3; I.k0 = 64 * (2 * (q_ >> 5) + hf_); I.n0 = 32 * (q_ & 31); } \
        else if ((r_ -= I_WOUT) < I_W1) { const int hf_ = r_ & 1, p_ = r_ >> 1, e_ = p_ >> 9, q_ = p_ & 511; I.src = F.w1 + (size_t)e_ * D * 2048; I.dst = (bf16*)((unsigned char*)F.W1T + (size_t)e_ * 2048 * D); I.N = 2048; I.nvalid = 2048; I.Kd = D; I.kind = 2; I.k0 = 64 * (2 * (q_ >> 6) + hf_); I.n0 = 32 * (q_ & 63); } \
        else { r_ -= I_W1; const int hf_ = r_ & 1, p_ = r_ >> 1, e_ = p_ >> 8, q_ = p_ & 255; I.src = F.w2 + (size_t)e_ * D * D; I.dst = (bf16*)((unsigned char*)F.W2T + (size_t)e_ * D * D); I.N = D; I.nvalid = D; I.Kd = D; I.kind = 3; I.k0 = 64 * (2 * (q_ >> 5) + hf_); I.n0 = 32 * (q_ & 31); } } while (0)
#define P0_LOAD(I, tv) do { int nn_ = I.n0 + (lane & 31); nn_ = nn_ < I.nvalid ? nn_ : I.nvalid - 1; const float* sp_ = I.src + (size_t)(I.k0 + (lane >> 5)) * I.N + nn_; \
        _Pragma("unroll") for (int i_ = 0; i_ < 32; ++i_) { const float* q_ = sp_ + (size_t)(2 * i_) * I.N; asm volatile("global_load_dword %0, %1, off" : "=v"(tv[i_]) : "v"(q_) : "memory"); } } while (0)
#define P0_NEXT(itv) do { itv = -1; for (; kr < nrounds && itv < 0; ++kr) { const int it_ = deal(kr); if (it_ >= item_lo && it_ < item_hi) itv = it_; } } while (0)
#define P0_PROCESS(I, tv) do { \
        _Pragma("unroll") for (int i = 0; i < 32; ++i) { const int kk = 2 * i + (lane >> 5); scr[kk * 33 + (lane & 31)] = tv[i]; } \
        LDS_WAIT(); asm volatile("" ::: "memory"); \
        { const int c = lane & 7; \
          _Pragma("unroll") for (int j = 0; j < 4; ++j) { const int n = (lane >> 3) + 8 * j; const LAS float* sq = scr + (8 * c) * 33 + n; \
            const int ng = I.n0 + n; const int row = (I.kind == 0 || I.kind == 3) ? ng : (I.kind == 1 ? RmWin{}(ng) : RmW1{}(ng)); \
            if (I.kind >= 2) { v2u o; o.x = pk4_fp8(sq[0 * 33] * WSCALE, sq[1 * 33] * WSCALE, sq[2 * 33] * WSCALE, sq[3 * 33] * WSCALE); o.y = pk4_fp8(sq[4 * 33] * WSCALE, sq[5 * 33] * WSCALE, sq[6 * 33] * WSCALE, sq[7 * 33] * WSCALE); \
                *(v2u*)((unsigned char*)I.dst + (size_t)row * I.Kd + I.k0 + 8 * c) = o; } \
            else { v4u o; o.x = pk2(sq[0 * 33], sq[1 * 33]); o.y = pk2(sq[2 * 33], sq[3 * 33]); o.z = pk2(sq[4 * 33], sq[5 * 33]); o.w = pk2(sq[6 * 33], sq[7 * 33]); \
                if (ng < I.nvalid) *(v4u*)(I.dst + (size_t)row * I.Kd + I.k0 + 8 * c) = o; } } \
          LDS_WAIT(); asm volatile("" ::: "memory"); } } while (0)
    It ia{}, ib{}; float ta[32], tb[32]; int ita = -1, itb = -1; int kr = 0;
    P0_NEXT(ita);
    if (ita >= 0) { P0_DECODE(ita, ia); P0_LOAD(ia, ta); }
    while (ita >= 0) {
        P0_NEXT(itb);
        if (itb >= 0) { P0_DECODE(itb, ib); P0_LOAD(ib, tb); asm volatile("s_waitcnt vmcnt(32)" ::: "memory"); } else { asm volatile("s_waitcnt vmcnt(0)" ::: "memory"); }
        __builtin_amdgcn_sched_barrier(0);
        P0_PROCESS(ia, ta);
        if (itb < 0) break;
        P0_NEXT(ita);
        if (ita >= 0) { P0_DECODE(ita, ia); P0_LOAD(ia, ta); asm volatile("s_waitcnt vmcnt(32)" ::: "memory"); } else { asm volatile("s_waitcnt vmcnt(0)" ::: "memory"); }
        __builtin_amdgcn_sched_barrier(0);
        P0_PROCESS(ib, tb);
    }
#undef P0_NEXT
#undef P0_PROCESS
#undef P0_DECODE
#undef P0_LOAD
}
__device__ __forceinline__ void p0_prologue(Frame& F) {
    if ((int)blockIdx.x < 96) {
        LAS float* sc = (LAS float*)F.lds;
        LAS float* part = (LAS float*)(F.lds + 36864);
        for (int idx = F.tid; idx < 9 * 1024; idx += 512) { const int r = idx >> 10, k = idx & 1023; const float v = (r < 8) ? F.c[r * 1024 + k] : F.c_ctx[k]; sc[idx] = silu_f(v); }
        __syncthreads();
        const int n = 64 * (int)blockIdx.x + F.lane, kb = 128 * F.wave;
        float acc[9];
#pragma unroll
        for (int r = 0; r < 9; ++r) acc[r] = 0.f;
#pragma unroll 8
        for (int k = 0; k < 128; ++k) { const float wv = F.w_mod[(size_t)(kb + k) * 6144 + n];
#pragma unroll
            for (int r = 0; r < 9; ++r) acc[r] += sc[r * 1024 + kb + k] * wv; }
#pragma unroll
        for (int r = 0; r < 9; ++r) part[(F.wave * 9 + r) * 64 + F.lane] = acc[r];
        __syncthreads();
        for (int idx = F.tid; idx < 9 * 64; idx += 512) { const int r = idx >> 6, col = idx & 63; float s = 0.f;
#pragma unroll
            for (int w = 0; w < 8; ++w) s += part[(w * 9 + r) * 64 + col];
            F.MOD[r * 6144 + 64 * (int)blockIdx.x + col] = s + F.b_mod[64 * (int)blockIdx.x + col]; }
        __syncthreads();
    }
    LAS float* scr = (LAS float*)(F.lds + F.wave * 16384);
    const int gw = (int)blockIdx.x * 8 + F.wave, NGW = F.G * 8, lane = F.lane;
    constexpr int I_POOL = 16 * 4 * 4, I_PAD = N1 - IN_COLS;
    for (int r = NGW - 1 - gw; r < I_POOL + I_PAD; r += NGW) {
        if (r < I_POOL) {
            const int kb = r >> 4, g = (r >> 2) & 3, ob = r & 3, k = 64 * kb + lane, o0 = 32 * ob;
            float acc[32];
#pragma unroll
            for (int o = 0; o < 32; ++o) acc[o] = 0.f;
            const float* arow = F.w_in + (size_t)k * IN_COLS + 4144 + g * 128;
            for (int i = 0; i < 128; ++i) { const float a = arow[i]; const float* pw = F.pool_w + (size_t)(g * 128 + i) * 128 + o0;
#pragma unroll
                for (int o = 0; o < 32; ++o) acc[o] += a * pw[o]; }
#pragma unroll
            for (int o = 0; o < 32; ++o) scr[lane * 33 + o] = acc[o] * F.pool_scale[g * 128 + o0 + o];
            LDS_WAIT(); asm volatile("" ::: "memory");
            p0_emit(F.WINT, D, RmOff{4096 + g * 128}, 64 * kb, o0, 1 << 30, scr, lane);
        } else { v4u z = {0u, 0u, 0u, 0u}; v4u* p = (v4u*)(F.WINT + (size_t)(IN_COLS + (r - I_POOL)) * D); p[lane] = z; p[lane + 64] = z; }
    }
    for (int i = (int)blockIdx.x * 512 + F.tid; i < T; i += F.G * 512) F.ROWID[i] = i;
    const bool wdeal = (F.G == 256);
    const int blk = (int)blockIdx.x;
    constexpr int R1 = 12, R2 = 20, R3 = 22;
    static_assert(R1 * 2048 + (R2 - R1) * 1280 + (R3 - R2) * 816 >= P0_NI - P0_NMOVE, "weighted dealing covers the items");
    auto deal = [=](int k) -> int { return wdeal ? (k < R1 ? 2 * ((k >> 1) * 2048 + gw) + (k & 1) : (k < R2 ? (blk >= 96 ? 2 * (R1 * 1024 + ((k - R1) >> 1) * 1280 + (gw - 768)) + (k & 1) : -1) : (k < R3 ? ((blk >= 96 && blk < 198) ? 2 * (R1 * 1024 + (R2 - R1) * 640 + ((k - R2) >> 1) * 816 + (gw - 768)) + (k & 1) : -1) : -1))) : 2 * ((k >> 1) * NGW + gw) + (k & 1); };
    p0_convert(F, deal, wdeal ? R3 : 2 * ((P0_NI / 2 + NGW - 1) / NGW), 0, wdeal ? P0_NI - P0_NMOVE : P0_NI);
}

__device__ __forceinline__ void p1_norm1(Frame& F) {
    const int gw = (int)blockIdx.x * 8 + F.wave, NGW = F.G * 8, lane = F.lane;
    const int per = (RTOT + NGW - 1) / NGW;
    const int rbeg = gw * per, rend = (rbeg + per < RTOT) ? rbeg + per : RTOT;
    int mb_cur = -1; f32x4 wsc[4], shv[4];
    for (int r0 = rbeg; r0 < rend; r0 += 4) {
        f32x4 v[4][4];
#pragma unroll
        for (int k = 0; k < 4; ++k) { const int r = (r0 + k < rend) ? r0 + k : rbeg; const float* xr = (r < T) ? F.x + (size_t)r * D : F.ctx + (size_t)(r - T) * D;
#pragma unroll
            for (int j = 0; j < 4; ++j) v[k][j] = *(const f32x4*)(xr + 4 * lane + 256 * j); }
#pragma unroll
        for (int k = 0; k < 4; ++k) { const int r = r0 + k; if (r < rend) {
            const int mb = (r < T) ? (r >> 12) : 8;
            if (mb != mb_cur) { const float* mod = F.MOD + (size_t)mb * 6144; mb_cur = mb;
#pragma unroll
                for (int j = 0; j < 4; ++j) { const int col = 4 * lane + 256 * j; wsc[j] = *(const f32x4*)(F.norm1_w + col) * (*(const f32x4*)(mod + 1024 + col) + 1.f); shv[j] = *(const f32x4*)(mod + col); } }
            float ss = 0.f;
#pragma unroll
            for (int j = 0; j < 4; ++j) ss += (v[k][j].x * v[k][j].x + v[k][j].y * v[k][j].y) + (v[k][j].z * v[k][j].z + v[k][j].w * v[k][j].w);
            const float rs = __builtin_amdgcn_rsqf(wave_sum(ss) * (1.f / D) + RMS_EPS);
#pragma unroll
            for (int j = 0; j < 4; ++j) { const int col = 4 * lane + 256 * j;
                const f32x4 h = (v[k][j] * rs) * wsc[j] + shv[j];
                v2u o; o.x = pk2(h.x, h.y); o.y = pk2(h.z, h.w);
                *(v2u*)(F.A1 + (size_t)r * D + col) = o; } } }
    }
}

struct Sched1 {   static constexpr bool TBL = false;
    const char* A; const char* Bt; int G, c;
    __device__ __forceinline__ bool next(int i, pg8::Unit& u) const {
        const int L = i * G + c; if (L >= 2432 + 88) return false;
        if (L < 2432) pg8::static_map(L, 128, 19, u.pm, u.pn);
        else { const int Lc = L - 2432, j = Lc >> 3; u.pm = 128 + (Lc & 7); u.pn = j < 10 ? j : 18; }
        u.e = 0; return true; }
    __device__ __forceinline__ const char* a_base(const pg8::Unit& u) const { return A + (size_t)u.pm * 256 * D * 2; }
    __device__ __forceinline__ const char* b_base(const pg8::Unit& u) const { return Bt + (size_t)u.pn * 256 * D * 2; }
    __device__ __forceinline__ const int* row_table(const pg8::Unit&) const { return nullptr; }
};
struct Epi1 {
    static constexpr bool PERM = true;
    bf16 *XBCPRE, *Z, *V; float* DTRAW;
    __device__ __forceinline__ void operator()(const f32x4 (&acc)[2][2][4][2], const pg8::Unit& u, int wr, int wc, int fr, int fq) const {
        const int row0 = u.pm * 256 + wr * 64 + fr;
        if (u.pn < 18) {
            bf16* base; int ldc, colt;
            if (u.pn < 10) { base = XBCPRE; ldc = CONV_CH; colt = u.pn * 256; } else if (u.pn < 16) { base = Z; ldc = SSD_W; colt = (u.pn - 10) * 256; } else { base = V; ldc = 512; colt = (u.pn - 16) * 256; }
            const int col0 = colt + wc * 32 + 8 * fq;
#pragma unroll
            for (int ai = 0; ai < 2; ++ai)
#pragma unroll
                for (int m = 0; m < 4; ++m) { bf16* rowp = base + (size_t)(row0 + ai * 128 + m * 16) * ldc + col0;
#pragma unroll
                    for (int bj = 0; bj < 2; ++bj) { const f32x4 v0 = acc[ai][bj][m][0], v1 = acc[ai][bj][m][1];
                        v4u w; w.x = pg8::cvt_pk_bf16(v0[0], v0[1]); w.y = pg8::cvt_pk_bf16(v0[2], v0[3]); w.z = pg8::cvt_pk_bf16(v1[0], v1[1]); w.w = pg8::cvt_pk_bf16(v1[2], v1[3]);
                        *(v4u*)(rowp + bj * 128) = w; } }
        } else if (wc < 2) {
            const int col0 = wc * 32 + 8 * fq;
#pragma unroll
            for (int ai = 0; ai < 2; ++ai)
#pragma unroll
                for (int m = 0; m < 4; ++m) { float* rowp = DTRAW + (size_t)(row0 + ai * 128 + m * 16) * 64 + col0;
                    *(f32x4*)(rowp) = acc[ai][0][m][0]; *(f32x4*)(rowp + 4) = acc[ai][0][m][1]; }
        }
    }
};

__device__ __forceinline__ bf16x8 frag_row(const LAS unsigned char* base, int rs, int row, int k0, int q) { return *(const LAS bf16x8*)(base + row * rs + (k0 + 8 * q) * 2); }
__device__ __forceinline__ bf16x8 frag_tr(const LAS unsigned char* base, int rs, int k0, int c0, int lane) {
    const int g = lane >> 4, qq = (lane & 15) >> 2, p = lane & 3;
    const LAS unsigned char* a = base + (k0 + 8 * g + qq) * rs + c0 * 2 + 8 * p;
    const s16x4 lo = __builtin_amdgcn_ds_read_tr16_b64_v4i16((LAS s16x4*)a);
    const s16x4 hi = __builtin_amdgcn_ds_read_tr16_b64_v4i16((LAS s16x4*)(a + 4 * rs));
    bf16x8 r; r[0] = lo[0]; r[1] = lo[1]; r[2] = lo[2]; r[3] = lo[3]; r[4] = hi[0]; r[5] = hi[1]; r[6] = hi[2]; r[7] = hi[3]; return r;
}
__device__ __forceinline__ f32x4 mfma16(bf16x8 a, bf16x8 b, f32x4 c) { return __builtin_amdgcn_mfma_f32_16x16x32_bf16(a, b, c, 0, 0, 0); }
__device__ __forceinline__ float wave_incl_scan(float v, int lane) {
#pragma unroll
    for (int o = 1; o < 64; o <<= 1) { const float t = __shfl_up(v, o); if (lane >= o) v += t; }
    return v;
}

__device__ __forceinline__ float silu_fast(float v) { return v * __builtin_amdgcn_rcpf(1.f + __builtin_amdgcn_exp2f(-1.44269504f * v)); }
__device__ __forceinline__ float softplus_f(float v) { return v > 20.f ? v : log1pf(__expf(v)); }
__device__ __forceinline__ void p4_scan(Frame& F, LAS float* Te, volatile LAS float* TOT, int d, int h, float raw0, float raw1, int lane, size_t chs_idx, float* rowsc) {
    const int s0 = d ? 127 - 2 * lane : 2 * lane, s1 = d ? s0 - 1 : s0 + 1;
    const float bias = F.dt_bias[d * NH + h];
    const float dt0 = softplus_f(raw0 + bias), dt1 = softplus_f(raw1 + bias);
    const float A2 = __expf(F.a_log[d * NH + h]) * 1.44269504f;
    const float a0 = -A2 * dt0, a1 = -A2 * dt1;
    const float incl = wave_incl_scan(a0 + a1, lane);
    const float c1 = incl, c0 = incl - a1, tot = __shfl(incl, 63);
    Te[d * 128 + s0] = c0; Te[d * 128 + s1] = c1;
    Te[(2 + d) * 128 + s0] = c0 - __builtin_amdgcn_logf(dt0); Te[(2 + d) * 128 + s1] = c1 - __builtin_amdgcn_logf(dt1);
    if (lane == 63) { F.CHS[chs_idx] = tot; *TOT = tot; }
    if (rowsc) { rowsc[s0] = __builtin_amdgcn_exp2f(c0); rowsc[s1] = __builtin_amdgcn_exp2f(c1); }
}
__device__ __forceinline__ v4u conv_piece(const v4u& r0, const v4u& r1, const v4u& r2, const v4u& r3, const v4u& r4, const float (&w)[5][8], const float (&bias)[8]) {
    float o[8];
#pragma unroll
    for (int e = 0; e < 8; ++e) o[e] = bias[e];
    const v4u rr[5] = {r0, r1, r2, r3, r4};
#pragma unroll
    for (int j = 0; j < 5; ++j) { const v4u q = rr[j];
        o[0] += w[j][0] * bflo(q.x); o[1] += w[j][1] * bfhi(q.x); o[2] += w[j][2] * bflo(q.y); o[3] += w[j][3] * bfhi(q.y);
        o[4] += w[j][4] * bflo(q.z); o[5] += w[j][5] * bfhi(q.z); o[6] += w[j][6] * bflo(q.w); o[7] += w[j][7] * bfhi(q.w); }
    v4u ov; ov.x = pk2(silu_fast(o[0]), silu_fast(o[1])); ov.y = pk2(silu_fast(o[2]), silu_fast(o[3])); ov.z = pk2(silu_fast(o[4]), silu_fast(o[5])); ov.w = pk2(silu_fast(o[6]), silu_fast(o[7]));
    return ov;
}
__device__ __forceinline__ void p4_states(Frame& F, const bf16x8 (&braw)[4], const LAS float* Te, const volatile LAS float* TOT2, const LAS unsigned char* Xs, size_t st_base, int w, int lane) {
    constexpr int RSX = 144;
    const int i16 = lane & 15, q4 = lane >> 4;
#pragma unroll
    for (int d = 0; d < 2; ++d) {
        const float tot = TOT2[d];
        f32x4 sa[4];
#pragma unroll
        for (int pt = 0; pt < 4; ++pt) sa[pt] = (f32x4){0.f, 0.f, 0.f, 0.f};
#pragma unroll
        for (int ks = 0; ks < 4; ++ks) {
            const LAS float* cp = Te + (2 + d) * 128 + 32 * ks + 8 * q4;
            const f32x4 c0 = *(const LAS f32x4*)cp, c1 = *(const LAS f32x4*)(cp + 4);
            float wv[8];
#pragma unroll
            for (int j = 0; j < 4; ++j) { wv[j] = __builtin_amdgcn_exp2f(tot - c0[j]); wv[4 + j] = __builtin_amdgcn_exp2f(tot - c1[j]); }
            const v4u bu = __builtin_bit_cast(v4u, braw[ks]); v4u su;
            su.x = pk2(bflo(bu.x) * wv[0], bfhi(bu.x) * wv[1]); su.y = pk2(bflo(bu.y) * wv[2], bfhi(bu.y) * wv[3]);
            su.z = pk2(bflo(bu.z) * wv[4], bfhi(bu.z) * wv[5]); su.w = pk2(bflo(bu.w) * wv[6], bfhi(bu.w) * wv[7]);
            const bf16x8 bs = __builtin_bit_cast(bf16x8, su);
#pragma unroll
            for (int pt = 0; pt < 4; ++pt) sa[pt] = mfma16(bs, frag_tr(Xs, RSX, 32 * ks, 16 * pt, lane), sa[pt]); }
        unsigned char* sp = (unsigned char*)F.ST + st_base + ((size_t)d * HDIM + i16) * NST + 16 * w + 4 * q4;
#pragma unroll
        for (int pt = 0; pt < 4; ++pt) { float c[4];
#pragma unroll
            for (int r = 0; r < 4; ++r) c[r] = fminf(fmaxf(sa[pt][r] * STSCALE, -440.f), 440.f);
            *(unsigned*)(sp + (size_t)16 * pt * NST) = pk4_fp8(c[0], c[1], c[2], c[3]); }
    }
}
__device__ __forceinline__ void p4_ssd_local(Frame& F) {
    constexpr int RS = 272, RSX = 144;
    constexpr int O_C = 0, O_B = 34816, O_M = 69632, O_X = 104448  , O_T = 141312  , O_CW = 153600  ;
    static_assert(O_CW + 9216 <= MISC_OFF, "P4 LDS map");
    LAS unsigned char* L = F.lds;
    LAS float* TAB = (LAS float*)(L + O_T);
    LAS float* CW = (LAS float*)(L + O_CW);
    volatile LAS float* TOT = (volatile LAS float*)(L + MISC_OFF + 64);
    volatile LAS float* DSK = (volatile LAS float*)(L + MISC_OFF + 128);
    const int tid = F.tid, w = F.wave;
    const int lb = 64 * (w & 1), sb = 32 * (w >> 1);
    const v4u zero4 = {0u, 0u, 0u, 0u};
    constexpr int NLAT = NB * 32 * NGRP, NCTX = NB * 2 * NGRP * HPG;
    int g_staged = -1;
    for (int v = (int)blockIdx.x; v < NLAT + NCTX; v += F.G) {
        const bool lat = v < NLAT;
        int tid_l = tid; asm volatile("" : "+v"(tid_l));
        const int lane_l = tid_l & 63, lane = lane_l, i16 = lane & 15, q4 = lane >> 4;
        const int p32 = tid_l & 31, rg = tid_l >> 5;
        const int xpc = tid_l & 7, rg2 = tid_l >> 3;
        int b, g, cc, r0, e_lo, e_hi; bool lo_ok, hi_ok;
        if (lat) { b = v >> 7; const int c = (v >> 2) & 31; g = v & 3; cc = c + 2; r0 = b * SEQ + c * CHUNK; lo_ok = c > 0; hi_ok = c < 31; e_lo = 0; e_hi = HPG; }
        else { const int q = v - NLAT; const int e = q % HPG; int t = q / HPG; g = t & 3; t >>= 2; cc = t & 1; b = t >> 1; r0 = T + b * CTXL + cc * CHUNK; lo_ok = cc > 0; hi_ok = cc < 1; e_lo = e; e_hi = e + 1; }
        const int rmin = lo_ok ? -2 : 0, rmax = hi_ok ? 129 : 127;
        const int chBC = SSD_W + (p32 >> 4) * (NGRP * NST) + g * NST + 8 * (p32 & 15);
        v4u raw[12];
#pragma unroll
        for (int j = 0; j < 12; ++j) { const int rr = 8 * rg - 2 + j; const int rc = rr < rmin ? rmin : (rr > rmax ? rmax : rr);
            const v4u t = *(const v4u*)(F.XBCPRE + (size_t)(r0 + rc) * CONV_CH + chBC); raw[j] = (rr == rc) ? t : zero4; }
        if (g != g_staged) {
            if (tid < HPG) DSK[tid] = F.d_skip[g * HPG + tid];
            float cwv[5];
#pragma unroll
            for (int q = 0; q < 5; ++q) { int idx = tid + 512 * q; idx = idx < HPG * 6 * 64 ? idx : HPG * 6 * 64 - 1; const int e_ = idx / 384, rem = idx - e_ * 384, j = rem >> 6, chl = rem & 63; const int ch = (g * HPG + e_) * HDIM + chl;
                const int jj = j < 5 ? j : 0; const float a = F.conv_w[jj * CONV_CH + ch], bq = F.conv_b[ch]; cwv[q] = (j < 5) ? a : bq; }
#pragma unroll
            for (int q = 0; q < 5; ++q) { const int idx = tid + 512 * q; if (idx < HPG * 6 * 64) CW[idx] = cwv[q]; }
            g_staged = g;
        }
        {
            float cw[5][8], cbias[8];
#pragma unroll
            for (int j = 0; j < 5; ++j) { const f32x4 a = *(const f32x4*)(F.conv_w + j * CONV_CH + chBC), bq = *(const f32x4*)(F.conv_w + j * CONV_CH + chBC + 4);
                cw[j][0] = a.x; cw[j][1] = a.y; cw[j][2] = a.z; cw[j][3] = a.w; cw[j][4] = bq.x; cw[j][5] = bq.y; cw[j][6] = bq.z; cw[j][7] = bq.w; }
            { const f32x4 a = *(const f32x4*)(F.conv_b + chBC), bq = *(const f32x4*)(F.conv_b + chBC + 4); cbias[0] = a.x; cbias[1] = a.y; cbias[2] = a.z; cbias[3] = a.w; cbias[4] = bq.x; cbias[5] = bq.y; cbias[6] = bq.z; cbias[7] = bq.w; }
            LAS unsigned char* dst = L + ((p32 >> 4) ? O_C : O_B) + (8 * rg) * RS + (p32 & 15) * 16;
#pragma unroll
            for (int i = 0; i < 8; ++i) { const v4u o = conv_piece(raw[i], raw[i + 1], raw[i + 2], raw[i + 3], raw[i + 4], cw, cbias);
                *(LAS v4u*)(dst + i * RS) = o;
                if (lat && (p32 >> 4)) *(v4u*)(F.CC + (size_t)(r0 + 8 * rg + i) * 512 + g * NST + 8 * (p32 & 15)) = o; }
        }
        v4u xraw[6];
#pragma unroll
        for (int j = 0; j < 6; ++j) { const int rr = 2 * rg2 - 2 + j; const int rc = rr < rmin ? rmin : (rr > rmax ? rmax : rr);
            xraw[j] = *(const v4u*)(F.XBCPRE + (size_t)(r0 + rc) * CONV_CH + (g * HPG + e_lo) * HDIM + 8 * xpc); }
        float pdt[2][2];
#pragma unroll
        for (int ii = 0; ii < 2; ++ii) { const int idx = (w + 8 * ii) < 12 ? (w + 8 * ii) : 11; const int e_ = idx % 6, d_ = idx / 6, h_ = g * HPG + e_; const int s0 = d_ ? 127 - 2 * lane_l : 2 * lane_l, s1 = d_ ? s0 - 1 : s0 + 1;
            pdt[ii][0] = F.DTRAW[(size_t)(r0 + s0) * 64 + d_ * NH + h_]; pdt[ii][1] = F.DTRAW[(size_t)(r0 + s1) * 64 + d_ * NH + h_]; }
#pragma unroll
        for (int ii = 0; ii < 2; ++ii) { const int idx = w + 8 * ii; const int e = idx % 6, d = idx / 6, h = g * HPG + e;
            if (idx < 12 && e >= e_lo && e < e_hi)
                p4_scan(F, TAB + e * 512, TOT + e * 2 + d, d, h, pdt[ii][0], pdt[ii][1], lane_l, ((size_t)(b * NCC + cc) * NH + h) * 2 + d, lat ? F.ROWSC + ((size_t)(b * 2 + d) * NH + h) * SEQ + (cc - 2) * CHUNK : nullptr); }
        __syncthreads();
        f32x4 cb[2][4];
        if (lat) {
#pragma unroll
            for (int ts = 0; ts < 2; ++ts)
#pragma unroll
                for (int tl = 0; tl < 4; ++tl) cb[ts][tl] = (f32x4){0.f, 0.f, 0.f, 0.f};
#pragma unroll
            for (int ks = 0; ks < 4; ++ks) { bf16x8 af[2], bfr[4];
#pragma unroll
                for (int ts = 0; ts < 2; ++ts) af[ts] = frag_row(L + O_B, RS, sb + 16 * ts + i16, 32 * ks, q4);
#pragma unroll
                for (int tl = 0; tl < 4; ++tl) bfr[tl] = frag_row(L + O_C, RS, lb + 16 * tl + i16, 32 * ks, q4);
#pragma unroll
                for (int ts = 0; ts < 2; ++ts)
#pragma unroll
                    for (int tl = 0; tl < 4; ++tl) cb[ts][tl] = mfma16(af[ts], bfr[tl], cb[ts][tl]); }
        }
        bf16x8 braw[4];
#pragma unroll
        for (int ks = 0; ks < 4; ++ks) braw[ks] = frag_tr(L + O_B, RS, 32 * ks, 16 * w, lane);
        for (int e = e_lo; e < e_hi; ++e) {
            const int h = g * HPG + e;
            const LAS float* Te = TAB + e * 512;
            LAS unsigned char* Xs = L + O_X + (e & 1) * 18432;
            LAS unsigned char* Ms = L + ((e & 1) ? O_C : O_M);
            {
                const LAS float* cwp = CW + (e * 6) * 64 + 8 * xpc;
#pragma unroll
                for (int i = 0; i < 2; ++i) {
                    f32x4 oa = *(const LAS f32x4*)(cwp + 5 * 64), ob = *(const LAS f32x4*)(cwp + 5 * 64 + 4);
#pragma unroll
                    for (int j = 0; j < 5; ++j) { const f32x4 wa = *(const LAS f32x4*)(cwp + j * 64), wb = *(const LAS f32x4*)(cwp + j * 64 + 4);
                        const int rr = 2 * rg2 - 2 + i + j; const v4u q = (rr >= rmin && rr <= rmax) ? xraw[i + j] : zero4;
                        oa.x += wa.x * bflo(q.x); oa.y += wa.y * bfhi(q.x); oa.z += wa.z * bflo(q.y); oa.w += wa.w * bfhi(q.y);
                        ob.x += wb.x * bflo(q.z); ob.y += wb.y * bfhi(q.z); ob.z += wb.z * bflo(q.w); ob.w += wb.w * bfhi(q.w); }
                    v4u ov; ov.x = pk2(silu_fast(oa.x), silu_fast(oa.y)); ov.y = pk2(silu_fast(oa.z), silu_fast(oa.w)); ov.z = pk2(silu_fast(ob.x), silu_fast(ob.y)); ov.w = pk2(silu_fast(ob.z), silu_fast(ob.w));
                    *(LAS v4u*)(Xs + (2 * rg2 + i) * RSX + xpc * 16) = ov; }
            }
            if (e + 1 < e_hi) {
#pragma unroll
                for (int j = 0; j < 6; ++j) { const int rr = 2 * rg2 - 2 + j; const int rc = rr < rmin ? rmin : (rr > rmax ? rmax : rr);
                    xraw[j] = *(const v4u*)(F.XBCPRE + (size_t)(r0 + rc) * CONV_CH + (h + 1) * HDIM + 8 * xpc); }
            }
            if (lat) {
                const float Dh = DSK[e];
#pragma unroll
                for (int tl = 0; tl < 4; ++tl) { const int l = lb + 16 * tl + i16; const int lt_abs = 4 * (w & 1) + tl; const float af_l = Te[l], rb_l = Te[128 + l];
#pragma unroll
                    for (int ts = 0; ts < 2; ++ts) { const int s0 = sb + 16 * ts + 4 * q4; const int st_abs = 2 * (w >> 1) + ts;
                        float m[4];
                        if (st_abs < lt_abs) {
                            const f32x4 acs = *(const LAS f32x4*)(Te + 256 + s0);
#pragma unroll
                            for (int r = 0; r < 4; ++r) m[r] = cb[ts][tl][r] * __builtin_amdgcn_exp2f(af_l - acs[r]);
                        } else if (st_abs > lt_abs) {
                            const f32x4 rbs = *(const LAS f32x4*)(Te + 384 + s0);
#pragma unroll
                            for (int r = 0; r < 4; ++r) m[r] = cb[ts][tl][r] * __builtin_amdgcn_exp2f(rb_l - rbs[r]);
                        } else {
                            const f32x4 acs = *(const LAS f32x4*)(Te + 256 + s0), rbs = *(const LAS f32x4*)(Te + 384 + s0);
#pragma unroll
                            for (int r = 0; r < 4; ++r) { const int sidx = s0 + r;
                                const float wf = (sidx <= l) ? __builtin_amdgcn_exp2f(af_l - acs[r]) : 0.f;
                                const float wb = (sidx >= l) ? __builtin_amdgcn_exp2f(rb_l - rbs[r]) : 0.f;
                                m[r] = cb[ts][tl][r] * (wf + wb) + ((sidx == l) ? Dh : 0.f); }
                        }
                        v2u o; o.x = pk2(m[0], m[1]); o.y = pk2(m[2], m[3]);
                        *(LAS v2u*)(Ms + l * RS + s0 * 2) = o; } }
            }
            __syncthreads();
            if (lat) {
                f32x4 ya[4];
#pragma unroll
                for (int pt = 0; pt < 4; ++pt) ya[pt] = (f32x4){0.f, 0.f, 0.f, 0.f};
#pragma unroll
                for (int ks = 0; ks < 4; ++ks) { const bf16x8 bm = frag_row(Ms, RS, 16 * w + i16, 32 * ks, q4);
#pragma unroll
                    for (int pt = 0; pt < 4; ++pt) ya[pt] = mfma16(frag_tr(Xs, RSX, 32 * ks, 16 * pt, lane), bm, ya[pt]); }
                bf16* yp = F.Y + (size_t)(r0 + 16 * w + i16) * SSD_W + h * HDIM + 4 * q4;
#pragma unroll
                for (int pt = 0; pt < 4; ++pt) { v2u o; o.x = pk2(ya[pt][0], ya[pt][1]); o.y = pk2(ya[pt][2], ya[pt][3]); *(v2u*)(yp + 16 * pt) = o; }
            }
            p4_states(F, braw, Te, TOT + e * 2, Xs, (((size_t)(b * NCC + cc) * NH + h) * 2) * HDIM * NST, w, lane);
        }
        __syncthreads();
    }
}

__device__ __forceinline__ void pool_grid_row(Frame& F, int gr) {
    LAS unsigned char* L = F.lds;
    const int tid = F.tid, rb = gr * 64;
    v4u pv[8];
#pragma unroll
    for (int k = 0; k < 8; ++k) { const int pc = tid + 512 * k, row = pc >> 6, ch = pc & 63; pv[k] = *(const v4u*)(F.V + (size_t)(rb + row) * 512 + ch * 8); }
#pragma unroll
    for (int k = 0; k < 8; ++k) { const int pc = tid + 512 * k, row = pc >> 6, ch = pc & 63; *(LAS v4u*)(L + row * 1024 + ch * 16) = pv[k]; }
    __syncthreads();
    {
        const int cg = tid & 63, tb = tid >> 6, hw = 1 << (cg >> 4);
        const LAS unsigned char* colp = L + cg * 16;
#pragma unroll 2
        for (int tt = 0; tt < 8; ++tt) { const int t = tb * 8 + tt; const int lo = t - hw < 0 ? 0 : t - hw, hi = t + hw > 64 ? 64 : t + hw;
            float sacc[8];
#pragma unroll
            for (int e = 0; e < 8; ++e) sacc[e] = 0.f;
            for (int q = lo; q < hi; ++q) { const v4u x = *(const LAS v4u*)(colp + q * 1024);
                sacc[0] += bflo(x.x); sacc[1] += bfhi(x.x); sacc[2] += bflo(x.y); sacc[3] += bfhi(x.y); sacc[4] += bflo(x.z); sacc[5] += bfhi(x.z); sacc[6] += bflo(x.w); sacc[7] += bfhi(x.w); }
            const v4u x = *(const LAS v4u*)(colp + t * 1024); const float inv = 1.f / (float)(hi - lo);
            float q[8] = {sacc[0] * inv - bflo(x.x), sacc[1] * inv - bfhi(x.x), sacc[2] * inv - bflo(x.y), sacc[3] * inv - bfhi(x.y), sacc[4] * inv - bflo(x.z), sacc[5] * inv - bfhi(x.z), sacc[6] * inv - bflo(x.w), sacc[7] * inv - bfhi(x.w)};
#pragma unroll
            for (int e = 0; e < 8; ++e) q[e] = fminf(fmaxf(q[e] * A2SCALE, -440.f), 440.f);
            v2u o; o.x = pk4_fp8(q[0], q[1], q[2], q[3]); o.y = pk4_fp8(q[4], q[5], q[6], q[7]);
            *(v2u*)((unsigned char*)F.A2 + (size_t)(rb + t) * 2048 + SSD_W + cg * 8) = o; }
    }
    __syncthreads();
}
__device__ __forceinline__ void p5_ssd_scan(Frame& F) {
    constexpr int RS = 272, O_RS = 4 * 34816;
    LAS unsigned char* L = F.lds;
    LAS float* RSB = (LAS float*)(L + O_RS);
    const int tid = F.tid, lane = F.lane, w = F.wave, i16 = lane & 15, q4 = lane >> 4;
    const int d = w >> 2, ps = w & 3, t8 = tid & 255;
    if (F.G == 256 && (int)blockIdx.x >= NB * NH) {
        for (int gr = (int)blockIdx.x - NB * NH; gr < T / 64; gr += F.G - NB * NH) pool_grid_row(F, gr);
        { const int sw = ((int)blockIdx.x - NB * NH) * 8 + F.wave, nsw = (F.G - NB * NH) * 8;
          auto deal2 = [=](int k) -> int { return P0_NI - P0_NMOVE + 2 * ((k >> 1) * nsw + sw) + (k & 1); };
          p0_convert(F, deal2, 2 * ((P0_NMOVE / 2 + nsw - 1) / nsw), P0_NI - P0_NMOVE, P0_NI); }
        return;
    }
    for (int u = (int)blockIdx.x; u < NB * NH; u += F.G) {
        const int b = u / NH, h = u - b * NH, g = h / HPG;
        float S[32];
#pragma unroll
        for (int k = 0; k < 32; ++k) S[k] = 0.f;
        v4u creg[8]; float rsreg = 0.f;
#pragma unroll
        for (int k = 0; k < 8; ++k) creg[k] = (v4u){0u, 0u, 0u, 0u};
        for (int j = 0; j < NCC; ++j) {
            const int cc = d == 0 ? j : (j < 2 ? 1 - j : 35 - j);
            LAS unsigned char* Cb = L + ((j & 1) * 2 + d) * 34816;
            if (j >= 2) {
#pragma unroll
                for (int k = 0; k < 8; ++k) { const int pc = t8 + 256 * k, row = pc >> 4, ch = pc & 15; *(LAS v4u*)(Cb + row * RS + ch * 16) = creg[k]; }
                if (t8 < 128) RSB[((j & 1) * 2 + d) * 128 + t8] = rsreg;
            }
            __syncthreads();
            if (j + 1 >= 2 && j + 1 < NCC) {
                const int cn = d == 0 ? j + 1 : 34 - j;
                const size_t rown = (size_t)b * SEQ + (size_t)(cn - 2) * CHUNK;
#pragma unroll
                for (int k = 0; k < 8; ++k) { const int pc = t8 + 256 * k, row = pc >> 4, ch = pc & 15; creg[k] = *(const v4u*)(F.CC + (rown + row) * 512 + g * NST + ch * 8); }
                if (t8 < 128) rsreg = F.ROWSC[((size_t)(b * 2 + d) * NH + h) * SEQ + (cn - 2) * CHUNK + t8];
            }
            const size_t sidx = ((size_t)(b * NCC + cc) * NH + h) * 2 + d;
            const unsigned char* stp = (const unsigned char*)F.ST + (sidx * HDIM + 16 * ps + i16) * NST + 8 * q4;
            v2u stv[4];
#pragma unroll
            for (int ks = 0; ks < 4; ++ks) stv[ks] = *(const v2u*)(stp + 32 * ks);
            const float decay = __builtin_amdgcn_exp2f(F.CHS[sidx]);
            if (j >= 2) {
                bf16x8 sf[4];
#pragma unroll
                for (int ks = 0; ks < 4; ++ks) { v4u t; t.x = pk2(S[ks * 8 + 0], S[ks * 8 + 1]); t.y = pk2(S[ks * 8 + 2], S[ks * 8 + 3]); t.z = pk2(S[ks * 8 + 4], S[ks * 8 + 5]); t.w = pk2(S[ks * 8 + 6], S[ks * 8 + 7]); sf[ks] = __builtin_bit_cast(bf16x8, t); }
                const size_t rowb = (size_t)b * SEQ + (size_t)(cc - 2) * CHUNK;
                const LAS float* rsl = RSB + ((j & 1) * 2 + d) * 128;
                const int c = cc - 2; const bool first = (d == 0) ? (c <= 15) : (c >= 16);
                unsigned yold[8];
                unsigned char* yo = (unsigned char*)F.YB + (rowb + i16) * SSD_W + h * HDIM + 16 * ps + 4 * q4;
                if (!first) {
#pragma unroll
                    for (int lt = 0; lt < 8; ++lt) yold[lt] = *(const unsigned*)(yo + (size_t)16 * lt * SSD_W);
                }
#pragma unroll
                for (int lt = 0; lt < 8; ++lt) {
                    f32x4 a = (f32x4){0.f, 0.f, 0.f, 0.f};
#pragma unroll
                    for (int ks = 0; ks < 4; ++ks) a = mfma16(sf[ks], frag_row(Cb, RS, 16 * lt + i16, 32 * ks, q4), a);
                    const float sc = rsl[16 * lt + i16] * YOSCALE;
                    float o[4] = {a[0] * sc, a[1] * sc, a[2] * sc, a[3] * sc};
                    if (!first) { const f32x2 lo = __builtin_amdgcn_cvt_pk_f32_fp8((int)yold[lt], false), hi = __builtin_amdgcn_cvt_pk_f32_fp8((int)yold[lt], true); o[0] += lo.x; o[1] += lo.y; o[2] += hi.x; o[3] += hi.y; }
#pragma unroll
                    for (int r = 0; r < 4; ++r) o[r] = fminf(fmaxf(o[r], -440.f), 440.f);
                    *(unsigned*)(yo + (size_t)16 * lt * SSD_W) = pk4_fp8(o[0], o[1], o[2], o[3]);
                }
            }
#pragma unroll
            for (int ks = 0; ks < 4; ++ks) { const v2u t = stv[ks];
                const f32x2 a0 = __builtin_amdgcn_cvt_pk_f32_fp8((int)t.x, false), a1 = __builtin_amdgcn_cvt_pk_f32_fp8((int)t.x, true), a2 = __builtin_amdgcn_cvt_pk_f32_fp8((int)t.y, false), a3 = __builtin_amdgcn_cvt_pk_f32_fp8((int)t.y, true);
                S[ks * 8 + 0] = decay * S[ks * 8 + 0] + a0.x * (1.f / STSCALE); S[ks * 8 + 1] = decay * S[ks * 8 + 1] + a0.y * (1.f / STSCALE);
                S[ks * 8 + 2] = decay * S[ks * 8 + 2] + a1.x * (1.f / STSCALE); S[ks * 8 + 3] = decay * S[ks * 8 + 3] + a1.y * (1.f / STSCALE);
                S[ks * 8 + 4] = decay * S[ks * 8 + 4] + a2.x * (1.f / STSCALE); S[ks * 8 + 5] = decay * S[ks * 8 + 5] + a2.y * (1.f / STSCALE);
                S[ks * 8 + 6] = decay * S[ks * 8 + 6] + a3.x * (1.f / STSCALE); S[ks * 8 + 7] = decay * S[ks * 8 + 7] + a3.y * (1.f / STSCALE); }
        }
        __syncthreads();
    }
}

__device__ __forceinline__ void p6_gate_pool(Frame& F) {
    LAS unsigned char* L = F.lds;
    const int tid = F.tid, lane = F.lane, w = F.wave;
    f32x4 nw[3][2];
#pragma unroll
    for (int j = 0; j < 3; ++j) { const int col = 8 * (lane + 64 * j); nw[j][0] = *(const f32x4*)(F.ssd_norm_w + col) * A2SCALE; nw[j][1] = *(const f32x4*)(F.ssd_norm_w + col + 4) * A2SCALE; }
    for (int gr = (int)blockIdx.x; gr < T / 64; gr += F.G) {
        const int rb = gr * 64;
        if (F.G != 256) pool_grid_row(F, gr);
        for (int rr = 0; rr < 8; rr += 2) {
            v4u ya[2][3], zz[2][3]; v2u yb[2][3];
#pragma unroll
            for (int k = 0; k < 2; ++k) { const int r = rb + 8 * w + rr + k;
#pragma unroll
                for (int j = 0; j < 3; ++j) { const int col = 8 * (lane + 64 * j);
                    ya[k][j] = *(const v4u*)(F.Y + (size_t)r * SSD_W + col); yb[k][j] = *(const v2u*)((const unsigned char*)F.YB + (size_t)r * SSD_W + col); zz[k][j] = *(const v4u*)(F.Z + (size_t)r * SSD_W + col); } }
#pragma unroll
            for (int k = 0; k < 2; ++k) { const int r = rb + 8 * w + rr + k;
                float v[24]; float ss = 0.f;
#pragma unroll
                for (int j = 0; j < 3; ++j) {
                    const unsigned yaw[4] = {ya[k][j].x, ya[k][j].y, ya[k][j].z, ya[k][j].w}, zw[4] = {zz[k][j].x, zz[k][j].y, zz[k][j].z, zz[k][j].w};
                    const f32x2 yo2[4] = {__builtin_amdgcn_cvt_pk_f32_fp8((int)yb[k][j].x, false), __builtin_amdgcn_cvt_pk_f32_fp8((int)yb[k][j].x, true), __builtin_amdgcn_cvt_pk_f32_fp8((int)yb[k][j].y, false), __builtin_amdgcn_cvt_pk_f32_fp8((int)yb[k][j].y, true)};
#pragma unroll
                    for (int e = 0; e < 4; ++e) { const float y0 = bflo(yaw[e]) + yo2[e].x * (1.f / YOSCALE), y1 = bfhi(yaw[e]) + yo2[e].y * (1.f / YOSCALE);
                        const float g0 = y0 * silu_f(bflo(zw[e])), g1 = y1 * silu_f(bfhi(zw[e])); v[j * 8 + 2 * e] = g0; v[j * 8 + 2 * e + 1] = g1; ss += g0 * g0 + g1 * g1; } }
                const float rs = __builtin_amdgcn_rsqf(wave_sum(ss) * (1.f / SSD_W) + RMS_EPS);
#pragma unroll
                for (int j = 0; j < 3; ++j) { const int col = 8 * (lane + 64 * j);
                    const f32x4 w0 = nw[j][0], w1 = nw[j][1];
                    const float rq = rs; float q[8] = {v[j * 8 + 0] * rq * w0.x, v[j * 8 + 1] * rq * w0.y, v[j * 8 + 2] * rq * w0.z, v[j * 8 + 3] * rq * w0.w, v[j * 8 + 4] * rq * w1.x, v[j * 8 + 5] * rq * w1.y, v[j * 8 + 6] * rq * w1.z, v[j * 8 + 7] * rq * w1.w};
#pragma unroll
                    for (int e = 0; e < 8; ++e) q[e] = fminf(fmaxf(q[e], -440.f), 440.f);
                    v2u o; o.x = pk4_fp8(q[0], q[1], q[2], q[3]); o.y = pk4_fp8(q[4], q[5], q[6], q[7]);
                    *(v2u*)((unsigned char*)F.A2 + (size_t)r * 2048 + col) = o; } }
        }
    }
}

struct Sched7 {
    static constexpr bool TBL = false;
    const char* A; const char* Bt; const int* rowid; int G, c;
    __device__ __forceinline__ bool next(int i, pg8::Unit& u) const { const int L = i * G + c; if (L >= 512) return false; pg8::static_map(L, 128, 4, u.pm, u.pn); u.e = 0; return true; }
    __device__ __forceinline__ const char* a_base(const pg8::Unit&) const { return A; }
    __device__ __forceinline__ const char* b_base(const pg8::Unit& u) const { return Bt + (size_t)u.pn * 256 * 2048; }
    __device__ __forceinline__ const int* row_table(const pg8::Unit& u) const { return rowid + u.pm * 256; }
};
struct Epi7 {
    static constexpr bool PERM = false;
    const float* x; const float* MOD; bf16* X1;
    __device__ __forceinline__ void operator()(const f32x4 (&acc)[2][2][4][2], const pg8::Unit& u, int wr, int wc, int fr, int fq) const {
        const int row0 = u.pm * 256 + wr * 64 + fr, col0 = u.pn * 256 + wc * 32 + 4 * fq;
        const float* g1 = MOD + (size_t)(u.pm >> 4) * 6144 + 2048;
        f32x4 gv[2][2];
#pragma unroll
        for (int bj = 0; bj < 2; ++bj)
#pragma unroll
            for (int n = 0; n < 2; ++n) gv[bj][n] = *(const f32x4*)(g1 + col0 + bj * 128 + n * 16);
#pragma unroll
        for (int ai = 0; ai < 2; ++ai)
#pragma unroll
            for (int m = 0; m < 4; ++m) { const size_t off = (size_t)(row0 + ai * 128 + m * 16) * D + col0;
#pragma unroll
                for (int bj = 0; bj < 2; ++bj)
#pragma unroll
                    for (int n = 0; n < 2; ++n) { const f32x4 xv = *(const f32x4*)(x + off + bj * 128 + n * 16); const f32x4 o = xv + gv[bj][n] * (acc[ai][bj][m][n] * (1.f / (WSCALE * A2SCALE))); v2u ov; ov.x = pk2(o.x, o.y); ov.y = pk2(o.z, o.w); *(v2u*)(X1 + off + bj * 128 + n * 16) = ov; } }
    }
};

__device__ __forceinline__ void p8_router(Frame& F) {
    LAS unsigned char* L = F.lds;
    LAS float* H2F = (LAS float*)L;
    constexpr int HP = 1028;
    LAS float* PART = (LAS float*)(L + 16 * HP * 4);
    LAS unsigned* HIST = (LAS unsigned*)(L + 16 * HP * 4 + 16384);
    const int tid = F.tid, lane = F.lane, w = F.wave, i16 = lane & 15, q4 = lane >> 4;
    if (tid < 32) HIST[tid] = 0u;
    float rw0[32], rw1[32];
#pragma unroll
    for (int kk = 0; kk < 32; ++kk) { const int k = 128 * w + 4 * kk + q4; rw0[kk] = F.router_w[k * 32 + i16]; rw1[kk] = F.router_w[k * 32 + 16 + i16]; }
    __syncthreads();
    const int GPB = (T / 16 + F.G - 1) / F.G, g_lo = (int)blockIdx.x * GPB, g_hi = (g_lo + GPB < T / 16) ? g_lo + GPB : T / 16;
    f32x4 wsc[4], shv[4]; int mb_cur = -1;
    v2u xq[2][4];
    if (g_lo < g_hi) {
#pragma unroll
        for (int rr = 0; rr < 2; ++rr)
#pragma unroll
            for (int j = 0; j < 4; ++j) xq[rr][j] = *(const v2u*)(F.X1 + (size_t)(g_lo * 16 + 2 * w + rr) * D + 4 * lane + 256 * j);
    }
    for (int gi = g_lo; gi < g_hi; ++gi) {
        const int rbase = gi * 16;
        { const int mb = rbase >> 12; if (mb != mb_cur) { mb_cur = mb; const float* mod = F.MOD + (size_t)mb * 6144;
#pragma unroll
            for (int j = 0; j < 4; ++j) { const int col = 4 * lane + 256 * j; wsc[j] = *(const f32x4*)(F.norm2_w + col) * (*(const f32x4*)(mod + 4096 + col) + 1.f); shv[j] = *(const f32x4*)(mod + 3072 + col); } } }
#pragma unroll
        for (int rr = 0; rr < 2; ++rr) {
            const int r16 = 2 * w + rr, r = rbase + r16;
            f32x4 v[4]; float ss = 0.f;
#pragma unroll
            for (int j = 0; j < 4; ++j) { const v2u q = xq[rr][j]; v[j] = (f32x4){bflo(q.x), bfhi(q.x), bflo(q.y), bfhi(q.y)}; ss += (v[j].x * v[j].x + v[j].y * v[j].y) + (v[j].z * v[j].z + v[j].w * v[j].w); }
            const float rs = __builtin_amdgcn_rsqf(wave_sum(ss) * (1.f / D) + RMS_EPS);
#pragma unroll
            for (int j = 0; j < 4; ++j) { const int col = 4 * lane + 256 * j;
                const f32x4 hh = (v[j] * rs) * wsc[j] + shv[j];
                *(LAS f32x4*)(H2F + r16 * HP + col) = hh;
                *(unsigned*)((unsigned char*)F.H2 + (size_t)r * D + col) = pk4_fp8(hh.x, hh.y, hh.z, hh.w); }
        }
        if (gi + 1 < g_hi) {
#pragma unroll
            for (int rr = 0; rr < 2; ++rr)
#pragma unroll
                for (int j = 0; j < 4; ++j) xq[rr][j] = *(const v2u*)(F.X1 + (size_t)((gi + 1) * 16 + 2 * w + rr) * D + 4 * lane + 256 * j);
        }
        __syncthreads();
        {
            f32x4 a0 = (f32x4){0.f, 0.f, 0.f, 0.f}, a1 = a0;
#pragma unroll
            for (int kk = 0; kk < 32; ++kk) { const int k = 128 * w + 4 * kk + q4;
                const float av = H2F[i16 * HP + k];
                a0 = __builtin_amdgcn_mfma_f32_16x16x4f32(av, rw0[kk], a0, 0, 0, 0); a1 = __builtin_amdgcn_mfma_f32_16x16x4f32(av, rw1[kk], a1, 0, 0, 0); }
#pragma unroll
            for (int r = 0; r < 4; ++r) { PART[(w * 16 + 4 * q4 + r) * 32 + i16] = a0[r]; PART[(w * 16 + 4 * q4 + r) * 32 + 16 + i16] = a1[r]; }
        }
        __syncthreads();
        {
            const int row = tid >> 5, e = tid & 31;
            float lg = F.router_b[e];
#pragma unroll
            for (int ww = 0; ww < 8; ++ww) lg += PART[(ww * 16 + row) * 32 + e];
            float tv[4]; int ti[4];
#pragma unroll
            for (int k = 0; k < 4; ++k) { float bv = lg; int bi = e;
#pragma unroll
                for (int o = 1; o < 32; o <<= 1) { const float ov = __shfl_xor(bv, o); const int oi = __shfl_xor(bi, o); if (ov > bv || (ov == bv && oi < bi)) { bv = ov; bi = oi; } }
                tv[k] = bv; ti[k] = bi; if (e == bi) lg = -INFINITY; }
            if (e == 0) {
                const float e1 = __expf(tv[1] - tv[0]), e2 = __expf(tv[2] - tv[0]), e3 = __expf(tv[3] - tv[0]); const float inv = 1.f / (1.f + e1 + e2 + e3);
                const float gt[4] = {inv, e1 * inv, e2 * inv, e3 * inv};
                const int tok = rbase + row;
#pragma unroll
                for (int k = 0; k < 4; ++k) { const unsigned lr = atomicAdd((unsigned*)&HIST[ti[k]], 1u); F.TOPE[tok * 4 + k] = ti[k]; F.TOPG[tok * 4 + k] = gt[k]; F.TOPR[tok * 4 + k] = (int)lr; }
            }
        }
        __syncthreads();
    }
    if (tid < 32) { const unsigned base = __hip_atomic_fetch_add(F.ctl + CW_GCOUNT + tid, HIST[tid], RLX_AGENT); F.BB[(int)blockIdx.x * 32 + tid] = (int)base; }
}

__device__ __forceinline__ int moe_tables(Frame& F) {
    LAS int* TE = (LAS int*)(F.lds + TE_OFF);
    LAS int* MC = (LAS int*)(F.lds + MOE_CNT_OFF);
    __syncthreads();
    if (F.tid == 0) { int ps = 0;
        for (int e = 0; e < NE; ++e) { const int c = (int)__hip_atomic_load(F.ctl + CW_GCOUNT + e, RLX_AGENT); MC[e] = c; MC[32 + e] = ps; const int nt = (c + 255) >> 8; for (int t = 0; t < nt; ++t) TE[(ps >> 8) + t] = e; ps += nt << 8; }
        MC[64] = ps >> 8; }
    __syncthreads();
    return MC[64];
}
__device__ __forceinline__ void p9_slots(Frame& F) {
    (void)moe_tables(F);
    const LAS int* MC = (const LAS int*)(F.lds + MOE_CNT_OFF);
    const int gt = (int)blockIdx.x * 512 + F.tid, NT_ = F.G * 512;
    for (int a = gt; a < T * TOPK; a += NT_) { const int tok = a >> 2, e = F.TOPE[a], blk = (tok >> 4) / ((T / 16 + F.G - 1) / F.G);
        const int slot = MC[32 + e] + F.BB[blk * 32 + e] + F.TOPR[a];
        F.SLOTTOK[slot] = tok; F.SLOTGATE[slot] = F.TOPG[a]; F.TOKSLOT[a] = slot; }
    for (int i = gt; i < MAX_SLOTS; i += NT_) F.SLOTID[i] = i;
    if ((int)blockIdx.x < NE) { const int e = (int)blockIdx.x, c = MC[e], ps = MC[32 + e], pe = ps + (((c + 255) >> 8) << 8);
        for (int s = ps + c + F.tid; s < pe; s += 512) { F.SLOTTOK[s] = 0; F.SLOTGATE[s] = 0.f; } }
}

struct SchedMoe {
    static constexpr bool TBL = true;
    const char* A; const char* W; const int* slot_tok; const LAS int* TE; int nM, nN, G, c; size_t wbytes  , tilebytes  , arowbytes;
    LAS unsigned char* tb;
    const float* f0; int f0_e, f0_n;
    const float* f1;
    __device__ __forceinline__ bool next(int i, pg8::Unit& u) const { const int L = i * G + c; if (L >= nM * nN) return false; pg8::static_map(L, nM, nN, u.pm, u.pn); u.e = TE[u.pm]; return true; }
    __device__ __forceinline__ const char* a_base(const pg8::Unit&) const { return A; }
    __device__ __forceinline__ const char* b_base(const pg8::Unit& u) const { return W + (size_t)u.e * wbytes + (size_t)u.pn * tilebytes; }
    __device__ __forceinline__ const int* row_table(const pg8::Unit& u) const { return slot_tok + u.pm * 256; }
    __device__ __forceinline__ const int* tab0(const pg8::Unit& u) const { return slot_tok + u.pm * 256; }
    __device__ __forceinline__ const float* tab1(const pg8::Unit& u) const { return f0 + (size_t)u.e * f0_e + u.pn * f0_n; }
    __device__ __forceinline__ const float* tab2(const pg8::Unit& u) const { return f1 ? f1 + u.pm * 256 : nullptr; }
};
struct Epi10 {
    static constexpr bool PERM = true;
    const float* b1; bf16* ACT;
    __device__ __forceinline__ void operator()(const f32x4 (&acc)[2][2][4][2], const pg8::Unit& u, int wr, int wc, int fr, int fq, const LAS unsigned char* tbuf) const {
        const int row0 = u.pm * 256 + wr * 64 + fr, j0 = u.pn * 128 + wc * 32 + 8 * fq;
        const LAS float* bp = (const LAS float*)(tbuf + 3072) + 2 * (wc * 32 + 8 * fq);
        const f32x4 q0 = *(const LAS f32x4*)bp, q1 = *(const LAS f32x4*)(bp + 4), q2 = *(const LAS f32x4*)(bp + 8), q3 = *(const LAS f32x4*)(bp + 12);
        const float bg[8] = {q0.x, q0.z, q1.x, q1.z, q2.x, q2.z, q3.x, q3.z}, bu[8] = {q0.y, q0.w, q1.y, q1.w, q2.y, q2.w, q3.y, q3.w};
#pragma unroll
        for (int ai = 0; ai < 2; ++ai)
#pragma unroll
            for (int m = 0; m < 4; ++m) { float o[8];
#pragma unroll
                for (int n = 0; n < 2; ++n)
#pragma unroll
                    for (int t = 0; t < 4; ++t) { const float hg = acc[ai][0][m][n][t] * (1.f / WSCALE) + bg[4 * n + t], hu = acc[ai][1][m][n][t] * (1.f / WSCALE) + bu[4 * n + t];
                        const float gp = fminf(hg, 7.f), up = fminf(fmaxf(hu, -7.f), 7.f);
                        o[4 * n + t] = gp * __builtin_amdgcn_rcpf(1.f + __builtin_amdgcn_exp2f(-1.702f * 1.44269504f * gp)) * (up + 1.f); }
                v2u wv; wv.x = pk4_fp8(o[0] * ASCALE, o[1] * ASCALE, o[2] * ASCALE, o[3] * ASCALE); wv.y = pk4_fp8(o[4] * ASCALE, o[5] * ASCALE, o[6] * ASCALE, o[7] * ASCALE);
                *(v2u*)((unsigned char*)ACT + (size_t)(row0 + ai * 128 + m * 16) * DFF + j0) = wv; }
    }
};
struct Epi11 {
    static constexpr bool PERM = true;
    bf16* YS;
    __device__ __forceinline__ void operator()(const f32x4 (&acc)[2][2][4][2], const pg8::Unit& u, int wr, int wc, int fr, int fq, const LAS unsigned char* tbuf) const {
        const int row0 = u.pm * 256 + wr * 64 + fr, col0 = u.pn * 256 + wc * 32 + 8 * fq;
        const LAS float* bl = (const LAS float*)(tbuf + 3072) + wc * 32 + 8 * fq; const LAS float* gl = (const LAS float*)(tbuf + 6144) + wr * 64 + fr;
        f32x4 bv[2][2];
#pragma unroll
        for (int bj = 0; bj < 2; ++bj)
#pragma unroll
            for (int n = 0; n < 2; ++n) bv[bj][n] = *(const LAS f32x4*)(bl + bj * 128 + 4 * n);
#pragma unroll
        for (int ai = 0; ai < 2; ++ai)
#pragma unroll
            for (int m = 0; m < 4; ++m) { const int row = row0 + ai * 128 + m * 16; const float gt = gl[ai * 128 + m * 16];
#pragma unroll
                for (int bj = 0; bj < 2; ++bj) { const float gs = gt * YSCALE; f32x4 v0 = (acc[ai][bj][m][0] * (1.f / (WSCALE * ASCALE)) + bv[bj][0]) * gs, v1 = (acc[ai][bj][m][1] * (1.f / (WSCALE * ASCALE)) + bv[bj][1]) * gs;
#pragma unroll
                    for (int t = 0; t < 4; ++t) { v0[t] = fminf(fmaxf(v0[t], -440.f), 440.f); v1[t] = fminf(fmaxf(v1[t], -440.f), 440.f); }
                    v2u wv; wv.x = pk4_fp8(v0[0], v0[1], v0[2], v0[3]); wv.y = pk4_fp8(v1[0], v1[1], v1[2], v1[3]);
                    *(v2u*)((unsigned char*)YS + (size_t)row * D + col0 + bj * 128) = wv; } }
    }
};

__device__ __forceinline__ void p12_combine(Frame& F) {
    const int gw = (int)blockIdx.x * 8 + F.wave, NGW = F.G * 8, lane = F.lane;
    for (int rb16 = gw; rb16 < T / 16; rb16 += NGW) {
        const int r0 = rb16 * 16;
        const float* g2p = F.MOD + (size_t)(r0 >> 12) * 6144 + 5120;
        f32x4 g2v[4], fw[4];
#pragma unroll
        for (int j = 0; j < 4; ++j) { const int col = 4 * lane + 256 * j; g2v[j] = *(const f32x4*)(g2p + col) * (1.f / YSCALE); fw[j] = *(const f32x4*)(F.final_norm_w + col); }
        for (int rp = 0; rp < 8; ++rp) {
            int sl[2][4];
#pragma unroll
            for (int k2 = 0; k2 < 2; ++k2)
#pragma unroll
                for (int k = 0; k < 4; ++k) sl[k2][k] = F.TOKSLOT[(r0 + rp * 2 + k2) * 4 + k];
            unsigned yv[2][4][4]; v2u xq[2][4];
#pragma unroll
            for (int k2 = 0; k2 < 2; ++k2)
#pragma unroll
                for (int j = 0; j < 4; ++j) { const int col = 4 * lane + 256 * j; xq[k2][j] = *(const v2u*)(F.X1 + (size_t)(r0 + rp * 2 + k2) * D + col);
#pragma unroll
                    for (int k = 0; k < 4; ++k) yv[k2][j][k] = *(const unsigned*)((const unsigned char*)F.YS + (size_t)sl[k2][k] * D + col); }
#pragma unroll
            for (int k2 = 0; k2 < 2; ++k2) { const int r = r0 + rp * 2 + k2;
                f32x4 v[4]; float ss = 0.f;
#pragma unroll
                for (int j = 0; j < 4; ++j) { f32x4 m = (f32x4){0.f, 0.f, 0.f, 0.f};
#pragma unroll
                    for (int k = 0; k < 4; ++k) { const int y = (int)yv[k2][j][k]; const f32x2 lo = __builtin_amdgcn_cvt_pk_f32_fp8(y, false), hi = __builtin_amdgcn_cvt_pk_f32_fp8(y, true); m.x += lo.x; m.y += lo.y; m.z += hi.x; m.w += hi.y; }
                    v[j] = (f32x4){bflo(xq[k2][j].x), bfhi(xq[k2][j].x), bflo(xq[k2][j].y), bfhi(xq[k2][j].y)} + g2v[j] * m;
                    ss += (v[j].x * v[j].x + v[j].y * v[j].y) + (v[j].z * v[j].z + v[j].w * v[j].w); }
                const float rs = __builtin_amdgcn_rsqf(wave_sum(ss) * (1.f / D) + RMS_EPS);
#pragma unroll
                for (int j = 0; j < 4; ++j) { const int col = 4 * lane + 256 * j; *(f32x4*)(F.out + (size_t)r * D + col) = (v[j] * rs) * fw[j]; } }
        }
    }
}

constexpr int NPHASE = 13;
struct Args { const float* in[25]; float* out; unsigned char* ws; int ph_lo, ph_hi; };
__global__ void __launch_bounds__(512, 2) mk_fwd(Args args) {
    extern __shared__ __attribute__((aligned(16))) unsigned char lds[];
    Frame F;
    F.lds = (LAS unsigned char*)lds;
    F.tid = threadIdx.x; F.lane = F.tid & 63; F.wave = __builtin_amdgcn_readfirstlane(F.tid >> 6); F.G = gridDim.x;
    unsigned char* ws = args.ws;
    F.ctl = (unsigned*)(ws + WS_CTL);
    F.x = args.in[0]; F.c = args.in[1]; F.ctx = args.in[2]; F.c_ctx = args.in[3]; F.w_mod = args.in[4]; F.b_mod = args.in[5]; F.norm1_w = args.in[6]; F.norm2_w = args.in[7];
    F.w_in = args.in[8]; F.conv_w = args.in[9]; F.conv_b = args.in[10]; F.dt_bias = args.in[11]; F.a_log = args.in[12]; F.d_skip = args.in[13]; F.ssd_norm_w = args.in[14];
    F.pool_w = args.in[15]; F.pool_scale = args.in[16]; F.w_out = args.in[17]; F.router_w = args.in[18]; F.router_b = args.in[19]; F.w1 = args.in[20]; F.b1 = args.in[21];
    F.w2 = args.in[22]; F.b2 = args.in[23]; F.final_norm_w = args.in[24]; F.out = args.out;
    F.MOD = (float*)(ws + WS_MOD); F.DTRAW = (float*)(ws + WS_DTRAW); F.DT = (float*)(ws + WS_DT); F.ROWSC = (float*)(ws + WS_ROWSC); F.CHS = (float*)(ws + WS_CHS); F.X1 = (bf16*)(ws + WS_X1);
    F.TOPG = (float*)(ws + WS_TOPG); F.SLOTGATE = (float*)(ws + WS_SLOTGATE); F.TOPE = (int*)(ws + WS_TOPE); F.TOPR = (int*)(ws + WS_TOPR); F.TOKSLOT = (int*)(ws + WS_TOKSLOT);
    F.SLOTTOK = (int*)(ws + WS_SLOTTOK); F.SLOTID = (int*)(ws + WS_SLOTID); F.ROWID = (int*)(ws + WS_ROWID); F.BB = (int*)(ws + WS_BB);
    F.WINT = (bf16*)(ws + WS_WINT); F.WOUTT = (bf16*)(ws + WS_WOUTT); F.W1T = (bf16*)(ws + WS_W1T); F.W2T = (bf16*)(ws + WS_W2T); F.A1 = (bf16*)(ws + WS_A1); F.XBCPRE = (bf16*)(ws + WS_XBCPRE);
    F.Z = (bf16*)(ws + WS_Z); F.V = (bf16*)(ws + WS_V); F.XBC = (bf16*)(ws + WS_XBC); F.CC = (bf16*)(ws + WS_CC); F.ST = (bf16*)(ws + WS_ST); F.Y = (bf16*)(ws + WS_Y); F.YB = (bf16*)(ws + WS_YB);
    F.A2 = (bf16*)(ws + WS_A2); F.H2 = (bf16*)(ws + WS_H2); F.ACT = (bf16*)(ws + WS_ACT); F.YS = (bf16*)(ws + WS_YS);
    volatile LAS unsigned* MISC = (volatile LAS unsigned*)(F.lds + MISC_OFF);
    for (int u = F.tid; u < 64; u += 512) MISC[u] = 0u;
    __syncthreads();
    const int lo = args.ph_lo, hi = args.ph_hi;
    XcdBarrier bar; bar.bar = F.ctl + CW_BAR; bar.x = 0; bar.st = nullptr;
    if (hi - lo > 1) bar = xcd_barrier_post(F.ctl + CW_BAR, MISC + 8);
#define IN(k) (lo <= (k) && (k) < hi)
#define SEAM(k) do { if (IN(k) && IN((k) + 1)) xcd_barrier(bar); } while (0)
#define BODY0 p0_prologue(F)
#define BODY1 p1_norm1(F)
#define BODY2 do { Sched1 S{(const char*)F.A1, (const char*)F.WINT, F.G, (int)blockIdx.x}; Epi1 E{F.XBCPRE, F.Z, F.V, F.DTRAW}; pg8::gemm_phase<Epi1, Sched1, false>(F.lds, D, S, E); } while (0)
#define BODY4 p4_ssd_local(F)
#define BODY5 p5_ssd_scan(F)
#define BODY6 p6_gate_pool(F)
#define BODY7 do { Sched7 S{(const char*)F.A2, (const char*)F.WOUTT, F.ROWID, F.G, (int)blockIdx.x}; Epi7 E{F.x, F.MOD, F.X1}; pg8::gemm_phase<Epi7, Sched7, true, true>(F.lds, 2048, S, E); } while (0)
#define BODY8 p8_router(F)
#define BODY9 p9_slots(F)
#define BODY10 do { const int ntl = moe_tables(F); \
        SchedMoe S{(const char*)F.H2, (const char*)F.W1T, F.SLOTTOK, (const LAS int*)(F.lds + TE_OFF), ntl, 8, F.G, (int)blockIdx.x, (size_t)2048 * D, (size_t)256 * D, (size_t)D, F.lds + TBL_OFF, F.b1, 2048, 256, nullptr}; \
        Epi10 E{F.b1, F.ACT}; pg8::gemm_phase<Epi10, SchedMoe, true, true>(F.lds, D, S, E); } while (0)
#define BODY11 do { const int ntl = moe_tables(F); \
        SchedMoe S{(const char*)F.ACT, (const char*)F.W2T, F.SLOTID, (const LAS int*)(F.lds + TE_OFF), ntl, 4, F.G, (int)blockIdx.x, (size_t)D * D, (size_t)256 * D, (size_t)D, F.lds + TBL_OFF, F.b2, D, 256, F.SLOTGATE}; \
        Epi11 E{F.YS}; pg8::gemm_phase<Epi11, SchedMoe, true, true>(F.lds, D, S, E); } while (0)
#define BODY12 p12_combine(F)
#define RUN(k) do { if (IN(k)) { BODY##k; if (PROBE_PH == (k)) { xcd_barrier(bar); BODY##k; } } SEAM(k); } while (0)
    RUN(0); RUN(1); RUN(2); RUN(4); RUN(5); RUN(6); RUN(7); RUN(8); RUN(9); RUN(10); RUN(11); RUN(12);
#undef IN
#undef SEAM
}

extern "C" void kernel_launch(void* const* d_in, const int* in_sizes, int n_in, void* d_out, int out_size, void* d_ws, size_t ws_size, hipStream_t stream) {
    static int grid = 0;
    if (grid == 0) {
        if (n_in != 25 || out_size != T * D || ws_size < WS_END) { fprintf(stderr, "kernel_launch: unexpected shapes (n_in %d, out %d, ws %zu)\n", n_in, out_size, ws_size); grid = -1; return; }
        int dev = 0, cus = 0, per_cu = 0;
        if (hipGetDevice(&dev) != hipSuccess || hipDeviceGetAttribute(&cus, hipDeviceAttributeMultiprocessorCount, dev) != hipSuccess) { grid = -1; return; }
        if (hipFuncSetAttribute((const void*)mk_fwd, hipFuncAttributeMaxDynamicSharedMemorySize, LDS_BYTES) != hipSuccess) { fprintf(stderr, "kernel_launch: hipFuncSetAttribute failed\n"); grid = -1; return; }
        if (hipOccupancyMaxActiveBlocksPerMultiprocessor(&per_cu, (const void*)mk_fwd, 512, LDS_BYTES) != hipSuccess || per_cu < 1) { fprintf(stderr, "kernel_launch: occupancy query says %d\n", per_cu); }
        (void)hipGetLastError();
        grid = cus;
    }
    if (grid < 0) return;
    (void)hipMemsetAsync((char*)d_ws + WS_CTL, 0, CTL_ZERO_BYTES, stream);
    Args a{};
    for (int i = 0; i < 25; ++i) a.in[i] = (const float*)d_in[i];
    a.out = (float*)d_out; a.ws = (unsigned char*)d_ws;
#if MK_SPLIT
    for (int p = 0; p < NPHASE; ++p) { a.ph_lo = p; a.ph_hi = p + 1; hipLaunchKernelGGL(mk_fwd, dim3(grid), dim3(512), LDS_BYTES, stream, a); }
#else
    a.ph_lo = 0; a.ph_hi = NPHASE; hipLaunchKernelGGL(mk_fwd, dim3(grid), dim3(512), LDS_BYTES, stream, a);
#endif
}
```

```cpp
#include <hip/hip_runtime.h>
#include <cstdio>
#include <cstdint>

#ifndef MK_SPLIT
#define MK_SPLIT 0
#endif

#ifndef PROBE_PH
#define PROBE_TRANS 0
#define PROBE_PH -1
#endif

#define GAS __attribute__((address_space(1)))
#define LAS __attribute__((address_space(3)))
typedef unsigned short bf16;
typedef unsigned v4u __attribute__((ext_vector_type(4)));
typedef unsigned v2u __attribute__((ext_vector_type(2)));
typedef float f32x4 __attribute__((ext_vector_type(4)));
typedef float f32x2 __attribute__((ext_vector_type(2)));
typedef short bf16x8 __attribute__((ext_vector_type(8)));
typedef short s16x4 __attribute__((ext_vector_type(4)));
#define RLX_AGENT __ATOMIC_RELAXED, __HIP_MEMORY_SCOPE_AGENT
#define LDS_WAIT() asm volatile("s_waitcnt lgkmcnt(0)" ::: "memory")
#define VM_WAIT() asm volatile("s_waitcnt vmcnt(0)" ::: "memory")

__device__ __forceinline__ unsigned f2bf(float f) { unsigned u = __builtin_bit_cast(unsigned, f); return (u + 0x7fffu + ((u >> 16) & 1u)) >> 16; }
typedef __bf16 nbf16x2 __attribute__((ext_vector_type(2)));
__device__ __forceinline__ unsigned pk2(float lo, float hi) { const f32x2 v = {lo, hi}; return __builtin_bit_cast(unsigned, __builtin_convertvector(v, nbf16x2)); }
constexpr float A2SCALE = 4.f;
constexpr float YOSCALE = 16.f;
constexpr float STSCALE = 32.f;
constexpr float YSCALE = 8.f;
constexpr float ASCALE = 4.f;
constexpr float WSCALE = 32.f;
__device__ __forceinline__ unsigned pk4_fp8(float a, float b, float c, float d) { int r = __builtin_amdgcn_cvt_pk_fp8_f32(a, b, 0, false); r = __builtin_amdgcn_cvt_pk_fp8_f32(c, d, r, true); return (unsigned)r; }
__device__ __forceinline__ float bflo(unsigned w) { return __builtin_bit_cast(float, w << 16); }
__device__ __forceinline__ float bfhi(unsigned w) { return __builtin_bit_cast(float, w & 0xffff0000u); }
__device__ __forceinline__ float silu_f(float v) { return v * __builtin_amdgcn_rcpf(1.f + __builtin_amdgcn_exp2f(-1.44269504f * v)); }
template <int CTRL> __device__ __forceinline__ float dpp_f(float v) { return __builtin_bit_cast(float, __builtin_amdgcn_update_dpp(0, __builtin_bit_cast(int, v), CTRL, 0xF, 0xF, false)); }
template <int CTRL> __device__ __forceinline__ int dpp_i(int v) { return __builtin_amdgcn_update_dpp(0, v, CTRL, 0xF, 0xF, false); }
constexpr int DPP_XOR1 = 0xB1  , DPP_XOR2 = 0x4E  , DPP_HMIRROR = 0x141  , DPP_MIRROR = 0x140  ;
__device__ __forceinline__ float wave_sum(float v) {
    v += dpp_f<DPP_XOR1>(v); v += dpp_f<DPP_XOR2>(v); v += dpp_f<DPP_HMIRROR>(v); v += dpp_f<DPP_MIRROR>(v);
    { const unsigned b = __builtin_bit_cast(unsigned, v); const auto r = __builtin_amdgcn_permlane16_swap(b, b, false, false); v = __builtin_bit_cast(float, (unsigned)r[0]) + __builtin_bit_cast(float, (unsigned)r[1]); }
    { const unsigned b = __builtin_bit_cast(unsigned, v); const auto r = __builtin_amdgcn_permlane32_swap(b, b, false, false); v = __builtin_bit_cast(float, (unsigned)r[0]) + __builtin_bit_cast(float, (unsigned)r[1]); }
    return v;
}

constexpr int D = 1024, NB = 8, SEQ = 4096, CTXL = 256, T = NB * SEQ, TC = NB * CTXL, RTOT = T + TC;
constexpr int CONV_CH = 2560, SSD_W = 1536, NH = 24, HDIM = 64, NGRP = 4, HPG = 6, NST = 128, CHUNK = 128;
constexpr int NCC = (CTXL + SEQ) / CHUNK;
constexpr int IN_COLS = 4656, N1 = 4864;
constexpr int NE = 32, TOPK = 4, DFF = 1024;
constexpr int MAX_TILES = (T * TOPK) / 256 + NE;
constexpr int MAX_SLOTS = MAX_TILES * 256;
constexpr float RMS_EPS = 1e-6f;

constexpr size_t MiB = 1u << 20;
constexpr size_t WS_CTL = 0, CTL_ZERO_BYTES = 32 * 1024;
constexpr size_t WS_MOD = 1 * MiB;
constexpr size_t WS_TOPE = 2 * MiB, WS_TOPG = WS_TOPE + 512 * 1024, WS_TOPR = WS_TOPG + 512 * 1024, WS_TOKSLOT = WS_TOPR + 512 * 1024;
constexpr size_t WS_SLOTTOK = 4 * MiB, WS_SLOTGATE = WS_SLOTTOK + 576 * 1024, WS_BB = WS_SLOTGATE + 576 * 1024, WS_CHS = WS_BB + 64 * 1024, WS_SLOTID = WS_CHS + 64 * 1024;
constexpr size_t WS_DTRAW = 6 * MiB;
constexpr size_t WS_ROWID = 21 * MiB + 512 * 1024;
constexpr size_t WS_DT = 15 * MiB;
constexpr size_t WS_ROWSC = 22 * MiB;
constexpr size_t WS_WINT = 32 * MiB, WS_WOUTT = 42 * MiB, WS_W1T = 46 * MiB, WS_W2T = 174 * MiB;
constexpr size_t WS_A = 240 * MiB;
constexpr size_t WS_A1 = WS_A, WS_CC = WS_A, WS_XBCPRE = WS_A + 68 * MiB, WS_Z = WS_A + 238 * MiB, WS_V = WS_A + 334 * MiB, WS_XBC = WS_A;
constexpr size_t WS_ST = WS_A + 366 * MiB, WS_Y = WS_A + 570 * MiB, WS_YB = WS_A + 666 * MiB;
constexpr size_t WS_A2 = WS_XBCPRE, WS_X1 = WS_A + 366 * MiB, WS_H2 = WS_A + 494 * MiB, WS_ACT = WS_A, WS_YS = WS_A + 494 * MiB;
constexpr size_t WS_END = WS_A + 766 * MiB;
static_assert(WS_END <= 1024 * MiB, "workspace map");
static_assert((size_t)RTOT * D * 2 <= 68 * MiB && (size_t)RTOT * CONV_CH * 2 <= 170 * MiB && (size_t)MAX_SLOTS * D * 2 <= 272 * MiB, "workspace map sizes");
static_assert((size_t)NB * NCC * NH * 2 * 8192 * 2 <= 204 * MiB, "ST size");
constexpr int CW_TMO = 0, CW_GCOUNT = 64  , CW_MODFLAG = 128, CW_BAR = 4096;

constexpr int LDS_BYTES = 163840;
constexpr int MISC_OFF = LDS_BYTES - 256;
constexpr int TE_OFF = 131072;
constexpr int MOE_CNT_OFF = TE_OFF + 4096;
constexpr int TBL_OFF = TE_OFF + 8192;

__device__ __forceinline__ int hw_lane_id() { int l; asm volatile("v_mbcnt_lo_u32_b32 %0, -1, 0\n\tv_mbcnt_hi_u32_b32 %0, -1, %0" : "=v"(l)); return l; }
namespace pg8 {
constexpr int BM = 256, BK = 64, HALF = 128, HTB = HALF * BK * 2, STAGE_BYTES = 8 * HTB, NXCD = 8, WGM = 8;
__host__ __device__ __forceinline__ int lds_byte(int r, int c) { const int st = (r >> 4) * 2 + (c >> 5), rr = r & 15, cc = c & 31, ob = rr * 64 + cc * 2; return st * 1024 + (ob ^ (((ob >> 9) & 1) << 5)); }
__host__ __device__ __forceinline__ void stage_rc(int b, int& R, int& C) { const int st = b / 1024, sb = b % 1024, swz = sb ^ (((sb >> 9) & 1) << 5); R = (st >> 1) * 16 + swz / 64; C = (st & 1) * 32 + (swz % 64) / 2; }
__host__ __device__ __forceinline__ int perm32(int rho) { const int n = rho >> 4, i = rho & 15; return 8 * (i >> 2) + 4 * n + (i & 3); }
struct Unit { int pm, pn, e; };
__device__ __forceinline__ unsigned cvt_pk_bf16(float lo, float hi) { unsigned r; asm volatile("v_cvt_pk_bf16_f32 %0, %1, %2" : "=v"(r) : "v"(lo), "v"(hi)); return r; }

__device__ __forceinline__ void static_map(int wgid, int nM, int nN, int& pm, int& pn) {
    const int nwg = nM * nN;
    { const int q = nwg / NXCD, r = nwg % NXCD, xcd = wgid % NXCD, off = wgid / NXCD; wgid = (xcd < r ? xcd * (q + 1) : r * (q + 1) + (xcd - r) * q) + off; }
    const int nig = WGM * nN, gid = wgid / nig, fm = gid * WGM, gsz = (nM - fm) < WGM ? (nM - fm) : WGM;
    pm = fm + ((wgid % nig) % gsz); pn = (wgid % nig) / gsz;
}

typedef int i32x8 __attribute__((ext_vector_type(8)));
typedef int v4i_t __attribute__((ext_vector_type(4)));
template <class Epi, class Sched, bool GATHER, bool FP8 = false, bool ALIGN_EPI = true>
__device__ __forceinline__ void gemm_phase(LAS unsigned char* lds, const int K, const Sched& S, const Epi& E, const int wave_index) {
    const int wid = wave_index, lane = hw_lane_id(), tid = wid * 64 + lane;
    const int wr = wid >> 2, wc = wid & 3, fr = lane & 15, fq = lane >> 4;
    constexpr int ES = FP8 ? 1 : 2, KOFF = FP8 ? 16 : 1024;
    const int nt = K / (FP8 ? 2 * BK : BK);
    unsigned voffB[2]; int RA[2], CA[2];
#pragma unroll
    for (int i = 0; i < 2; ++i) { int R, C; stage_rc(tid * 16 + i * 8192, R, C); const int Rb = Epi::PERM ? ((R & ~31) + perm32(R & 31)) : R;
        RA[i] = R; CA[i] = C; voffB[i] = (unsigned)(Rb * K * ES + C * 2); }
    const size_t kstep = (size_t)(BK * 2);
    const size_t hstep = (size_t)HALF * K * ES;
    const unsigned ldsw = (unsigned)wid * 1024u;
    const int aoff = lds_byte(wr * 64 + fr, fq * (FP8 ? 16 : 8)), boff = lds_byte(wc * 32 + fr, fq * (FP8 ? 16 : 8));
#define PG8_SA(b, h) (((b) * 2 + (h)) * HTB)
#define PG8_SB(b, h) ((4 + (b) * 2 + (h)) * HTB)
#define PG8_STAGE(bufoff, gbase, voff) do { _Pragma("unroll") for (int _i = 0; _i < 2; ++_i) \
        __builtin_amdgcn_global_load_lds((const unsigned*)((const char*)(gbase) + (voff)[_i]), (LAS unsigned*)(lds + (bufoff) + ldsw + _i * 8192), 16, 0, 0); } while (0)
#define PG8_LDA(dst, b, h) do { _Pragma("unroll") for (int m = 0; m < 4; ++m) _Pragma("unroll") for (int k = 0; k < 2; ++k) dst[m][k] = *(const LAS bf16x8*)(lds + PG8_SA(b, h) + aoff + m * 2048 + k * KOFF); } while (0)
#define PG8_LDB(dst, b, h) do { _Pragma("unroll") for (int n = 0; n < 2; ++n) _Pragma("unroll") for (int k = 0; k < 2; ++k) dst[n][k] = *(const LAS bf16x8*)(lds + PG8_SB(b, h) + boff + n * 2048 + k * KOFF); } while (0)
#define PG8_CAT(lo, hi) __builtin_shufflevector(__builtin_bit_cast(v4i_t, lo), __builtin_bit_cast(v4i_t, hi), 0, 1, 2, 3, 4, 5, 6, 7)
#define PG8_MMA(ai, bj, At, Bt) do { __builtin_amdgcn_s_setprio(1); \
        if constexpr (FP8) { _Pragma("unroll") for (int m = 0; m < 4; ++m) _Pragma("unroll") for (int n = 0; n < 2; ++n) \
            acc[ai][bj][m][n] = __builtin_amdgcn_mfma_scale_f32_16x16x128_f8f6f4(PG8_CAT(Bt[n][0], Bt[n][1]), PG8_CAT(At[m][0], At[m][1]), acc[ai][bj][m][n], 0, 0, 0, 0x7f7f7f7f, 0, 0x7f7f7f7f); } \
        else { _Pragma("unroll") for (int m = 0; m < 4; ++m) _Pragma("unroll") for (int n = 0; n < 2; ++n) _Pragma("unroll") for (int k = 0; k < 2; ++k) \
            acc[ai][bj][m][n] = __builtin_amdgcn_mfma_f32_16x16x32_bf16(Bt[n][k], At[m][k], acc[ai][bj][m][n], 0, 0, 0); } \
        __builtin_amdgcn_s_setprio(0); } while (0)
#define PG8_WAIT_V(n) asm volatile("s_waitcnt vmcnt(" #n ")" ::: "memory")
#define PG8_WAIT_L(n) asm volatile("s_waitcnt lgkmcnt(" #n ")" ::: "memory")
#define PG8_BAR __builtin_amdgcn_s_barrier()
#define PG8_SCHED __builtin_amdgcn_sched_barrier(0)
#define PG8_AOFFS(U, dst) do { \
        if constexpr (GATHER) { int t_ = tid, R_, C_; asm volatile("" : "+v"(t_)); stage_rc(t_ * 16, R_, C_);     \
            const int* st_ = S.row_table(U) + R_; _Pragma("unroll") for (int _h = 0; _h < 2; ++_h) _Pragma("unroll") for (int _i = 0; _i < 2; ++_i) \
            dst[_h][_i] = (unsigned)st_[_h * HALF + _i * 64] * (unsigned)(K * ES) + (unsigned)(C_ * 2); } \
        else { _Pragma("unroll") for (int _h = 0; _h < 2; ++_h) _Pragma("unroll") for (int _i = 0; _i < 2; ++_i) dst[_h][_i] = (unsigned)((_h * HALF + RA[_i]) * K * ES + CA[_i] * 2); } } while (0)
#define PG8_AOFFS_NEXT(dst) do { if constexpr (Sched::TBL) { int t_ = tid, R_, C_; asm volatile("" : "+v"(t_)); stage_rc(t_ * 16, R_, C_); \
            const unsigned la_ = (unsigned)(size_t)(S.tb + ((ui + 1) % 3) * 1024) + (unsigned)R_ * 4u; unsigned r0_, r1_, r2_, r3_; \
            asm volatile("ds_read_b32 %0, %4\n\tds_read_b32 %1, %4 offset:256\n\tds_read_b32 %2, %4 offset:512\n\tds_read_b32 %3, %4 offset:768\n\ts_waitcnt lgkmcnt(0)" \
                         : "=&v"(r0_), "=&v"(r1_), "=&v"(r2_), "=&v"(r3_) : "v"(la_) : "memory"); \
            dst[0][0] = r0_ * (unsigned)(K * ES) + (unsigned)(C_ * 2); dst[0][1] = r1_ * (unsigned)(K * ES) + (unsigned)(C_ * 2); \
            dst[1][0] = r2_ * (unsigned)(K * ES) + (unsigned)(C_ * 2); dst[1][1] = r3_ * (unsigned)(K * ES) + (unsigned)(C_ * 2); } else { PG8_AOFFS(nxt, dst); } } while (0)
    Unit cur, nxt; int ui = 0;
    if (!S.next(0, cur)) return;
    f32x4 acc[2][2][4][2];
#pragma unroll
    for (int a = 0; a < 2; ++a)
#pragma unroll
        for (int b = 0; b < 2; ++b)
#pragma unroll
            for (int m = 0; m < 4; ++m)
#pragma unroll
                for (int n = 0; n < 2; ++n) acc[a][b][m][n] = (f32x4){0.f, 0.f, 0.f, 0.f};
    bf16x8 At[4][2], B0[2][2], B1[2][2];
    unsigned oc[2][2];
    const char* cA = S.a_base(cur); const char* cB = S.b_base(cur);
    PG8_AOFFS(cur, oc);
#define PG8_TABLES(U, buf) do { if constexpr (Sched::TBL) { LAS unsigned char* tb_ = S.tb + (buf) * 1024;   const int lane = hw_lane_id();   \
        if (wid < 4) { __builtin_amdgcn_global_load_lds((const unsigned*)(S.tab0(U) + 64 * wid + lane), (LAS unsigned*)(tb_ + wid * 256), 4, 0, 0); \
            if (S.tab2(U)) __builtin_amdgcn_global_load_lds((const unsigned*)(S.tab2(U) + 64 * wid + lane), (LAS unsigned*)(tb_ + 6144 + wid * 256), 4, 0, 0); } \
        else { __builtin_amdgcn_global_load_lds((const unsigned*)(S.tab1(U) + 64 * (wid - 4) + lane), (LAS unsigned*)(tb_ + 3072 + (wid - 4) * 256), 4, 0, 0); } } } while (0)
    PG8_TABLES(cur, 0);
    PG8_STAGE(PG8_SB(0, 0), cB, voffB); PG8_STAGE(PG8_SB(0, 1), cB + hstep, voffB); PG8_STAGE(PG8_SA(0, 0), cA, oc[0]); PG8_STAGE(PG8_SA(0, 1), cA, oc[1]);
    if (wr == 1) PG8_BAR;
    PG8_WAIT_V(2); PG8_BAR;
    PG8_STAGE(PG8_SB(1, 0), cB + kstep, voffB); PG8_STAGE(PG8_SA(1, 0), cA + kstep, oc[0]); PG8_STAGE(PG8_SB(1, 1), cB + hstep + kstep, voffB);
    PG8_WAIT_V(6); PG8_BAR;
    for (;;) {
        const bool has_next = S.next(ui + 1, nxt);
        const char* nA = has_next ? S.a_base(nxt) : cA; const char* nB = has_next ? S.b_base(nxt) : cB;
        if (has_next) { PG8_TABLES(nxt, (ui + 1) % 3); }
        for (int t = 0; t < nt; t += 2) {
            const bool last = (t == nt - 2);
            const char* a1 = cA + (size_t)(t + 1) * kstep;
            const char* a2 = last ? nA : cA + (size_t)(t + 2) * kstep; const char* b2 = last ? nB : cB + (size_t)(t + 2) * kstep;
            const char* a3 = a2 + kstep; const char* b3 = b2 + kstep;
            PG8_LDB(B0, 0, 0); PG8_LDB(B1, 0, 1); PG8_SCHED; PG8_LDA(At, 0, 0); PG8_STAGE(PG8_SA(1, 1), a1, oc[1]);
            PG8_WAIT_V(8); PG8_WAIT_L(0); PG8_BAR; PG8_MMA(0, 0, At, B0); PG8_MMA(0, 1, At, B1); PG8_BAR; PG8_SCHED;
            if (last && has_next) { PG8_AOFFS_NEXT(oc); }
            PG8_LDA(At, 0, 1); PG8_STAGE(PG8_SB(0, 0), b2, voffB); PG8_STAGE(PG8_SB(0, 1), b2 + hstep, voffB); PG8_STAGE(PG8_SA(0, 0), a2, oc[0]);
            PG8_WAIT_V(8); PG8_WAIT_L(0); PG8_BAR; PG8_MMA(1, 0, At, B0); PG8_MMA(1, 1, At, B1); PG8_BAR; PG8_SCHED;
            PG8_LDB(B0, 1, 0); PG8_LDB(B1, 1, 1); PG8_SCHED; PG8_LDA(At, 1, 0); PG8_STAGE(PG8_SA(0, 1), a2, oc[1]);
            PG8_WAIT_V(8); PG8_WAIT_L(0); PG8_BAR; PG8_MMA(0, 0, At, B0); PG8_MMA(0, 1, At, B1); PG8_BAR; PG8_SCHED;
            PG8_LDA(At, 1, 1); PG8_STAGE(PG8_SB(1, 0), b3, voffB); PG8_STAGE(PG8_SB(1, 1), b3 + hstep, voffB); PG8_STAGE(PG8_SA(1, 0), a3, oc[0]);
            PG8_WAIT_V(8); PG8_WAIT_L(0); PG8_BAR; PG8_MMA(1, 0, At, B0); PG8_MMA(1, 1, At, B1); PG8_BAR; PG8_SCHED;
        }
        if constexpr (ALIGN_EPI) { if (wr == 0) PG8_BAR; }
        if constexpr (Sched::TBL) E(acc, cur, wr, wc, fr, fq, S.tb + (ui % 3) * 1024); else E(acc, cur, wr, wc, fr, fq);
        if (!has_next) break;
#pragma unroll
        for (int a = 0; a < 2; ++a)
#pragma unroll
            for (int b = 0; b < 2; ++b)
#pragma unroll
                for (int m = 0; m < 4; ++m)
#pragma unroll
                    for (int n = 0; n < 2; ++n) acc[a][b][m][n] = (f32x4){0.f, 0.f, 0.f, 0.f};
        cur = nxt; cA = nA; cB = nB; ++ui;
        if constexpr (ALIGN_EPI) { if (wr == 1) PG8_BAR; }
    }
    PG8_WAIT_V(0);
    if constexpr (!ALIGN_EPI) { if (wr == 0) PG8_BAR; }
    PG8_BAR;
#undef PG8_SA
#undef PG8_SB
#undef PG8_STAGE
#undef PG8_LDA
#undef PG8_LDB
#undef PG8_MMA
#undef PG8_WAIT_V
#undef PG8_WAIT_L
#undef PG8_BAR
#undef PG8_SCHED
#undef PG8_AOFFS
#undef PG8_AOFFS_NEXT
#undef PG8_TABLES
#undef PG8_CAT
}
}

#define XB_TMO      128
#define XB_XCNT(j)  (256  + 64 * (j))
#define XB_XSUB(j)  (1280 + 64 * (j))
#define XB_XGEN(j)  (2304 + 64 * (j))
#define XB_TOP      3328
#define XB_TOPGEN   3392
#define XCD_BAR_WORDS 3456
#define XB_SPIN_CAP (1u << 18)
__device__ __forceinline__ unsigned xb_ld(unsigned* p)              { return __hip_atomic_load(p, __ATOMIC_RELAXED, __HIP_MEMORY_SCOPE_AGENT); }
__device__ __forceinline__ unsigned xb_add(unsigned* p, unsigned v) { return __hip_atomic_fetch_add(p, v, __ATOMIC_RELAXED, __HIP_MEMORY_SCOPE_AGENT); }
__device__ __forceinline__ unsigned xb_xcc_id() { return (unsigned)__builtin_amdgcn_s_getreg((3 << 11) | 20) & 0xFu; }
#define XB_SPIN(cond, bar) do { unsigned _sp = 0; while (cond) { __builtin_amdgcn_s_sleep(1); \
    if ((++_sp & 255u) == 0u) { if (xb_ld(&(bar)[XB_TMO])) break; if (_sp > XB_SPIN_CAP) { atomicAdd(&(bar)[XB_TMO], 1u); break; } } } } while (0)
struct XcdBarrier { unsigned* bar; unsigned x; volatile LAS unsigned* st; int wave; };
__device__ __forceinline__ XcdBarrier xcd_barrier_post(unsigned* bar, volatile LAS unsigned* st, int wave) {
    XcdBarrier b; b.bar = bar; b.x = xb_xcc_id(); b.st = st; b.wave = wave;
    if (wave == 0 && hw_lane_id() == 0) (void)xb_add(&bar[XB_XCNT(b.x)], 1u);
    return b;
}
__device__ __forceinline__ void xcd_barrier_complete(unsigned* bar, unsigned x, unsigned& nloc, unsigned& nx) {
    const unsigned G = gridDim.x * gridDim.y * gridDim.z;
    unsigned sum, cnt, mine, sp = 0u;
    for (;;) {
        sum = 0u; cnt = 0u; mine = 0u;
#pragma unroll
        for (unsigned j = 0; j < 16; ++j) { const unsigned c = xb_ld(&bar[XB_XCNT(j)]); sum += c; cnt += (c > 0u) ? 1u : 0u; mine = (j == x) ? c : mine; }
        if (sum == G) break;
        __builtin_amdgcn_s_sleep(1);
        if ((++sp & 255u) == 0u) { if (xb_ld(&bar[XB_TMO])) break; if (sp > XB_SPIN_CAP) { atomicAdd(&bar[XB_TMO], 1u); break; } }
    }
    nloc = mine > 0u ? mine : 1u; nx = cnt > 0u ? cnt : 1u;
}
__device__ __forceinline__ void xcd_barrier(const XcdBarrier& b) {
    asm volatile("s_waitcnt vmcnt(0)" ::: "memory");
    __syncthreads();
    if (b.wave == 0 && hw_lane_id() == 0) {
        unsigned* bar = b.bar;
        __builtin_amdgcn_s_waitcnt(0);
        unsigned nloc = b.st[0], nx = b.st[1];
        if (nloc == 0u) { xcd_barrier_complete(bar, b.x, nloc, nx); b.st[0] = nloc; b.st[1] = nx; }
        const unsigned old = xb_add(&bar[XB_XSUB(b.x)], 1u);
        const unsigned gen = old / nloc;
        if (old + 1u == (gen + 1u) * nloc) {
            __builtin_amdgcn_fence(__ATOMIC_RELEASE, "agent");
            asm volatile("s_waitcnt vmcnt(0)" ::: "memory");
            const unsigned og = xb_add(&bar[XB_TOP], 1u);
            const unsigned tg = og / nx;
            if (og + 1u == (tg + 1u) * nx) xb_add(&bar[XB_TOPGEN], 1u);
            else XB_SPIN(xb_ld(&bar[XB_TOPGEN]) == tg, bar);
            __builtin_amdgcn_fence(__ATOMIC_ACQUIRE, "agent");
            xb_add(&bar[XB_XGEN(b.x)], 1u);
            asm volatile("s_waitcnt vmcnt(0)" ::: "memory");
        } else {
            const unsigned pos = old - gen * nloc;
            if (pos == 0u || pos == (3u * nloc) / 4u) { __builtin_amdgcn_fence(__ATOMIC_RELEASE, "agent"); asm volatile("s_waitcnt vmcnt(0)" ::: "memory"); }
            XB_SPIN(xb_ld(&bar[XB_XGEN(b.x)]) == gen, bar);
            __builtin_amdgcn_fence(__ATOMIC_ACQUIRE, "agent");
            asm volatile("s_waitcnt vmcnt(0)" ::: "memory");
        }
    }
    __syncthreads();
}

struct Frame {
    LAS unsigned char* lds;
    unsigned* ctl;
    int wave, G;
    __device__ __forceinline__ int lane_() const { return hw_lane_id(); }
    __device__ __forceinline__ int tid_() const { return wave * 64 + hw_lane_id(); }
    const float *x, *c, *ctx, *c_ctx, *w_mod, *b_mod, *norm1_w, *norm2_w, *w_in, *conv_w, *conv_b, *dt_bias, *a_log, *d_skip, *ssd_norm_w, *pool_w, *pool_scale, *w_out, *router_w, *router_b, *w1, *b1, *w2, *b2, *final_norm_w;
    float* out;
    float *MOD, *DTRAW, *DT, *ROWSC, *CHS, *TOPG, *SLOTGATE;
    bf16* X1;
    int *TOPE, *TOPR, *TOKSLOT, *SLOTTOK, *SLOTID, *ROWID, *BB;
    bf16 *WINT, *WOUTT, *W1T, *W2T, *A1, *XBCPRE, *Z, *V, *XBC, *CC, *ST, *Y, *YB, *A2, *H2, *ACT, *YS;
};

template <class RowMap>
__device__ __forceinline__ void p0_emit(bf16* WT, int Kd, RowMap rm, int k0, int n0, int nvalid, LAS float* scr, int lane) {
    const int c = lane & 7;
#pragma unroll
    for (int j = 0; j < 4; ++j) { const int n = (lane >> 3) + 8 * j; const LAS float* s = scr + (8 * c) * 33 + n;
        v4u o; o.x = pk2(s[0 * 33], s[1 * 33]); o.y = pk2(s[2 * 33], s[3 * 33]); o.z = pk2(s[4 * 33], s[5 * 33]); o.w = pk2(s[6 * 33], s[7 * 33]);
        if (n0 + n < nvalid) *(v4u*)(WT + (size_t)rm(n0 + n) * Kd + k0 + 8 * c) = o; }
    LDS_WAIT(); asm volatile("" ::: "memory");
}
template <class RowMap>
__device__ __forceinline__ void p0_transpose_item(const float* W, int N, int nvalid, bf16* WT, int Kd, RowMap rm, LAS float* scr, int kb, int nb, int lane) {
    const int k0 = 64 * kb, n0 = 32 * nb, nn = n0 + (lane & 31); const bool ok = nn < nvalid;
    float tv[32];
#pragma unroll
    for (int i = 0; i < 32; ++i) { const int kk = 2 * i + (lane >> 5); tv[i] = ok ? W[(size_t)(k0 + kk) * N + nn] : 0.f; }
#pragma unroll
    for (int i = 0; i < 32; ++i) { const int kk = 2 * i + (lane >> 5); scr[kk * 33 + (lane & 31)] = tv[i]; }
    LDS_WAIT(); asm volatile("" ::: "memory");
    p0_emit(WT, Kd, rm, k0, n0, nvalid, scr, lane);
}
struct RmId { __device__ __forceinline__ int operator()(int n) const { return n; } };
struct RmOff { int off; __device__ __forceinline__ int operator()(int n) const { return n + off; } };
struct RmWin { __device__ __forceinline__ int operator()(int n) const { return n < 2560 ? n : (n < 2608 ? 4608 + (n - 2560) : 2560 + (n - 2608)); } };
struct RmW1 { __device__ __forceinline__ int operator()(int n) const { const int j = n >> 1; return 256 * (j >> 7) + 128 * (n & 1) + (j & 127); } };

constexpr int P0_I_WIN = 16 * 130, P0_I_WOUT = 32 * 32, P0_I_W1 = 32 * 16 * 64, P0_I_W2 = 32 * 16 * 32, P0_NI = P0_I_WIN + P0_I_WOUT + P0_I_W1 + P0_I_W2;
constexpr int P0_NMOVE = 16384;
template <class Deal>
__device__ __forceinline__ void p0_convert(Frame& F, const Deal& deal, int nrounds, int item_lo, int item_hi) {
    LAS float* scr = (LAS float*)(F.lds + F.wave * 16384);
    const int lane = F.lane_();
    constexpr int I_WIN = P0_I_WIN, I_WOUT = P0_I_WOUT, I_W1 = P0_I_W1;
    struct It { const float* src; bf16* dst; int N, nvalid, Kd, kind, k0, n0; };
#define P0_DECODE(it, I) do { int r_ = (it); \
        if (r_ < I_WIN) { I.src = F.w_in; I.dst = F.WINT; I.N = IN_COLS; I.nvalid = 4144; I.Kd = D; I.kind = 1; I.k0 = 64 * (r_ / 130); I.n0 = 32 * (r_ % 130); } \
        else if ((r_ -= I_WIN) < I_WOUT) { const int hf_ = r_ & 1, q_ = r_ >> 1; I.src = F.w_out; I.dst = F.WOUTT; I.N = D; I.nvalid = D; I.Kd = 2048; I.kind = 3; I.k0 = 64 * (2 * (q_ >> 5) + hf_); I.n0 = 32 * (q_ & 31); } \
        else if ((r_ -= I_WOUT) < I_W1) { const int hf_ = r_ & 1, p_ = r_ >> 1, e_ = p_ >> 9, q_ = p_ & 511; I.src = F.w1 + (size_t)e_ * D * 2048; I.dst = (bf16*)((unsigned char*)F.W1T + (size_t)e_ * 2048 * D); I.N = 2048; I.nvalid = 2048; I.Kd = D; I.kind = 2; I.k0 = 64 * (2 * (q_ >> 6) + hf_); I.n0 = 32 * (q_ & 63); } \
        else { r_ -= I_W1; const int hf_ = r_ & 1, p_ = r_ >> 1, e_ = p_ >> 8, q_ = p_ & 255; I.src = F.w2 + (size_t)e_ * D * D; I.dst = (bf16*)((unsigned char*)F.W2T + (size_t)e_ * D * D); I.N = D; I.nvalid = D; I.Kd = D; I.kind = 3; I.k0 = 64 * (2 * (q_ >> 5) + hf_); I.n0 = 32 * (q_ & 31); } } while (0)
#define P0_LOAD(I, tv) do { int nn_ = I.n0 + (lane & 31); nn_ = nn_ < I.nvalid ? nn_ : I.nvalid - 1; const float* sp_ = I.src + (size_t)(I.k0 + (lane >> 5)) * I.N + nn_; \
        _Pragma("unroll") for (int i_ = 0; i_ < 32; ++i_) { const float* q_ = sp_ + (size_t)(2 * i_) * I.N; asm volatile("global_load_dword %0, %1, off nt" : "=v"(tv[i_]) : "v"(q_) : "memory"); } } while (0)
#define P0_NEXT(itv) do { itv = -1; for (; kr < nrounds && itv < 0; ++kr) { const int it_ = deal(kr); if (it_ >= item_lo && it_ < item_hi) itv = it_; } } while (0)
#define P0_PROCESS(I, tv) do { \
        _Pragma("unroll") for (int i = 0; i < 32; ++i) { const int kk = 2 * i + (lane >> 5); scr[kk * 33 + (lane & 31)] = tv[i]; } \
        LDS_WAIT(); asm volatile("" ::: "memory"); \
        { const int c = lane & 7; \
          _Pragma("unroll") for (int j = 0; j < 4; ++j) { const int n = (lane >> 3) + 8 * j; const LAS float* sq = scr + (8 * c) * 33 + n; \
            const int ng = I.n0 + n; const int row = (I.kind == 0 || I.kind == 3) ? ng : (I.kind == 1 ? RmWin{}(ng) : RmW1{}(ng)); \
            if (I.kind >= 2) { v2u o; o.x = pk4_fp8(sq[0 * 33] * WSCALE, sq[1 * 33] * WSCALE, sq[2 * 33] * WSCALE, sq[3 * 33] * WSCALE); o.y = pk4_fp8(sq[4 * 33] * WSCALE, sq[5 * 33] * WSCALE, sq[6 * 33] * WSCALE, sq[7 * 33] * WSCALE); \
                *(v2u*)((unsigned char*)I.dst + (size_t)row * I.Kd + I.k0 + 8 * c) = o; } \
            else { v4u o; o.x = pk2(sq[0 * 33], sq[1 * 33]); o.y = pk2(sq[2 * 33], sq[3 * 33]); o.z = pk2(sq[4 * 33], sq[5 * 33]); o.w = pk2(sq[6 * 33], sq[7 * 33]); \
                if (ng < I.nvalid) *(v4u*)(I.dst + (size_t)row * I.Kd + I.k0 + 8 * c) = o; } } \
          LDS_WAIT(); asm volatile("" ::: "memory"); } } while (0)
    It ia{}, ib{}; float ta[32], tb[32]; int ita = -1, itb = -1; int kr = 0;
    P0_NEXT(ita);
    if (ita >= 0) { P0_DECODE(ita, ia); P0_LOAD(ia, ta); }
    while (ita >= 0) {
        P0_NEXT(itb);
        if (itb >= 0) { P0_DECODE(itb, ib); P0_LOAD(ib, tb); asm volatile("s_waitcnt vmcnt(32)" ::: "memory"); } else { asm volatile("s_waitcnt vmcnt(0)" ::: "memory"); }
        __builtin_amdgcn_sched_barrier(0);
        P0_PROCESS(ia, ta);
        if (itb < 0) break;
        P0_NEXT(ita);
        if (ita >= 0) { P0_DECODE(ita, ia); P0_LOAD(ia, ta); asm volatile("s_waitcnt vmcnt(32)" ::: "memory"); } else { asm volatile("s_waitcnt vmcnt(0)" ::: "memory"); }
        __builtin_amdgcn_sched_barrier(0);
        P0_PROCESS(ib, tb);
    }
#undef P0_NEXT
#undef P0_PROCESS
#undef P0_DECODE
#undef P0_LOAD
}
__device__ __forceinline__ void p0_prologue(Frame& F) {
    if ((int)blockIdx.x < 96) {
        LAS float* sc = (LAS float*)F.lds;
        LAS float* part = (LAS float*)(F.lds + 36864);
        for (int idx = F.tid_(); idx < 9 * 1024; idx += 512) { const int r = idx >> 10, k = idx & 1023; const float v = (r < 8) ? F.c[r * 1024 + k] : F.c_ctx[k]; sc[idx] = silu_f(v); }
        __syncthreads();
        const int n = 64 * (int)blockIdx.x + F.lane_(), kb = 128 * F.wave;
        float acc[9];
#pragma unroll
        for (int r = 0; r < 9; ++r) acc[r] = 0.f;
#define P0_GL(w, k0) do { _Pragma("unroll") for (int j = 0; j < 32; ++j) w[j] = __builtin_nontemporal_load(F.w_mod + (size_t)(kb + (k0) + j) * 6144 + n); } while (0)
#define P0_GF(w, k0) do { _Pragma("unroll") for (int j = 0; j < 32; ++j) { _Pragma("unroll") for (int r = 0; r < 9; ++r) acc[r] += sc[r * 1024 + kb + (k0) + j] * w[j]; } } while (0)
        float wa[32], wb[32];
        P0_GL(wa, 0); __builtin_amdgcn_sched_barrier(0);
        P0_GL(wb, 32); __builtin_amdgcn_sched_barrier(0);
        P0_GF(wa, 0); __builtin_amdgcn_sched_barrier(0);
        P0_GL(wa, 64); __builtin_amdgcn_sched_barrier(0);
        P0_GF(wb, 32); __builtin_amdgcn_sched_barrier(0);
        P0_GL(wb, 96); __builtin_amdgcn_sched_barrier(0);
        P0_GF(wa, 64); __builtin_amdgcn_sched_barrier(0);
        P0_GF(wb, 96);
#undef P0_GL
#undef P0_GF
#pragma unroll
        for (int r = 0; r < 9; ++r) part[(F.wave * 9 + r) * 64 + F.lane_()] = acc[r];
        __syncthreads();
        for (int idx = F.tid_(); idx < 9 * 64; idx += 512) { const int r = idx >> 6, col = idx & 63; float s = 0.f;
#pragma unroll
            for (int w = 0; w < 8; ++w) s += part[(w * 9 + r) * 64 + col];
            F.MOD[r * 6144 + 64 * (int)blockIdx.x + col] = s + F.b_mod[64 * (int)blockIdx.x + col]; }
        __builtin_amdgcn_fence(__ATOMIC_RELEASE, "agent");
        __syncthreads();
        if (F.wave == 0 && hw_lane_id() == 0) (void)__hip_atomic_fetch_add(F.ctl + CW_MODFLAG, 1u, RLX_AGENT);
    }
    LAS float* scr = (LAS float*)(F.lds + F.wave * 16384);
    const int gw = (int)blockIdx.x * 8 + F.wave, NGW = F.G * 8, lane = F.lane_();
    constexpr int I_POOL = 16 * 4 * 4, I_PAD = N1 - IN_COLS;
    for (int r = NGW - 1 - gw; r < I_POOL + I_PAD; r += NGW) {
        if (r < I_POOL) {
            const int kb = r >> 4, g = (r >> 2) & 3, ob = r & 3, k = 64 * kb + lane, o0 = 32 * ob;
            float acc[32];
#pragma unroll
            for (int o = 0; o < 32; ++o) acc[o] = 0.f;
            const float* arow = F.w_in + (size_t)k * IN_COLS + 4144 + g * 128;
            for (int i = 0; i < 128; ++i) { const float a = arow[i]; const float* pw = F.pool_w + (size_t)(g * 128 + i) * 128 + o0;
#pragma unroll
                for (int o = 0; o < 32; ++o) acc[o] += a * pw[o]; }
#pragma unroll
            for (int o = 0; o < 32; ++o) scr[lane * 33 + o] = acc[o] * F.pool_scale[g * 128 + o0 + o];
            LDS_WAIT(); asm volatile("" ::: "memory");
            p0_emit(F.WINT, D, RmOff{4096 + g * 128}, 64 * kb, o0, 1 << 30, scr, lane);
        } else { v4u z = {0u, 0u, 0u, 0u}; v4u* p = (v4u*)(F.WINT + (size_t)(IN_COLS + (r - I_POOL)) * D); p[lane] = z; p[lane + 64] = z; }
    }
    for (int i = (int)blockIdx.x * 512 + F.tid_(); i < T; i += F.G * 512) F.ROWID[i] = i;
    const bool wdeal = (F.G == 256);
    const int blk = (int)blockIdx.x;
    constexpr int R1 = 18, R2 = 18, R3 = 18;
    static_assert(R1 * 2048 + (R2 - R1) * 1280 + (R3 - R2) * 816 >= P0_NI - P0_NMOVE, "weighted dealing covers the items");
    auto deal = [=](int k) -> int { return wdeal ? (k < R1 ? 2 * ((k >> 1) * 2048 + gw) + (k & 1) : (k < R2 ? (blk >= 96 ? 2 * (R1 * 1024 + ((k - R1) >> 1) * 1280 + (gw - 768)) + (k & 1) : -1) : (k < R3 ? ((blk >= 96 && blk < 198) ? 2 * (R1 * 1024 + (R2 - R1) * 640 + ((k - R2) >> 1) * 816 + (gw - 768)) + (k & 1) : -1) : -1))) : 2 * ((k >> 1) * NGW + gw) + (k & 1); };
    p0_convert(F, deal, wdeal ? R3 : 2 * ((P0_NI / 2 + NGW - 1) / NGW), 0, wdeal ? P0_NI - P0_NMOVE : P0_NI);
}

__device__ __forceinline__ void p1_norm1(Frame& F) {
    const int gw = (int)blockIdx.x * 8 + F.wave, NGW = F.G * 8;
    if (F.wave == 0 && hw_lane_id() == 0) { unsigned sp = 0;
        while (__hip_atomic_load(F.ctl + CW_MODFLAG, RLX_AGENT) < 96u) { __builtin_amdgcn_s_sleep(1); if (++sp > (1u << 22)) break; } }
    __syncthreads();
    __builtin_amdgcn_fence(__ATOMIC_ACQUIRE, "agent");
#define P1_LOAD(v, rb) do { _Pragma("unroll") for (int k = 0; k < 4; ++k) { const float* xr = F.x + (size_t)((rb) + k) * D; \
        _Pragma("unroll") for (int j = 0; j < 4; ++j) v[k][j] = __builtin_nontemporal_load((const f32x4*)(xr + 4 * lane + 256 * j)); } } while (0)
#define P1_ROW(vr, r) do { float ss = 0.f; \
            _Pragma("unroll") for (int j = 0; j < 4; ++j) ss += (vr[j].x * vr[j].x + vr[j].y * vr[j].y) + (vr[j].z * vr[j].z + vr[j].w * vr[j].w); \
            const float rs = __builtin_amdgcn_rsqf(wave_sum(ss) * (1.f / D) + RMS_EPS); \
            _Pragma("unroll") for (int j = 0; j < 4; ++j) { const int col = 4 * lane + 256 * j; \
                const f32x4 h = (vr[j] * rs) * wsc[j] + shv[j]; \
                v2u o; o.x = pk2(h.x, h.y); o.y = pk2(h.z, h.w); \
                *(v2u*)(F.A1 + (size_t)(r) * D + col) = o; } } while (0)
#define P1_MOD(mb) do { const float* mod = F.MOD + (size_t)(mb) * 6144; \
        _Pragma("unroll") for (int j = 0; j < 4; ++j) { const int col = 4 * lane + 256 * j; wsc[j] = *(const f32x4*)(F.norm1_w + col) * (*(const f32x4*)(mod + 1024 + col) + 1.f); shv[j] = *(const f32x4*)(mod + col); } } while (0)
#define P1_SB __builtin_amdgcn_sched_barrier(0)
    for (int blk = gw; blk < T / 16; blk += NGW) {
        const int rb = blk * 16, lane = hw_lane_id();
        const bool has_ctx = blk < RTOT - T;
        f32x4 wsc[4], shv[4], va[4][4], vb[4][4], vc[4], nw[4], m1[4];
        { const float* mod = F.MOD + (size_t)(rb >> 12) * 6144;
#pragma unroll
          for (int j = 0; j < 4; ++j) { const int col = 4 * lane + 256 * j; nw[j] = *(const f32x4*)(F.norm1_w + col); m1[j] = *(const f32x4*)(mod + 1024 + col); shv[j] = *(const f32x4*)(mod + col); } }
        P1_SB;
        P1_LOAD(va, rb);
        P1_SB;
#pragma unroll
        for (int j = 0; j < 4; ++j) wsc[j] = nw[j] * (m1[j] + 1.f);
        P1_SB;
        P1_LOAD(vb, rb + 4);
        P1_SB;
#pragma unroll
        for (int k = 0; k < 4; ++k) P1_ROW(va[k], rb + k);
        P1_SB;
        P1_LOAD(va, rb + 8);
        P1_SB;
#pragma unroll
        for (int k = 0; k < 4; ++k) P1_ROW(vb[k], rb + 4 + k);
        P1_SB;
        P1_LOAD(vb, rb + 12);
        P1_SB;
#pragma unroll
        for (int k = 0; k < 4; ++k) P1_ROW(va[k], rb + 8 + k);
        P1_SB;
        if (has_ctx) { const float* mod = F.MOD + (size_t)8 * 6144;
#pragma unroll
            for (int j = 0; j < 4; ++j) { const int col = 4 * lane + 256 * j; vc[j] = __builtin_nontemporal_load((const f32x4*)(F.ctx + (size_t)blk * D + col)); va[1][j] = *(const f32x4*)(F.norm1_w + col); va[2][j] = *(const f32x4*)(mod + 1024 + col); va[0][j] = *(const f32x4*)(mod + col); } }
        P1_SB;
#pragma unroll
        for (int k = 0; k < 4; ++k) P1_ROW(vb[k], rb + 12 + k);
        if (has_ctx) {
#pragma unroll
            for (int j = 0; j < 4; ++j) { wsc[j] = va[1][j] * (va[2][j] + 1.f); shv[j] = va[0][j]; }
            P1_ROW(vc, T + blk); }
    }
#undef P1_SB
#undef P1_LOAD
#undef P1_ROW
#undef P1_MOD
}

struct Sched1 {   static constexpr bool TBL = false;
    const char* A; const char* Bt; int G, c;
    __device__ __forceinline__ bool next(int i, pg8::Unit& u) const {
        const int L = i * G + c; if (L >= 2432 + 88) return false;
        if (L < 2432) pg8::static_map(L, 128, 19, u.pm, u.pn);
        else { const int Lc = L - 2432, j = Lc >> 3; u.pm = 128 + (Lc & 7); u.pn = j < 10 ? j : 18; }
        u.e = 0; return true; }
    __device__ __forceinline__ const char* a_base(const pg8::Unit& u) const { return A + (size_t)u.pm * 256 * D * 2; }
    __device__ __forceinline__ const char* b_base(const pg8::Unit& u) const { return Bt + (size_t)u.pn * 256 * D * 2; }
    __device__ __forceinline__ const int* row_table(const pg8::Unit&) const { return nullptr; }
};
struct Epi1 {
    static constexpr bool PERM = true;
    bf16 *XBCPRE, *Z, *V; float* DTRAW;
    __device__ __forceinline__ void operator()(const f32x4 (&acc)[2][2][4][2], const pg8::Unit& u, int wr, int wc, int fr, int fq) const {
        const int row0 = u.pm * 256 + wr * 64 + fr;
        if (u.pn < 18) {
            bf16* base; int ldc, colt;
            if (u.pn < 10) { base = XBCPRE; ldc = CONV_CH; colt = u.pn * 256; } else if (u.pn < 16) { base = Z; ldc = SSD_W; colt = (u.pn - 10) * 256; } else { base = V; ldc = 512; colt = (u.pn - 16) * 256; }
            const int col0 = colt + wc * 32 + 8 * fq;
#pragma unroll
            for (int ai = 0; ai < 2; ++ai)
#pragma unroll
                for (int m = 0; m < 4; ++m) { bf16* rowp = base + (size_t)(row0 + ai * 128 + m * 16) * ldc + col0;
#pragma unroll
                    for (int bj = 0; bj < 2; ++bj) { const f32x4 v0 = acc[ai][bj][m][0], v1 = acc[ai][bj][m][1];
                        v4u w; w.x = pg8::cvt_pk_bf16(v0[0], v0[1]); w.y = pg8::cvt_pk_bf16(v0[2], v0[3]); w.z = pg8::cvt_pk_bf16(v1[0], v1[1]); w.w = pg8::cvt_pk_bf16(v1[2], v1[3]);
                        if (u.pn < 10) *(v4u*)(rowp + bj * 128) = w; else __builtin_nontemporal_store(w, (v4u*)(rowp + bj * 128)); } }
        } else if (wc < 2) {
            const int col0 = wc * 32 + 8 * fq;
#pragma unroll
            for (int ai = 0; ai < 2; ++ai)
#pragma unroll
                for (int m = 0; m < 4; ++m) { float* rowp = DTRAW + (size_t)(row0 + ai * 128 + m * 16) * 64 + col0;
                    *(f32x4*)(rowp) = acc[ai][0][m][0]; *(f32x4*)(rowp + 4) = acc[ai][0][m][1]; }
        }
    }
};

__device__ __forceinline__ bf16x8 frag_row(const LAS unsigned char* base, int rs, int row, int k0, int q) { return *(const LAS bf16x8*)(base + row * rs + (k0 + 8 * q) * 2); }
__device__ __forceinline__ bf16x8 frag_tr(const LAS unsigned char* base, int rs, int k0, int c0, int lane) {
    const int g = lane >> 4, qq = (lane & 15) >> 2, p = lane & 3;
    const LAS unsigned char* a = base + (k0 + 8 * g + qq) * rs + c0 * 2 + 8 * p;
    const s16x4 lo = __builtin_amdgcn_ds_read_tr16_b64_v4i16((LAS s16x4*)a);
    const s16x4 hi = __builtin_amdgcn_ds_read_tr16_b64_v4i16((LAS s16x4*)(a + 4 * rs));
    bf16x8 r; r[0] = lo[0]; r[1] = lo[1]; r[2] = lo[2]; r[3] = lo[3]; r[4] = hi[0]; r[5] = hi[1]; r[6] = hi[2]; r[7] = hi[3]; return r;
}
__device__ __forceinline__ f32x4 mfma16(bf16x8 a, bf16x8 b, f32x4 c) { return __builtin_amdgcn_mfma_f32_16x16x32_bf16(a, b, c, 0, 0, 0); }
template <int CTRL, int ROWMASK> __device__ __forceinline__ float dpp_f0(float v) { return __builtin_bit_cast(float, __builtin_amdgcn_update_dpp(0, __builtin_bit_cast(int, v), CTRL, ROWMASK, 0xF, true)); }
__device__ __forceinline__ float wave_incl_scan(float v, int lane) {
    (void)lane;
    v += dpp_f0<0x111, 0xF>(v); v += dpp_f0<0x112, 0xF>(v); v += dpp_f0<0x114, 0xF>(v); v += dpp_f0<0x118, 0xF>(v);
    v += dpp_f0<0x142, 0xA>(v); v += dpp_f0<0x143, 0xC>(v);
    return v;
}

__device__ __forceinline__ float silu_fast(float v) { return v * __builtin_amdgcn_rcpf(1.f + __builtin_amdgcn_exp2f(-1.44269504f * v)); }
__device__ __forceinline__ float softplus_f(float v) { return v > 20.f ? v : log1pf(__expf(v)); }
__device__ __forceinline__ void p4_scan(Frame& F, LAS float* Te, volatile LAS float* TOT, int d, int h, float raw0, float raw1, int lane, size_t chs_idx, float* rowsc) {
    const int s0 = d ? 127 - 2 * lane : 2 * lane, s1 = d ? s0 - 1 : s0 + 1;
    const float bias = F.dt_bias[d * NH + h];
    const float dt0 = softplus_f(raw0 + bias), dt1 = softplus_f(raw1 + bias);
    const float A2 = __expf(F.a_log[d * NH + h]) * 1.44269504f;
    const float a0 = -A2 * dt0, a1 = -A2 * dt1;
    const float incl = wave_incl_scan(a0 + a1, lane);
    const float c1 = incl, c0 = incl - a1, tot = __builtin_bit_cast(float, __builtin_amdgcn_readlane(__builtin_bit_cast(int, incl), 63));
    Te[d * 128 + s0] = c0; Te[d * 128 + s1] = c1;
    Te[(2 + d) * 128 + s0] = c0 - __builtin_amdgcn_logf(dt0); Te[(2 + d) * 128 + s1] = c1 - __builtin_amdgcn_logf(dt1);
    if (lane == 63) { F.CHS[chs_idx] = tot; *TOT = tot; }
    if (rowsc) { rowsc[s0] = __builtin_amdgcn_exp2f(c0); rowsc[s1] = __builtin_amdgcn_exp2f(c1); }
}
__device__ __forceinline__ v4u conv_piece(const v4u& r0, const v4u& r1, const v4u& r2, const v4u& r3, const v4u& r4, const float (&w)[5][8], const float (&bias)[8]) {
    float o[8];
#pragma unroll
    for (int e = 0; e < 8; ++e) o[e] = bias[e];
    const v4u rr[5] = {r0, r1, r2, r3, r4};
#pragma unroll
    for (int j = 0; j < 5; ++j) { const v4u q = rr[j];
        o[0] += w[j][0] * bflo(q.x); o[1] += w[j][1] * bfhi(q.x); o[2] += w[j][2] * bflo(q.y); o[3] += w[j][3] * bfhi(q.y);
        o[4] += w[j][4] * bflo(q.z); o[5] += w[j][5] * bfhi(q.z); o[6] += w[j][6] * bflo(q.w); o[7] += w[j][7] * bfhi(q.w); }
    v4u ov; ov.x = pk2(silu_fast(o[0]), silu_fast(o[1])); ov.y = pk2(silu_fast(o[2]), silu_fast(o[3])); ov.z = pk2(silu_fast(o[4]), silu_fast(o[5])); ov.w = pk2(silu_fast(o[6]), silu_fast(o[7]));
    return ov;
}
__device__ __forceinline__ void p4_states(Frame& F, const bf16x8 (&braw)[4], const LAS unsigned char* WGP, const LAS unsigned char* Xs, size_t st_base, int w, int lane) {
    constexpr int RSX = 144, RSB = 272;
    const int i16 = lane & 15, q4 = lane >> 4;
    f32x4 sa[2][4];
#pragma unroll
    for (int d = 0; d < 2; ++d)
#pragma unroll
        for (int pt = 0; pt < 4; ++pt) sa[d][pt] = (f32x4){0.f, 0.f, 0.f, 0.f};
#pragma unroll
    for (int ks = 0; ks < 4; ++ks) {
        __builtin_amdgcn_sched_barrier(0);
        bf16x8 xf[4];
#pragma unroll
        for (int pt = 0; pt < 4; ++pt) xf[pt] = frag_tr(Xs, RSX, 32 * ks, 16 * pt, lane);
        const LAS unsigned char* wp = WGP + (32 * ks + 8 * q4) * RSB;
        f32x2 w2[8];
#pragma unroll
        for (int j = 0; j < 8; ++j) w2[j] = *(const LAS f32x2*)(wp + j * RSB);
        const v4u bu = __builtin_bit_cast(v4u, braw[ks]);
#pragma unroll
        for (int d = 0; d < 2; ++d) { v4u su;
            su.x = pk2(bflo(bu.x) * w2[0][d], bfhi(bu.x) * w2[1][d]); su.y = pk2(bflo(bu.y) * w2[2][d], bfhi(bu.y) * w2[3][d]);
            su.z = pk2(bflo(bu.z) * w2[4][d], bfhi(bu.z) * w2[5][d]); su.w = pk2(bflo(bu.w) * w2[6][d], bfhi(bu.w) * w2[7][d]);
            const bf16x8 bs = __builtin_bit_cast(bf16x8, su);
#pragma unroll
            for (int pt = 0; pt < 4; ++pt) sa[d][pt] = mfma16(bs, xf[pt], sa[d][pt]); } }
#pragma unroll
    for (int d = 0; d < 2; ++d) {
        unsigned char* sp = (unsigned char*)F.ST + st_base + ((size_t)d * HDIM + i16) * NST + 16 * w + 4 * q4;
#pragma unroll
        for (int pt = 0; pt < 4; ++pt) { float c[4];
#pragma unroll
            for (int r = 0; r < 4; ++r) c[r] = fminf(fmaxf(sa[d][pt][r] * STSCALE, -440.f), 440.f);
            *(unsigned*)(sp + (size_t)16 * pt * NST) = pk4_fp8(c[0], c[1], c[2], c[3]); }
    }
}
__device__ __forceinline__ void p4_stage_cw(Frame& F, const int g) {
    constexpr int O_CW = 153600;
    LAS float* CW = (LAS float*)(F.lds + O_CW);
    volatile LAS float* DSK = (volatile LAS float*)(F.lds + MISC_OFF + 128);
    const int tid = F.tid_();
    if (tid < HPG) DSK[tid] = F.d_skip[g * HPG + tid];
    float cwv[5];
#pragma unroll
    for (int q = 0; q < 5; ++q) { int idx = tid + 512 * q; idx = idx < HPG * 6 * 64 ? idx : HPG * 6 * 64 - 1; const int e_ = idx / 384, rem = idx - e_ * 384, j = rem >> 6, chl = rem & 63; const int ch = (g * HPG + e_) * HDIM + chl;
        const int jj = j < 5 ? j : 0; const float a = F.conv_w[jj * CONV_CH + ch], bq = F.conv_b[ch]; cwv[q] = (j < 5) ? a : bq; }
#pragma unroll
    for (int q = 0; q < 5; ++q) { const int idx = tid + 512 * q; if (idx < HPG * 6 * 64) CW[idx] = cwv[q]; }
}
__device__ __forceinline__ void p4_ssd_local(Frame& F, const int g_prestaged) {
    constexpr int RS = 272, RSX = 144;
    constexpr int O_C = 0, O_B = 34816, O_M = 69632, O_X = 104448  , O_T = 141312  , O_CW = 153600  ;
    static_assert(O_CW + 9216 <= MISC_OFF, "P4 LDS map");
    LAS unsigned char* L = F.lds;
    LAS float* TAB = (LAS float*)(L + O_T);
    LAS float* CW = (LAS float*)(L + O_CW);
    volatile LAS float* TOT = (volatile LAS float*)(L + MISC_OFF + 64);
    volatile LAS float* DSK = (volatile LAS float*)(L + MISC_OFF + 128);
    const int tid = F.tid_(), w = F.wave;
    const int lb = 64 * (w & 1), sb = 32 * (w >> 1);
    const v4u zero4 = {0u, 0u, 0u, 0u};
    constexpr int NLAT = NB * 32 * NGRP, NCTX = NB * 2 * NGRP * HPG;
    int g_staged = g_prestaged;
    for (int v = (int)blockIdx.x; v < NLAT + NCTX; v += F.G) {
        const bool lat = v < NLAT;
        int tid_l = tid; asm volatile("" : "+v"(tid_l));
        const int lane_l = tid_l & 63, lane = lane_l, i16 = lane & 15, q4 = lane >> 4;
        const int p32 = tid_l & 31, rg = tid_l >> 5;
        const int xpc = tid_l & 7, rg2 = tid_l >> 3;
        int b, g, cc, r0, e_lo, e_hi; bool lo_ok, hi_ok;
        if (lat) { b = v >> 7; const int c = (v >> 2) & 31; g = v & 3; cc = c + 2; r0 = b * SEQ + c * CHUNK; lo_ok = c > 0; hi_ok = c < 31; e_lo = 0; e_hi = HPG; }
        else { const int q = v - NLAT; const int e = q % HPG; int t = q / HPG; g = t & 3; t >>= 2; cc = t & 1; b = t >> 1; r0 = T + b * CTXL + cc * CHUNK; lo_ok = cc > 0; hi_ok = cc < 1; e_lo = e; e_hi = e + 1; }
        const int rmin = lo_ok ? -2 : 0, rmax = hi_ok ? 129 : 127;
        const int chBC = SSD_W + (p32 >> 4) * (NGRP * NST) + g * NST + 8 * (p32 & 15);
        v4u raw[12];
#pragma unroll
        for (int j = 0; j < 12; ++j) { const int rr = 8 * rg - 2 + j; const int rc = rr < rmin ? rmin : (rr > rmax ? rmax : rr);
            const v4u t = __builtin_nontemporal_load((const v4u*)(F.XBCPRE + (size_t)(r0 + rc) * CONV_CH + chBC)); raw[j] = (rr == rc) ? t : zero4; }
        if (g != g_staged) { p4_stage_cw(F, g); g_staged = g; }
        {
            float cw[5][8], cbias[8];
#pragma unroll
            for (int j = 0; j < 5; ++j) { const f32x4 a = *(const f32x4*)(F.conv_w + j * CONV_CH + chBC), bq = *(const f32x4*)(F.conv_w + j * CONV_CH + chBC + 4);
                cw[j][0] = a.x; cw[j][1] = a.y; cw[j][2] = a.z; cw[j][3] = a.w; cw[j][4] = bq.x; cw[j][5] = bq.y; cw[j][6] = bq.z; cw[j][7] = bq.w; }
            { const f32x4 a = *(const f32x4*)(F.conv_b + chBC), bq = *(const f32x4*)(F.conv_b + chBC + 4); cbias[0] = a.x; cbias[1] = a.y; cbias[2] = a.z; cbias[3] = a.w; cbias[4] = bq.x; cbias[5] = bq.y; cbias[6] = bq.z; cbias[7] = bq.w; }
            LAS unsigned char* dst = L + ((p32 >> 4) ? O_C : O_B) + (8 * rg) * RS + (p32 & 15) * 16;
#pragma unroll
            for (int i = 0; i < 8; ++i) { const v4u o = conv_piece(raw[i], raw[i + 1], raw[i + 2], raw[i + 3], raw[i + 4], cw, cbias);
                *(LAS v4u*)(dst + i * RS) = o;
                if (lat && (p32 >> 4)) *(v4u*)(F.CC + (size_t)(r0 + 8 * rg + i) * 512 + g * NST + 8 * (p32 & 15)) = o; }
        }
        v4u xraw[6];
#pragma unroll
        for (int j = 0; j < 6; ++j) { const int rr = 2 * rg2 - 2 + j; const int rc = rr < rmin ? rmin : (rr > rmax ? rmax : rr);
            xraw[j] = __builtin_nontemporal_load((const v4u*)(F.XBCPRE + (size_t)(r0 + rc) * CONV_CH + (g * HPG + e_lo) * HDIM + 8 * xpc)); }
        float pdt[2][2];
#pragma unroll
        for (int ii = 0; ii < 2; ++ii) { const int idx = (w + 8 * ii) < 12 ? (w + 8 * ii) : 11; const int e_ = idx % 6, d_ = idx / 6, h_ = g * HPG + e_; const int s0 = d_ ? 127 - 2 * lane_l : 2 * lane_l, s1 = d_ ? s0 - 1 : s0 + 1;
            pdt[ii][0] = F.DTRAW[(size_t)(r0 + s0) * 64 + d_ * NH + h_]; pdt[ii][1] = F.DTRAW[(size_t)(r0 + s1) * 64 + d_ * NH + h_]; }
#pragma unroll
        for (int ii = 0; ii < 2; ++ii) { const int idx = w + 8 * ii; const int e = idx % 6, d = idx / 6, h = g * HPG + e;
            if (idx < 12 && e >= e_lo && e < e_hi)
                p4_scan(F, TAB + e * 512, TOT + e * 2 + d, d, h, pdt[ii][0], pdt[ii][1], lane_l, ((size_t)(b * NCC + cc) * NH + h) * 2 + d, lat ? F.ROWSC + ((size_t)(b * 2 + d) * NH + h) * SEQ + (cc - 2) * CHUNK : nullptr); }
        __syncthreads();
        f32x4 cb[2][4];
        if (lat) {
#pragma unroll
            for (int ts = 0; ts < 2; ++ts)
#pragma unroll
                for (int tl = 0; tl < 4; ++tl) cb[ts][tl] = (f32x4){0.f, 0.f, 0.f, 0.f};
#pragma unroll
            for (int ks = 0; ks < 4; ++ks) { bf16x8 af[2], bfr[4];
#pragma unroll
                for (int ts = 0; ts < 2; ++ts) af[ts] = frag_row(L + O_B, RS, sb + 16 * ts + i16, 32 * ks, q4);
#pragma unroll
                for (int tl = 0; tl < 4; ++tl) bfr[tl] = frag_row(L + O_C, RS, lb + 16 * tl + i16, 32 * ks, q4);
#pragma unroll
                for (int ts = 0; ts < 2; ++ts)
#pragma unroll
                    for (int tl = 0; tl < 4; ++tl) cb[ts][tl] = mfma16(af[ts], bfr[tl], cb[ts][tl]); }
        }
        bf16x8 braw[4];
#pragma unroll
        for (int ks = 0; ks < 4; ++ks) braw[ks] = frag_tr(L + O_B, RS, 32 * ks, 16 * w, lane);
        for (int e = e_lo; e < e_hi; ++e) {
            const int h = g * HPG + e;
            const LAS float* Te = TAB + e * 512;
            LAS unsigned char* Xs = L + O_X + (e & 1) * 18432;
            LAS unsigned char* Ms = L + ((e & 1) ? O_C : O_M);
            if (w < 4) { const int t_ = w * 64 + hw_lane_id(), d_ = w >> 1, s_ = t_ & 127;
                *(LAS float*)(L + O_B + s_ * RS + 256 + 8 * (e & 1) + 4 * d_) = __builtin_amdgcn_exp2f(TOT[e * 2 + d_] - Te[(2 + d_) * 128 + s_]); }
            {
                const LAS float* cwp = CW + (e * 6) * 64 + 8 * xpc;
#pragma unroll
                for (int i = 0; i < 2; ++i) {
                    f32x4 oa = *(const LAS f32x4*)(cwp + 5 * 64), ob = *(const LAS f32x4*)(cwp + 5 * 64 + 4);
#pragma unroll
                    for (int j = 0; j < 5; ++j) { const f32x4 wa = *(const LAS f32x4*)(cwp + j * 64), wb = *(const LAS f32x4*)(cwp + j * 64 + 4);
                        const int rr = 2 * rg2 - 2 + i + j; const v4u q = (rr >= rmin && rr <= rmax) ? xraw[i + j] : zero4;
                        oa.x += wa.x * bflo(q.x); oa.y += wa.y * bfhi(q.x); oa.z += wa.z * bflo(q.y); oa.w += wa.w * bfhi(q.y);
                        ob.x += wb.x * bflo(q.z); ob.y += wb.y * bfhi(q.z); ob.z += wb.z * bflo(q.w); ob.w += wb.w * bfhi(q.w); }
                    v4u ov; ov.x = pk2(silu_fast(oa.x), silu_fast(oa.y)); ov.y = pk2(silu_fast(oa.z), silu_fast(oa.w)); ov.z = pk2(silu_fast(ob.x), silu_fast(ob.y)); ov.w = pk2(silu_fast(ob.z), silu_fast(ob.w));
                    *(LAS v4u*)(Xs + (2 * rg2 + i) * RSX + xpc * 16) = ov; }
            }
            if (e + 1 < e_hi) {
#pragma unroll
                for (int j = 0; j < 6; ++j) { const int rr = 2 * rg2 - 2 + j; const int rc = rr < rmin ? rmin : (rr > rmax ? rmax : rr);
                    xraw[j] = __builtin_nontemporal_load((const v4u*)(F.XBCPRE + (size_t)(r0 + rc) * CONV_CH + (h + 1) * HDIM + 8 * xpc)); }
            }
            if (lat) {
                const float Dh = DSK[e];
                f32x4 acsv[2], rbsv[2]; float afv[4], rbv[4];
#pragma unroll
                for (int ts = 0; ts < 2; ++ts) { const int s0 = sb + 16 * ts + 4 * q4; acsv[ts] = *(const LAS f32x4*)(Te + 256 + s0); rbsv[ts] = *(const LAS f32x4*)(Te + 384 + s0); }
#pragma unroll
                for (int tl = 0; tl < 4; ++tl) { const int l = lb + 16 * tl + i16; afv[tl] = Te[l]; rbv[tl] = Te[128 + l]; }
#pragma unroll
                for (int tl = 0; tl < 4; ++tl) { const int l = lb + 16 * tl + i16; const int lt_abs = 4 * (w & 1) + tl; const float af_l = afv[tl], rb_l = rbv[tl];
#pragma unroll
                    for (int ts = 0; ts < 2; ++ts) { const int s0 = sb + 16 * ts + 4 * q4; const int st_abs = 2 * (w >> 1) + ts;
                        float m[4];
                        if (st_abs < lt_abs) {
                            const f32x4 acs = acsv[ts];
#pragma unroll
                            for (int r = 0; r < 4; ++r) m[r] = cb[ts][tl][r] * __builtin_amdgcn_exp2f(af_l - acs[r]);
                        } else if (st_abs > lt_abs) {
                            const f32x4 rbs = rbsv[ts];
#pragma unroll
                            for (int r = 0; r < 4; ++r) m[r] = cb[ts][tl][r] * __builtin_amdgcn_exp2f(rb_l - rbs[r]);
                        } else {
                            const f32x4 acs = acsv[ts], rbs = rbsv[ts];
#pragma unroll
                            for (int r = 0; r < 4; ++r) { const int sidx = s0 + r;
                                const float wf = (sidx <= l) ? __builtin_amdgcn_exp2f(af_l - acs[r]) : 0.f;
                                const float wb = (sidx >= l) ? __builtin_amdgcn_exp2f(rb_l - rbs[r]) : 0.f;
                                m[r] = cb[ts][tl][r] * (wf + wb) + ((sidx == l) ? Dh : 0.f); }
                        }
                        v2u o; o.x = pk2(m[0], m[1]); o.y = pk2(m[2], m[3]);
                        *(LAS v2u*)(Ms + l * RS + s0 * 2) = o; } }
            }
            __syncthreads();
            if (lat) {
                f32x4 ya[4];
#pragma unroll
                for (int pt = 0; pt < 4; ++pt) ya[pt] = (f32x4){0.f, 0.f, 0.f, 0.f};
#pragma unroll
                for (int ks = 0; ks < 4; ++ks) { const bf16x8 bm = frag_row(Ms, RS, 16 * w + i16, 32 * ks, q4);
#pragma unroll
                    for (int pt = 0; pt < 4; ++pt) ya[pt] = mfma16(frag_tr(Xs, RSX, 32 * ks, 16 * pt, lane), bm, ya[pt]); }
                bf16* yp = F.Y + (size_t)(r0 + 16 * w + i16) * SSD_W + h * HDIM + 4 * q4;
#pragma unroll
                for (int pt = 0; pt < 4; ++pt) { v2u o; o.x = pk2(ya[pt][0], ya[pt][1]); o.y = pk2(ya[pt][2], ya[pt][3]); *(v2u*)(yp + 16 * pt) = o; }
            }
            p4_states(F, braw, L + O_B + 256 + 8 * (e & 1), Xs, (((size_t)(b * NCC + cc) * NH + h) * 2) * HDIM * NST, w, lane);
        }
        __syncthreads();
    }
}

__device__ __forceinline__ void pool_grid_row(Frame& F, int gr) {
    LAS unsigned char* L = F.lds;
    const int tid = F.tid_(), rb = gr * 64;
    v4u pv[8];
#pragma unroll
    for (int k = 0; k < 8; ++k) { const int pc = tid + 512 * k, row = pc >> 6, ch = pc & 63; pv[k] = *(const v4u*)(F.V + (size_t)(rb + row) * 512 + ch * 8); }
#pragma unroll
    for (int k = 0; k < 8; ++k) { const int pc = tid + 512 * k, row = pc >> 6, ch = pc & 63; *(LAS v4u*)(L + row * 1024 + ch * 16) = pv[k]; }
    __syncthreads();
    {
        const int cg = tid & 63, tb = tid >> 6, hw = 1 << (cg >> 4);
        const LAS unsigned char* colp = L + cg * 16;
#pragma unroll 2
        for (int tt = 0; tt < 8; ++tt) { const int t = tb * 8 + tt; const int lo = t - hw < 0 ? 0 : t - hw, hi = t + hw > 64 ? 64 : t + hw;
            float sacc[8];
#pragma unroll
            for (int e = 0; e < 8; ++e) sacc[e] = 0.f;
            for (int q = lo; q < hi; ++q) { const v4u x = *(const LAS v4u*)(colp + q * 1024);
                sacc[0] += bflo(x.x); sacc[1] += bfhi(x.x); sacc[2] += bflo(x.y); sacc[3] += bfhi(x.y); sacc[4] += bflo(x.z); sacc[5] += bfhi(x.z); sacc[6] += bflo(x.w); sacc[7] += bfhi(x.w); }
            const v4u x = *(const LAS v4u*)(colp + t * 1024); const float inv = 1.f / (float)(hi - lo);
            float q[8] = {sacc[0] * inv - bflo(x.x), sacc[1] * inv - bfhi(x.x), sacc[2] * inv - bflo(x.y), sacc[3] * inv - bfhi(x.y), sacc[4] * inv - bflo(x.z), sacc[5] * inv - bfhi(x.z), sacc[6] * inv - bflo(x.w), sacc[7] * inv - bfhi(x.w)};
#pragma unroll
            for (int e = 0; e < 8; ++e) q[e] = fminf(fmaxf(q[e] * A2SCALE, -440.f), 440.f);
            v2u o; o.x = pk4_fp8(q[0], q[1], q[2], q[3]); o.y = pk4_fp8(q[4], q[5], q[6], q[7]);
            *(v2u*)((unsigned char*)F.A2 + (size_t)(rb + t) * 2048 + SSD_W + cg * 8) = o; }
    }
    __syncthreads();
}
__device__ __forceinline__ void p5_ssd_scan(Frame& F) {
    constexpr int RS = 272, O_RS = 4 * 34816;
    LAS unsigned char* L = F.lds;
    LAS float* RSB = (LAS float*)(L + O_RS);
    const int tid = F.tid_(), lane = F.lane_(), w = F.wave, i16 = lane & 15, q4 = lane >> 4;
    const int d = w >> 2, ps = w & 3, t8 = tid & 255;
    if (F.G == 256 && (int)blockIdx.x >= NB * NH) {
        for (int gr = (int)blockIdx.x - NB * NH; gr < T / 64; gr += F.G - NB * NH) pool_grid_row(F, gr);
        { const int sw = ((int)blockIdx.x - NB * NH) * 8 + F.wave, nsw = (F.G - NB * NH) * 8;
          auto deal2 = [=](int k) -> int { return P0_NI - P0_NMOVE + 2 * ((k >> 1) * nsw + sw) + (k & 1); };
          p0_convert(F, deal2, 2 * ((P0_NMOVE / 2 + nsw - 1) / nsw), P0_NI - P0_NMOVE, P0_NI); }
        return;
    }
    for (int u = (int)blockIdx.x; u < NB * NH; u += F.G) {
        const int b = u / NH, h = u - b * NH, g = h / HPG;
        float S[32];
#pragma unroll
        for (int k = 0; k < 32; ++k) S[k] = 0.f;
        v4u creg[8]; float rsreg = 0.f;
#pragma unroll
        for (int k = 0; k < 8; ++k) creg[k] = (v4u){0u, 0u, 0u, 0u};
        for (int j = 0; j < NCC; ++j) {
            const int cc = d == 0 ? j : (j < 2 ? 1 - j : 35 - j);
            LAS unsigned char* Cb = L + ((j & 1) * 2 + d) * 34816;
            if (j >= 2) {
#pragma unroll
                for (int k = 0; k < 8; ++k) { const int pc = t8 + 256 * k, row = pc >> 4, ch = pc & 15; *(LAS v4u*)(Cb + row * RS + ch * 16) = creg[k]; }
                if (t8 < 128) RSB[((j & 1) * 2 + d) * 128 + t8] = rsreg;
            }
            __syncthreads();
            if (j + 1 >= 2 && j + 1 < NCC) {
                const int cn = d == 0 ? j + 1 : 34 - j;
                const size_t rown = (size_t)b * SEQ + (size_t)(cn - 2) * CHUNK;
#pragma unroll
                for (int k = 0; k < 8; ++k) { const int pc = t8 + 256 * k, row = pc >> 4, ch = pc & 15; creg[k] = *(const v4u*)(F.CC + (rown + row) * 512 + g * NST + ch * 8); }
                if (t8 < 128) rsreg = F.ROWSC[((size_t)(b * 2 + d) * NH + h) * SEQ + (cn - 2) * CHUNK + t8];
            }
            const size_t sidx = ((size_t)(b * NCC + cc) * NH + h) * 2 + d;
            const unsigned char* stp = (const unsigned char*)F.ST + (sidx * HDIM + 16 * ps + i16) * NST + 8 * q4;
            v2u stv[4];
#pragma unroll
            for (int ks = 0; ks < 4; ++ks) stv[ks] = __builtin_nontemporal_load((const v2u*)(stp + 32 * ks));
            const float decay = __builtin_amdgcn_exp2f(F.CHS[sidx]);
            if (j >= 2) {
                bf16x8 sf[4];
#pragma unroll
                for (int ks = 0; ks < 4; ++ks) { v4u t; t.x = pk2(S[ks * 8 + 0], S[ks * 8 + 1]); t.y = pk2(S[ks * 8 + 2], S[ks * 8 + 3]); t.z = pk2(S[ks * 8 + 4], S[ks * 8 + 5]); t.w = pk2(S[ks * 8 + 6], S[ks * 8 + 7]); sf[ks] = __builtin_bit_cast(bf16x8, t); }
                const size_t rowb = (size_t)b * SEQ + (size_t)(cc - 2) * CHUNK;
                const LAS float* rsl = RSB + ((j & 1) * 2 + d) * 128;
                const int c = cc - 2; const bool first = (d == 0) ? (c <= 15) : (c >= 16);
                unsigned yold[8];
                unsigned char* yo = (unsigned char*)F.YB + (rowb + i16) * SSD_W + h * HDIM + 16 * ps + 4 * q4;
                if (!first) {
#pragma unroll
                    for (int lt = 0; lt < 8; ++lt) yold[lt] = *(const unsigned*)(yo + (size_t)16 * lt * SSD_W);
                }
#pragma unroll
                for (int lt = 0; lt < 8; ++lt) {
                    f32x4 a = (f32x4){0.f, 0.f, 0.f, 0.f};
#pragma unroll
                    for (int ks = 0; ks < 4; ++ks) a = mfma16(sf[ks], frag_row(Cb, RS, 16 * lt + i16, 32 * ks, q4), a);
                    const float sc = rsl[16 * lt + i16] * (YOSCALE / STSCALE);
                    float o[4] = {a[0] * sc, a[1] * sc, a[2] * sc, a[3] * sc};
                    if (!first) { const f32x2 lo = __builtin_amdgcn_cvt_pk_f32_fp8((int)yold[lt], false), hi = __builtin_amdgcn_cvt_pk_f32_fp8((int)yold[lt], true); o[0] += lo.x; o[1] += lo.y; o[2] += hi.x; o[3] += hi.y; }
#pragma unroll
                    for (int r = 0; r < 4; ++r) o[r] = fminf(fmaxf(o[r], -440.f), 440.f);
                    *(unsigned*)(yo + (size_t)16 * lt * SSD_W) = pk4_fp8(o[0], o[1], o[2], o[3]);
                }
            }
#pragma unroll
            for (int ks = 0; ks < 4; ++ks) { const v2u t = stv[ks];
                const f32x2 a0 = __builtin_amdgcn_cvt_pk_f32_fp8((int)t.x, false), a1 = __builtin_amdgcn_cvt_pk_f32_fp8((int)t.x, true), a2 = __builtin_amdgcn_cvt_pk_f32_fp8((int)t.y, false), a3 = __builtin_amdgcn_cvt_pk_f32_fp8((int)t.y, true);
                S[ks * 8 + 0] = decay * S[ks * 8 + 0] + a0.x; S[ks * 8 + 1] = decay * S[ks * 8 + 1] + a0.y;
                S[ks * 8 + 2] = decay * S[ks * 8 + 2] + a1.x; S[ks * 8 + 3] = decay * S[ks * 8 + 3] + a1.y;
                S[ks * 8 + 4] = decay * S[ks * 8 + 4] + a2.x; S[ks * 8 + 5] = decay * S[ks * 8 + 5] + a2.y;
                S[ks * 8 + 6] = decay * S[ks * 8 + 6] + a3.x; S[ks * 8 + 7] = decay * S[ks * 8 + 7] + a3.y; }
        }
        __syncthreads();
    }
}

__device__ __forceinline__ void p6_gate_pool(Frame& F) {
    LAS unsigned char* L = F.lds;
    const int tid = F.tid_(), lane = F.lane_(), w = F.wave;
    f32x4 nw[3][2];
#pragma unroll
    for (int j = 0; j < 3; ++j) { const int col = 8 * (lane + 64 * j); nw[j][0] = *(const f32x4*)(F.ssd_norm_w + col) * A2SCALE; nw[j][1] = *(const f32x4*)(F.ssd_norm_w + col + 4) * A2SCALE; }
    for (int gr = (int)blockIdx.x; gr < T / 64; gr += F.G) {
        const int rb = gr * 64;
        if (F.G != 256) pool_grid_row(F, gr);
        for (int rr = 0; rr < 8; rr += 2) {
            v4u ya[2][3], zz[2][3]; v2u yb[2][3];
#pragma unroll
            for (int k = 0; k < 2; ++k) { const int r = rb + 8 * w + rr + k;
#pragma unroll
                for (int j = 0; j < 3; ++j) { const int col = 8 * (lane + 64 * j);
                    ya[k][j] = __builtin_nontemporal_load((const v4u*)(F.Y + (size_t)r * SSD_W + col)); yb[k][j] = __builtin_nontemporal_load((const v2u*)((const unsigned char*)F.YB + (size_t)r * SSD_W + col)); zz[k][j] = __builtin_nontemporal_load((const v4u*)(F.Z + (size_t)r * SSD_W + col)); } }
#pragma unroll
            for (int k = 0; k < 2; ++k) { const int r = rb + 8 * w + rr + k;
                float v[24]; float ss = 0.f;
#pragma unroll
                for (int j = 0; j < 3; ++j) {
                    const unsigned yaw[4] = {ya[k][j].x, ya[k][j].y, ya[k][j].z, ya[k][j].w}, zw[4] = {zz[k][j].x, zz[k][j].y, zz[k][j].z, zz[k][j].w};
                    const f32x2 yo2[4] = {__builtin_amdgcn_cvt_pk_f32_fp8((int)yb[k][j].x, false), __builtin_amdgcn_cvt_pk_f32_fp8((int)yb[k][j].x, true), __builtin_amdgcn_cvt_pk_f32_fp8((int)yb[k][j].y, false), __builtin_amdgcn_cvt_pk_f32_fp8((int)yb[k][j].y, true)};
#pragma unroll
                    for (int e = 0; e < 4; ++e) { const float y0 = bflo(yaw[e]) + yo2[e].x * (1.f / YOSCALE), y1 = bfhi(yaw[e]) + yo2[e].y * (1.f / YOSCALE);
                        const float g0 = y0 * silu_f(bflo(zw[e])), g1 = y1 * silu_f(bfhi(zw[e])); v[j * 8 + 2 * e] = g0; v[j * 8 + 2 * e + 1] = g1; ss += g0 * g0 + g1 * g1; } }
                const float rs = __builtin_amdgcn_rsqf(wave_sum(ss) * (1.f / SSD_W) + RMS_EPS);
#pragma unroll
                for (int j = 0; j < 3; ++j) { const int col = 8 * (lane + 64 * j);
                    const f32x4 w0 = nw[j][0], w1 = nw[j][1];
                    const float rq = rs; float q[8] = {v[j * 8 + 0] * rq * w0.x, v[j * 8 + 1] * rq * w0.y, v[j * 8 + 2] * rq * w0.z, v[j * 8 + 3] * rq * w0.w, v[j * 8 + 4] * rq * w1.x, v[j * 8 + 5] * rq * w1.y, v[j * 8 + 6] * rq * w1.z, v[j * 8 + 7] * rq * w1.w};
#pragma unroll
                    for (int e = 0; e < 8; ++e) q[e] = fminf(fmaxf(q[e], -440.f), 440.f);
                    v2u o; o.x = pk4_fp8(q[0], q[1], q[2], q[3]); o.y = pk4_fp8(q[4], q[5], q[6], q[7]);
                    *(v2u*)((unsigned char*)F.A2 + (size_t)r * 2048 + col) = o; } }
        }
    }
}

struct Sched7 {
    static constexpr bool TBL = false;
    const char* A; const char* Bt; const int* rowid; int G, c;
    __device__ __forceinline__ bool next(int i, pg8::Unit& u) const { const int L = i * G + c; if (L >= 512) return false; pg8::static_map(L, 128, 4, u.pm, u.pn); u.e = 0; return true; }
    __device__ __forceinline__ const char* a_base(const pg8::Unit&) const { return A; }
    __device__ __forceinline__ const char* b_base(const pg8::Unit& u) const { return Bt + (size_t)u.pn * 256 * 2048; }
    __device__ __forceinline__ const int* row_table(const pg8::Unit& u) const { return rowid + u.pm * 256; }
};
struct Epi7 {
    static constexpr bool PERM = true, PUBLISH = false;
    const float* x; const float* MOD; bf16* X1;
    __device__ __forceinline__ void operator()(const f32x4 (&acc)[2][2][4][2], const pg8::Unit& u, int wr, int wc, int fr, int fq) const {
        const int row0 = u.pm * 256 + wr * 64 + fr, col0 = u.pn * 256 + wc * 32 + 8 * fq;
        const float* g1 = MOD + (size_t)(u.pm >> 4) * 6144 + 2048;
        f32x4 gv[2][2];
#pragma unroll
        for (int bj = 0; bj < 2; ++bj)
#pragma unroll
            for (int n = 0; n < 2; ++n) gv[bj][n] = *(const f32x4*)(g1 + col0 + bj * 128 + n * 4);
#pragma unroll
        for (int ai = 0; ai < 2; ++ai)
#pragma unroll
            for (int m = 0; m < 4; ++m) { const size_t off = (size_t)(row0 + ai * 128 + m * 16) * D + col0;
#pragma unroll
                for (int bj = 0; bj < 2; ++bj) { v4u ov;
                    { const f32x4 xv = __builtin_nontemporal_load((const f32x4*)(x + off + bj * 128)); const f32x4 o = xv + gv[bj][0] * (acc[ai][bj][m][0] * (1.f / (WSCALE * A2SCALE))); ov.x = pk2(o.x, o.y); ov.y = pk2(o.z, o.w); }
                    { const f32x4 xv = __builtin_nontemporal_load((const f32x4*)(x + off + bj * 128 + 4)); const f32x4 o = xv + gv[bj][1] * (acc[ai][bj][m][1] * (1.f / (WSCALE * A2SCALE))); ov.z = pk2(o.x, o.y); ov.w = pk2(o.z, o.w); }
                    *(v4u*)(X1 + off + bj * 128) = ov; } }
    }
};

__device__ __forceinline__ void p8_preload(Frame& F, v4u (&rwh)[4][2], v4u (&rwl)[4][2]) {
    const int lane = F.lane_(), w = F.wave, i16 = lane & 15, q4 = lane >> 4;
#pragma unroll
    for (int ks = 0; ks < 4; ++ks)
#pragma unroll
        for (int hf = 0; hf < 2; ++hf) { float t[8];
#pragma unroll
            for (int j = 0; j < 8; ++j) t[j] = F.router_w[(128 * w + 32 * ks + 8 * q4 + j) * 32 + 16 * hf + i16];
            unsigned hh[4], ll[4];
#pragma unroll
            for (int j = 0; j < 4; ++j) { hh[j] = pk2(t[2 * j], t[2 * j + 1]); ll[j] = pk2(t[2 * j] - bflo(hh[j]), t[2 * j + 1] - bfhi(hh[j])); }
            rwh[ks][hf] = (v4u){hh[0], hh[1], hh[2], hh[3]}; rwl[ks][hf] = (v4u){ll[0], ll[1], ll[2], ll[3]}; }
}
__device__ __forceinline__ void p8_router(Frame& F, v4u (&rwh)[4][2], v4u (&rwl)[4][2], const bool preloaded) {
    LAS unsigned char* L = F.lds;
    LAS float* H2F = (LAS float*)L;
    constexpr int HP = 1028;
    LAS float* PART = (LAS float*)(L + 16 * HP * 4);
    LAS unsigned* HIST = (LAS unsigned*)(L + 16 * HP * 4 + 16384);
    const int tid = F.tid_(), lane = F.lane_(), w = F.wave, i16 = lane & 15, q4 = lane >> 4;
    if (tid < 32) HIST[tid] = 0u;
    if (!preloaded) p8_preload(F, rwh, rwl);
    __syncthreads();
    const int GPB = (T / 16 + F.G - 1) / F.G, g_lo = (int)blockIdx.x * GPB, g_hi = (g_lo + GPB < T / 16) ? g_lo + GPB : T / 16;
    f32x4 wsc[4], shv[4]; int mb_cur = -1;
    v2u xq[2][4];
    if (g_lo < g_hi) {
#pragma unroll
        for (int rr = 0; rr < 2; ++rr)
#pragma unroll
            for (int j = 0; j < 4; ++j) xq[rr][j] = __builtin_nontemporal_load((const v2u*)(F.X1 + (size_t)(g_lo * 16 + 2 * w + rr) * D + 4 * lane + 256 * j));
    }
    for (int gi = g_lo; gi < g_hi; ++gi) {
        const int rbase = gi * 16;
        { const int mb = rbase >> 12; if (mb != mb_cur) { mb_cur = mb; const float* mod = F.MOD + (size_t)mb * 6144;
#pragma unroll
            for (int j = 0; j < 4; ++j) { const int col = 4 * lane + 256 * j; wsc[j] = *(const f32x4*)(F.norm2_w + col) * (*(const f32x4*)(mod + 4096 + col) + 1.f); shv[j] = *(const f32x4*)(mod + 3072 + col); } } }
#pragma unroll
        for (int rr = 0; rr < 2; ++rr) {
            const int r16 = 2 * w + rr, r = rbase + r16;
            f32x4 v[4]; float ss = 0.f;
#pragma unroll
            for (int j = 0; j < 4; ++j) { const v2u q = xq[rr][j]; v[j] = (f32x4){bflo(q.x), bfhi(q.x), bflo(q.y), bfhi(q.y)}; ss += (v[j].x * v[j].x + v[j].y * v[j].y) + (v[j].z * v[j].z + v[j].w * v[j].w); }
            const float rs = __builtin_amdgcn_rsqf(wave_sum(ss) * (1.f / D) + RMS_EPS);
#pragma unroll
            for (int j = 0; j < 4; ++j) { const int col = 4 * lane + 256 * j;
                const f32x4 hh = (v[j] * rs) * wsc[j] + shv[j];
                *(LAS f32x4*)(H2F + r16 * HP + col) = hh;
                *(unsigned*)((unsigned char*)F.H2 + (size_t)r * D + col) = pk4_fp8(hh.x, hh.y, hh.z, hh.w); }
        }
        if (gi + 1 < g_hi) {
#pragma unroll
            for (int rr = 0; rr < 2; ++rr)
#pragma unroll
                for (int j = 0; j < 4; ++j) xq[rr][j] = __builtin_nontemporal_load((const v2u*)(F.X1 + (size_t)((gi + 1) * 16 + 2 * w + rr) * D + 4 * lane + 256 * j));
        }
        __syncthreads();
        {
            f32x4 a0 = (f32x4){0.f, 0.f, 0.f, 0.f}, a1 = a0;
#pragma unroll
            for (int ks = 0; ks < 4; ++ks) { const LAS float* hp = H2F + i16 * HP + 128 * w + 32 * ks + 8 * q4;
                const f32x4 x0 = *(const LAS f32x4*)hp, x1 = *(const LAS f32x4*)(hp + 4);
                v4u xh, xl;
                xh.x = pk2(x0.x, x0.y); xh.y = pk2(x0.z, x0.w); xh.z = pk2(x1.x, x1.y); xh.w = pk2(x1.z, x1.w);
                xl.x = pk2(x0.x - bflo(xh.x), x0.y - bfhi(xh.x)); xl.y = pk2(x0.z - bflo(xh.y), x0.w - bfhi(xh.y)); xl.z = pk2(x1.x - bflo(xh.z), x1.y - bfhi(xh.z)); xl.w = pk2(x1.z - bflo(xh.w), x1.w - bfhi(xh.w));
                const bf16x8 ah = __builtin_bit_cast(bf16x8, xh), al = __builtin_bit_cast(bf16x8, xl);
                a0 = mfma16(ah, __builtin_bit_cast(bf16x8, rwl[ks][0]), a0); a1 = mfma16(ah, __builtin_bit_cast(bf16x8, rwl[ks][1]), a1);
                a0 = mfma16(al, __builtin_bit_cast(bf16x8, rwh[ks][0]), a0); a1 = mfma16(al, __builtin_bit_cast(bf16x8, rwh[ks][1]), a1);
                a0 = mfma16(ah, __builtin_bit_cast(bf16x8, rwh[ks][0]), a0); a1 = mfma16(ah, __builtin_bit_cast(bf16x8, rwh[ks][1]), a1); }
#pragma unroll
            for (int r = 0; r < 4; ++r) { PART[(w * 16 + 4 * q4 + r) * 32 + i16] = a0[r]; PART[(w * 16 + 4 * q4 + r) * 32 + 16 + i16] = a1[r]; }
        }
        __syncthreads();
        {
            const int row = tid >> 5, e = tid & 31;
            float lg = F.router_b[e];
#pragma unroll
            for (int ww = 0; ww < 8; ++ww) lg += PART[(ww * 16 + row) * 32 + e];
            float tv[4]; int ti[4];
#pragma unroll
            for (int k = 0; k < 4; ++k) { float bv = lg; int bi = e;
#pragma unroll
#define P8_ARG(OV, OI) do { const float ov_ = (OV); const int oi_ = (OI); if (ov_ > bv || (ov_ == bv && oi_ < bi)) { bv = ov_; bi = oi_; } } while (0)
                P8_ARG(dpp_f<DPP_XOR1>(bv), dpp_i<DPP_XOR1>(bi)); P8_ARG(dpp_f<DPP_XOR2>(bv), dpp_i<DPP_XOR2>(bi));
                P8_ARG(dpp_f<DPP_HMIRROR>(bv), dpp_i<DPP_HMIRROR>(bi)); P8_ARG(dpp_f<DPP_MIRROR>(bv), dpp_i<DPP_MIRROR>(bi));
                { const unsigned vb = __builtin_bit_cast(unsigned, bv); const auto rv = __builtin_amdgcn_permlane16_swap(vb, vb, false, false); const auto ri = __builtin_amdgcn_permlane16_swap((unsigned)bi, (unsigned)bi, false, false);
                  bv = __builtin_bit_cast(float, (unsigned)rv[0]); bi = (int)ri[0]; P8_ARG(__builtin_bit_cast(float, (unsigned)rv[1]), (int)ri[1]); }
#undef P8_ARG
                tv[k] = bv; ti[k] = bi; if (e == bi) lg = -INFINITY; }
            if (e < 4) {
                const float e1 = __expf(tv[1] - tv[0]), e2 = __expf(tv[2] - tv[0]), e3 = __expf(tv[3] - tv[0]); const float inv = 1.f / (1.f + e1 + e2 + e3);
                const float gk = (e == 0 ? 1.f : (e == 1 ? e1 : (e == 2 ? e2 : e3))) * inv;
                const int tk = e == 0 ? ti[0] : (e == 1 ? ti[1] : (e == 2 ? ti[2] : ti[3]));
                const int tok = rbase + row;
                const unsigned lr = atomicAdd((unsigned*)&HIST[tk], 1u);
                F.TOPE[tok * 4 + e] = tk; F.TOPG[tok * 4 + e] = gk; F.TOPR[tok * 4 + e] = (int)lr;
            }
        }
        __syncthreads();
    }
    if (tid < 32) { const unsigned base = __hip_atomic_fetch_add(F.ctl + CW_GCOUNT + tid, HIST[tid], RLX_AGENT); F.BB[(int)blockIdx.x * 32 + tid] = (int)base; }
}

__device__ __forceinline__ int moe_tables(Frame& F) {
    LAS int* TE = (LAS int*)(F.lds + TE_OFF);
    LAS int* MC = (LAS int*)(F.lds + MOE_CNT_OFF);
    __syncthreads();
    const int tid = F.tid_();
    if (tid < 64) { const int e = tid & 31;
        const int c = (tid < NE) ? (int)__hip_atomic_load(F.ctl + CW_GCOUNT + e, RLX_AGENT) : 0;
        const int nt = (c + 255) >> 8;
        int incl = nt;
#pragma unroll
        for (int o = 1; o < 32; o <<= 1) { const int v = __shfl_up(incl, o); if (tid >= o) incl += v; }
        if (tid < NE) { const int pst = incl - nt; MC[e] = c; MC[32 + e] = pst << 8;
            for (int t = 0; t < nt; ++t) TE[pst + t] = e;
            if (e == NE - 1) MC[64] = incl; } }
    __syncthreads();
    return MC[64];
}
__device__ __forceinline__ void p9_slots(Frame& F) {
    (void)moe_tables(F);
    const LAS int* MC = (const LAS int*)(F.lds + MOE_CNT_OFF);
    const int gt = (int)blockIdx.x * 512 + F.tid_(), NT_ = F.G * 512;
    for (int a = gt; a < T * TOPK; a += NT_) { const int tok = a >> 2, e = F.TOPE[a], blk = (tok >> 4) / ((T / 16 + F.G - 1) / F.G);
        const int slot = MC[32 + e] + F.BB[blk * 32 + e] + F.TOPR[a];
        F.SLOTTOK[slot] = tok; F.SLOTGATE[slot] = F.TOPG[a]; F.TOKSLOT[a] = slot; }
    for (int i = gt; i < MAX_SLOTS; i += NT_) F.SLOTID[i] = i;
    if ((int)blockIdx.x < NE) { const int e = (int)blockIdx.x, c = MC[e], ps = MC[32 + e], pe = ps + (((c + 255) >> 8) << 8);
        for (int s = ps + c + F.tid_(); s < pe; s += 512) { F.SLOTTOK[s] = 0; F.SLOTGATE[s] = 0.f; } }
}

struct SchedMoe {
    static constexpr bool TBL = true;
    const char* A; const char* W; const int* slot_tok; const LAS int* TE; int nM, nN, G, c; size_t wbytes  , tilebytes  , arowbytes;
    LAS unsigned char* tb;
    const float* f0; int f0_e, f0_n;
    const float* f1;
    __device__ __forceinline__ bool next(int i, pg8::Unit& u) const { const int L = i * G + c; if (L >= nM * nN) return false; pg8::static_map(L, nM, nN, u.pm, u.pn); u.e = TE[u.pm]; return true; }
    __device__ __forceinline__ const char* a_base(const pg8::Unit&) const { return A; }
    __device__ __forceinline__ const char* b_base(const pg8::Unit& u) const { return W + (size_t)u.e * wbytes + (size_t)u.pn * tilebytes; }
    __device__ __forceinline__ const int* row_table(const pg8::Unit& u) const { return slot_tok + u.pm * 256; }
    __device__ __forceinline__ const int* tab0(const pg8::Unit& u) const { return slot_tok + u.pm * 256; }
    __device__ __forceinline__ const float* tab1(const pg8::Unit& u) const { return f0 + (size_t)u.e * f0_e + u.pn * f0_n; }
    __device__ __forceinline__ const float* tab2(const pg8::Unit& u) const { return f1 ? f1 + u.pm * 256 : nullptr; }
};
struct Epi10 {
    static constexpr bool PERM = true;
    const float* b1; bf16* ACT;
    __device__ __forceinline__ void operator()(const f32x4 (&acc)[2][2][4][2], const pg8::Unit& u, int wr, int wc, int fr, int fq, const LAS unsigned char* tbuf) const {
        const int row0 = u.pm * 256 + wr * 64 + fr, j0 = u.pn * 128 + wc * 32 + 8 * fq;
        const LAS float* bp = (const LAS float*)(tbuf + 3072) + 2 * (wc * 32 + 8 * fq);
        const f32x4 q0 = *(const LAS f32x4*)bp, q1 = *(const LAS f32x4*)(bp + 4), q2 = *(const LAS f32x4*)(bp + 8), q3 = *(const LAS f32x4*)(bp + 12);
        const float bg[8] = {q0.x, q0.z, q1.x, q1.z, q2.x, q2.z, q3.x, q3.z}, bu[8] = {q0.y, q0.w, q1.y, q1.w, q2.y, q2.w, q3.y, q3.w};
        constexpr float KS = 1.702f * 1.44269504f;
        f32x2 kbg2[4], bu2[4];
#pragma unroll
        for (int q = 0; q < 4; ++q) { kbg2[q] = (f32x2){bg[2 * q], bg[2 * q + 1]} * KS; bu2[q] = (f32x2){bu[2 * q], bu[2 * q + 1]}; }
        v2u wprev = {0u, 0u};
        unsigned char* const abase = (unsigned char*)ACT + (size_t)(row0 + 16 * (fq & 1)) * DFF + j0 - 8 * (fq & 1);
#pragma unroll
        for (int ai = 0; ai < 2; ++ai)
#pragma unroll
            for (int m = 0; m < 4; ++m) { f32x2 o[4];
#pragma unroll
                for (int n = 0; n < 2; ++n)
#pragma unroll
                    for (int pp = 0; pp < 2; ++pp) { const int q = 2 * n + pp;
                        const f32x2 ag = (f32x2){acc[ai][0][m][n][2 * pp], acc[ai][0][m][n][2 * pp + 1]}, au = (f32x2){acc[ai][1][m][n][2 * pp], acc[ai][1][m][n][2 * pp + 1]};
                        const f32x2 hg = ag * (KS / WSCALE) + kbg2[q], hu = au * (1.f / WSCALE) + bu2[q];
                        const f32x2 gp = (f32x2){fminf(hg.x, 7.f * KS), fminf(hg.y, 7.f * KS)};
                        const f32x2 up = (f32x2){fminf(fmaxf(hu.x, -7.f), 7.f), fminf(fmaxf(hu.y, -7.f), 7.f)};
                        const f32x2 d = (f32x2){__builtin_amdgcn_exp2f(-gp.x), __builtin_amdgcn_exp2f(-gp.y)} + 1.f;
                        f32x2 r = (f32x2){__builtin_amdgcn_rcpf(d.x), __builtin_amdgcn_rcpf(d.y)};
#if PROBE_TRANS
                        { float g0 = -gp.x, g1 = -gp.y; asm volatile("" : "+v"(g0), "+v"(g1)); float d0 = __builtin_amdgcn_exp2f(g0) + 1.f, d1 = __builtin_amdgcn_exp2f(g1) + 1.f; asm volatile("" : "+v"(d0), "+v"(d1));
                          r = (r + (f32x2){__builtin_amdgcn_rcpf(d0), __builtin_amdgcn_rcpf(d1)}) * 0.5f; }
#endif
                        o[q] = (gp * r) * (up * (ASCALE / KS) + (ASCALE / KS)); }
                v2u wv; wv.x = pk4_fp8(o[0].x, o[0].y, o[1].x, o[1].y); wv.y = pk4_fp8(o[2].x, o[2].y, o[3].x, o[3].y);
                if ((m & 1) == 0) wprev = wv;
                else { const auto rx = __builtin_amdgcn_permlane16_swap(wprev.x, wv.x, false, false), ry = __builtin_amdgcn_permlane16_swap(wprev.y, wv.y, false, false);
                    v4u ow; ow.x = (unsigned)rx[0]; ow.y = (unsigned)ry[0]; ow.z = (unsigned)rx[1]; ow.w = (unsigned)ry[1];
                    *(v4u*)(abase + (size_t)(ai * 128 + (m - 1) * 16) * DFF) = ow; } }
    }
};
struct Epi11 {
    static constexpr bool PERM = true;
    bf16* YS;
    __device__ __forceinline__ void operator()(const f32x4 (&acc)[2][2][4][2], const pg8::Unit& u, int wr, int wc, int fr, int fq_in, const LAS unsigned char* tbuf) const {
        int fq = fq_in; asm volatile("" : "+v"(fq));
        const int row0 = u.pm * 256 + wr * 64 + fr, col0 = u.pn * 256 + wc * 32 + 8 * fq;
        const LAS float* bl = (const LAS float*)(tbuf + 3072) + wc * 32 + 8 * fq; const LAS float* gl = (const LAS float*)(tbuf + 6144) + wr * 64 + fr;
        f32x4 bv[2][2];
#pragma unroll
        for (int bj = 0; bj < 2; ++bj)
#pragma unroll
            for (int n = 0; n < 2; ++n) bv[bj][n] = *(const LAS f32x4*)(bl + bj * 128 + 4 * n);
        const int odd = fq & 1;
        unsigned char* const ybase = (unsigned char*)YS + (size_t)(row0 + 16 * odd) * D + col0 - 8 * odd;
#pragma unroll
        for (int ai = 0; ai < 2; ++ai)
#pragma unroll
            for (int mp = 0; mp < 2; ++mp) {
#pragma unroll
                for (int bj = 0; bj < 2; ++bj) { v2u wv[2];
#pragma unroll
                    for (int k = 0; k < 2; ++k) { const int m = 2 * mp + k; const float gs = gl[ai * 128 + m * 16] * YSCALE;
                        f32x4 v0 = (acc[ai][bj][m][0] * (1.f / (WSCALE * ASCALE)) + bv[bj][0]) * gs, v1 = (acc[ai][bj][m][1] * (1.f / (WSCALE * ASCALE)) + bv[bj][1]) * gs;
#pragma unroll
                        for (int t = 0; t < 4; ++t) { v0[t] = fminf(fmaxf(v0[t], -440.f), 440.f); v1[t] = fminf(fmaxf(v1[t], -440.f), 440.f); }
                        wv[k].x = pk4_fp8(v0[0], v0[1], v0[2], v0[3]); wv[k].y = pk4_fp8(v1[0], v1[1], v1[2], v1[3]); }
                    const auto rx = __builtin_amdgcn_permlane16_swap(wv[0].x, wv[1].x, false, false), ry = __builtin_amdgcn_permlane16_swap(wv[0].y, wv[1].y, false, false);
                    v4u o; o.x = (unsigned)rx[0]; o.y = (unsigned)ry[0]; o.z = (unsigned)rx[1]; o.w = (unsigned)ry[1];
                    *(v4u*)(ybase + (size_t)(ai * 128 + mp * 32) * D + bj * 128) = o; } }
    }
};

__device__ __forceinline__ void p12_combine(Frame& F) {
    const int gw = (int)blockIdx.x * 8 + F.wave, NGW = F.G * 8, lane = F.lane_();
    for (int rb16 = gw; rb16 < T / 16; rb16 += NGW) {
        const int r0 = rb16 * 16;
        const float* g2p = F.MOD + (size_t)(r0 >> 12) * 6144 + 5120;
        f32x4 g2v[4], fw[4];
#pragma unroll
        for (int j = 0; j < 4; ++j) { const int col = 4 * lane + 256 * j; g2v[j] = *(const f32x4*)(g2p + col) * (1.f / YSCALE); fw[j] = *(const f32x4*)(F.final_norm_w + col); }
        for (int rp = 0; rp < 8; ++rp) {
            int sl[2][4];
#pragma unroll
            for (int k2 = 0; k2 < 2; ++k2)
#pragma unroll
                for (int k = 0; k < 4; ++k) sl[k2][k] = F.TOKSLOT[(r0 + rp * 2 + k2) * 4 + k];
            unsigned yv[2][4][4]; v2u xq[2][4];
#pragma unroll
            for (int k2 = 0; k2 < 2; ++k2)
#pragma unroll
                for (int j = 0; j < 4; ++j) { const int col = 4 * lane + 256 * j; xq[k2][j] = __builtin_nontemporal_load((const v2u*)(F.X1 + (size_t)(r0 + rp * 2 + k2) * D + col));
#pragma unroll
                    for (int k = 0; k < 4; ++k) yv[k2][j][k] = __builtin_nontemporal_load((const unsigned*)((const unsigned char*)F.YS + (size_t)sl[k2][k] * D + col)); }
#pragma unroll
            for (int k2 = 0; k2 < 2; ++k2) { const int r = r0 + rp * 2 + k2;
                f32x4 v[4]; float ss = 0.f;
#pragma unroll
                for (int j = 0; j < 4; ++j) { f32x4 m = (f32x4){0.f, 0.f, 0.f, 0.f};
#pragma unroll
                    for (int k = 0; k < 4; ++k) { const int y = (int)yv[k2][j][k]; const f32x2 lo = __builtin_amdgcn_cvt_pk_f32_fp8(y, false), hi = __builtin_amdgcn_cvt_pk_f32_fp8(y, true); m.x += lo.x; m.y += lo.y; m.z += hi.x; m.w += hi.y; }
                    v[j] = (f32x4){bflo(xq[k2][j].x), bfhi(xq[k2][j].x), bflo(xq[k2][j].y), bfhi(xq[k2][j].y)} + g2v[j] * m;
                    ss += (v[j].x * v[j].x + v[j].y * v[j].y) + (v[j].z * v[j].z + v[j].w * v[j].w); }
                const float rs = __builtin_amdgcn_rsqf(wave_sum(ss) * (1.f / D) + RMS_EPS);
#pragma unroll
                for (int j = 0; j < 4; ++j) { const int col = 4 * lane + 256 * j; __builtin_nontemporal_store((v[j] * rs) * fw[j], (f32x4*)(F.out + (size_t)r * D + col)); } }
        }
    }
}

constexpr int NPHASE = 13;
struct Args { const float* in[25]; float* out; unsigned char* ws; int ph_lo, ph_hi; };
__global__ void __launch_bounds__(512, 2) mk_fwd(Args args) {
    extern __shared__ __attribute__((aligned(16))) unsigned char lds[];
    Frame F;
    F.lds = (LAS unsigned char*)lds;
    F.wave = __builtin_amdgcn_readfirstlane((int)threadIdx.x >> 6); F.G = gridDim.x;
    unsigned char* ws = args.ws;
    F.ctl = (unsigned*)(ws + WS_CTL);
    F.x = args.in[0]; F.c = args.in[1]; F.ctx = args.in[2]; F.c_ctx = args.in[3]; F.w_mod = args.in[4]; F.b_mod = args.in[5]; F.norm1_w = args.in[6]; F.norm2_w = args.in[7];
    F.w_in = args.in[8]; F.conv_w = args.in[9]; F.conv_b = args.in[10]; F.dt_bias = args.in[11]; F.a_log = args.in[12]; F.d_skip = args.in[13]; F.ssd_norm_w = args.in[14];
    F.pool_w = args.in[15]; F.pool_scale = args.in[16]; F.w_out = args.in[17]; F.router_w = args.in[18]; F.router_b = args.in[19]; F.w1 = args.in[20]; F.b1 = args.in[21];
    F.w2 = args.in[22]; F.b2 = args.in[23]; F.final_norm_w = args.in[24]; F.out = args.out;
    F.MOD = (float*)(ws + WS_MOD); F.DTRAW = (float*)(ws + WS_DTRAW); F.DT = (float*)(ws + WS_DT); F.ROWSC = (float*)(ws + WS_ROWSC); F.CHS = (float*)(ws + WS_CHS); F.X1 = (bf16*)(ws + WS_X1);
    F.TOPG = (float*)(ws + WS_TOPG); F.SLOTGATE = (float*)(ws + WS_SLOTGATE); F.TOPE = (int*)(ws + WS_TOPE); F.TOPR = (int*)(ws + WS_TOPR); F.TOKSLOT = (int*)(ws + WS_TOKSLOT);
    F.SLOTTOK = (int*)(ws + WS_SLOTTOK); F.SLOTID = (int*)(ws + WS_SLOTID); F.ROWID = (int*)(ws + WS_ROWID); F.BB = (int*)(ws + WS_BB);
    F.WINT = (bf16*)(ws + WS_WINT); F.WOUTT = (bf16*)(ws + WS_WOUTT); F.W1T = (bf16*)(ws + WS_W1T); F.W2T = (bf16*)(ws + WS_W2T); F.A1 = (bf16*)(ws + WS_A1); F.XBCPRE = (bf16*)(ws + WS_XBCPRE);
    F.Z = (bf16*)(ws + WS_Z); F.V = (bf16*)(ws + WS_V); F.XBC = (bf16*)(ws + WS_XBC); F.CC = (bf16*)(ws + WS_CC); F.ST = (bf16*)(ws + WS_ST); F.Y = (bf16*)(ws + WS_Y); F.YB = (bf16*)(ws + WS_YB);
    F.A2 = (bf16*)(ws + WS_A2); F.H2 = (bf16*)(ws + WS_H2); F.ACT = (bf16*)(ws + WS_ACT); F.YS = (bf16*)(ws + WS_YS);
    volatile LAS unsigned* MISC = (volatile LAS unsigned*)(F.lds + MISC_OFF);
    for (int u = F.tid_(); u < 64; u += 512) MISC[u] = 0u;
    __syncthreads();
    const int lo = args.ph_lo, hi = args.ph_hi;
    XcdBarrier bar; bar.bar = F.ctl + CW_BAR; bar.x = 0; bar.st = nullptr; bar.wave = F.wave;
    if (hi - lo > 1) bar = xcd_barrier_post(F.ctl + CW_BAR, MISC + 8, F.wave);
#define IN(k) (lo <= (k) && (k) < hi)
#define SEAM(k) do { if (IN(k) && IN((k) + 1)) xcd_barrier(bar); } while (0)
#define BODY0 p0_prologue(F)
#define BODY1 p1_norm1(F)
#define BODY2 do { Sched1 S{(const char*)F.A1, (const char*)F.WINT, F.G, (int)blockIdx.x}; Epi1 E{F.XBCPRE, F.Z, F.V, F.DTRAW}; pg8::gemm_phase<Epi1, Sched1, false>(F.lds, D, S, E, F.wave); } while (0)
#define BODY4 p4_ssd_local(F, (IN(2) && (F.G & 3) == 0) ? ((int)blockIdx.x & 3) : -1)
#define BODY5 p5_ssd_scan(F)
#define BODY6 p6_gate_pool(F)
#define BODY7 do { Sched7 S{(const char*)F.A2, (const char*)F.WOUTT, F.ROWID, F.G, (int)blockIdx.x}; Epi7 E{F.x, F.MOD, F.X1}; pg8::gemm_phase<Epi7, Sched7, true, true>(F.lds, 2048, S, E, F.wave); } while (0)
#define BODY8 p8_router(F, rwh_, rwl_, IN(7))
#define BODY9 p9_slots(F)
#define BODY10 do { const int ntl = IN(9) ? ((const LAS int*)(F.lds + MOE_CNT_OFF))[64] : moe_tables(F);     \
        SchedMoe S{(const char*)F.H2, (const char*)F.W1T, F.SLOTTOK, (const LAS int*)(F.lds + TE_OFF), ntl, 8, F.G, (int)blockIdx.x, (size_t)2048 * D, (size_t)256 * D, (size_t)D, F.lds + TBL_OFF, F.b1, 2048, 256, nullptr}; \
        Epi10 E{F.b1, F.ACT}; pg8::gemm_phase<Epi10, SchedMoe, true, true>(F.lds, D, S, E, F.wave); } while (0)
#define BODY11 do { const int ntl = (IN(9) || IN(10)) ? ((const LAS int*)(F.lds + MOE_CNT_OFF))[64] : moe_tables(F); \
        SchedMoe S{(const char*)F.ACT, (const char*)F.W2T, F.SLOTID, (const LAS int*)(F.lds + TE_OFF), ntl, 4, F.G, (int)blockIdx.x, (size_t)D * D, (size_t)256 * D, (size_t)D, F.lds + TBL_OFF, F.b2, D, 256, F.SLOTGATE}; \
        Epi11 E{F.YS}; pg8::gemm_phase<Epi11, SchedMoe, true, true>(F.lds, D, S, E, F.wave); } while (0)
#define BODY12 p12_combine(F)
#define RUN(k) do { if (IN(k)) { BODY##k; if (PROBE_PH == (k)) { xcd_barrier(bar); BODY##k; } } SEAM(k); } while (0)
    do { if (IN(0)) { BODY0; if (PROBE_PH == 0) { BODY0; } } } while (0);
    v4u rwh_[4][2], rwl_[4][2];
    RUN(1);
    do { if (IN(2)) { BODY2; if (IN(4) && (F.G & 3) == 0) p4_stage_cw(F, (int)blockIdx.x & 3); } SEAM(2); } while (0);
    RUN(4); RUN(5); RUN(6);
    do { if (IN(7)) { BODY7; if (IN(8)) p8_preload(F, rwh_, rwl_); } SEAM(7); } while (0);
    RUN(8); RUN(9); RUN(10); RUN(11); RUN(12);
#undef IN
#undef SEAM
}

extern "C" void kernel_launch(void* const* d_in, const int* in_sizes, int n_in, void* d_out, int out_size, void* d_ws, size_t ws_size, hipStream_t stream) {
    static int grid = 0;
    if (grid == 0) {
        if (n_in != 25 || out_size != T * D || ws_size < WS_END) { fprintf(stderr, "kernel_launch: unexpected shapes (n_in %d, out %d, ws %zu)\n", n_in, out_size, ws_size); grid = -1; return; }
        int dev = 0, cus = 0, per_cu = 0;
        if (hipGetDevice(&dev) != hipSuccess || hipDeviceGetAttribute(&cus, hipDeviceAttributeMultiprocessorCount, dev) != hipSuccess) { grid = -1; return; }
        if (hipFuncSetAttribute((const void*)mk_fwd, hipFuncAttributeMaxDynamicSharedMemorySize, LDS_BYTES) != hipSuccess) { fprintf(stderr, "kernel_launch: hipFuncSetAttribute failed\n"); grid = -1; return; }
        if (hipOccupancyMaxActiveBlocksPerMultiprocessor(&per_cu, (const void*)mk_fwd, 512, LDS_BYTES) != hipSuccess || per_cu < 1) { fprintf(stderr, "kernel_launch: occupancy query says %d\n", per_cu); }
        (void)hipGetLastError();
        grid = cus;
    }
    if (grid < 0) return;
    (void)hipMemsetAsync((char*)d_ws + WS_CTL, 0, CTL_ZERO_BYTES, stream);
    Args a{};
    for (int i = 0; i < 25; ++i) a.in[i] = (const float*)d_in[i];
    a.out = (float*)d_out; a.ws = (unsigned char*)d_ws;
#if MK_SPLIT
    for (int p = 0; p < NPHASE; ++p) { a.ph_lo = p; a.ph_hi = p + 1; hipLaunchKernelGGL(mk_fwd, dim3(grid), dim3(512), LDS_BYTES, stream, a); }
#else
    a.ph_lo = 0; a.ph_hi = NPHASE; hipLaunchKernelGGL(mk_fwd, dim3(grid), dim3(512), LDS_BYTES, stream, a);
#endif
}
```

```cpp
#include <hip/hip_runtime.h>
#include <cstdio>
#include <cstdint>

#ifndef MK_SPLIT
#define MK_SPLIT 0
#endif

#ifndef PROBE_PH
#define PROBE_TRANS 0
#define PROBE_PH -1
#endif

#define GAS __attribute__((address_space(1)))
#define LAS __attribute__((address_space(3)))
typedef unsigned short bf16;
typedef unsigned v4u __attribute__((ext_vector_type(4)));
typedef unsigned v2u __attribute__((ext_vector_type(2)));
typedef float f32x4 __attribute__((ext_vector_type(4)));
typedef float f32x2 __attribute__((ext_vector_type(2)));
typedef short bf16x8 __attribute__((ext_vector_type(8)));
typedef short s16x4 __attribute__((ext_vector_type(4)));
#define RLX_AGENT __ATOMIC_RELAXED, __HIP_MEMORY_SCOPE_AGENT
#define LDS_WAIT() asm volatile("s_waitcnt lgkmcnt(0)" ::: "memory")
#define VM_WAIT() asm volatile("s_waitcnt vmcnt(0)" ::: "memory")

__device__ __forceinline__ unsigned f2bf(float f) { unsigned u = __builtin_bit_cast(unsigned, f); return (u + 0x7fffu + ((u >> 16) & 1u)) >> 16; }
typedef __bf16 nbf16x2 __attribute__((ext_vector_type(2)));
__device__ __forceinline__ unsigned pk2(float lo, float hi) { const f32x2 v = {lo, hi}; return __builtin_bit_cast(unsigned, __builtin_convertvector(v, nbf16x2)); }
constexpr float A2SCALE = 4.f;
constexpr float YOSCALE = 16.f;
constexpr float STSCALE = 32.f;
constexpr float YSCALE = 8.f;
constexpr float ASCALE = 4.f;
constexpr float WSCALE = 32.f;
__device__ __forceinline__ unsigned pk4_fp8(float a, float b, float c, float d) { int r = __builtin_amdgcn_cvt_pk_fp8_f32(a, b, 0, false); r = __builtin_amdgcn_cvt_pk_fp8_f32(c, d, r, true); return (unsigned)r; }
__device__ __forceinline__ float bflo(unsigned w) { return __builtin_bit_cast(float, w << 16); }
__device__ __forceinline__ float bfhi(unsigned w) { return __builtin_bit_cast(float, w & 0xffff0000u); }
__device__ __forceinline__ float silu_f(float v) { return v * __builtin_amdgcn_rcpf(1.f + __builtin_amdgcn_exp2f(-1.44269504f * v)); }
template <int CTRL> __device__ __forceinline__ float dpp_f(float v) { return __builtin_bit_cast(float, __builtin_amdgcn_update_dpp(0, __builtin_bit_cast(int, v), CTRL, 0xF, 0xF, false)); }
template <int CTRL> __device__ __forceinline__ int dpp_i(int v) { return __builtin_amdgcn_update_dpp(0, v, CTRL, 0xF, 0xF, false); }
constexpr int DPP_XOR1 = 0xB1  , DPP_XOR2 = 0x4E  , DPP_HMIRROR = 0x141  , DPP_MIRROR = 0x140  ;
__device__ __forceinline__ float wave_sum(float v) {
    v += dpp_f<DPP_XOR1>(v); v += dpp_f<DPP_XOR2>(v); v += dpp_f<DPP_HMIRROR>(v); v += dpp_f<DPP_MIRROR>(v);
    { const unsigned b = __builtin_bit_cast(unsigned, v); const auto r = __builtin_amdgcn_permlane16_swap(b, b, false, false); v = __builtin_bit_cast(float, (unsigned)r[0]) + __builtin_bit_cast(float, (unsigned)r[1]); }
    { const unsigned b = __builtin_bit_cast(unsigned, v); const auto r = __builtin_amdgcn_permlane32_swap(b, b, false, false); v = __builtin_bit_cast(float, (unsigned)r[0]) + __builtin_bit_cast(float, (unsigned)r[1]); }
    return v;
}

constexpr int D = 1024, NB = 8, SEQ = 4096, CTXL = 256, T = NB * SEQ, TC = NB * CTXL, RTOT = T + TC;
constexpr int CONV_CH = 2560, SSD_W = 1536, NH = 24, HDIM = 64, NGRP = 4, HPG = 6, NST = 128, CHUNK = 128;
constexpr int NCC = (CTXL + SEQ) / CHUNK;
constexpr int IN_COLS = 4656, N1 = 4864;
constexpr int NE = 32, TOPK = 4, DFF = 1024;
constexpr int MAX_TILES = (T * TOPK) / 256 + NE;
constexpr int MAX_SLOTS = MAX_TILES * 256;
constexpr float RMS_EPS = 1e-6f;

constexpr size_t MiB = 1u << 20;
constexpr size_t WS_CTL = 0, CTL_ZERO_BYTES = 32 * 1024;
constexpr size_t WS_MOD = 1 * MiB;
constexpr size_t WS_TOPE = 2 * MiB, WS_TOPG = WS_TOPE + 512 * 1024, WS_TOPR = WS_TOPG + 512 * 1024, WS_TOKSLOT = WS_TOPR + 512 * 1024;
constexpr size_t WS_SLOTTOK = 4 * MiB, WS_SLOTGATE = WS_SLOTTOK + 576 * 1024, WS_BB = WS_SLOTGATE + 576 * 1024, WS_CHS = WS_BB + 64 * 1024, WS_SLOTID = WS_CHS + 64 * 1024;
constexpr size_t WS_DTRAW = 6 * MiB;
constexpr size_t WS_ROWID = 21 * MiB + 512 * 1024;
constexpr size_t WS_DT = 15 * MiB;
constexpr size_t WS_ROWSC = 22 * MiB;
constexpr size_t WS_WINT = 32 * MiB, WS_WOUTT = 42 * MiB, WS_W1T = 46 * MiB, WS_W2T = 174 * MiB;
constexpr size_t WS_A = 240 * MiB;
constexpr size_t WS_A1 = WS_A, WS_CC = WS_A, WS_XBCPRE = WS_A + 68 * MiB, WS_Z = WS_A + 238 * MiB, WS_V = WS_A + 334 * MiB, WS_XBC = WS_A;
constexpr size_t WS_ST = WS_A + 366 * MiB, WS_Y = WS_A + 570 * MiB, WS_YB = WS_A + 666 * MiB;
constexpr size_t WS_A2 = WS_XBCPRE, WS_X1 = WS_A + 366 * MiB, WS_H2 = WS_A + 494 * MiB, WS_ACT = WS_A, WS_YS = WS_A + 494 * MiB;
constexpr size_t WS_END = WS_A + 766 * MiB;
static_assert(WS_END <= 1024 * MiB, "workspace map");
static_assert((size_t)RTOT * D * 2 <= 68 * MiB && (size_t)RTOT * CONV_CH * 2 <= 170 * MiB && (size_t)MAX_SLOTS * D * 2 <= 272 * MiB, "workspace map sizes");
static_assert((size_t)NB * NCC * NH * 2 * 8192 * 2 <= 204 * MiB, "ST size");
constexpr int CW_TMO = 0, CW_GCOUNT = 64  , CW_MODFLAG = 128, CW_BAR = 4096;

constexpr int LDS_BYTES = 163840;
constexpr int MISC_OFF = LDS_BYTES - 256;
constexpr int TE_OFF = 131072;
constexpr int MOE_CNT_OFF = TE_OFF + 4096;
constexpr int TBL_OFF = TE_OFF + 8192;

__device__ __forceinline__ int hw_lane_id() { int l; asm volatile("v_mbcnt_lo_u32_b32 %0, -1, 0\n\tv_mbcnt_hi_u32_b32 %0, -1, %0" : "=v"(l)); return l; }
namespace pg8 {
constexpr int BM = 256, BK = 64, HALF = 128, HTB = HALF * BK * 2, STAGE_BYTES = 8 * HTB, NXCD = 8, WGM = 8;
__host__ __device__ __forceinline__ int lds_byte(int r, int c) { const int st = (r >> 4) * 2 + (c >> 5), rr = r & 15, cc = c & 31, ob = rr * 64 + cc * 2; return st * 1024 + (ob ^ (((ob >> 9) & 1) << 5)); }
__host__ __device__ __forceinline__ void stage_rc(int b, int& R, int& C) { const int st = b / 1024, sb = b % 1024, swz = sb ^ (((sb >> 9) & 1) << 5); R = (st >> 1) * 16 + swz / 64; C = (st & 1) * 32 + (swz % 64) / 2; }
__host__ __device__ __forceinline__ int perm32(int rho) { const int n = rho >> 4, i = rho & 15; return 8 * (i >> 2) + 4 * n + (i & 3); }
struct Unit { int pm, pn, e; };
__device__ __forceinline__ unsigned cvt_pk_bf16(float lo, float hi) { unsigned r; asm volatile("v_cvt_pk_bf16_f32 %0, %1, %2" : "=v"(r) : "v"(lo), "v"(hi)); return r; }

__device__ __forceinline__ void static_map(int wgid, int nM, int nN, int& pm, int& pn) {
    const int nwg = nM * nN;
    { const int q = nwg / NXCD, r = nwg % NXCD, xcd = wgid % NXCD, off = wgid / NXCD; wgid = (xcd < r ? xcd * (q + 1) : r * (q + 1) + (xcd - r) * q) + off; }
    const int nig = WGM * nN, gid = wgid / nig, fm = gid * WGM, gsz = (nM - fm) < WGM ? (nM - fm) : WGM;
    pm = fm + ((wgid % nig) % gsz); pn = (wgid % nig) / gsz;
}

typedef int i32x8 __attribute__((ext_vector_type(8)));
typedef int v4i_t __attribute__((ext_vector_type(4)));
template <class Epi, class Sched, bool GATHER, bool FP8 = false, bool ALIGN_EPI = true>
__device__ __forceinline__ void gemm_phase(LAS unsigned char* lds, const int K, const Sched& S, const Epi& E, const int wave_index) {
    const int wid = wave_index, lane = hw_lane_id(), tid = wid * 64 + lane;
    const int wr = wid >> 2, wc = wid & 3, fr = lane & 15, fq = lane >> 4;
    constexpr int ES = FP8 ? 1 : 2, KOFF = FP8 ? 16 : 1024;
    const int nt = K / (FP8 ? 2 * BK : BK);
    unsigned voffB[2]; int RA[2], CA[2];
#pragma unroll
    for (int i = 0; i < 2; ++i) { int R, C; stage_rc(tid * 16 + i * 8192, R, C); const int Rb = Epi::PERM ? ((R & ~31) + perm32(R & 31)) : R;
        RA[i] = R; CA[i] = C; voffB[i] = (unsigned)(Rb * K * ES + C * 2); }
    const size_t kstep = (size_t)(BK * 2);
    const size_t hstep = (size_t)HALF * K * ES;
    const unsigned ldsw = (unsigned)wid * 1024u;
    const int aoff = lds_byte(wr * 64 + fr, fq * (FP8 ? 16 : 8)), boff = lds_byte(wc * 32 + fr, fq * (FP8 ? 16 : 8));
#define PG8_SA(b, h) (((b) * 2 + (h)) * HTB)
#define PG8_SB(b, h) ((4 + (b) * 2 + (h)) * HTB)
#define PG8_STAGE(bufoff, gbase, voff) do { _Pragma("unroll") for (int _i = 0; _i < 2; ++_i) \
        __builtin_amdgcn_global_load_lds((const unsigned*)((const char*)(gbase) + (voff)[_i]), (LAS unsigned*)(lds + (bufoff) + ldsw + _i * 8192), 16, 0, 0); } while (0)
#define PG8_LDA(dst, b, h) do { _Pragma("unroll") for (int m = 0; m < 4; ++m) _Pragma("unroll") for (int k = 0; k < 2; ++k) dst[m][k] = *(const LAS bf16x8*)(lds + PG8_SA(b, h) + aoff + m * 2048 + k * KOFF); } while (0)
#define PG8_LDB(dst, b, h) do { _Pragma("unroll") for (int n = 0; n < 2; ++n) _Pragma("unroll") for (int k = 0; k < 2; ++k) dst[n][k] = *(const LAS bf16x8*)(lds + PG8_SB(b, h) + boff + n * 2048 + k * KOFF); } while (0)
#define PG8_CAT(lo, hi) __builtin_shufflevector(__builtin_bit_cast(v4i_t, lo), __builtin_bit_cast(v4i_t, hi), 0, 1, 2, 3, 4, 5, 6, 7)
#define PG8_MMA(ai, bj, At, Bt) do { __builtin_amdgcn_s_setprio(1); \
        if constexpr (FP8) { _Pragma("unroll") for (int m = 0; m < 4; ++m) _Pragma("unroll") for (int n = 0; n < 2; ++n) \
            acc[ai][bj][m][n] = __builtin_amdgcn_mfma_scale_f32_16x16x128_f8f6f4(PG8_CAT(Bt[n][0], Bt[n][1]), PG8_CAT(At[m][0], At[m][1]), acc[ai][bj][m][n], 0, 0, 0, 0x7f7f7f7f, 0, 0x7f7f7f7f); } \
        else { _Pragma("unroll") for (int m = 0; m < 4; ++m) _Pragma("unroll") for (int n = 0; n < 2; ++n) _Pragma("unroll") for (int k = 0; k < 2; ++k) \
            acc[ai][bj][m][n] = __builtin_amdgcn_mfma_f32_16x16x32_bf16(Bt[n][k], At[m][k], acc[ai][bj][m][n], 0, 0, 0); } \
        __builtin_amdgcn_s_setprio(0); } while (0)
#define PG8_WAIT_V(n) asm volatile("s_waitcnt vmcnt(" #n ")" ::: "memory")
#define PG8_WAIT_L(n) asm volatile("s_waitcnt lgkmcnt(" #n ")" ::: "memory")
#define PG8_BAR __builtin_amdgcn_s_barrier()
#define PG8_SCHED __builtin_amdgcn_sched_barrier(0)
#define PG8_AOFFS(U, dst) do { \
        if constexpr (GATHER) { int t_ = tid, R_, C_; asm volatile("" : "+v"(t_)); stage_rc(t_ * 16, R_, C_);     \
            const int* st_ = S.row_table(U) + R_; _Pragma("unroll") for (int _h = 0; _h < 2; ++_h) _Pragma("unroll") for (int _i = 0; _i < 2; ++_i) \
            dst[_h][_i] = (unsigned)st_[_h * HALF + _i * 64] * (unsigned)(K * ES) + (unsigned)(C_ * 2); } \
        else { _Pragma("unroll") for (int _h = 0; _h < 2; ++_h) _Pragma("unroll") for (int _i = 0; _i < 2; ++_i) dst[_h][_i] = (unsigned)((_h * HALF + RA[_i]) * K * ES + CA[_i] * 2); } } while (0)
#define PG8_AOFFS_NEXT(dst) do { if constexpr (Sched::TBL) { int t_ = tid, R_, C_; asm volatile("" : "+v"(t_)); stage_rc(t_ * 16, R_, C_); \
            const unsigned la_ = (unsigned)(size_t)(S.tb + ((ui + 1) % 3) * 1024) + (unsigned)R_ * 4u; unsigned r0_, r1_, r2_, r3_; \
            asm volatile("ds_read_b32 %0, %4\n\tds_read_b32 %1, %4 offset:256\n\tds_read_b32 %2, %4 offset:512\n\tds_read_b32 %3, %4 offset:768\n\ts_waitcnt lgkmcnt(0)" \
                         : "=&v"(r0_), "=&v"(r1_), "=&v"(r2_), "=&v"(r3_) : "v"(la_) : "memory"); \
            dst[0][0] = r0_ * (unsigned)(K * ES) + (unsigned)(C_ * 2); dst[0][1] = r1_ * (unsigned)(K * ES) + (unsigned)(C_ * 2); \
            dst[1][0] = r2_ * (unsigned)(K * ES) + (unsigned)(C_ * 2); dst[1][1] = r3_ * (unsigned)(K * ES) + (unsigned)(C_ * 2); } else { PG8_AOFFS(nxt, dst); } } while (0)
    Unit cur, nxt; int ui = 0;
    if (!S.next(0, cur)) return;
    f32x4 acc[2][2][4][2];
#pragma unroll
    for (int a = 0; a < 2; ++a)
#pragma unroll
        for (int b = 0; b < 2; ++b)
#pragma unroll
            for (int m = 0; m < 4; ++m)
#pragma unroll
                for (int n = 0; n < 2; ++n) acc[a][b][m][n] = (f32x4){0.f, 0.f, 0.f, 0.f};
    bf16x8 At[4][2], B0[2][2], B1[2][2];
    unsigned oc[2][2];
    const char* cA = S.a_base(cur); const char* cB = S.b_base(cur);
    PG8_AOFFS(cur, oc);
#define PG8_TABLES(U, buf) do { if constexpr (Sched::TBL) { LAS unsigned char* tb_ = S.tb + (buf) * 1024;   const int lane = hw_lane_id();   \
        if (wid < 4) { __builtin_amdgcn_global_load_lds((const unsigned*)(S.tab0(U) + 64 * wid + lane), (LAS unsigned*)(tb_ + wid * 256), 4, 0, 0); \
            if (S.tab2(U)) __builtin_amdgcn_global_load_lds((const unsigned*)(S.tab2(U) + 64 * wid + lane), (LAS unsigned*)(tb_ + 6144 + wid * 256), 4, 0, 0); } \
        else { __builtin_amdgcn_global_load_lds((const unsigned*)(S.tab1(U) + 64 * (wid - 4) + lane), (LAS unsigned*)(tb_ + 3072 + (wid - 4) * 256), 4, 0, 0); } } } while (0)
    PG8_TABLES(cur, 0);
    PG8_STAGE(PG8_SB(0, 0), cB, voffB); PG8_STAGE(PG8_SB(0, 1), cB + hstep, voffB); PG8_STAGE(PG8_SA(0, 0), cA, oc[0]); PG8_STAGE(PG8_SA(0, 1), cA, oc[1]);
    if (wr == 1) PG8_BAR;
    PG8_WAIT_V(2); PG8_BAR;
    PG8_STAGE(PG8_SB(1, 0), cB + kstep, voffB); PG8_STAGE(PG8_SA(1, 0), cA + kstep, oc[0]); PG8_STAGE(PG8_SB(1, 1), cB + hstep + kstep, voffB);
    PG8_WAIT_V(6); PG8_BAR;
    for (;;) {
        const bool has_next = S.next(ui + 1, nxt);
        const char* nA = has_next ? S.a_base(nxt) : cA; const char* nB = has_next ? S.b_base(nxt) : cB;
        if (has_next) { PG8_TABLES(nxt, (ui + 1) % 3); }
        for (int t = 0; t < nt; t += 2) {
            const bool last = (t == nt - 2);
            const char* a1 = cA + (size_t)(t + 1) * kstep;
            const char* a2 = last ? nA : cA + (size_t)(t + 2) * kstep; const char* b2 = last ? nB : cB + (size_t)(t + 2) * kstep;
            const char* a3 = a2 + kstep; const char* b3 = b2 + kstep;
            PG8_LDB(B0, 0, 0); PG8_LDB(B1, 0, 1); PG8_SCHED; PG8_LDA(At, 0, 0); PG8_STAGE(PG8_SA(1, 1), a1, oc[1]);
            PG8_WAIT_V(8); PG8_WAIT_L(0); PG8_BAR; PG8_MMA(0, 0, At, B0); PG8_MMA(0, 1, At, B1); PG8_BAR; PG8_SCHED;
            if (last && has_next) { PG8_AOFFS_NEXT(oc); }
            PG8_LDA(At, 0, 1); PG8_STAGE(PG8_SB(0, 0), b2, voffB); PG8_STAGE(PG8_SB(0, 1), b2 + hstep, voffB); PG8_STAGE(PG8_SA(0, 0), a2, oc[0]);
            PG8_WAIT_V(8); PG8_WAIT_L(0); PG8_BAR; PG8_MMA(1, 0, At, B0); PG8_MMA(1, 1, At, B1); PG8_BAR; PG8_SCHED;
            PG8_LDB(B0, 1, 0); PG8_LDB(B1, 1, 1); PG8_SCHED; PG8_LDA(At, 1, 0); PG8_STAGE(PG8_SA(0, 1), a2, oc[1]);
            PG8_WAIT_V(8); PG8_WAIT_L(0); PG8_BAR; PG8_MMA(0, 0, At, B0); PG8_MMA(0, 1, At, B1); PG8_BAR; PG8_SCHED;
            PG8_LDA(At, 1, 1); PG8_STAGE(PG8_SB(1, 0), b3, voffB); PG8_STAGE(PG8_SB(1, 1), b3 + hstep, voffB); PG8_STAGE(PG8_SA(1, 0), a3, oc[0]);
            PG8_WAIT_V(8); PG8_WAIT_L(0); PG8_BAR; PG8_MMA(1, 0, At, B0); PG8_MMA(1, 1, At, B1); PG8_BAR; PG8_SCHED;
        }
        if constexpr (ALIGN_EPI) { if (wr == 0) PG8_BAR; }
        if constexpr (Sched::TBL) E(acc, cur, wr, wc, fr, fq, S.tb + (ui % 3) * 1024); else E(acc, cur, wr, wc, fr, fq);
        if (!has_next) break;
#pragma unroll
        for (int a = 0; a < 2; ++a)
#pragma unroll
            for (int b = 0; b < 2; ++b)
#pragma unroll
                for (int m = 0; m < 4; ++m)
#pragma unroll
                    for (int n = 0; n < 2; ++n) acc[a][b][m][n] = (f32x4){0.f, 0.f, 0.f, 0.f};
        cur = nxt; cA = nA; cB = nB; ++ui;
        if constexpr (ALIGN_EPI) { if (wr == 1) PG8_BAR; }
    }
    PG8_WAIT_V(0);
    if constexpr (!ALIGN_EPI) { if (wr == 0) PG8_BAR; }
    PG8_BAR;
#undef PG8_SA
#undef PG8_SB
#undef PG8_STAGE
#undef PG8_LDA
#undef PG8_LDB
#undef PG8_MMA
#undef PG8_WAIT_V
#undef PG8_WAIT_L
#undef PG8_BAR
#undef PG8_SCHED
#undef PG8_AOFFS
#undef PG8_AOFFS_NEXT
#undef PG8_TABLES
#undef PG8_CAT
}
}

#define XB_TMO      128
#define XB_XCNT(j)  (256  + 64 * (j))
#define XB_XSUB(j)  (1280 + 64 * (j))
#define XB_XGEN(j)  (2304 + 64 * (j))
#define XB_TOP      3328
#define XB_TOPGEN   3392
#define XCD_BAR_WORDS 3456
#define XB_SPIN_CAP (1u << 18)
__device__ __forceinline__ unsigned xb_ld(unsigned* p)              { return __hip_atomic_load(p, __ATOMIC_RELAXED, __HIP_MEMORY_SCOPE_AGENT); }
__device__ __forceinline__ unsigned xb_add(unsigned* p, unsigned v) { return __hip_atomic_fetch_add(p, v, __ATOMIC_RELAXED, __HIP_MEMORY_SCOPE_AGENT); }
__device__ __forceinline__ unsigned xb_xcc_id() { return (unsigned)__builtin_amdgcn_s_getreg((3 << 11) | 20) & 0xFu; }
#define XB_SPIN(cond, bar) do { unsigned _sp = 0; while (cond) { __builtin_amdgcn_s_sleep(1); \
    if ((++_sp & 255u) == 0u) { if (xb_ld(&(bar)[XB_TMO])) break; if (_sp > XB_SPIN_CAP) { atomicAdd(&(bar)[XB_TMO], 1u); break; } } } } while (0)
struct XcdBarrier { unsigned* bar; unsigned x; volatile LAS unsigned* st; int wave; };
__device__ __forceinline__ XcdBarrier xcd_barrier_post(unsigned* bar, volatile LAS unsigned* st, int wave) {
    XcdBarrier b; b.bar = bar; b.x = xb_xcc_id(); b.st = st; b.wave = wave;
    if (wave == 0 && hw_lane_id() == 0) (void)xb_add(&bar[XB_XCNT(b.x)], 1u);
    return b;
}
__device__ __forceinline__ void xcd_barrier_complete(unsigned* bar, unsigned x, unsigned& nloc, unsigned& nx) {
    const unsigned G = gridDim.x * gridDim.y * gridDim.z;
    unsigned sum, cnt, mine, sp = 0u;
    for (;;) {
        sum = 0u; cnt = 0u; mine = 0u;
#pragma unroll
        for (unsigned j = 0; j < 16; ++j) { const unsigned c = xb_ld(&bar[XB_XCNT(j)]); sum += c; cnt += (c > 0u) ? 1u : 0u; mine = (j == x) ? c : mine; }
        if (sum == G) break;
        __builtin_amdgcn_s_sleep(1);
        if ((++sp & 255u) == 0u) { if (xb_ld(&bar[XB_TMO])) break; if (sp > XB_SPIN_CAP) { atomicAdd(&bar[XB_TMO], 1u); break; } }
    }
    nloc = mine > 0u ? mine : 1u; nx = cnt > 0u ? cnt : 1u;
}
__device__ __forceinline__ void xcd_barrier(const XcdBarrier& b) {
    asm volatile("s_waitcnt vmcnt(0)" ::: "memory");
    __syncthreads();
    if (b.wave == 0 && hw_lane_id() == 0) {
        unsigned* bar = b.bar;
        __builtin_amdgcn_s_waitcnt(0);
        unsigned nloc = b.st[0], nx = b.st[1];
        if (nloc == 0u) { xcd_barrier_complete(bar, b.x, nloc, nx); b.st[0] = nloc; b.st[1] = nx; }
        const unsigned old = xb_add(&bar[XB_XSUB(b.x)], 1u);
        const unsigned gen = old / nloc;
        if (old + 1u == (gen + 1u) * nloc) {
            __builtin_amdgcn_fence(__ATOMIC_RELEASE, "agent");
            asm volatile("s_waitcnt vmcnt(0)" ::: "memory");
            const unsigned og = xb_add(&bar[XB_TOP], 1u);
            const unsigned tg = og / nx;
            if (og + 1u == (tg + 1u) * nx) xb_add(&bar[XB_TOPGEN], 1u);
            else XB_SPIN(xb_ld(&bar[XB_TOPGEN]) == tg, bar);
            __builtin_amdgcn_fence(__ATOMIC_ACQUIRE, "agent");
            xb_add(&bar[XB_XGEN(b.x)], 1u);
            asm volatile("s_waitcnt vmcnt(0)" ::: "memory");
        } else {
            const unsigned pos = old - gen * nloc;
            if (pos == 0u || pos == (3u * nloc) / 4u) { __builtin_amdgcn_fence(__ATOMIC_RELEASE, "agent"); asm volatile("s_waitcnt vmcnt(0)" ::: "memory"); }
            XB_SPIN(xb_ld(&bar[XB_XGEN(b.x)]) == gen, bar);
            __builtin_amdgcn_fence(__ATOMIC_ACQUIRE, "agent");
            asm volatile("s_waitcnt vmcnt(0)" ::: "memory");
        }
    }
    __syncthreads();
}

struct Frame {
    LAS unsigned char* lds;
    unsigned* ctl;
    int wave, G;
    __device__ __forceinline__ int lane_() const { return hw_lane_id(); }
    __device__ __forceinline__ int tid_() const { return wave * 64 + hw_lane_id(); }
    const float *x, *c, *ctx, *c_ctx, *w_mod, *b_mod, *norm1_w, *norm2_w, *w_in, *conv_w, *conv_b, *dt_bias, *a_log, *d_skip, *ssd_norm_w, *pool_w, *pool_scale, *w_out, *router_w, *router_b, *w1, *b1, *w2, *b2, *final_norm_w;
    float* out;
    float *MOD, *DTRAW, *DT, *ROWSC, *CHS, *TOPG, *SLOTGATE;
    bf16* X1;
    int *TOPE, *TOPR, *TOKSLOT, *SLOTTOK, *SLOTID, *ROWID, *BB;
    bf16 *WINT, *WOUTT, *W1T, *W2T, *A1, *XBCPRE, *Z, *V, *XBC, *CC, *ST, *Y, *YB, *A2, *H2, *ACT, *YS;
};

template <class RowMap>
__device__ __forceinline__ void p0_emit(bf16* WT, int Kd, RowMap rm, int k0, int n0, int nvalid, LAS float* scr, int lane) {
    const int c = lane & 7;
#pragma unroll
    for (int j = 0; j < 4; ++j) { const int n = (lane >> 3) + 8 * j; const LAS float* s = scr + (8 * c) * 33 + n;
        v4u o; o.x = pk2(s[0 * 33], s[1 * 33]); o.y = pk2(s[2 * 33], s[3 * 33]); o.z = pk2(s[4 * 33], s[5 * 33]); o.w = pk2(s[6 * 33], s[7 * 33]);
        if (n0 + n < nvalid) *(v4u*)(WT + (size_t)rm(n0 + n) * Kd + k0 + 8 * c) = o; }
    LDS_WAIT(); asm volatile("" ::: "memory");
}
template <class RowMap>
__device__ __forceinline__ void p0_transpose_item(const float* W, int N, int nvalid, bf16* WT, int Kd, RowMap rm, LAS float* scr, int kb, int nb, int lane) {
    const int k0 = 64 * kb, n0 = 32 * nb, nn = n0 + (lane & 31); const bool ok = nn < nvalid;
    float tv[32];
#pragma unroll
    for (int i = 0; i < 32; ++i) { const int kk = 2 * i + (lane >> 5); tv[i] = ok ? W[(size_t)(k0 + kk) * N + nn] : 0.f; }
#pragma unroll
    for (int i = 0; i < 32; ++i) { const int kk = 2 * i + (lane >> 5); scr[kk * 33 + (lane & 31)] = tv[i]; }
    LDS_WAIT(); asm volatile("" ::: "memory");
    p0_emit(WT, Kd, rm, k0, n0, nvalid, scr, lane);
}
struct RmId { __device__ __forceinline__ int operator()(int n) const { return n; } };
struct RmOff { int off; __device__ __forceinline__ int operator()(int n) const { return n + off; } };
struct RmWin { __device__ __forceinline__ int operator()(int n) const { return n < 2560 ? n : (n < 2608 ? 4608 + (n - 2560) : 2560 + (n - 2608)); } };
struct RmW1 { __device__ __forceinline__ int operator()(int n) const { const int j = n >> 1; return 256 * (j >> 7) + 128 * (n & 1) + (j & 127); } };

constexpr int P0_I_WIN = 16 * 130, P0_I_WOUT = 32 * 32, P0_I_W1 = 32 * 16 * 64, P0_I_W2 = 32 * 16 * 32, P0_NI = P0_I_WIN + P0_I_WOUT + P0_I_W1 + P0_I_W2;
constexpr int P0_NMOVE = 28672;
template <class Deal>
__device__ __forceinline__ void p0_convert(Frame& F, const Deal& deal, int nrounds, int item_lo, int item_hi) {
    LAS float* scr = (LAS float*)(F.lds + F.wave * 16384);
    const int lane = F.lane_();
    constexpr int I_WIN = P0_I_WIN, I_WOUT = P0_I_WOUT, I_W1 = P0_I_W1;
    struct It { const float* src; bf16* dst; int N, nvalid, Kd, kind, k0, n0; };
#define P0_DECODE(it, I) do { int r_ = (it); \
        if (r_ < I_WIN) { I.src = F.w_in; I.dst = F.WINT; I.N = IN_COLS; I.nvalid = 4144; I.Kd = D; I.kind = 1; I.k0 = 64 * (r_ / 130); I.n0 = 32 * (r_ % 130); } \
        else if ((r_ -= I_WIN) < I_WOUT) { const int hf_ = r_ & 1, q_ = r_ >> 1; I.src = F.w_out; I.dst = F.WOUTT; I.N = D; I.nvalid = D; I.Kd = 2048; I.kind = 3; I.k0 = 64 * (2 * (q_ >> 5) + hf_); I.n0 = 32 * (q_ & 31); } \
        else if ((r_ -= I_WOUT) < I_W1) { const int hf_ = r_ & 1, p_ = r_ >> 1, e_ = p_ >> 9, q_ = p_ & 511; I.src = F.w1 + (size_t)e_ * D * 2048; I.dst = (bf16*)((unsigned char*)F.W1T + (size_t)e_ * 2048 * D); I.N = 2048; I.nvalid = 2048; I.Kd = D; I.kind = 2; I.k0 = 64 * (2 * (q_ >> 6) + hf_); I.n0 = 32 * (q_ & 63); } \
        else { r_ -= I_W1; const int hf_ = r_ & 1, p_ = r_ >> 1, e_ = p_ >> 8, q_ = p_ & 255; I.src = F.w2 + (size_t)e_ * D * D; I.dst = (bf16*)((unsigned char*)F.W2T + (size_t)e_ * D * D); I.N = D; I.nvalid = D; I.Kd = D; I.kind = 3; I.k0 = 64 * (2 * (q_ >> 5) + hf_); I.n0 = 32 * (q_ & 31); } } while (0)
#define P0_LOAD(I, tv) do { int nn_ = I.n0 + (lane & 31); nn_ = nn_ < I.nvalid ? nn_ : I.nvalid - 1; const float* sp_ = I.src + (size_t)(I.k0 + (lane >> 5)) * I.N + nn_; \
        _Pragma("unroll") for (int i_ = 0; i_ < 32; ++i_) { const float* q_ = sp_ + (size_t)(2 * i_) * I.N; asm volatile("global_load_dword %0, %1, off nt" : "=v"(tv[i_]) : "v"(q_) : "memory"); } } while (0)
#define P0_NEXT(itv) do { itv = -1; for (; kr < nrounds && itv < 0; ++kr) { const int it_ = deal(kr); if (it_ >= item_lo && it_ < item_hi) itv = it_; } } while (0)
#define P0_PROCESS(I, tv) do { \
        _Pragma("unroll") for (int i = 0; i < 32; ++i) { const int kk = 2 * i + (lane >> 5); scr[kk * 33 + (lane & 31)] = tv[i]; } \
        LDS_WAIT(); asm volatile("" ::: "memory"); \
        { const int c = lane & 7; \
          _Pragma("unroll") for (int j = 0; j < 4; ++j) { const int n = (lane >> 3) + 8 * j; const LAS float* sq = scr + (8 * c) * 33 + n; \
            const int ng = I.n0 + n; const int row = (I.kind == 0 || I.kind == 3) ? ng : (I.kind == 1 ? RmWin{}(ng) : RmW1{}(ng)); \
            if (I.kind >= 2) { v2u o; o.x = pk4_fp8(sq[0 * 33] * WSCALE, sq[1 * 33] * WSCALE, sq[2 * 33] * WSCALE, sq[3 * 33] * WSCALE); o.y = pk4_fp8(sq[4 * 33] * WSCALE, sq[5 * 33] * WSCALE, sq[6 * 33] * WSCALE, sq[7 * 33] * WSCALE); \
                *(v2u*)((unsigned char*)I.dst + (size_t)row * I.Kd + I.k0 + 8 * c) = o; } \
            else { v4u o; o.x = pk2(sq[0 * 33], sq[1 * 33]); o.y = pk2(sq[2 * 33], sq[3 * 33]); o.z = pk2(sq[4 * 33], sq[5 * 33]); o.w = pk2(sq[6 * 33], sq[7 * 33]); \
                if (ng < I.nvalid) *(v4u*)(I.dst + (size_t)row * I.Kd + I.k0 + 8 * c) = o; } } \
          LDS_WAIT(); asm volatile("" ::: "memory"); } } while (0)
    It ia{}, ib{}; float ta[32], tb[32]; int ita = -1, itb = -1; int kr = 0;
    P0_NEXT(ita);
    if (ita >= 0) { P0_DECODE(ita, ia); P0_LOAD(ia, ta); }
    while (ita >= 0) {
        P0_NEXT(itb);
        if (itb >= 0) { P0_DECODE(itb, ib); P0_LOAD(ib, tb); asm volatile("s_waitcnt vmcnt(32)" ::: "memory"); } else { asm volatile("s_waitcnt vmcnt(0)" ::: "memory"); }
        __builtin_amdgcn_sched_barrier(0);
        P0_PROCESS(ia, ta);
        if (itb < 0) break;
        P0_NEXT(ita);
        if (ita >= 0) { P0_DECODE(ita, ia); P0_LOAD(ia, ta); asm volatile("s_waitcnt vmcnt(32)" ::: "memory"); } else { asm volatile("s_waitcnt vmcnt(0)" ::: "memory"); }
        __builtin_amdgcn_sched_barrier(0);
        P0_PROCESS(ib, tb);
    }
#undef P0_NEXT
#undef P0_PROCESS
#undef P0_DECODE
#undef P0_LOAD
}
__device__ __forceinline__ void p0_prologue(Frame& F) {
    if ((int)blockIdx.x < 96) {
        LAS float* sc = (LAS float*)F.lds;
        LAS float* part = (LAS float*)(F.lds + 36864);
        for (int idx = F.tid_(); idx < 9 * 1024; idx += 512) { const int r = idx >> 10, k = idx & 1023; const float v = (r < 8) ? F.c[r * 1024 + k] : F.c_ctx[k]; sc[idx] = silu_f(v); }
        __syncthreads();
        const int n = 64 * (int)blockIdx.x + F.lane_(), kb = 128 * F.wave;
        float acc[9];
#pragma unroll
        for (int r = 0; r < 9; ++r) acc[r] = 0.f;
#define P0_GL(w, k0) do { _Pragma("unroll") for (int j = 0; j < 32; ++j) w[j] = __builtin_nontemporal_load(F.w_mod + (size_t)(kb + (k0) + j) * 6144 + n); } while (0)
#define P0_GF(w, k0) do { _Pragma("unroll") for (int j = 0; j < 32; ++j) { _Pragma("unroll") for (int r = 0; r < 9; ++r) acc[r] += sc[r * 1024 + kb + (k0) + j] * w[j]; } } while (0)
        float wa[32], wb[32];
        P0_GL(wa, 0); __builtin_amdgcn_sched_barrier(0);
        P0_GL(wb, 32); __builtin_amdgcn_sched_barrier(0);
        P0_GF(wa, 0); __builtin_amdgcn_sched_barrier(0);
        P0_GL(wa, 64); __builtin_amdgcn_sched_barrier(0);
        P0_GF(wb, 32); __builtin_amdgcn_sched_barrier(0);
        P0_GL(wb, 96); __builtin_amdgcn_sched_barrier(0);
        P0_GF(wa, 64); __builtin_amdgcn_sched_barrier(0);
        P0_GF(wb, 96);
#undef P0_GL
#undef P0_GF
#pragma unroll
        for (int r = 0; r < 9; ++r) part[(F.wave * 9 + r) * 64 + F.lane_()] = acc[r];
        __syncthreads();
        for (int idx = F.tid_(); idx < 9 * 64; idx += 512) { const int r = idx >> 6, col = idx & 63; float s = 0.f;
#pragma unroll
            for (int w = 0; w < 8; ++w) s += part[(w * 9 + r) * 64 + col];
            F.MOD[r * 6144 + 64 * (int)blockIdx.x + col] = s + F.b_mod[64 * (int)blockIdx.x + col]; }
        __builtin_amdgcn_fence(__ATOMIC_RELEASE, "agent");
        __syncthreads();
        if (F.wave == 0 && hw_lane_id() == 0) (void)__hip_atomic_fetch_add(F.ctl + CW_MODFLAG, 1u, RLX_AGENT);
    }
    LAS float* scr = (LAS float*)(F.lds + F.wave * 16384);
    const int gw = (int)blockIdx.x * 8 + F.wave, NGW = F.G * 8, lane = F.lane_();
    constexpr int I_POOL = 16 * 4 * 4, I_PAD = N1 - IN_COLS;
    const bool spread = (F.G == 256);
    for (int r = spread ? (F.wave == 7 ? (int)blockIdx.x : (F.wave == 6 ? I_POOL + (int)blockIdx.x : I_POOL + I_PAD)) : NGW - 1 - gw; r < I_POOL + I_PAD; r += spread ? (I_POOL + I_PAD) : NGW) {
        if (r < I_POOL) {
            const int kb = r >> 4, g = (r >> 2) & 3, ob = r & 3, o0 = 32 * ob;
            float acc[32];
#pragma unroll
            for (int o = 0; o < 32; ++o) acc[o] = 0.f;
            const int lr = lane >> 3, lc = lane & 7;
            for (int qq = 0; qq < 4; ++qq) {
                f32x4 t[8];
#pragma unroll
                for (int j = 0; j < 8; ++j) t[j] = __builtin_nontemporal_load((const f32x4*)(F.w_in + (size_t)(64 * kb + 8 * j + lr) * IN_COLS + 4144 + g * 128 + 32 * qq + 4 * lc));
                f32x4 tb[4];
#pragma unroll
                for (int j = 0; j < 4; ++j) tb[j] = *(const f32x4*)(F.pool_w + (size_t)(g * 128 + 32 * qq + 8 * j + lr) * 128 + o0 + 4 * lc);
                LDS_WAIT(); asm volatile("" ::: "memory");
#pragma unroll
                for (int j = 0; j < 8; ++j) { LAS float* w_ = scr + (8 * j + lr) * 33 + 4 * lc; w_[0] = t[j].x; w_[1] = t[j].y; w_[2] = t[j].z; w_[3] = t[j].w; }
                LAS float* Bs = scr + 2176;
#pragma unroll
                for (int j = 0; j < 4; ++j) *(LAS f32x4*)(Bs + (8 * j + lr) * 32 + 4 * lc) = tb[j];
                LDS_WAIT(); asm volatile("" ::: "memory");
#pragma unroll 4
                for (int i = 0; i < 32; ++i) { const float a = scr[lane * 33 + i]; const LAS float* pw = Bs + i * 32;
#pragma unroll
                    for (int o4 = 0; o4 < 8; ++o4) { const f32x4 b4 = *(const LAS f32x4*)(pw + 4 * o4); acc[4 * o4] += a * b4.x; acc[4 * o4 + 1] += a * b4.y; acc[4 * o4 + 2] += a * b4.z; acc[4 * o4 + 3] += a * b4.w; } }
            }
            LDS_WAIT(); asm volatile("" ::: "memory");
#pragma unroll
            for (int o = 0; o < 32; ++o) scr[lane * 33 + o] = acc[o] * F.pool_scale[g * 128 + o0 + o];
            LDS_WAIT(); asm volatile("" ::: "memory");
            p0_emit(F.WINT, D, RmOff{4096 + g * 128}, 64 * kb, o0, 1 << 30, scr, lane);
        } else { v4u z = {0u, 0u, 0u, 0u}; v4u* p = (v4u*)(F.WINT + (size_t)(IN_COLS + (r - I_POOL)) * D); p[lane] = z; p[lane + 64] = z; }
    }
    for (int i = (int)blockIdx.x * 512 + F.tid_(); i < T; i += F.G * 512) F.ROWID[i] = i;
    const bool wdeal = (F.G == 256);
    const int blk = (int)blockIdx.x;
    constexpr int R1 = (P0_NI - P0_NMOVE - 3104) / 2048, R3 = R1 + 2;   static_assert((P0_NI - P0_NMOVE - 3104) % 2048 == 0, "whole rounds");
    static_assert(R1 * 2048 + (R3 - R1) * 1792 >= P0_NI - P0_NMOVE, "dealing covers the items");
    const int w7 = F.wave;
    auto deal = [=](int k) -> int { return wdeal ? (k < R1 ? 2 * ((k >> 1) * 2048 + gw) + (k & 1) : (w7 != 7 ? 2 * (R1 * 1024 + ((k - R1) >> 1) * 1792 + (blk * 7 + w7)) + (k & 1) : -1)) : 2 * ((k >> 1) * NGW + gw) + (k & 1); };
    p0_convert(F, deal, wdeal ? R3 : 2 * ((P0_NI / 2 + NGW - 1) / NGW), 0, wdeal ? P0_NI - P0_NMOVE : P0_NI);
}

__device__ __forceinline__ void p1_norm1(Frame& F) {
    const int gw = (int)blockIdx.x * 8 + F.wave, NGW = F.G * 8;
    if (F.wave == 0 && hw_lane_id() == 0) { unsigned sp = 0;
        while (__hip_atomic_load(F.ctl + CW_MODFLAG, RLX_AGENT) < 96u) { __builtin_amdgcn_s_sleep(1); if (++sp > (1u << 22)) break; } }
    __syncthreads();
    __builtin_amdgcn_fence(__ATOMIC_ACQUIRE, "agent");
#define P1_LOAD(v, rb) do { _Pragma("unroll") for (int k = 0; k < 4; ++k) { const float* xr = F.x + (size_t)((rb) + k) * D; \
        _Pragma("unroll") for (int j = 0; j < 4; ++j) v[k][j] = __builtin_nontemporal_load((const f32x4*)(xr + 4 * lane + 256 * j)); } } while (0)
#define P1_ROW(vr, r) do { float ss = 0.f; \
            _Pragma("unroll") for (int j = 0; j < 4; ++j) ss += (vr[j].x * vr[j].x + vr[j].y * vr[j].y) + (vr[j].z * vr[j].z + vr[j].w * vr[j].w); \
            const float rs = __builtin_amdgcn_rsqf(wave_sum(ss) * (1.f / D) + RMS_EPS); \
            _Pragma("unroll") for (int j = 0; j < 4; ++j) { const int col = 4 * lane + 256 * j; \
                const f32x4 h = (vr[j] * rs) * wsc[j] + shv[j]; \
                v2u o; o.x = pk2(h.x, h.y); o.y = pk2(h.z, h.w); \
                *(v2u*)(F.A1 + (size_t)(r) * D + col) = o; } } while (0)
#define P1_MOD(mb) do { const float* mod = F.MOD + (size_t)(mb) * 6144; \
        _Pragma("unroll") for (int j = 0; j < 4; ++j) { const int col = 4 * lane + 256 * j; wsc[j] = *(const f32x4*)(F.norm1_w + col) * (*(const f32x4*)(mod + 1024 + col) + 1.f); shv[j] = *(const f32x4*)(mod + col); } } while (0)
#define P1_SB __builtin_amdgcn_sched_barrier(0)
    for (int blk = gw; blk < T / 16; blk += NGW) {
        const int rb = blk * 16, lane = hw_lane_id();
        const bool has_ctx = blk < RTOT - T;
        f32x4 wsc[4], shv[4], va[4][4], vb[4][4], vc[4], nw[4], m1[4];
        { const float* mod = F.MOD + (size_t)(rb >> 12) * 6144;
#pragma unroll
          for (int j = 0; j < 4; ++j) { const int col = 4 * lane + 256 * j; nw[j] = *(const f32x4*)(F.norm1_w + col); m1[j] = *(const f32x4*)(mod + 1024 + col); shv[j] = *(const f32x4*)(mod + col); } }
        P1_SB;
        P1_LOAD(va, rb);
        P1_SB;
#pragma unroll
        for (int j = 0; j < 4; ++j) wsc[j] = nw[j] * (m1[j] + 1.f);
        P1_SB;
        P1_LOAD(vb, rb + 4);
        P1_SB;
#pragma unroll
        for (int k = 0; k < 4; ++k) P1_ROW(va[k], rb + k);
        P1_SB;
        P1_LOAD(va, rb + 8);
        P1_SB;
#pragma unroll
        for (int k = 0; k < 4; ++k) P1_ROW(vb[k], rb + 4 + k);
        P1_SB;
        P1_LOAD(vb, rb + 12);
        P1_SB;
#pragma unroll
        for (int k = 0; k < 4; ++k) P1_ROW(va[k], rb + 8 + k);
        P1_SB;
        if (has_ctx) { const float* mod = F.MOD + (size_t)8 * 6144;
#pragma unroll
            for (int j = 0; j < 4; ++j) { const int col = 4 * lane + 256 * j; vc[j] = __builtin_nontemporal_load((const f32x4*)(F.ctx + (size_t)blk * D + col)); va[1][j] = *(const f32x4*)(F.norm1_w + col); va[2][j] = *(const f32x4*)(mod + 1024 + col); va[0][j] = *(const f32x4*)(mod + col); } }
        P1_SB;
#pragma unroll
        for (int k = 0; k < 4; ++k) P1_ROW(vb[k], rb + 12 + k);
        if (has_ctx) {
#pragma unroll
            for (int j = 0; j < 4; ++j) { wsc[j] = va[1][j] * (va[2][j] + 1.f); shv[j] = va[0][j]; }
            P1_ROW(vc, T + blk); }
    }
#undef P1_SB
#undef P1_LOAD
#undef P1_ROW
#undef P1_MOD
}

struct Sched1 {   static constexpr bool TBL = false;
    const char* A; const char* Bt; int G, c;
    __device__ __forceinline__ bool next(int i, pg8::Unit& u) const {
        const int L = i * G + c; if (L >= 2432 + 88) return false;
        if (L < 2432) pg8::static_map(L, 128, 19, u.pm, u.pn);
        else { const int Lc = L - 2432, j = Lc >> 3; u.pm = 128 + (Lc & 7); u.pn = j < 10 ? j : 18; }
        u.e = 0; return true; }
    __device__ __forceinline__ const char* a_base(const pg8::Unit& u) const { return A + (size_t)u.pm * 256 * D * 2; }
    __device__ __forceinline__ const char* b_base(const pg8::Unit& u) const { return Bt + (size_t)u.pn * 256 * D * 2; }
    __device__ __forceinline__ const int* row_table(const pg8::Unit&) const { return nullptr; }
};
struct Epi1 {
    static constexpr bool PERM = true;
    bf16 *XBCPRE, *Z, *V; float* DTRAW;
    __device__ __forceinline__ void operator()(const f32x4 (&acc)[2][2][4][2], const pg8::Unit& u, int wr, int wc, int fr, int fq) const {
        const int row0 = u.pm * 256 + wr * 64 + fr;
        if (u.pn < 18) {
            bf16* base; int ldc, colt;
            if (u.pn < 10) { base = XBCPRE; ldc = CONV_CH; colt = u.pn * 256; } else if (u.pn < 16) { base = Z; ldc = SSD_W; colt = (u.pn - 10) * 256; } else { base = V; ldc = 512; colt = (u.pn - 16) * 256; }
            const int col0 = colt + wc * 32 + 8 * fq;
#pragma unroll
            for (int ai = 0; ai < 2; ++ai)
#pragma unroll
                for (int m = 0; m < 4; ++m) { bf16* rowp = base + (size_t)(row0 + ai * 128 + m * 16) * ldc + col0;
#pragma unroll
                    for (int bj = 0; bj < 2; ++bj) { const f32x4 v0 = acc[ai][bj][m][0], v1 = acc[ai][bj][m][1];
                        v4u w; w.x = pg8::cvt_pk_bf16(v0[0], v0[1]); w.y = pg8::cvt_pk_bf16(v0[2], v0[3]); w.z = pg8::cvt_pk_bf16(v1[0], v1[1]); w.w = pg8::cvt_pk_bf16(v1[2], v1[3]);
                        *(v4u*)(rowp + bj * 128) = w; } }
        } else if (wc < 2) {
            const int col0 = wc * 32 + 8 * fq;
#pragma unroll
            for (int ai = 0; ai < 2; ++ai)
#pragma unroll
                for (int m = 0; m < 4; ++m) { float* rowp = DTRAW + (size_t)(row0 + ai * 128 + m * 16) * 64 + col0;
                    *(f32x4*)(rowp) = acc[ai][0][m][0]; *(f32x4*)(rowp + 4) = acc[ai][0][m][1]; }
        }
    }
};

__device__ __forceinline__ bf16x8 frag_row(const LAS unsigned char* base, int rs, int row, int k0, int q) { return *(const LAS bf16x8*)(base + row * rs + (k0 + 8 * q) * 2); }
__device__ __forceinline__ bf16x8 frag_tr(const LAS unsigned char* base, int rs, int k0, int c0, int lane) {
    const int g = lane >> 4, qq = (lane & 15) >> 2, p = lane & 3;
    const LAS unsigned char* a = base + (k0 + 8 * g + qq) * rs + c0 * 2 + 8 * p;
    const s16x4 lo = __builtin_amdgcn_ds_read_tr16_b64_v4i16((LAS s16x4*)a);
    const s16x4 hi = __builtin_amdgcn_ds_read_tr16_b64_v4i16((LAS s16x4*)(a + 4 * rs));
    bf16x8 r; r[0] = lo[0]; r[1] = lo[1]; r[2] = lo[2]; r[3] = lo[3]; r[4] = hi[0]; r[5] = hi[1]; r[6] = hi[2]; r[7] = hi[3]; return r;
}
__device__ __forceinline__ f32x4 mfma16(bf16x8 a, bf16x8 b, f32x4 c) { return __builtin_amdgcn_mfma_f32_16x16x32_bf16(a, b, c, 0, 0, 0); }
template <int CTRL, int ROWMASK> __device__ __forceinline__ float dpp_f0(float v) { return __builtin_bit_cast(float, __builtin_amdgcn_update_dpp(0, __builtin_bit_cast(int, v), CTRL, ROWMASK, 0xF, true)); }
__device__ __forceinline__ float wave_incl_scan(float v, int lane) {
    (void)lane;
    v += dpp_f0<0x111, 0xF>(v); v += dpp_f0<0x112, 0xF>(v); v += dpp_f0<0x114, 0xF>(v); v += dpp_f0<0x118, 0xF>(v);
    v += dpp_f0<0x142, 0xA>(v); v += dpp_f0<0x143, 0xC>(v);
    return v;
}

__device__ __forceinline__ float silu_fast(float v) { return v * __builtin_amdgcn_rcpf(1.f + __builtin_amdgcn_exp2f(-1.44269504f * v)); }
__device__ __forceinline__ float softplus_f(float v) { return v > 20.f ? v : log1pf(__expf(v)); }
__device__ __forceinline__ void p4_scan(Frame& F, LAS float* Te, volatile LAS float* TOT, int d, int h, float raw0, float raw1, int lane, size_t chs_idx, float* rowsc) {
    const int s0 = d ? 127 - 2 * lane : 2 * lane, s1 = d ? s0 - 1 : s0 + 1;
    const float bias = F.dt_bias[d * NH + h];
    const float dt0 = softplus_f(raw0 + bias), dt1 = softplus_f(raw1 + bias);
    const float A2 = __expf(F.a_log[d * NH + h]) * 1.44269504f;
    const float a0 = -A2 * dt0, a1 = -A2 * dt1;
    const float incl = wave_incl_scan(a0 + a1, lane);
    const float c1 = incl, c0 = incl - a1, tot = __builtin_bit_cast(float, __builtin_amdgcn_readlane(__builtin_bit_cast(int, incl), 63));
    Te[d * 128 + s0] = c0; Te[d * 128 + s1] = c1;
    Te[(2 + d) * 128 + s0] = c0 - __builtin_amdgcn_logf(dt0); Te[(2 + d) * 128 + s1] = c1 - __builtin_amdgcn_logf(dt1);
    if (lane == 63) { F.CHS[chs_idx] = tot; *TOT = tot; }
    if (rowsc) { rowsc[s0] = __builtin_amdgcn_exp2f(c0); rowsc[s1] = __builtin_amdgcn_exp2f(c1); }
}
__device__ __forceinline__ v4u conv_piece(const v4u& r0, const v4u& r1, const v4u& r2, const v4u& r3, const v4u& r4, const float (&w)[5][8], const float (&bias)[8]) {
    float o[8];
#pragma unroll
    for (int e = 0; e < 8; ++e) o[e] = bias[e];
    const v4u rr[5] = {r0, r1, r2, r3, r4};
#pragma unroll
    for (int j = 0; j < 5; ++j) { const v4u q = rr[j];
        o[0] += w[j][0] * bflo(q.x); o[1] += w[j][1] * bfhi(q.x); o[2] += w[j][2] * bflo(q.y); o[3] += w[j][3] * bfhi(q.y);
        o[4] += w[j][4] * bflo(q.z); o[5] += w[j][5] * bfhi(q.z); o[6] += w[j][6] * bflo(q.w); o[7] += w[j][7] * bfhi(q.w); }
    v4u ov; ov.x = pk2(silu_fast(o[0]), silu_fast(o[1])); ov.y = pk2(silu_fast(o[2]), silu_fast(o[3])); ov.z = pk2(silu_fast(o[4]), silu_fast(o[5])); ov.w = pk2(silu_fast(o[6]), silu_fast(o[7]));
    return ov;
}
__device__ __forceinline__ void p4_states(Frame& F, const bf16x8 (&braw)[4], const LAS unsigned char* WGP, const LAS unsigned char* Xs, size_t st_base, int w, int lane) {
    constexpr int RSX = 144, RSB = 272;
    const int i16 = lane & 15, q4 = lane >> 4;
    f32x4 sa[2][4];
#pragma unroll
    for (int d = 0; d < 2; ++d)
#pragma unroll
        for (int pt = 0; pt < 4; ++pt) sa[d][pt] = (f32x4){0.f, 0.f, 0.f, 0.f};
#pragma unroll
    for (int ks = 0; ks < 4; ++ks) {
        __builtin_amdgcn_sched_barrier(0);
        bf16x8 xf[4];
#pragma unroll
        for (int pt = 0; pt < 4; ++pt) xf[pt] = frag_tr(Xs, RSX, 32 * ks, 16 * pt, lane);
        const LAS unsigned char* wp = WGP + (32 * ks + 8 * q4) * RSB;
        f32x2 w2[8];
#pragma unroll
        for (int j = 0; j < 8; ++j) w2[j] = *(const LAS f32x2*)(wp + j * RSB);
        const v4u bu = __builtin_bit_cast(v4u, braw[ks]);
#pragma unroll
        for (int d = 0; d < 2; ++d) { v4u su;
            su.x = pk2(bflo(bu.x) * w2[0][d], bfhi(bu.x) * w2[1][d]); su.y = pk2(bflo(bu.y) * w2[2][d], bfhi(bu.y) * w2[3][d]);
            su.z = pk2(bflo(bu.z) * w2[4][d], bfhi(bu.z) * w2[5][d]); su.w = pk2(bflo(bu.w) * w2[6][d], bfhi(bu.w) * w2[7][d]);
            const bf16x8 bs = __builtin_bit_cast(bf16x8, su);
#pragma unroll
            for (int pt = 0; pt < 4; ++pt) sa[d][pt] = mfma16(bs, xf[pt], sa[d][pt]); } }
#pragma unroll
    for (int d = 0; d < 2; ++d) {
        unsigned char* sp = (unsigned char*)F.ST + st_base + ((size_t)d * HDIM + i16) * NST + 16 * w + 4 * q4;
#pragma unroll
        for (int pt = 0; pt < 4; ++pt) { float c[4];
#pragma unroll
            for (int r = 0; r < 4; ++r) c[r] = fminf(fmaxf(sa[d][pt][r] * STSCALE, -440.f), 440.f);
            *(unsigned*)(sp + (size_t)16 * pt * NST) = pk4_fp8(c[0], c[1], c[2], c[3]); }
    }
}
__device__ __forceinline__ void p4_stage_cw(Frame& F, const int g) {
    constexpr int O_CW = 153600;
    LAS float* CW = (LAS float*)(F.lds + O_CW);
    volatile LAS float* DSK = (volatile LAS float*)(F.lds + MISC_OFF + 128);
    const int tid = F.tid_();
    if (tid < HPG) DSK[tid] = F.d_skip[g * HPG + tid];
    float cwv[5];
#pragma unroll
    for (int q = 0; q < 5; ++q) { int idx = tid + 512 * q; idx = idx < HPG * 6 * 64 ? idx : HPG * 6 * 64 - 1; const int e_ = idx / 384, rem = idx - e_ * 384, j = rem >> 6, chl = rem & 63; const int ch = (g * HPG + e_) * HDIM + chl;
        const int jj = j < 5 ? j : 0; const float a = F.conv_w[jj * CONV_CH + ch], bq = F.conv_b[ch]; cwv[q] = (j < 5) ? a : bq; }
#pragma unroll
    for (int q = 0; q < 5; ++q) { const int idx = tid + 512 * q; if (idx < HPG * 6 * 64) CW[idx] = cwv[q]; }
}
__device__ __forceinline__ void p4_ssd_local(Frame& F, const int g_prestaged) {
    constexpr int RS = 272, RSX = 144;
    constexpr int O_C = 0, O_B = 34816, O_M = 69632, O_X = 104448  , O_T = 141312  , O_CW = 153600  ;
    static_assert(O_CW + 9216 <= MISC_OFF, "P4 LDS map");
    LAS unsigned char* L = F.lds;
    LAS float* TAB = (LAS float*)(L + O_T);
    LAS float* CW = (LAS float*)(L + O_CW);
    volatile LAS float* TOT = (volatile LAS float*)(L + MISC_OFF + 64);
    volatile LAS float* DSK = (volatile LAS float*)(L + MISC_OFF + 128);
    const int tid = F.tid_(), w = F.wave;
    const int lb = 64 * (w & 1), sb = 32 * (w >> 1);
    const v4u zero4 = {0u, 0u, 0u, 0u};
    constexpr int NLAT = NB * 32 * NGRP, NCTX = NB * 2 * NGRP * HPG;
    int g_staged = g_prestaged;
    for (int v = (int)blockIdx.x; v < NLAT + NCTX; v += F.G) {
        const bool lat = v < NLAT;
        int tid_l = tid; asm volatile("" : "+v"(tid_l));
        const int lane_l = tid_l & 63, lane = lane_l, i16 = lane & 15, q4 = lane >> 4;
        const int p32 = tid_l & 31, rg = tid_l >> 5;
        const int xpc = tid_l & 7, rg2 = tid_l >> 3;
        int b, g, cc, r0, e_lo, e_hi; bool lo_ok, hi_ok;
        if (lat) { b = v >> 7; const int c = (v >> 2) & 31; g = v & 3; cc = c + 2; r0 = b * SEQ + c * CHUNK; lo_ok = c > 0; hi_ok = c < 31; e_lo = 0; e_hi = HPG; }
        else { const int q = v - NLAT; const int e = q % HPG; int t = q / HPG; g = t & 3; t >>= 2; cc = t & 1; b = t >> 1; r0 = T + b * CTXL + cc * CHUNK; lo_ok = cc > 0; hi_ok = cc < 1; e_lo = e; e_hi = e + 1; }
        const int rmin = lo_ok ? -2 : 0, rmax = hi_ok ? 129 : 127;
        const int chBC = SSD_W + (p32 >> 4) * (NGRP * NST) + g * NST + 8 * (p32 & 15);
        v4u raw[12];
#pragma unroll
        for (int j = 0; j < 12; ++j) { const int rr = 8 * rg - 2 + j; const int rc = rr < rmin ? rmin : (rr > rmax ? rmax : rr);
            const v4u t = __builtin_nontemporal_load((const v4u*)(F.XBCPRE + (size_t)(r0 + rc) * CONV_CH + chBC)); raw[j] = (rr == rc) ? t : zero4; }
        if (g != g_staged) { p4_stage_cw(F, g); g_staged = g; }
        {
            float cw[5][8], cbias[8];
#pragma unroll
            for (int j = 0; j < 5; ++j) { const f32x4 a = *(const f32x4*)(F.conv_w + j * CONV_CH + chBC), bq = *(const f32x4*)(F.conv_w + j * CONV_CH + chBC + 4);
                cw[j][0] = a.x; cw[j][1] = a.y; cw[j][2] = a.z; cw[j][3] = a.w; cw[j][4] = bq.x; cw[j][5] = bq.y; cw[j][6] = bq.z; cw[j][7] = bq.w; }
            { const f32x4 a = *(const f32x4*)(F.conv_b + chBC), bq = *(const f32x4*)(F.conv_b + chBC + 4); cbias[0] = a.x; cbias[1] = a.y; cbias[2] = a.z; cbias[3] = a.w; cbias[4] = bq.x; cbias[5] = bq.y; cbias[6] = bq.z; cbias[7] = bq.w; }
            LAS unsigned char* dst = L + ((p32 >> 4) ? O_C : O_B) + (8 * rg) * RS + (p32 & 15) * 16;
#pragma unroll
            for (int i = 0; i < 8; ++i) { const v4u o = conv_piece(raw[i], raw[i + 1], raw[i + 2], raw[i + 3], raw[i + 4], cw, cbias);
                *(LAS v4u*)(dst + i * RS) = o;
                if (lat && (p32 >> 4)) *(v4u*)(F.CC + (size_t)(r0 + 8 * rg + i) * 512 + g * NST + 8 * (p32 & 15)) = o; }
        }
        v4u xraw[6];
#pragma unroll
        for (int j = 0; j < 6; ++j) { const int rr = 2 * rg2 - 2 + j; const int rc = rr < rmin ? rmin : (rr > rmax ? rmax : rr);
            xraw[j] = __builtin_nontemporal_load((const v4u*)(F.XBCPRE + (size_t)(r0 + rc) * CONV_CH + (g * HPG + e_lo) * HDIM + 8 * xpc)); }
        float pdt[2][2];
#pragma unroll
        for (int ii = 0; ii < 2; ++ii) { const int idx = (w + 8 * ii) < 12 ? (w + 8 * ii) : 11; const int e_ = idx % 6, d_ = idx / 6, h_ = g * HPG + e_; const int s0 = d_ ? 127 - 2 * lane_l : 2 * lane_l, s1 = d_ ? s0 - 1 : s0 + 1;
            pdt[ii][0] = F.DTRAW[(size_t)(r0 + s0) * 64 + d_ * NH + h_]; pdt[ii][1] = F.DTRAW[(size_t)(r0 + s1) * 64 + d_ * NH + h_]; }
#pragma unroll
        for (int ii = 0; ii < 2; ++ii) { const int idx = w + 8 * ii; const int e = idx % 6, d = idx / 6, h = g * HPG + e;
            if (idx < 12 && e >= e_lo && e < e_hi)
                p4_scan(F, TAB + e * 512, TOT + e * 2 + d, d, h, pdt[ii][0], pdt[ii][1], lane_l, ((size_t)(b * NCC + cc) * NH + h) * 2 + d, lat ? F.ROWSC + ((size_t)(b * 2 + d) * NH + h) * SEQ + (cc - 2) * CHUNK : nullptr); }
        __syncthreads();
        f32x4 cb[2][4];
        if (lat) {
#pragma unroll
            for (int ts = 0; ts < 2; ++ts)
#pragma unroll
                for (int tl = 0; tl < 4; ++tl) cb[ts][tl] = (f32x4){0.f, 0.f, 0.f, 0.f};
#pragma unroll
            for (int ks = 0; ks < 4; ++ks) { bf16x8 af[2], bfr[4];
#pragma unroll
                for (int ts = 0; ts < 2; ++ts) af[ts] = frag_row(L + O_B, RS, sb + 16 * ts + i16, 32 * ks, q4);
#pragma unroll
                for (int tl = 0; tl < 4; ++tl) bfr[tl] = frag_row(L + O_C, RS, lb + 16 * tl + i16, 32 * ks, q4);
#pragma unroll
                for (int ts = 0; ts < 2; ++ts)
#pragma unroll
                    for (int tl = 0; tl < 4; ++tl) cb[ts][tl] = mfma16(af[ts], bfr[tl], cb[ts][tl]); }
        }
        bf16x8 braw[4];
#pragma unroll
        for (int ks = 0; ks < 4; ++ks) braw[ks] = frag_tr(L + O_B, RS, 32 * ks, 16 * w, lane);
        for (int e = e_lo; e < e_hi; ++e) {
            const int h = g * HPG + e;
            const LAS float* Te = TAB + e * 512;
            LAS unsigned char* Xs = L + O_X + (e & 1) * 18432;
            LAS unsigned char* Ms = L + ((e & 1) ? O_C : O_M);
            if (w < 4) { const int t_ = w * 64 + hw_lane_id(), d_ = w >> 1, s_ = t_ & 127;
                *(LAS float*)(L + O_B + s_ * RS + 256 + 8 * (e & 1) + 4 * d_) = __builtin_amdgcn_exp2f(TOT[e * 2 + d_] - Te[(2 + d_) * 128 + s_]); }
            {
                const LAS float* cwp = CW + (e * 6) * 64 + 8 * xpc;
#pragma unroll
                for (int i = 0; i < 2; ++i) {
                    f32x4 oa = *(const LAS f32x4*)(cwp + 5 * 64), ob = *(const LAS f32x4*)(cwp + 5 * 64 + 4);
#pragma unroll
                    for (int j = 0; j < 5; ++j) { const f32x4 wa = *(const LAS f32x4*)(cwp + j * 64), wb = *(const LAS f32x4*)(cwp + j * 64 + 4);
                        const int rr = 2 * rg2 - 2 + i + j; const v4u q = (rr >= rmin && rr <= rmax) ? xraw[i + j] : zero4;
                        oa.x += wa.x * bflo(q.x); oa.y += wa.y * bfhi(q.x); oa.z += wa.z * bflo(q.y); oa.w += wa.w * bfhi(q.y);
                        ob.x += wb.x * bflo(q.z); ob.y += wb.y * bfhi(q.z); ob.z += wb.z * bflo(q.w); ob.w += wb.w * bfhi(q.w); }
                    v4u ov; ov.x = pk2(silu_fast(oa.x), silu_fast(oa.y)); ov.y = pk2(silu_fast(oa.z), silu_fast(oa.w)); ov.z = pk2(silu_fast(ob.x), silu_fast(ob.y)); ov.w = pk2(silu_fast(ob.z), silu_fast(ob.w));
                    *(LAS v4u*)(Xs + (2 * rg2 + i) * RSX + xpc * 16) = ov; }
            }
            if (e + 1 < e_hi) {
#pragma unroll
                for (int j = 0; j < 6; ++j) { const int rr = 2 * rg2 - 2 + j; const int rc = rr < rmin ? rmin : (rr > rmax ? rmax : rr);
                    xraw[j] = __builtin_nontemporal_load((const v4u*)(F.XBCPRE + (size_t)(r0 + rc) * CONV_CH + (h + 1) * HDIM + 8 * xpc)); }
            }
            if (lat) {
                const float Dh = DSK[e];
                f32x4 acsv[2], rbsv[2]; float afv[4], rbv[4];
#pragma unroll
                for (int ts = 0; ts < 2; ++ts) { const int s0 = sb + 16 * ts + 4 * q4; acsv[ts] = *(const LAS f32x4*)(Te + 256 + s0); rbsv[ts] = *(const LAS f32x4*)(Te + 384 + s0); }
#pragma unroll
                for (int tl = 0; tl < 4; ++tl) { const int l = lb + 16 * tl + i16; afv[tl] = Te[l]; rbv[tl] = Te[128 + l]; }
#pragma unroll
                for (int tl = 0; tl < 4; ++tl) { const int l = lb + 16 * tl + i16; const int lt_abs = 4 * (w & 1) + tl; const float af_l = afv[tl], rb_l = rbv[tl];
#pragma unroll
                    for (int ts = 0; ts < 2; ++ts) { const int s0 = sb + 16 * ts + 4 * q4; const int st_abs = 2 * (w >> 1) + ts;
                        float m[4];
                        if (st_abs < lt_abs) {
                            const f32x4 acs = acsv[ts];
#pragma unroll
                            for (int r = 0; r < 4; ++r) m[r] = cb[ts][tl][r] * __builtin_amdgcn_exp2f(af_l - acs[r]);
                        } else if (st_abs > lt_abs) {
                            const f32x4 rbs = rbsv[ts];
#pragma unroll
                            for (int r = 0; r < 4; ++r) m[r] = cb[ts][tl][r] * __builtin_amdgcn_exp2f(rb_l - rbs[r]);
                        } else {
                            const f32x4 acs = acsv[ts], rbs = rbsv[ts];
#pragma unroll
                            for (int r = 0; r < 4; ++r) { const int sidx = s0 + r;
                                const float wf = (sidx <= l) ? __builtin_amdgcn_exp2f(af_l - acs[r]) : 0.f;
                                const float wb = (sidx >= l) ? __builtin_amdgcn_exp2f(rb_l - rbs[r]) : 0.f;
                                m[r] = cb[ts][tl][r] * (wf + wb) + ((sidx == l) ? Dh : 0.f); }
                        }
                        v2u o; o.x = pk2(m[0], m[1]); o.y = pk2(m[2], m[3]);
                        *(LAS v2u*)(Ms + l * RS + s0 * 2) = o; } }
            }
            __syncthreads();
            if (lat) {
                f32x4 ya[4];
#pragma unroll
                for (int pt = 0; pt < 4; ++pt) ya[pt] = (f32x4){0.f, 0.f, 0.f, 0.f};
#pragma unroll
                for (int ks = 0; ks < 4; ++ks) { const bf16x8 bm = frag_row(Ms, RS, 16 * w + i16, 32 * ks, q4);
#pragma unroll
                    for (int pt = 0; pt < 4; ++pt) ya[pt] = mfma16(frag_tr(Xs, RSX, 32 * ks, 16 * pt, lane), bm, ya[pt]); }
                bf16* yp = F.Y + (size_t)(r0 + 16 * w + i16) * SSD_W + h * HDIM + 4 * q4;
#pragma unroll
                for (int pt = 0; pt < 4; ++pt) { v2u o; o.x = pk2(ya[pt][0], ya[pt][1]); o.y = pk2(ya[pt][2], ya[pt][3]); *(v2u*)(yp + 16 * pt) = o; }
            }
            p4_states(F, braw, L + O_B + 256 + 8 * (e & 1), Xs, (((size_t)(b * NCC + cc) * NH + h) * 2) * HDIM * NST, w, lane);
        }
        __syncthreads();
    }
}

__device__ __forceinline__ void pool_grid_row(Frame& F, int gr) {
    LAS unsigned char* L = F.lds;
    const int tid = F.tid_(), rb = gr * 64;
    v4u pv[8];
#pragma unroll
    for (int k = 0; k < 8; ++k) { const int pc = tid + 512 * k, row = pc >> 6, ch = pc & 63; pv[k] = *(const v4u*)(F.V + (size_t)(rb + row) * 512 + ch * 8); }
#pragma unroll
    for (int k = 0; k < 8; ++k) { const int pc = tid + 512 * k, row = pc >> 6, ch = pc & 63; *(LAS v4u*)(L + row * 1024 + ch * 16) = pv[k]; }
    __syncthreads();
    {
        const int cg = tid & 63, tb = tid >> 6, hw = 1 << (cg >> 4);
        const LAS unsigned char* colp = L + cg * 16;
        const int t0 = tb * 8;
        float sacc[8];
#pragma unroll
        for (int e = 0; e < 8; ++e) sacc[e] = 0.f;
#define POOL_ACC(Q, SGN) do { const v4u x_ = *(const LAS v4u*)(colp + (Q) * 1024); \
            sacc[0] += SGN bflo(x_.x); sacc[1] += SGN bfhi(x_.x); sacc[2] += SGN bflo(x_.y); sacc[3] += SGN bfhi(x_.y); sacc[4] += SGN bflo(x_.z); sacc[5] += SGN bfhi(x_.z); sacc[6] += SGN bflo(x_.w); sacc[7] += SGN bfhi(x_.w); } while (0)
#pragma unroll 4
        for (int j = 0; j < 16; ++j) { const int q = t0 - hw + j; if (j < 2 * hw && q >= 0 && q < 64) POOL_ACC(q, +); }
#pragma unroll 2
        for (int tt = 0; tt < 8; ++tt) { const int t = t0 + tt;
            if (tt > 0) { const int qa = t + hw - 1, qr = t - hw - 1; if (qa < 64) POOL_ACC(qa, +); if (qr >= 0) POOL_ACC(qr, -); }
            const int lo = t - hw < 0 ? 0 : t - hw, hi = t + hw > 64 ? 64 : t + hw;
            const v4u x = *(const LAS v4u*)(colp + t * 1024); const float inv = __builtin_amdgcn_rcpf((float)(hi - lo));
            float q[8] = {sacc[0] * inv - bflo(x.x), sacc[1] * inv - bfhi(x.x), sacc[2] * inv - bflo(x.y), sacc[3] * inv - bfhi(x.y), sacc[4] * inv - bflo(x.z), sacc[5] * inv - bfhi(x.z), sacc[6] * inv - bflo(x.w), sacc[7] * inv - bfhi(x.w)};
#pragma unroll
            for (int e = 0; e < 8; ++e) q[e] = fminf(fmaxf(q[e] * A2SCALE, -440.f), 440.f);
            v2u o; o.x = pk4_fp8(q[0], q[1], q[2], q[3]); o.y = pk4_fp8(q[4], q[5], q[6], q[7]);
            *(v2u*)((unsigned char*)F.A2 + (size_t)(rb + t) * 2048 + SSD_W + cg * 8) = o; }
#undef POOL_ACC
    }
    __syncthreads();
}
__device__ __forceinline__ void p5_ssd_scan(Frame& F) {
    constexpr int RS = 272, O_RS = 4 * 34816;
    LAS unsigned char* L = F.lds;
    LAS float* RSB = (LAS float*)(L + O_RS);
    const int tid = F.tid_(), lane = F.lane_(), w = F.wave, i16 = lane & 15, q4 = lane >> 4;
    const int d = w >> 2, ps = w & 3, t8 = tid & 255;
    if (F.G == 256 && (int)blockIdx.x >= NB * NH) {
        for (int gr = (int)blockIdx.x - NB * NH; gr < T / 64; gr += F.G - NB * NH) pool_grid_row(F, gr);
        { const int sw = ((int)blockIdx.x - NB * NH) * 8 + F.wave, nsw = (F.G - NB * NH) * 8;
          auto deal2 = [=](int k) -> int { return P0_NI - P0_NMOVE + 2 * ((k >> 1) * nsw + sw) + (k & 1); };
          p0_convert(F, deal2, 2 * ((P0_NMOVE / 2 + nsw - 1) / nsw), P0_NI - P0_NMOVE, P0_NI); }
        return;
    }
    for (int u = (int)blockIdx.x; u < NB * NH; u += F.G) {
        const int b = u / NH, h = u - b * NH, g = h / HPG;
        float S[32];
#pragma unroll
        for (int k = 0; k < 32; ++k) S[k] = 0.f;
        v4u creg[8]; float rsreg = 0.f;
#pragma unroll
        for (int k = 0; k < 8; ++k) creg[k] = (v4u){0u, 0u, 0u, 0u};
        v2u stn[4]; float chn;
        { const size_t sidx0 = ((size_t)(b * NCC + (d == 0 ? 0 : 1)) * NH + h) * 2 + d;
          const unsigned char* stp0 = (const unsigned char*)F.ST + (sidx0 * HDIM + 16 * ps + i16) * NST + 8 * q4;
#pragma unroll
          for (int ks = 0; ks < 4; ++ks) stn[ks] = __builtin_nontemporal_load((const v2u*)(stp0 + 32 * ks));
          chn = F.CHS[sidx0]; }
        for (int j = 0; j < NCC; ++j) {
            const int cc = d == 0 ? j : (j < 2 ? 1 - j : 35 - j);
            LAS unsigned char* Cb = L + ((j & 1) * 2 + d) * 34816;
            if (j >= 2) {
#pragma unroll
                for (int k = 0; k < 8; ++k) { const int pc = t8 + 256 * k, row = pc >> 4, ch = pc & 15; *(LAS v4u*)(Cb + row * RS + ch * 16) = creg[k]; }
                if (t8 < 128) RSB[((j & 1) * 2 + d) * 128 + t8] = rsreg;
            }
            __syncthreads();
            const size_t rowb = (size_t)b * SEQ + (size_t)(cc - 2) * CHUNK;
            const int c = cc - 2; const bool first = (d == 0) ? (c <= 15) : (c >= 16);
            unsigned yold[8];
            unsigned char* yo = (unsigned char*)F.YB + (rowb + i16) * SSD_W + h * HDIM + 16 * ps + 4 * q4;
            if (j >= 2 && !first) {
#pragma unroll
                for (int lt = 0; lt < 8; ++lt) yold[lt] = *(const unsigned*)(yo + (size_t)16 * lt * SSD_W);
            }
            if (j + 1 >= 2 && j + 1 < NCC) {
                const int cn = d == 0 ? j + 1 : 34 - j;
                const size_t rown = (size_t)b * SEQ + (size_t)(cn - 2) * CHUNK;
#pragma unroll
                for (int k = 0; k < 8; ++k) { const int pc = t8 + 256 * k, row = pc >> 4, ch = pc & 15; creg[k] = *(const v4u*)(F.CC + (rown + row) * 512 + g * NST + ch * 8); }
                if (t8 < 128) rsreg = F.ROWSC[((size_t)(b * 2 + d) * NH + h) * SEQ + (cn - 2) * CHUNK + t8];
            }
            v2u stv[4];
#pragma unroll
            for (int ks = 0; ks < 4; ++ks) stv[ks] = stn[ks];
            const float decay = __builtin_amdgcn_exp2f(chn);
            if (j + 1 < NCC) {
                const int j1 = j + 1, cc1 = d == 0 ? j1 : (j1 < 2 ? 1 - j1 : 35 - j1);
                const size_t sidx = ((size_t)(b * NCC + cc1) * NH + h) * 2 + d;
                const unsigned char* stp = (const unsigned char*)F.ST + (sidx * HDIM + 16 * ps + i16) * NST + 8 * q4;
#pragma unroll
                for (int ks = 0; ks < 4; ++ks) stn[ks] = __builtin_nontemporal_load((const v2u*)(stp + 32 * ks));
                chn = F.CHS[sidx];
            }
            if (j >= 2) {
                bf16x8 sf[4];
#pragma unroll
                for (int ks = 0; ks < 4; ++ks) { v4u t; t.x = pk2(S[ks * 8 + 0], S[ks * 8 + 1]); t.y = pk2(S[ks * 8 + 2], S[ks * 8 + 3]); t.z = pk2(S[ks * 8 + 4], S[ks * 8 + 5]); t.w = pk2(S[ks * 8 + 6], S[ks * 8 + 7]); sf[ks] = __builtin_bit_cast(bf16x8, t); }
                const LAS float* rsl = RSB + ((j & 1) * 2 + d) * 128;
#pragma unroll
                for (int lt = 0; lt < 8; ++lt) {
                    f32x4 a = (f32x4){0.f, 0.f, 0.f, 0.f};
                    __builtin_amdgcn_s_setprio(1);
#pragma unroll
                    for (int ks = 0; ks < 4; ++ks) a = mfma16(sf[ks], frag_row(Cb, RS, 16 * lt + i16, 32 * ks, q4), a);
                    __builtin_amdgcn_s_setprio(0);
                    const float sc = rsl[16 * lt + i16] * (YOSCALE / STSCALE);
                    float o[4] = {a[0] * sc, a[1] * sc, a[2] * sc, a[3] * sc};
                    if (!first) { const f32x2 lo = __builtin_amdgcn_cvt_pk_f32_fp8((int)yold[lt], false), hi = __builtin_amdgcn_cvt_pk_f32_fp8((int)yold[lt], true); o[0] += lo.x; o[1] += lo.y; o[2] += hi.x; o[3] += hi.y; }
#pragma unroll
                    for (int r = 0; r < 4; ++r) o[r] = fminf(fmaxf(o[r], -440.f), 440.f);
                    *(unsigned*)(yo + (size_t)16 * lt * SSD_W) = pk4_fp8(o[0], o[1], o[2], o[3]);
                }
            }
#pragma unroll
            for (int ks = 0; ks < 4; ++ks) { const v2u t = stv[ks];
                const f32x2 a0 = __builtin_amdgcn_cvt_pk_f32_fp8((int)t.x, false), a1 = __builtin_amdgcn_cvt_pk_f32_fp8((int)t.x, true), a2 = __builtin_amdgcn_cvt_pk_f32_fp8((int)t.y, false), a3 = __builtin_amdgcn_cvt_pk_f32_fp8((int)t.y, true);
                S[ks * 8 + 0] = decay * S[ks * 8 + 0] + a0.x; S[ks * 8 + 1] = decay * S[ks * 8 + 1] + a0.y;
                S[ks * 8 + 2] = decay * S[ks * 8 + 2] + a1.x; S[ks * 8 + 3] = decay * S[ks * 8 + 3] + a1.y;
                S[ks * 8 + 4] = decay * S[ks * 8 + 4] + a2.x; S[ks * 8 + 5] = decay * S[ks * 8 + 5] + a2.y;
                S[ks * 8 + 6] = decay * S[ks * 8 + 6] + a3.x; S[ks * 8 + 7] = decay * S[ks * 8 + 7] + a3.y; }
        }
        __syncthreads();
    }
}

__device__ __forceinline__ void p6_gate_pool(Frame& F) {
    LAS unsigned char* L = F.lds;
    const int tid = F.tid_(), lane = F.lane_(), w = F.wave;
    f32x4 nw[3][2];
#pragma unroll
    for (int j = 0; j < 3; ++j) { const int col = 8 * (lane + 64 * j); nw[j][0] = *(const f32x4*)(F.ssd_norm_w + col) * A2SCALE; nw[j][1] = *(const f32x4*)(F.ssd_norm_w + col + 4) * A2SCALE; }
    for (int gr = (int)blockIdx.x; gr < T / 64; gr += F.G) {
        const int rb = gr * 64;
        if (F.G != 256) pool_grid_row(F, gr);
        for (int rr = 0; rr < 8; rr += 2) {
            v4u ya[2][3], zz[2][3]; v2u yb[2][3];
#pragma unroll
            for (int k = 0; k < 2; ++k) { const int r = rb + 8 * w + rr + k;
#pragma unroll
                for (int j = 0; j < 3; ++j) { const int col = 8 * (lane + 64 * j);
                    ya[k][j] = __builtin_nontemporal_load((const v4u*)(F.Y + (size_t)r * SSD_W + col)); yb[k][j] = __builtin_nontemporal_load((const v2u*)((const unsigned char*)F.YB + (size_t)r * SSD_W + col)); zz[k][j] = __builtin_nontemporal_load((const v4u*)(F.Z + (size_t)r * SSD_W + col)); } }
#pragma unroll
            for (int k = 0; k < 2; ++k) { const int r = rb + 8 * w + rr + k;
                float v[24]; float ss = 0.f;
#pragma unroll
                for (int j = 0; j < 3; ++j) {
                    const unsigned yaw[4] = {ya[k][j].x, ya[k][j].y, ya[k][j].z, ya[k][j].w}, zw[4] = {zz[k][j].x, zz[k][j].y, zz[k][j].z, zz[k][j].w};
                    const f32x2 yo2[4] = {__builtin_amdgcn_cvt_pk_f32_fp8((int)yb[k][j].x, false), __builtin_amdgcn_cvt_pk_f32_fp8((int)yb[k][j].x, true), __builtin_amdgcn_cvt_pk_f32_fp8((int)yb[k][j].y, false), __builtin_amdgcn_cvt_pk_f32_fp8((int)yb[k][j].y, true)};
#pragma unroll
                    for (int e = 0; e < 4; ++e) { const float y0 = bflo(yaw[e]) + yo2[e].x * (1.f / YOSCALE), y1 = bfhi(yaw[e]) + yo2[e].y * (1.f / YOSCALE);
                        const float g0 = y0 * silu_f(bflo(zw[e])), g1 = y1 * silu_f(bfhi(zw[e])); v[j * 8 + 2 * e] = g0; v[j * 8 + 2 * e + 1] = g1; ss += g0 * g0 + g1 * g1; } }
                const float rs = __builtin_amdgcn_rsqf(wave_sum(ss) * (1.f / SSD_W) + RMS_EPS);
#pragma unroll
                for (int j = 0; j < 3; ++j) { const int col = 8 * (lane + 64 * j);
                    const f32x4 w0 = nw[j][0], w1 = nw[j][1];
                    const float rq = rs; float q[8] = {v[j * 8 + 0] * rq * w0.x, v[j * 8 + 1] * rq * w0.y, v[j * 8 + 2] * rq * w0.z, v[j * 8 + 3] * rq * w0.w, v[j * 8 + 4] * rq * w1.x, v[j * 8 + 5] * rq * w1.y, v[j * 8 + 6] * rq * w1.z, v[j * 8 + 7] * rq * w1.w};
#pragma unroll
                    for (int e = 0; e < 8; ++e) q[e] = fminf(fmaxf(q[e], -440.f), 440.f);
                    v2u o; o.x = pk4_fp8(q[0], q[1], q[2], q[3]); o.y = pk4_fp8(q[4], q[5], q[6], q[7]);
                    *(v2u*)((unsigned char*)F.A2 + (size_t)r * 2048 + col) = o; } }
        }
    }
}

struct Sched7 {
    static constexpr bool TBL = false;
    const char* A; const char* Bt; const int* rowid; int G, c;
    __device__ __forceinline__ bool next(int i, pg8::Unit& u) const { const int L = i * G + c; if (L >= 512) return false; pg8::static_map(L, 128, 4, u.pm, u.pn); u.e = 0; return true; }
    __device__ __forceinline__ const char* a_base(const pg8::Unit&) const { return A; }
    __device__ __forceinline__ const char* b_base(const pg8::Unit& u) const { return Bt + (size_t)u.pn * 256 * 2048; }
    __device__ __forceinline__ const int* row_table(const pg8::Unit& u) const { return rowid + u.pm * 256; }
};
struct Epi7 {
    static constexpr bool PERM = true, PUBLISH = false;
    const float* x; const float* MOD; bf16* X1;
    __device__ __forceinline__ void operator()(const f32x4 (&acc)[2][2][4][2], const pg8::Unit& u, int wr, int wc, int fr, int fq) const {
        const int row0 = u.pm * 256 + wr * 64 + fr, col0 = u.pn * 256 + wc * 32 + 8 * fq;
        const float* g1 = MOD + (size_t)(u.pm >> 4) * 6144 + 2048;
        f32x4 gv[2][2];
#pragma unroll
        for (int bj = 0; bj < 2; ++bj)
#pragma unroll
            for (int n = 0; n < 2; ++n) gv[bj][n] = *(const f32x4*)(g1 + col0 + bj * 128 + n * 4);
#pragma unroll
        for (int ai = 0; ai < 2; ++ai)
#pragma unroll
            for (int m = 0; m < 4; ++m) { const size_t off = (size_t)(row0 + ai * 128 + m * 16) * D + col0;
#pragma unroll
                for (int bj = 0; bj < 2; ++bj) { v4u ov;
                    { const f32x4 xv = __builtin_nontemporal_load((const f32x4*)(x + off + bj * 128)); const f32x4 o = xv + gv[bj][0] * (acc[ai][bj][m][0] * (1.f / (WSCALE * A2SCALE))); ov.x = pk2(o.x, o.y); ov.y = pk2(o.z, o.w); }
                    { const f32x4 xv = __builtin_nontemporal_load((const f32x4*)(x + off + bj * 128 + 4)); const f32x4 o = xv + gv[bj][1] * (acc[ai][bj][m][1] * (1.f / (WSCALE * A2SCALE))); ov.z = pk2(o.x, o.y); ov.w = pk2(o.z, o.w); }
                    *(v4u*)(X1 + off + bj * 128) = ov; } }
    }
};

__device__ __forceinline__ void p8_preload(Frame& F, v4u (&rwh)[4][2], v4u (&rwl)[4][2]) {
    const int lane = F.lane_(), w = F.wave, i16 = lane & 15, q4 = lane >> 4;
#pragma unroll
    for (int ks = 0; ks < 4; ++ks)
#pragma unroll
        for (int hf = 0; hf < 2; ++hf) { float t[8];
#pragma unroll
            for (int j = 0; j < 8; ++j) t[j] = F.router_w[(128 * w + 32 * ks + 8 * q4 + j) * 32 + 16 * hf + i16];
            unsigned hh[4], ll[4];
#pragma unroll
            for (int j = 0; j < 4; ++j) { hh[j] = pk2(t[2 * j], t[2 * j + 1]); ll[j] = pk2(t[2 * j] - bflo(hh[j]), t[2 * j + 1] - bfhi(hh[j])); }
            rwh[ks][hf] = (v4u){hh[0], hh[1], hh[2], hh[3]}; rwl[ks][hf] = (v4u){ll[0], ll[1], ll[2], ll[3]}; }
}
__device__ __forceinline__ void p8_router(Frame& F, v4u (&rwh)[4][2], v4u (&rwl)[4][2], const bool preloaded) {
    LAS unsigned char* L = F.lds;
    LAS float* H2F = (LAS float*)L;
    constexpr int HP = 1028;
    LAS float* PART = (LAS float*)(L + 16 * HP * 4);
    LAS unsigned* HIST = (LAS unsigned*)(L + 16 * HP * 4 + 16384);
    const int tid = F.tid_(), lane = F.lane_(), w = F.wave, i16 = lane & 15, q4 = lane >> 4;
    if (tid < 32) HIST[tid] = 0u;
    if (!preloaded) p8_preload(F, rwh, rwl);
    __syncthreads();
    const int GPB = (T / 16 + F.G - 1) / F.G, g_lo = (int)blockIdx.x * GPB, g_hi = (g_lo + GPB < T / 16) ? g_lo + GPB : T / 16;
    f32x4 wsc[4], shv[4]; int mb_cur = -1;
    v2u xq[2][4];
    if (g_lo < g_hi) {
#pragma unroll
        for (int rr = 0; rr < 2; ++rr)
#pragma unroll
            for (int j = 0; j < 4; ++j) xq[rr][j] = __builtin_nontemporal_load((const v2u*)(F.X1 + (size_t)(g_lo * 16 + 2 * w + rr) * D + 4 * lane + 256 * j));
    }
    for (int gi = g_lo; gi < g_hi; ++gi) {
        const int rbase = gi * 16;
        { const int mb = rbase >> 12; if (mb != mb_cur) { mb_cur = mb; const float* mod = F.MOD + (size_t)mb * 6144;
#pragma unroll
            for (int j = 0; j < 4; ++j) { const int col = 4 * lane + 256 * j; wsc[j] = *(const f32x4*)(F.norm2_w + col) * (*(const f32x4*)(mod + 4096 + col) + 1.f); shv[j] = *(const f32x4*)(mod + 3072 + col); } } }
#pragma unroll
        for (int rr = 0; rr < 2; ++rr) {
            const int r16 = 2 * w + rr, r = rbase + r16;
            f32x4 v[4]; float ss = 0.f;
#pragma unroll
            for (int j = 0; j < 4; ++j) { const v2u q = xq[rr][j]; v[j] = (f32x4){bflo(q.x), bfhi(q.x), bflo(q.y), bfhi(q.y)}; ss += (v[j].x * v[j].x + v[j].y * v[j].y) + (v[j].z * v[j].z + v[j].w * v[j].w); }
            const float rs = __builtin_amdgcn_rsqf(wave_sum(ss) * (1.f / D) + RMS_EPS);
#pragma unroll
            for (int j = 0; j < 4; ++j) { const int col = 4 * lane + 256 * j;
                const f32x4 hh = (v[j] * rs) * wsc[j] + shv[j];
                *(LAS f32x4*)(H2F + r16 * HP + col) = hh;
                *(unsigned*)((unsigned char*)F.H2 + (size_t)r * D + col) = pk4_fp8(hh.x, hh.y, hh.z, hh.w); }
        }
        if (gi + 1 < g_hi) {
#pragma unroll
            for (int rr = 0; rr < 2; ++rr)
#pragma unroll
                for (int j = 0; j < 4; ++j) xq[rr][j] = __builtin_nontemporal_load((const v2u*)(F.X1 + (size_t)((gi + 1) * 16 + 2 * w + rr) * D + 4 * lane + 256 * j));
        }
        __syncthreads();
        {
            f32x4 a0 = (f32x4){0.f, 0.f, 0.f, 0.f}, a1 = a0;
#pragma unroll
            for (int ks = 0; ks < 4; ++ks) { const LAS float* hp = H2F + i16 * HP + 128 * w + 32 * ks + 8 * q4;
                const f32x4 x0 = *(const LAS f32x4*)hp, x1 = *(const LAS f32x4*)(hp + 4);
                v4u xh, xl;
                xh.x = pk2(x0.x, x0.y); xh.y = pk2(x0.z, x0.w); xh.z = pk2(x1.x, x1.y); xh.w = pk2(x1.z, x1.w);
                xl.x = pk2(x0.x - bflo(xh.x), x0.y - bfhi(xh.x)); xl.y = pk2(x0.z - bflo(xh.y), x0.w - bfhi(xh.y)); xl.z = pk2(x1.x - bflo(xh.z), x1.y - bfhi(xh.z)); xl.w = pk2(x1.z - bflo(xh.w), x1.w - bfhi(xh.w));
                const bf16x8 ah = __builtin_bit_cast(bf16x8, xh), al = __builtin_bit_cast(bf16x8, xl);
                a0 = mfma16(ah, __builtin_bit_cast(bf16x8, rwl[ks][0]), a0); a1 = mfma16(ah, __builtin_bit_cast(bf16x8, rwl[ks][1]), a1);
                a0 = mfma16(al, __builtin_bit_cast(bf16x8, rwh[ks][0]), a0); a1 = mfma16(al, __builtin_bit_cast(bf16x8, rwh[ks][1]), a1);
                a0 = mfma16(ah, __builtin_bit_cast(bf16x8, rwh[ks][0]), a0); a1 = mfma16(ah, __builtin_bit_cast(bf16x8, rwh[ks][1]), a1); }
#pragma unroll
            for (int r = 0; r < 4; ++r) { PART[(w * 16 + 4 * q4 + r) * 32 + i16] = a0[r]; PART[(w * 16 + 4 * q4 + r) * 32 + 16 + i16] = a1[r]; }
        }
        __syncthreads();
        {
            const int row = tid >> 5, e = tid & 31;
            float lg = F.router_b[e];
#pragma unroll
            for (int ww = 0; ww < 8; ++ww) lg += PART[(ww * 16 + row) * 32 + e];
            float tv[4]; int ti[4];
#pragma unroll
            for (int k = 0; k < 4; ++k) { float bv = lg; int bi = e;
#pragma unroll
#define P8_ARG(OV, OI) do { const float ov_ = (OV); const int oi_ = (OI); if (ov_ > bv || (ov_ == bv && oi_ < bi)) { bv = ov_; bi = oi_; } } while (0)
                P8_ARG(dpp_f<DPP_XOR1>(bv), dpp_i<DPP_XOR1>(bi)); P8_ARG(dpp_f<DPP_XOR2>(bv), dpp_i<DPP_XOR2>(bi));
                P8_ARG(dpp_f<DPP_HMIRROR>(bv), dpp_i<DPP_HMIRROR>(bi)); P8_ARG(dpp_f<DPP_MIRROR>(bv), dpp_i<DPP_MIRROR>(bi));
                { const unsigned vb = __builtin_bit_cast(unsigned, bv); const auto rv = __builtin_amdgcn_permlane16_swap(vb, vb, false, false); const auto ri = __builtin_amdgcn_permlane16_swap((unsigned)bi, (unsigned)bi, false, false);
                  bv = __builtin_bit_cast(float, (unsigned)rv[0]); bi = (int)ri[0]; P8_ARG(__builtin_bit_cast(float, (unsigned)rv[1]), (int)ri[1]); }
#undef P8_ARG
                tv[k] = bv; ti[k] = bi; if (e == bi) lg = -INFINITY; }
            if (e < 4) {
                const float e1 = __expf(tv[1] - tv[0]), e2 = __expf(tv[2] - tv[0]), e3 = __expf(tv[3] - tv[0]); const float inv = 1.f / (1.f + e1 + e2 + e3);
                const float gk = (e == 0 ? 1.f : (e == 1 ? e1 : (e == 2 ? e2 : e3))) * inv;
                const int tk = e == 0 ? ti[0] : (e == 1 ? ti[1] : (e == 2 ? ti[2] : ti[3]));
                const int tok = rbase + row;
                const unsigned lr = atomicAdd((unsigned*)&HIST[tk], 1u);
                F.TOPE[tok * 4 + e] = tk; F.TOPG[tok * 4 + e] = gk; F.TOPR[tok * 4 + e] = (int)lr;
            }
        }
        __syncthreads();
    }
    if (tid < 32) { const unsigned base = __hip_atomic_fetch_add(F.ctl + CW_GCOUNT + tid, HIST[tid], RLX_AGENT); F.BB[(int)blockIdx.x * 32 + tid] = (int)base; }
}

__device__ __forceinline__ int moe_tables(Frame& F) {
    LAS int* TE = (LAS int*)(F.lds + TE_OFF);
    LAS int* MC = (LAS int*)(F.lds + MOE_CNT_OFF);
    __syncthreads();
    const int tid = F.tid_();
    if (tid < 64) { const int e = tid & 31;
        const int c = (tid < NE) ? (int)__hip_atomic_load(F.ctl + CW_GCOUNT + e, RLX_AGENT) : 0;
        const int nt = (c + 255) >> 8;
        int incl = nt;
#pragma unroll
        for (int o = 1; o < 32; o <<= 1) { const int v = __shfl_up(incl, o); if (tid >= o) incl += v; }
        if (tid < NE) { const int pst = incl - nt; MC[e] = c; MC[32 + e] = pst << 8;
            for (int t = 0; t < nt; ++t) TE[pst + t] = e;
            if (e == NE - 1) MC[64] = incl; } }
    __syncthreads();
    return MC[64];
}
__device__ __forceinline__ void p9_slots(Frame& F) {
    (void)moe_tables(F);
    const LAS int* MC = (const LAS int*)(F.lds + MOE_CNT_OFF);
    const int gt = (int)blockIdx.x * 512 + F.tid_(), NT_ = F.G * 512;
    for (int a = gt; a < T * TOPK; a += NT_) { const int tok = a >> 2, e = F.TOPE[a], blk = (tok >> 4) / ((T / 16 + F.G - 1) / F.G);
        const int slot = MC[32 + e] + F.BB[blk * 32 + e] + F.TOPR[a];
        F.SLOTTOK[slot] = tok; F.SLOTGATE[slot] = F.TOPG[a]; F.TOKSLOT[a] = slot; }
    for (int i = gt; i < MAX_SLOTS; i += NT_) F.SLOTID[i] = i;
    if ((int)blockIdx.x < NE) { const int e = (int)blockIdx.x, c = MC[e], ps = MC[32 + e], pe = ps + (((c + 255) >> 8) << 8);
        for (int s = ps + c + F.tid_(); s < pe; s += 512) { F.SLOTTOK[s] = 0; F.SLOTGATE[s] = 0.f; } }
}

struct SchedMoe {
    static constexpr bool TBL = true;
    const char* A; const char* W; const int* slot_tok; const LAS int* TE; int nM, nN, G, c; size_t wbytes  , tilebytes  , arowbytes;
    LAS unsigned char* tb;
    const float* f0; int f0_e, f0_n;
    const float* f1;
    __device__ __forceinline__ bool next(int i, pg8::Unit& u) const { const int L = i * G + c; if (L >= nM * nN) return false; pg8::static_map(L, nM, nN, u.pm, u.pn); u.e = TE[u.pm]; return true; }
    __device__ __forceinline__ const char* a_base(const pg8::Unit&) const { return A; }
    __device__ __forceinline__ const char* b_base(const pg8::Unit& u) const { return W + (size_t)u.e * wbytes + (size_t)u.pn * tilebytes; }
    __device__ __forceinline__ const int* row_table(const pg8::Unit& u) const { return slot_tok + u.pm * 256; }
    __device__ __forceinline__ const int* tab0(const pg8::Unit& u) const { return slot_tok + u.pm * 256; }
    __device__ __forceinline__ const float* tab1(const pg8::Unit& u) const { return f0 + (size_t)u.e * f0_e + u.pn * f0_n; }
    __device__ __forceinline__ const float* tab2(const pg8::Unit& u) const { return f1 ? f1 + u.pm * 256 : nullptr; }
};
struct Epi10 {
    static constexpr bool PERM = true;
    const float* b1; bf16* ACT;
    __device__ __forceinline__ void operator()(const f32x4 (&acc)[2][2][4][2], const pg8::Unit& u, int wr, int wc, int fr, int fq, const LAS unsigned char* tbuf) const {
        const int row0 = u.pm * 256 + wr * 64 + fr, j0 = u.pn * 128 + wc * 32 + 8 * fq;
        const LAS float* bp = (const LAS float*)(tbuf + 3072) + 2 * (wc * 32 + 8 * fq);
        const f32x4 q0 = *(const LAS f32x4*)bp, q1 = *(const LAS f32x4*)(bp + 4), q2 = *(const LAS f32x4*)(bp + 8), q3 = *(const LAS f32x4*)(bp + 12);
        const float bg[8] = {q0.x, q0.z, q1.x, q1.z, q2.x, q2.z, q3.x, q3.z}, bu[8] = {q0.y, q0.w, q1.y, q1.w, q2.y, q2.w, q3.y, q3.w};
        constexpr float KS = 1.702f * 1.44269504f;
        f32x2 kbg2[4], bu2[4];
#pragma unroll
        for (int q = 0; q < 4; ++q) { kbg2[q] = (f32x2){bg[2 * q], bg[2 * q + 1]} * KS; bu2[q] = (f32x2){bu[2 * q], bu[2 * q + 1]}; }
        v2u wprev = {0u, 0u};
        unsigned char* const abase = (unsigned char*)ACT + (size_t)(row0 + 16 * (fq & 1)) * DFF + j0 - 8 * (fq & 1);
#pragma unroll
        for (int ai = 0; ai < 2; ++ai)
#pragma unroll
            for (int m = 0; m < 4; ++m) { f32x2 o[4];
#pragma unroll
                for (int n = 0; n < 2; ++n)
#pragma unroll
                    for (int pp = 0; pp < 2; ++pp) { const int q = 2 * n + pp;
                        const f32x2 ag = (f32x2){acc[ai][0][m][n][2 * pp], acc[ai][0][m][n][2 * pp + 1]}, au = (f32x2){acc[ai][1][m][n][2 * pp], acc[ai][1][m][n][2 * pp + 1]};
                        const f32x2 hg = ag * (KS / WSCALE) + kbg2[q], hu = au * (1.f / WSCALE) + bu2[q];
                        const f32x2 gp = (f32x2){fminf(hg.x, 7.f * KS), fminf(hg.y, 7.f * KS)};
                        const f32x2 up = (f32x2){fminf(fmaxf(hu.x, -7.f), 7.f), fminf(fmaxf(hu.y, -7.f), 7.f)};
                        const f32x2 d = (f32x2){__builtin_amdgcn_exp2f(-gp.x), __builtin_amdgcn_exp2f(-gp.y)} + 1.f;
                        f32x2 r = (f32x2){__builtin_amdgcn_rcpf(d.x), __builtin_amdgcn_rcpf(d.y)};
#if PROBE_TRANS
                        { float g0 = -gp.x, g1 = -gp.y; asm volatile("" : "+v"(g0), "+v"(g1)); float d0 = __builtin_amdgcn_exp2f(g0) + 1.f, d1 = __builtin_amdgcn_exp2f(g1) + 1.f; asm volatile("" : "+v"(d0), "+v"(d1));
                          r = (r + (f32x2){__builtin_amdgcn_rcpf(d0), __builtin_amdgcn_rcpf(d1)}) * 0.5f; }
#endif
                        o[q] = (gp * r) * (up * (ASCALE / KS) + (ASCALE / KS)); }
                v2u wv; wv.x = pk4_fp8(o[0].x, o[0].y, o[1].x, o[1].y); wv.y = pk4_fp8(o[2].x, o[2].y, o[3].x, o[3].y);
                if ((m & 1) == 0) wprev = wv;
                else { const auto rx = __builtin_amdgcn_permlane16_swap(wprev.x, wv.x, false, false), ry = __builtin_amdgcn_permlane16_swap(wprev.y, wv.y, false, false);
                    v4u ow; ow.x = (unsigned)rx[0]; ow.y = (unsigned)ry[0]; ow.z = (unsigned)rx[1]; ow.w = (unsigned)ry[1];
                    *(v4u*)(abase + (size_t)(ai * 128 + (m - 1) * 16) * DFF) = ow; } }
    }
};
struct Epi11 {
    static constexpr bool PERM = true;
    bf16* YS;
    __device__ __forceinline__ void operator()(const f32x4 (&acc)[2][2][4][2], const pg8::Unit& u, int wr, int wc, int fr, int fq_in, const LAS unsigned char* tbuf) const {
        int fq = fq_in; asm volatile("" : "+v"(fq));
        const int row0 = u.pm * 256 + wr * 64 + fr, col0 = u.pn * 256 + wc * 32 + 8 * fq;
        const LAS float* bl = (const LAS float*)(tbuf + 3072) + wc * 32 + 8 * fq; const LAS float* gl = (const LAS float*)(tbuf + 6144) + wr * 64 + fr;
        f32x4 bv[2][2];
#pragma unroll
        for (int bj = 0; bj < 2; ++bj)
#pragma unroll
            for (int n = 0; n < 2; ++n) bv[bj][n] = *(const LAS f32x4*)(bl + bj * 128 + 4 * n);
        const int odd = fq & 1;
        unsigned char* const ybase = (unsigned char*)YS + (size_t)(row0 + 16 * odd) * D + col0 - 8 * odd;
#pragma unroll
        for (int ai = 0; ai < 2; ++ai)
#pragma unroll
            for (int mp = 0; mp < 2; ++mp) {
#pragma unroll
                for (int bj = 0; bj < 2; ++bj) { v2u wv[2];
#pragma unroll
                    for (int k = 0; k < 2; ++k) { const int m = 2 * mp + k; const float gs = gl[ai * 128 + m * 16] * YSCALE;
                        f32x4 v0 = (acc[ai][bj][m][0] * (1.f / (WSCALE * ASCALE)) + bv[bj][0]) * gs, v1 = (acc[ai][bj][m][1] * (1.f / (WSCALE * ASCALE)) + bv[bj][1]) * gs;
#pragma unroll
                        for (int t = 0; t < 4; ++t) { v0[t] = fminf(fmaxf(v0[t], -440.f), 440.f); v1[t] = fminf(fmaxf(v1[t], -440.f), 440.f); }
                        wv[k].x = pk4_fp8(v0[0], v0[1], v0[2], v0[3]); wv[k].y = pk4_fp8(v1[0], v1[1], v1[2], v1[3]); }
                    const auto rx = __builtin_amdgcn_permlane16_swap(wv[0].x, wv[1].x, false, false), ry = __builtin_amdgcn_permlane16_swap(wv[0].y, wv[1].y, false, false);
                    v4u o; o.x = (unsigned)rx[0]; o.y = (unsigned)ry[0]; o.z = (unsigned)rx[1]; o.w = (unsigned)ry[1];
                    *(v4u*)(ybase + (size_t)(ai * 128 + mp * 32) * D + bj * 128) = o; } }
    }
};

__device__ __forceinline__ void p12_combine(Frame& F) {
    const int gw = (int)blockIdx.x * 8 + F.wave, NGW = F.G * 8, lane = F.lane_();
    for (int rb16 = gw; rb16 < T / 16; rb16 += NGW) {
        const int r0 = rb16 * 16;
        const float* g2p = F.MOD + (size_t)(r0 >> 12) * 6144 + 5120;
        f32x4 g2v[4], fw[4];
#pragma unroll
        for (int j = 0; j < 4; ++j) { const int col = 4 * lane + 256 * j; g2v[j] = *(const f32x4*)(g2p + col) * (1.f / YSCALE); fw[j] = *(const f32x4*)(F.final_norm_w + col); }
        for (int rp = 0; rp < 8; ++rp) {
            int sl[2][4];
#pragma unroll
            for (int k2 = 0; k2 < 2; ++k2)
#pragma unroll
                for (int k = 0; k < 4; ++k) sl[k2][k] = F.TOKSLOT[(r0 + rp * 2 + k2) * 4 + k];
            unsigned yv[2][4][4]; v2u xq[2][4];
#pragma unroll
            for (int k2 = 0; k2 < 2; ++k2)
#pragma unroll
                for (int j = 0; j < 4; ++j) { const int col = 4 * lane + 256 * j; xq[k2][j] = __builtin_nontemporal_load((const v2u*)(F.X1 + (size_t)(r0 + rp * 2 + k2) * D + col));
#pragma unroll
                    for (int k = 0; k < 4; ++k) yv[k2][j][k] = __builtin_nontemporal_load((const unsigned*)((const unsigned char*)F.YS + (size_t)sl[k2][k] * D + col)); }
#pragma unroll
            for (int k2 = 0; k2 < 2; ++k2) { const int r = r0 + rp * 2 + k2;
                f32x4 v[4]; float ss = 0.f;
#pragma unroll
                for (int j = 0; j < 4; ++j) { f32x4 m = (f32x4){0.f, 0.f, 0.f, 0.f};
#pragma unroll
                    for (int k = 0; k < 4; ++k) { const int y = (int)yv[k2][j][k]; const f32x2 lo = __builtin_amdgcn_cvt_pk_f32_fp8(y, false), hi = __builtin_amdgcn_cvt_pk_f32_fp8(y, true); m.x += lo.x; m.y += lo.y; m.z += hi.x; m.w += hi.y; }
                    v[j] = (f32x4){bflo(xq[k2][j].x), bfhi(xq[k2][j].x), bflo(xq[k2][j].y), bfhi(xq[k2][j].y)} + g2v[j] * m;
                    ss += (v[j].x * v[j].x + v[j].y * v[j].y) + (v[j].z * v[j].z + v[j].w * v[j].w); }
                const float rs = __builtin_amdgcn_rsqf(wave_sum(ss) * (1.f / D) + RMS_EPS);
#pragma unroll
                for (int j = 0; j < 4; ++j) { const int col = 4 * lane + 256 * j; __builtin_nontemporal_store((v[j] * rs) * fw[j], (f32x4*)(F.out + (size_t)r * D + col)); } }
        }
    }
}

constexpr int NPHASE = 13;
struct Args { const float* in[25]; float* out; unsigned char* ws; int ph_lo, ph_hi; };
__global__ void __launch_bounds__(512, 2) mk_fwd(Args args) {
    extern __shared__ __attribute__((aligned(16))) unsigned char lds[];
    Frame F;
    F.lds = (LAS unsigned char*)lds;
    F.wave = __builtin_amdgcn_readfirstlane((int)threadIdx.x >> 6); F.G = gridDim.x;
    unsigned char* ws = args.ws;
    F.ctl = (unsigned*)(ws + WS_CTL);
    F.x = args.in[0]; F.c = args.in[1]; F.ctx = args.in[2]; F.c_ctx = args.in[3]; F.w_mod = args.in[4]; F.b_mod = args.in[5]; F.norm1_w = args.in[6]; F.norm2_w = args.in[7];
    F.w_in = args.in[8]; F.conv_w = args.in[9]; F.conv_b = args.in[10]; F.dt_bias = args.in[11]; F.a_log = args.in[12]; F.d_skip = args.in[13]; F.ssd_norm_w = args.in[14];
    F.pool_w = args.in[15]; F.pool_scale = args.in[16]; F.w_out = args.in[17]; F.router_w = args.in[18]; F.router_b = args.in[19]; F.w1 = args.in[20]; F.b1 = args.in[21];
    F.w2 = args.in[22]; F.b2 = args.in[23]; F.final_norm_w = args.in[24]; F.out = args.out;
    F.MOD = (float*)(ws + WS_MOD); F.DTRAW = (float*)(ws + WS_DTRAW); F.DT = (float*)(ws + WS_DT); F.ROWSC = (float*)(ws + WS_ROWSC); F.CHS = (float*)(ws + WS_CHS); F.X1 = (bf16*)(ws + WS_X1);
    F.TOPG = (float*)(ws + WS_TOPG); F.SLOTGATE = (float*)(ws + WS_SLOTGATE); F.TOPE = (int*)(ws + WS_TOPE); F.TOPR = (int*)(ws + WS_TOPR); F.TOKSLOT = (int*)(ws + WS_TOKSLOT);
    F.SLOTTOK = (int*)(ws + WS_SLOTTOK); F.SLOTID = (int*)(ws + WS_SLOTID); F.ROWID = (int*)(ws + WS_ROWID); F.BB = (int*)(ws + WS_BB);
    F.WINT = (bf16*)(ws + WS_WINT); F.WOUTT = (bf16*)(ws + WS_WOUTT); F.W1T = (bf16*)(ws + WS_W1T); F.W2T = (bf16*)(ws + WS_W2T); F.A1 = (bf16*)(ws + WS_A1); F.XBCPRE = (bf16*)(ws + WS_XBCPRE);
    F.Z = (bf16*)(ws + WS_Z); F.V = (bf16*)(ws + WS_V); F.XBC = (bf16*)(ws + WS_XBC); F.CC = (bf16*)(ws + WS_CC); F.ST = (bf16*)(ws + WS_ST); F.Y = (bf16*)(ws + WS_Y); F.YB = (bf16*)(ws + WS_YB);
    F.A2 = (bf16*)(ws + WS_A2); F.H2 = (bf16*)(ws + WS_H2); F.ACT = (bf16*)(ws + WS_ACT); F.YS = (bf16*)(ws + WS_YS);
    volatile LAS unsigned* MISC = (volatile LAS unsigned*)(F.lds + MISC_OFF);
    for (int u = F.tid_(); u < 64; u += 512) MISC[u] = 0u;
    __syncthreads();
    const int lo = args.ph_lo, hi = args.ph_hi;
    XcdBarrier bar; bar.bar = F.ctl + CW_BAR; bar.x = 0; bar.st = nullptr; bar.wave = F.wave;
    if (hi - lo > 1) bar = xcd_barrier_post(F.ctl + CW_BAR, MISC + 8, F.wave);
#define IN(k) (lo <= (k) && (k) < hi)
#define SEAM(k) do { if (IN(k) && IN((k) + 1)) xcd_barrier(bar); } while (0)
#define BODY0 p0_prologue(F)
#define BODY1 p1_norm1(F)
#define BODY2 do { Sched1 S{(const char*)F.A1, (const char*)F.WINT, F.G, (int)blockIdx.x}; Epi1 E{F.XBCPRE, F.Z, F.V, F.DTRAW}; pg8::gemm_phase<Epi1, Sched1, false>(F.lds, D, S, E, F.wave); } while (0)
#define BODY4 p4_ssd_local(F, (IN(2) && (F.G & 3) == 0) ? ((int)blockIdx.x & 3) : -1)
#define BODY5 p5_ssd_scan(F)
#define BODY6 p6_gate_pool(F)
#define BODY7 do { Sched7 S{(const char*)F.A2, (const char*)F.WOUTT, F.ROWID, F.G, (int)blockIdx.x}; Epi7 E{F.x, F.MOD, F.X1}; pg8::gemm_phase<Epi7, Sched7, true, true>(F.lds, 2048, S, E, F.wave); } while (0)
#define BODY8 p8_router(F, rwh_, rwl_, IN(7))
#define BODY9 p9_slots(F)
#define BODY10 do { const int ntl = IN(9) ? ((const LAS int*)(F.lds + MOE_CNT_OFF))[64] : moe_tables(F);     \
        SchedMoe S{(const char*)F.H2, (const char*)F.W1T, F.SLOTTOK, (const LAS int*)(F.lds + TE_OFF), ntl, 8, F.G, (int)blockIdx.x, (size_t)2048 * D, (size_t)256 * D, (size_t)D, F.lds + TBL_OFF, F.b1, 2048, 256, nullptr}; \
        Epi10 E{F.b1, F.ACT}; pg8::gemm_phase<Epi10, SchedMoe, true, true>(F.lds, D, S, E, F.wave); } while (0)
#define BODY11 do { const int ntl = (IN(9) || IN(10)) ? ((const LAS int*)(F.lds + MOE_CNT_OFF))[64] : moe_tables(F); \
        SchedMoe S{(const char*)F.ACT, (const char*)F.W2T, F.SLOTID, (const LAS int*)(F.lds + TE_OFF), ntl, 4, F.G, (int)blockIdx.x, (size_t)D * D, (size_t)256 * D, (size_t)D, F.lds + TBL_OFF, F.b2, D, 256, F.SLOTGATE}; \
        Epi11 E{F.YS}; pg8::gemm_phase<Epi11, SchedMoe, true, true>(F.lds, D, S, E, F.wave); } while (0)
#define BODY12 p12_combine(F)
#define RUN(k) do { if (IN(k)) { BODY##k; if (PROBE_PH == (k)) { xcd_barrier(bar); BODY##k; } } SEAM(k); } while (0)
    do { if (IN(0)) { BODY0; if (PROBE_PH == 0) { BODY0; } } } while (0);
    v4u rwh_[4][2], rwl_[4][2];
    RUN(1);
    do { if (IN(2)) { BODY2; if (IN(4) && (F.G & 3) == 0) p4_stage_cw(F, (int)blockIdx.x & 3); } SEAM(2); } while (0);
    RUN(4); RUN(5); RUN(6);
    do { if (IN(7)) { BODY7; if (IN(8)) p8_preload(F, rwh_, rwl_); } SEAM(7); } while (0);
    RUN(8); RUN(9); RUN(10); RUN(11); RUN(12);
#undef IN
#undef SEAM
}

extern "C" void kernel_launch(void* const* d_in, const int* in_sizes, int n_in, void* d_out, int out_size, void* d_ws, size_t ws_size, hipStream_t stream) {
    static int grid = 0;
    if (grid == 0) {
        if (n_in != 25 || out_size != T * D || ws_size < WS_END) { fprintf(stderr, "kernel_launch: unexpected shapes (n_in %d, out %d, ws %zu)\n", n_in, out_size, ws_size); grid = -1; return; }
        int dev = 0, cus = 0, per_cu = 0;
        if (hipGetDevice(&dev) != hipSuccess || hipDeviceGetAttribute(&cus, hipDeviceAttributeMultiprocessorCount, dev) != hipSuccess) { grid = -1; return; }
        if (hipFuncSetAttribute((const void*)mk_fwd, hipFuncAttributeMaxDynamicSharedMemorySize, LDS_BYTES) != hipSuccess) { fprintf(stderr, "kernel_launch: hipFuncSetAttribute failed\n"); grid = -1; return; }
        if (hipOccupancyMaxActiveBlocksPerMultiprocessor(&per_cu, (const void*)mk_fwd, 512, LDS_BYTES) != hipSuccess || per_cu < 1) { fprintf(stderr, "kernel_launch: occupancy query says %d\n", per_cu); }
        (void)hipGetLastError();
        grid = cus;
    }
    if (grid < 0) return;
    (void)hipMemsetAsync((char*)d_ws + WS_CTL, 0, CTL_ZERO_BYTES, stream);
    Args a{};
    for (int i = 0; i < 25; ++i) a.in[i] = (const float*)d_in[i];
    a.out = (float*)d_out; a.ws = (unsigned char*)d_ws;
#if MK_SPLIT
    for (int p = 0; p < NPHASE; ++p) { a.ph_lo = p; a.ph_hi = p + 1; hipLaunchKernelGGL(mk_fwd, dim3(grid), dim3(512), LDS_BYTES, stream, a); }
#else
    a.ph_lo = 0; a.ph_hi = NPHASE; hipLaunchKernelGGL(mk_fwd, dim3(grid), dim3(512), LDS_BYTES, stream, a);
#endif
}
```
